# Optimizing an MI355X kernel written in HIP

```python
import math
import jax, jax.numpy as jnp
from jax import lax
import numpy as np

D_MODEL = 1024
BATCH = 16
SEQ = 4096
DEPTH = 4

CHUNK = 64
HEAD_DIM = 64
H_A = 8
LEFT_CHUNKS = 8
REL_MAX = 256
H_B = 4
H_C = 8
H_IDX = 4
D_IDX = 64
TOPK_MAX = 256
H_X = 4
MEM_LEN = 256
D_FF = -(-8 * D_MODEL // (3 * 256)) * 256
QB = 128
ROPE_THETA = 10000.0
EPS = 1e-6

W_A = H_A * HEAD_DIM
W_B = H_B * 2 * HEAD_DIM
W_C = H_C * HEAD_DIM
IN_SPLITS = (W_A, W_A, W_A, W_B, W_B, W_B, W_C, W_C, W_C, H_IDX * D_IDX, D_IDX, H_IDX, 3 * D_MODEL)
N_IN = 3 * W_A + 3 * W_B + 3 * W_C + H_IDX * D_IDX + D_IDX + H_IDX + 3 * D_MODEL
REL_TABLE = CHUNK + REL_MAX

kernel_name = 'hybrid_chunk_causal_encoder'


def rmsnorm(x, g):
    x32 = x.astype(jnp.float32)
    y = x32 * lax.rsqrt(jnp.mean(x32 * x32, axis=-1, keepdims=True) + EPS)
    return y.astype(x.dtype) * g


def rope_tables(seq):
    pos = jnp.arange(seq, dtype=jnp.float32)
    inv = ROPE_THETA ** (-jnp.arange(0, HEAD_DIM, 2, dtype=jnp.float32) / HEAD_DIM)
    ang = pos[:, None] * inv[None, :]
    return jnp.cos(ang), jnp.sin(ang)


def apply_rope(x, cos, sin):
    extra = x.ndim - 3
    shp = (cos.shape[0],) + (1,) * extra + (cos.shape[1],)
    c = cos.reshape(shp).astype(x.dtype)
    s = sin.reshape(shp).astype(x.dtype)
    x1, x2 = jnp.split(x, 2, axis=-1)
    return jnp.concatenate([x1 * c - x2 * s, x2 * c + x1 * s], axis=-1)


def masked_softmax(scores, mask):
    return jax.nn.softmax(jnp.where(mask, scores.astype(jnp.float32), -jnp.inf), axis=-1)


def chunk_band_attention(q, k, v, rel_bias):
    b, s, h, d = q.shape
    nc = s // CHUNK
    band = LEFT_CHUNKS + 1
    pad = ((0, 0), (LEFT_CHUNKS * CHUNK, 0), (0, 0), (0, 0))
    kp = jnp.pad(k, pad)
    vp = jnp.pad(v, pad)
    i = jnp.arange(CHUNK)[:, None]
    j = jnp.arange(band * CHUNK)[None, :]
    rel = jnp.clip(LEFT_CHUNKS * CHUNK + i - j, -(CHUNK - 1), REL_MAX) + (CHUNK - 1)
    bias = rel_bias[:, rel].astype(jnp.float32)
    key_off = jnp.arange(band * CHUNK) // CHUNK - LEFT_CHUNKS
    scale = d ** -0.5

    def one_chunk(n):
        start = n * CHUNK
        qn = lax.dynamic_slice_in_dim(q, start, CHUNK, axis=1)
        kn = lax.dynamic_slice_in_dim(kp, start, band * CHUNK, axis=1)
        vn = lax.dynamic_slice_in_dim(vp, start, band * CHUNK, axis=1)
        sc = jnp.einsum('bqhd,bkhd->bhqk', qn, kn).astype(jnp.float32) * scale + bias[None]
        valid = (n + key_off >= 0)[None, None, None, :]
        p = masked_softmax(sc, valid).astype(v.dtype)
        return jnp.einsum('bhqk,bkhd->bqhd', p, vn)

    o = lax.map(one_chunk, jnp.arange(nc))
    return o.transpose(1, 0, 2, 3, 4).reshape(b, s, h * d)


def diff_attention(q, k, v, lam, lambda_init, subln):
    b, s, h, _, d = q.shape
    key_chunk = jnp.arange(s) // CHUNK
    scale = d ** -0.5

    def one_block(n):
        qn = lax.dynamic_slice_in_dim(q, n * QB, QB, axis=1)
        sc = jnp.einsum('bqhcd,bkhcd->bhcqk', qn, k).astype(jnp.float32) * scale
        q_chunk = (n * QB + jnp.arange(QB)) // CHUNK
        valid = key_chunk[None, :] <= q_chunk[:, None]
        p = masked_softmax(sc, valid)
        a = p[:, :, 0] - lam * p[:, :, 1]
        return jnp.einsum('bhqk,bkhe->bqhe', a.astype(v.dtype), v)

    o = lax.map(one_block, jnp.arange(s // QB))
    o = o.transpose(1, 0, 2, 3, 4).reshape(b, s, h, 2 * d)
    o = rmsnorm(o, subln) * (1.0 - lambda_init)
    return o.reshape(b, s, h * 2 * d)


def dsa_attention(q, k, v, q_idx, k_idx, w_idx, topk):
    b, s, h, d = q.shape
    key_pos = jnp.arange(s)
    gather = jax.vmap(lambda t, idx: t[idx])
    scale = d ** -0.5

    def one_chunk(n):
        start = n * CHUNK
        qn = lax.dynamic_slice_in_dim(q, start, CHUNK, axis=1)
        qi = lax.dynamic_slice_in_dim(q_idx, start, CHUNK, axis=1)
        wi = lax.dynamic_slice_in_dim(w_idx, start, CHUNK, axis=1).astype(jnp.float32)
        logits = jnp.einsum('bqhd,bsd->bqhs', qi, k_idx).astype(jnp.float32) * D_IDX ** -0.5
        score = jnp.einsum('bqhs,bqh->bqs', jax.nn.relu(logits), wi)
        admissible = key_pos < start + CHUNK
        score = jnp.where(admissible[None, None, :], score, -jnp.inf)
        vals, idx = lax.top_k(score, topk)
        valid = jnp.isfinite(vals)
        kg = gather(k, idx)
        vg = gather(v, idx)
        sc = jnp.einsum('bqhd,bqkhd->bhqk', qn, kg).astype(jnp.float32) * scale
        p = masked_softmax(sc, valid[:, None]).astype(v.dtype)
        return jnp.einsum('bhqk,bqkhd->bqhd', p, vg)

    o = lax.map(one_chunk, jnp.arange(s // CHUNK))
    return o.transpose(1, 0, 2, 3, 4).reshape(b, s, h * d)


def memory_cross_attention(hn, mem_n, w_q, w_kv, w_o):
    b, s, _ = hn.shape
    m = mem_n.shape[1]
    q = (hn @ w_q).reshape(b, s, H_X, HEAD_DIM)
    kv = (mem_n @ w_kv).reshape(b, m, 2, H_X, HEAD_DIM)
    sc = jnp.einsum('bqhd,bmhd->bhqm', q, kv[:, :, 0]).astype(jnp.float32) * HEAD_DIM ** -0.5
    p = jax.nn.softmax(sc, axis=-1).astype(hn.dtype)
    o = jnp.einsum('bhqm,bmhd->bqhd', p, kv[:, :, 1]).reshape(b, s, H_X * HEAD_DIM)
    return o @ w_o


def swiglu(hn, w_gu, w_down):
    g, u = jnp.split(hn @ w_gu, 2, axis=-1)
    return (jax.nn.silu(g) * u) @ w_down


def setup_inputs(seed: int = 0) -> dict:
    key = jax.random.key(seed)
    ks = jax.random.split(key, 20)

    def normal(k, shape, scale):
        return jax.random.normal(k, shape, jnp.float32) * scale

    def gain(k, shape):
        return 1.0 + normal(k, shape, 0.05)

    return {
        'x': normal(ks[0], (BATCH, SEQ, D_MODEL), 1.0),
        'mem': normal(ks[1], (BATCH, MEM_LEN, D_MODEL), 1.0),
        'norm_mix': gain(ks[2], (DEPTH, D_MODEL)),
        'w_in': normal(ks[3], (DEPTH, D_MODEL, N_IN), D_MODEL ** -0.5),
        'rel_bias_a': normal(ks[4], (DEPTH, H_A, REL_TABLE), 0.5),
        'lambda_vecs': normal(ks[5], (DEPTH, 4, HEAD_DIM), 0.1),
        'subln_b': gain(ks[6], (DEPTH, 2 * HEAD_DIM)),
        'w_up_a': normal(ks[7], (DEPTH, W_A, D_MODEL), W_A ** -0.5),
        'w_up_b': normal(ks[8], (DEPTH, W_B, D_MODEL), W_B ** -0.5),
        'w_up_c': normal(ks[9], (DEPTH, W_C, D_MODEL), W_C ** -0.5),
        'w_out': normal(ks[10], (DEPTH, D_MODEL, D_MODEL), D_MODEL ** -0.5),
        'norm_cross': gain(ks[11], (DEPTH, D_MODEL)),
        'w_q_x': normal(ks[12], (DEPTH, D_MODEL, H_X * HEAD_DIM), D_MODEL ** -0.5),
        'w_kv_x': normal(ks[13], (DEPTH, D_MODEL, 2 * H_X * HEAD_DIM), D_MODEL ** -0.5),
        'w_o_x': normal(ks[14], (DEPTH, H_X * HEAD_DIM, D_MODEL), (H_X * HEAD_DIM) ** -0.5),
        'norm_ffn': gain(ks[15], (DEPTH, D_MODEL)),
        'w_gu': normal(ks[16], (DEPTH, D_MODEL, 2 * D_FF), D_MODEL ** -0.5),
        'w_down': normal(ks[17], (DEPTH, D_FF, D_MODEL), D_FF ** -0.5),
        'mem_norm': gain(ks[18], (D_MODEL,)),
        'final_norm': gain(ks[19], (D_MODEL,)),
    }


def reference(x, mem, norm_mix, w_in, rel_bias_a, lambda_vecs, subln_b, w_up_a, w_up_b, w_up_c,
              w_out, norm_cross, w_q_x, w_kv_x, w_o_x, norm_ffn, w_gu, w_down, mem_norm, final_norm):
    b, s, _ = x.shape
    topk = min(TOPK_MAX, s // 4)
    cos, sin = rope_tables(s)
    offsets = [int(o) for o in np.cumsum(IN_SPLITS)[:-1]]
    mem_n = rmsnorm(mem, mem_norm)
    shp_a = (b, s, H_A, HEAD_DIM)
    shp_b = (b, s, H_B, 2, HEAD_DIM)
    shp_c = (b, s, H_C, HEAD_DIM)
    for l in range(DEPTH):
        xn = rmsnorm(x, norm_mix[l])
        (qa, ka, va, qb, kb, vb, qc, kc, vc, qi, ki, wi, gates) = jnp.split(xn @ w_in[l], offsets, axis=-1)
        o_a = chunk_band_attention(qa.reshape(shp_a), ka.reshape(shp_a), va.reshape(shp_a), rel_bias_a[l])
        lam_init = 0.8 - 0.6 * math.exp(-0.3 * l)
        lv = lambda_vecs[l].astype(jnp.float32)
        lam = jnp.exp(jnp.sum(lv[0] * lv[1])) - jnp.exp(jnp.sum(lv[2] * lv[3])) + lam_init
        o_b = diff_attention(apply_rope(qb.reshape(shp_b), cos, sin), apply_rope(kb.reshape(shp_b), cos, sin),
                             vb.reshape(b, s, H_B, 2 * HEAD_DIM), lam, lam_init, subln_b[l])
        o_c = dsa_attention(apply_rope(qc.reshape(shp_c), cos, sin), apply_rope(kc.reshape(shp_c), cos, sin),
                            vc.reshape(shp_c),
                            apply_rope(qi.reshape(b, s, H_IDX, D_IDX), cos, sin),
                            apply_rope(ki[:, :, None, :], cos, sin)[:, :, 0],
                            wi * H_IDX ** -0.5, topk)
        g = jax.nn.sigmoid(gates).reshape(b, s, 3, D_MODEL)
        y = (g[:, :, 0] * (o_a @ w_up_a[l]) + g[:, :, 1] * (o_b @ w_up_b[l])
             + g[:, :, 2] * (o_c @ w_up_c[l]))
        x = x + y @ w_out[l]
        x = x + memory_cross_attention(rmsnorm(x, norm_cross[l]), mem_n, w_q_x[l], w_kv_x[l], w_o_x[l])
        x = x + swiglu(rmsnorm(x, norm_ffn[l]), w_gu[l], w_down[l])
    return rmsnorm(x, final_norm)
```

```cpp
#include <hip/hip_runtime.h>
#include <hip/hip_bf16.h>
#include <cstdio>
#include <cstdint>
#include <cmath>
namespace pg8 {
#define PG8_LAS __attribute__((address_space(3)))
typedef unsigned short bf16_t;
typedef short bf16x8 __attribute__((ext_vector_type(8)));
typedef float f32x4 __attribute__((ext_vector_type(4)));
typedef unsigned u32x4 __attribute__((ext_vector_type(4)));
constexpr int BM = 256, BK = 64, HALF = 128, HTB = HALF * BK * 2  , STAGE_BYTES = 8 * HTB, NXCD = 8, WGM = 8;

__host__ __device__ __forceinline__ int lds_byte(int r, int c) { const int st = (r >> 4) * 2 + (c >> 5), rr = r & 15, cc = c & 31, ob = rr * 64 + cc * 2; return st * 1024 + (ob ^ (((ob >> 9) & 1) << 5)); }
__host__ __device__ __forceinline__ void stage_rc(int b, int& R, int& C) { const int st = b / 1024, sb = b % 1024, swz = sb ^ (((sb >> 9) & 1) << 5); R = (st >> 1) * 16 + swz / 64; C = (st & 1) * 32 + (swz % 64) / 2; }
__host__ __device__ __forceinline__ int perm32(int rho) { const int n = rho >> 4, i = rho & 15; return 8 * (i >> 2) + 4 * n + (i & 3); }

struct Unit { int pm, pn, az; };
struct Gemm { const bf16_t* A; const bf16_t* Bt; int M, N, K; size_t azs; };

struct StaticOrder {
    int nM, nN, nwg, G, c;
    __host__ __device__ void init(int M, int N, int G_, int c_) { nM = M / BM; nN = N / BM; nwg = nM * nN; G = G_; c = c_; }
    __host__ __device__ bool next(int i, Unit& u) const {
        const long L = (long)i * G + c; if (L >= nwg) return false;
        int wgid = (int)L; { const int q = nwg / NXCD, r = nwg % NXCD, xcd = wgid % NXCD, off = wgid / NXCD; wgid = (xcd < r ? xcd * (q + 1) : r * (q + 1) + (xcd - r) * q) + off; }
        const int nig = WGM * nN, gid = wgid / nig, fm = gid * WGM, gsz = (nM - fm) < WGM ? (nM - fm) : WGM;
        u.pm = fm + ((wgid % nig) % gsz); u.pn = (wgid % nig) / gsz; u.az = 0; return true;
    }
    __device__ __forceinline__ void a_ready(const Unit&) const {}
    __device__ __forceinline__ void done(const Unit&) const {}
};

__device__ __forceinline__ unsigned cvt_pk_bf16(float lo, float hi) { unsigned r; asm volatile("v_cvt_pk_bf16_f32 %0, %1, %2" : "=v"(r) : "v"(lo), "v"(hi)); return r; }
typedef float f32x2c_t __attribute__((ext_vector_type(2))); typedef __bf16 bf16x2c_t __attribute__((ext_vector_type(2)));
__device__ __forceinline__ unsigned cvt_pk_bf16_c(float lo, float hi) { const f32x2c_t v = {lo, hi}; const bf16x2c_t b = __builtin_convertvector(v, bf16x2c_t); return __builtin_bit_cast(unsigned, b); }
typedef float f32x2 __attribute__((ext_vector_type(2)));

typedef unsigned u32x2 __attribute__((ext_vector_type(2)));
#define PG8_GAS __attribute__((address_space(1)))
__device__ __forceinline__ float bf_lo(unsigned w) { return __uint_as_float(w << 16); }
__device__ __forceinline__ float bf_hi(unsigned w) { return __uint_as_float(w & 0xffff0000u); }

__device__ __forceinline__ float row_rstd(const float* ss, size_t row) {
    const PG8_GAS f32x4* p = (const PG8_GAS f32x4*)(ss + row * 16);
    const f32x4 a = p[0], b = p[1], c = p[2], d = p[3];
    const float s = (((a[0] + a[1]) + (a[2] + a[3])) + ((b[0] + b[1]) + (b[2] + b[3]))) + (((c[0] + c[1]) + (c[2] + c[3])) + ((d[0] + d[1]) + (d[2] + d[3])));
    float eps = 1e-6f; asm volatile("" : "+v"(eps));
    return 1.0f / sqrtf(s * (1.0f / 1024.0f) + eps);
}
__device__ __forceinline__ void stage_rstd(const float* ss, PG8_LAS float* rs, int pm, int tid) {
    const int r = tid >> 1, h = tid & 1;
    const PG8_GAS f32x4* p = (const PG8_GAS f32x4*)(ss + ((size_t)pm * BM + r) * 16 + h * 8);
    const f32x4 a = p[0], b = p[1];
    float s = ((a[0] + a[1]) + (a[2] + a[3])) + ((b[0] + b[1]) + (b[2] + b[3]));
    s += __shfl_xor(s, 1);
    float eps = 1e-6f; asm volatile("" : "+v"(eps));
    if (h == 0) rs[r] = 1.0f / sqrtf(s * (1.0f / 1024.0f) + eps);
    asm volatile("s_waitcnt lgkmcnt(0)" ::: "memory"); __builtin_amdgcn_s_barrier(); asm volatile("" ::: "memory");
}
struct EpiRes {
    static constexpr bool PERM = true, AFTER_DRAIN = false, CARRY = false, RSTD = false;
    bf16_t* xb; int ldc; float* ss; float s;
    __device__ __forceinline__ void operator()(const f32x4 (&acc)[2][2][4][2], const Unit& u, int wr, int wc, int fr, int fq) const {
        const int row0 = u.pm * BM + wr * 64 + fr, col0 = u.pn * BM + wc * 32 + 8 * fq;
#pragma unroll
        for (int ai = 0; ai < 2; ++ai)
#pragma unroll
            for (int m = 0; m < 4; ++m) { const size_t row = (size_t)(row0 + ai * HALF + m * 16); bf16_t* rowp = xb + row * ldc + col0; float sq = 0.f;
#pragma unroll
                for (int bj = 0; bj < 2; ++bj) { const u32x4 b = *(const PG8_GAS u32x4*)(rowp + bj * HALF);
                    const f32x4 b0 = {__uint_as_float(b.x << 16), __uint_as_float(b.x & 0xffff0000u), __uint_as_float(b.y << 16), __uint_as_float(b.y & 0xffff0000u)};
                    const f32x4 b1 = {__uint_as_float(b.z << 16), __uint_as_float(b.z & 0xffff0000u), __uint_as_float(b.w << 16), __uint_as_float(b.w & 0xffff0000u)};
                    const f32x4 v0 = b0 + acc[ai][bj][m][0] * s, v1 = b1 + acc[ai][bj][m][1] * s;
                    u32x4 w; w.x = cvt_pk_bf16(v0[0], v0[1]); w.y = cvt_pk_bf16(v0[2], v0[3]); w.z = cvt_pk_bf16(v1[0], v1[1]); w.w = cvt_pk_bf16(v1[2], v1[3]);
                    *(PG8_GAS u32x4*)(rowp + bj * HALF) = w;
                    sq += ((v0[0] * v0[0] + v0[1] * v0[1]) + (v0[2] * v0[2] + v0[3] * v0[3])) + ((v1[0] * v1[0] + v1[1] * v1[1]) + (v1[2] * v1[2] + v1[3] * v1[3])); }
                sq += __shfl_xor(sq, 16); sq += __shfl_xor(sq, 32);
                if (fq == 0) *(PG8_GAS float*)(ss + row * 16 + u.pn * 4 + wc) = sq; }
    }
};

struct EpiBf16S {
    static constexpr bool PERM = true, AFTER_DRAIN = false, CARRY = false, RSTD = true;
    bf16_t* O; int ldc; float sc; const float* ss; PG8_LAS float* rs;
    __device__ __forceinline__ void stage(int pm, int tid) const { if (ss) stage_rstd(ss, rs, pm, tid); }
    __device__ __forceinline__ void operator()(const f32x4 (&acc)[2][2][4][2], const Unit& u, int wr, int wc, int fr, int fq) const {
        const int row0 = u.pm * BM + wr * 64 + fr, col0 = u.pn * BM + wc * 32 + 8 * fq;
#pragma unroll
        for (int ai = 0; ai < 2; ++ai)
#pragma unroll
            for (int m = 0; m < 4; ++m) { bf16_t* rowp = O + (size_t)(row0 + ai * HALF + m * 16) * ldc + col0; const float rq = ss ? sc * rs[ai * HALF + wr * 64 + m * 16 + fr] : sc;
#pragma unroll
                for (int bj = 0; bj < 2; ++bj) { const f32x4 v0 = acc[ai][bj][m][0] * rq, v1 = acc[ai][bj][m][1] * rq;
                    u32x4 w; w.x = cvt_pk_bf16(v0[0], v0[1]); w.y = cvt_pk_bf16(v0[2], v0[3]); w.z = cvt_pk_bf16(v1[0], v1[1]); w.w = cvt_pk_bf16(v1[2], v1[3]);
                    *(PG8_GAS u32x4*)(rowp + bj * HALF) = w; } }
    }
};

struct EpiProj {
    static constexpr bool PERM = true, AFTER_DRAIN = false, CARRY = false, RSTD = true;
    __device__ __forceinline__ void stage(int pm, int tid) const { stage_rstd(ss, rs, pm, tid); }
    bf16_t* qkv; bf16_t* qi; bf16_t* ki; bf16_t* gates; const float* cs; float qscale; size_t bufstride; const float* ss; PG8_LAS float* rs;
    __device__ __forceinline__ void operator()(const f32x4 (&acc)[2][2][4][2], const Unit& u, int wr, int wc, int fr, int fq) const {
        const int pn = u.pn;
        bf16_t* dst; int ld, colbase; float sc = 1.f; int mode;
        if (pn < 18) { const int buf = pn >> 1, kind = buf % 3, mixer = buf / 3; dst = qkv + (size_t)buf * bufstride; ld = 512; colbase = (pn & 1) * 256;
            mode = (mixer >= 1 && kind < 2) ? 1 : 0; if (kind == 0) sc = qscale; }
        else if (pn == 18) { dst = qi; ld = 256; colbase = 0; mode = 1; }
        else if (pn == 19) { dst = ki; ld = 256; colbase = 0; mode = 3; }
        else { dst = gates; ld = 3072; colbase = (pn - 20) * 256; mode = 2; }
        const int row0 = u.pm * BM + wr * 64 + fr;
        const int jj = 4 * (wc & 1) + fq;
        if (mode == 1 || mode == 3) {
#pragma unroll
            for (int ai = 0; ai < 2; ++ai)
#pragma unroll
                for (int m = 0; m < 4; ++m) {
                    const int row = row0 + ai * HALF + m * 16;
                    bf16_t* rowp = dst + (size_t)row * ld + colbase;
                    const float rstd = rs[ai * HALF + wr * 64 + m * 16 + fr];
                    const float* t = cs + (size_t)(row & 4095) * 64 + 4 * jj; const f32x4 c4v = *(const PG8_GAS f32x4*)t, s4v = *(const PG8_GAS f32x4*)(t + 32);
#pragma unroll
                    for (int bj = 0; bj < 2; ++bj) {
                        const f32x4 x1 = acc[ai][bj][m][0] * rstd, x2 = acc[ai][bj][m][1] * rstd;
                        const int blk = 2 * bj + (wc >> 1);
                        if (mode == 1 || blk == 0) {
                            const f32x4 o1 = (x1 * c4v - x2 * s4v) * sc, o2 = (x2 * c4v + x1 * s4v) * sc;
                            u32x2 w1, w2; w1.x = cvt_pk_bf16(o1[0], o1[1]); w1.y = cvt_pk_bf16(o1[2], o1[3]); w2.x = cvt_pk_bf16(o2[0], o2[1]); w2.y = cvt_pk_bf16(o2[2], o2[3]);
                            *(PG8_GAS u32x2*)(rowp + 64 * blk + 4 * jj) = w1; *(PG8_GAS u32x2*)(rowp + 64 * blk + 32 + 4 * jj) = w2;
                        } else {
                            const f32x4 v0 = x1 * sc, v1 = x2 * sc;
                            u32x4 w; w.x = cvt_pk_bf16(v0[0], v0[1]); w.y = cvt_pk_bf16(v0[2], v0[3]); w.z = cvt_pk_bf16(v1[0], v1[1]); w.w = cvt_pk_bf16(v1[2], v1[3]);
                            *(PG8_GAS u32x4*)(rowp + bj * HALF + wc * 32 + 8 * fq) = w;
                        }
                    }
                }
        } else if (mode == 2) {
#pragma unroll
            for (int ai = 0; ai < 2; ++ai)
#pragma unroll
                for (int m = 0; m < 4; ++m) {
                    bf16_t* rowp = dst + (size_t)(row0 + ai * HALF + m * 16) * ld + colbase;
                    const float rq = rs[ai * HALF + wr * 64 + m * 16 + fr] * -1.4426950408889634f;
#pragma unroll
                    for (int bj = 0; bj < 2; ++bj) {
                        f32x4 v0 = acc[ai][bj][m][0] * rq, v1 = acc[ai][bj][m][1] * rq;
#pragma unroll
                        for (int e = 0; e < 4; ++e) { v0[e] = __builtin_amdgcn_exp2f(fminf(v0[e], 60.f)); v1[e] = __builtin_amdgcn_exp2f(fminf(v1[e], 60.f)); }
                        u32x4 w; w.x = cvt_pk_bf16_c(v0[0], v0[1]); w.y = cvt_pk_bf16_c(v0[2], v0[3]); w.z = cvt_pk_bf16_c(v1[0], v1[1]); w.w = cvt_pk_bf16_c(v1[2], v1[3]);
                        *(PG8_GAS u32x4*)(rowp + bj * HALF + wc * 32 + 8 * fq) = w;
                    }
                }
        } else {
#pragma unroll
            for (int ai = 0; ai < 2; ++ai)
#pragma unroll
                for (int m = 0; m < 4; ++m) {
                    bf16_t* rowp = dst + (size_t)(row0 + ai * HALF + m * 16) * ld + colbase;
                    const float rq = rs[ai * HALF + wr * 64 + m * 16 + fr] * sc;
#pragma unroll
                    for (int bj = 0; bj < 2; ++bj) {
                        const f32x4 v0 = acc[ai][bj][m][0] * rq, v1 = acc[ai][bj][m][1] * rq;
                        u32x4 w; w.x = cvt_pk_bf16(v0[0], v0[1]); w.y = cvt_pk_bf16(v0[2], v0[3]); w.z = cvt_pk_bf16(v1[0], v1[1]); w.w = cvt_pk_bf16(v1[2], v1[3]);
                        *(PG8_GAS u32x4*)(rowp + bj * HALF + wc * 32 + 8 * fq) = w;
                    }
                }
        }
    }
};

struct EpiSwiglu {
    static constexpr bool PERM = true, AFTER_DRAIN = false, CARRY = false, RSTD = true;
    bf16_t* H; int ldh; const float* ss; PG8_LAS float* rs;
    __device__ __forceinline__ void stage(int pm, int tid) const { stage_rstd(ss, rs, pm, tid); }
    __device__ __forceinline__ void operator()(const f32x4 (&acc)[2][2][4][2], const Unit& u, int wr, int wc, int fr, int fq) const {
        const int row0 = u.pm * BM + wr * 64 + fr, col0 = u.pn * (BM / 2) + wc * 16 + 4 * fq;
#pragma unroll
        for (int ai = 0; ai < 2; ++ai)
#pragma unroll
            for (int m = 0; m < 4; ++m) { bf16_t* rowp = H + (size_t)(row0 + ai * HALF + m * 16) * ldh + col0; const float rstd = rs[ai * HALF + wr * 64 + m * 16 + fr];
#pragma unroll
                for (int bj = 0; bj < 2; ++bj) { const f32x4 g = acc[ai][bj][m][0] * rstd, up = acc[ai][bj][m][1] * rstd; f32x4 h;
#pragma unroll
                    for (int e = 0; e < 4; ++e) h[e] = g[e] * __builtin_amdgcn_rcpf(1.f + __builtin_amdgcn_exp2f(-1.4426950408889634f * g[e])) * up[e];
                    u32x2 w; w.x = cvt_pk_bf16(h[0], h[1]); w.y = cvt_pk_bf16(h[2], h[3]);
                    *(PG8_GAS u32x2*)(rowp + bj * (HALF / 2)) = w; } }
    }
};

struct EpiGateC {
    static constexpr bool PERM = true, AFTER_DRAIN = false, CARRY = true, RSTD = false;
    const bf16_t* gates; bf16_t* Y;
    __device__ __forceinline__ bool carry(f32x4 (&acc)[2][2][4][2], const Unit& u, int wr, int wc, int fr, int fq) const {
        const int branch = u.pn >> 2, row0 = u.pm * BM + wr * 64 + fr, col0 = (u.pn & 3) * BM + wc * 32 + 8 * fq;
#pragma unroll
        for (int ai = 0; ai < 2; ++ai)
#pragma unroll
            for (int m = 0; m < 4; ++m) { const size_t row = (size_t)(row0 + ai * HALF + m * 16);
#pragma unroll
                for (int bj = 0; bj < 2; ++bj) {
                    const u32x4 g = *(const PG8_GAS u32x4*)(gates + row * 3072 + branch * 1024 + col0 + bj * HALF);
                    float gc[8] = {bf_lo(g.x), bf_hi(g.x), bf_lo(g.y), bf_hi(g.y), bf_lo(g.z), bf_hi(g.z), bf_lo(g.w), bf_hi(g.w)};
                    if (branch < 2) {
                        const u32x4 h = *(const PG8_GAS u32x4*)(gates + row * 3072 + (branch + 1) * 1024 + col0 + bj * HALF);
                        const float gn[8] = {bf_lo(h.x), bf_hi(h.x), bf_lo(h.y), bf_hi(h.y), bf_lo(h.z), bf_hi(h.z), bf_lo(h.w), bf_hi(h.w)};
#pragma unroll
                        for (int e = 0; e < 8; ++e) gc[e] = (1.f + gn[e]) * __builtin_amdgcn_rcpf(1.f + gc[e]);
                        acc[ai][bj][m][0] = acc[ai][bj][m][0] * (f32x4){gc[0], gc[1], gc[2], gc[3]};
                        acc[ai][bj][m][1] = acc[ai][bj][m][1] * (f32x4){gc[4], gc[5], gc[6], gc[7]};
                    } else {
                        const f32x4 a0 = acc[ai][bj][m][0], a1 = acc[ai][bj][m][1];
#pragma unroll
                        for (int e = 0; e < 8; ++e) gc[e] = __builtin_amdgcn_rcpf(1.f + gc[e]);
                        u32x4 w; w.x = cvt_pk_bf16(gc[0] * a0[0], gc[1] * a0[1]); w.y = cvt_pk_bf16(gc[2] * a0[2], gc[3] * a0[3]); w.z = cvt_pk_bf16(gc[4] * a1[0], gc[5] * a1[1]); w.w = cvt_pk_bf16(gc[6] * a1[2], gc[7] * a1[3]);
                        *(PG8_GAS u32x4*)(Y + row * 1024 + col0 + bj * HALF) = w;
                    } } }
        return branch < 2;
    }
};

struct UpOrder {
    StaticOrder so;
    __host__ __device__ void init(int M, int G_, int c_) { so.init(M, 1024, G_, c_); }
    __host__ __device__ bool next(int i, Unit& u) const { const int br = i % 3; if (!so.next(i / 3, u)) return false; u.pn += 4 * br; u.az = br; return true; }
    __device__ __forceinline__ void a_ready(const Unit&) const {}
    __device__ __forceinline__ void done(const Unit&) const {}
};
template <class Epi, class Sched, bool ALIGN_EPI = false, bool SP2 = false>
__device__ __forceinline__ void gemm_phase(PG8_LAS unsigned char* lds, const Gemm g, const Sched& S, const Epi& E, int tid_in) {
    int tid_l = tid_in; asm volatile("" : "+v"(tid_l));
    const int tid = tid_l, wid = __builtin_amdgcn_readfirstlane(tid >> 6), lane = tid & 63, wr = wid >> 2, wc = wid & 3, fr = lane & 15, fq = lane >> 4;
    const int K = g.K, nt = K / BK;
    unsigned voffA[2], voffB[2];
#pragma unroll
    for (int i = 0; i < 2; ++i) { int R, C; stage_rc(tid * 16 + i * 8192, R, C); const int Rb = Epi::PERM ? ((R & ~31) + perm32(R & 31)) : R;
        voffA[i] = (unsigned)(R * K + C) * 2u; voffB[i] = (unsigned)(Rb * K + C) * 2u; }
    const size_t kstep = (size_t)(BK * 2);
    const size_t hstep = (size_t)HALF * K * 2;
    const size_t tstep = 2 * hstep;
    const unsigned ldsw = (unsigned)wid * 1024u;
    const int aoff = lds_byte(wr * 64 + fr, fq * 8), boff = lds_byte(wc * 32 + fr, fq * 8);
#define PG8_SA(b, h) (((b) * 2 + (h)) * HTB)
#define PG8_SB(b, h) ((4 + (b) * 2 + (h)) * HTB)
#define PG8_STAGE(bufoff, gbase, voff) do { _Pragma("unroll") for (int _i = 0; _i < 2; ++_i) \
        __builtin_amdgcn_global_load_lds((const unsigned*)((const char*)(gbase) + (voff)[_i]), (PG8_LAS unsigned*)(lds + (bufoff) + ldsw + _i * 8192), 16, 0, 0); } while (0)
#define PG8_LDA(dst, b, h) do { _Pragma("unroll") for (int m = 0; m < 4; ++m) _Pragma("unroll") for (int k = 0; k < 2; ++k) dst[m][k] = *(const PG8_LAS bf16x8*)(lds + PG8_SA(b, h) + aoff + m * 2048 + k * 1024); } while (0)
#define PG8_LDB(dst, b, h) do { _Pragma("unroll") for (int n = 0; n < 2; ++n) _Pragma("unroll") for (int k = 0; k < 2; ++k) dst[n][k] = *(const PG8_LAS bf16x8*)(lds + PG8_SB(b, h) + boff + n * 2048 + k * 1024); } while (0)
#define PG8_MMA(ai, bj, At, Bt) do { __builtin_amdgcn_s_setprio(1); _Pragma("unroll") for (int m = 0; m < 4; ++m) _Pragma("unroll") for (int n = 0; n < 2; ++n) _Pragma("unroll") for (int k = 0; k < 2; ++k) \
        acc[ai][bj][m][n] = __builtin_amdgcn_mfma_f32_16x16x32_bf16(Bt[n][k], At[m][k], acc[ai][bj][m][n], 0, 0, 0); __builtin_amdgcn_s_setprio(0); } while (0)
#define PG8_WAIT_V(n) asm volatile("s_waitcnt vmcnt(" #n ")" ::: "memory")
#define PG8_WAIT_L(n) asm volatile("s_waitcnt lgkmcnt(" #n ")" ::: "memory")
#define PG8_BAR __builtin_amdgcn_s_barrier()
#define PG8_SCHED __builtin_amdgcn_sched_barrier(0)
    Unit cur, nxt; int ui = 0; int rs_pm = -1;
    if (!S.next(0, cur)) return;
    f32x4 acc[2][2][4][2];
#pragma unroll
    for (int a = 0; a < 2; ++a)
#pragma unroll
        for (int b = 0; b < 2; ++b)
#pragma unroll
            for (int m = 0; m < 4; ++m)
#pragma unroll
                for (int n = 0; n < 2; ++n) acc[a][b][m][n] = (f32x4){0.f, 0.f, 0.f, 0.f};
    bf16x8 At[4][2], B0[2][2], B1[2][2];
    const char* cA = (const char*)g.A + (size_t)cur.pm * tstep + (size_t)cur.az * g.azs; const char* cB = (const char*)g.Bt + (size_t)cur.pn * tstep;
    S.a_ready(cur);
    if constexpr (SP2) {
        PG8_STAGE(PG8_SB(0, 0), cB, voffB); PG8_STAGE(PG8_SB(0, 1), cB + hstep, voffB); PG8_STAGE(PG8_SA(0, 0), cA, voffA); PG8_STAGE(PG8_SA(0, 1), cA + hstep, voffA);
        if (wr == 1) PG8_BAR;
        PG8_WAIT_V(2); PG8_BAR;
        PG8_STAGE(PG8_SB(1, 0), cB + kstep, voffB); PG8_STAGE(PG8_SA(1, 0), cA + kstep, voffA); PG8_STAGE(PG8_SB(1, 1), cB + hstep + kstep, voffB);
        PG8_WAIT_V(6); PG8_BAR;
    } else {
        PG8_STAGE(PG8_SB(0, 0), cB, voffB); PG8_STAGE(PG8_SA(0, 0), cA, voffA); PG8_STAGE(PG8_SB(0, 1), cB + hstep, voffB); PG8_STAGE(PG8_SA(0, 1), cA + hstep, voffA);
        if (wr == 1) PG8_BAR;
        PG8_WAIT_V(4); PG8_BAR;
        PG8_STAGE(PG8_SB(1, 0), cB + kstep, voffB); PG8_STAGE(PG8_SA(1, 0), cA + kstep, voffA); PG8_STAGE(PG8_SB(1, 1), cB + hstep + kstep, voffB);
        PG8_WAIT_V(6); PG8_BAR;
    }
    for (;;) {
        const bool has_next = S.next(ui + 1, nxt);
        const char* nA = has_next ? (const char*)g.A + (size_t)nxt.pm * tstep + (size_t)nxt.az * g.azs : cA; const char* nB = has_next ? (const char*)g.Bt + (size_t)nxt.pn * tstep : cB;
        for (int t = 0; t < nt; t += 2) {
            const bool last = (t == nt - 2);
            const char* a1 = cA + (size_t)(t + 1) * kstep;
            const char* a2 = last ? nA : cA + (size_t)(t + 2) * kstep; const char* b2 = last ? nB : cB + (size_t)(t + 2) * kstep;
            const char* a3 = a2 + kstep; const char* b3 = b2 + kstep;
            if (last && has_next) S.a_ready(nxt);
            if constexpr (SP2) {
            PG8_LDB(B0, 0, 0); PG8_LDB(B1, 0, 1); PG8_SCHED; PG8_LDA(At, 0, 0); PG8_STAGE(PG8_SA(1, 1), a1 + hstep, voffA);
            PG8_WAIT_V(8); PG8_WAIT_L(0); PG8_BAR; PG8_MMA(0, 0, At, B0); PG8_MMA(0, 1, At, B1); PG8_BAR; PG8_SCHED;
            PG8_LDA(At, 0, 1); PG8_STAGE(PG8_SB(0, 0), b2, voffB); PG8_STAGE(PG8_SB(0, 1), b2 + hstep, voffB); PG8_STAGE(PG8_SA(0, 0), a2, voffA);
            PG8_WAIT_V(8); PG8_WAIT_L(0); PG8_BAR; PG8_MMA(1, 0, At, B0); PG8_MMA(1, 1, At, B1); PG8_BAR; PG8_SCHED;
            PG8_LDB(B0, 1, 0); PG8_LDB(B1, 1, 1); PG8_SCHED; PG8_LDA(At, 1, 0); PG8_STAGE(PG8_SA(0, 1), a2 + hstep, voffA);
            PG8_WAIT_V(8); PG8_WAIT_L(0); PG8_BAR; PG8_MMA(0, 0, At, B0); PG8_MMA(0, 1, At, B1); PG8_BAR; PG8_SCHED;
            PG8_LDA(At, 1, 1); PG8_STAGE(PG8_SB(1, 0), b3, voffB); PG8_STAGE(PG8_SB(1, 1), b3 + hstep, voffB); PG8_STAGE(PG8_SA(1, 0), a3, voffA);
            PG8_WAIT_V(8); PG8_WAIT_L(0); PG8_BAR; PG8_MMA(1, 0, At, B0); PG8_MMA(1, 1, At, B1); PG8_BAR; PG8_SCHED;
            } else {
            PG8_LDB(B0, 0, 0); PG8_SCHED; PG8_LDA(At, 0, 0); PG8_STAGE(PG8_SA(1, 1), a1 + hstep, voffA);
            PG8_WAIT_L(8); PG8_BAR; PG8_WAIT_L(0); PG8_MMA(0, 0, At, B0); PG8_BAR; PG8_SCHED;
            PG8_LDB(B1, 0, 1); PG8_STAGE(PG8_SB(0, 0), b2, voffB);
            PG8_BAR; PG8_WAIT_L(0); PG8_MMA(0, 1, At, B1); PG8_BAR;
            PG8_LDA(At, 0, 1); PG8_STAGE(PG8_SA(0, 0), a2, voffA);
            PG8_BAR; PG8_WAIT_L(0); PG8_MMA(1, 0, At, B0); PG8_BAR; PG8_SCHED;
            PG8_STAGE(PG8_SB(0, 1), b2 + hstep, voffB);
            PG8_WAIT_V(6); PG8_BAR; PG8_MMA(1, 1, At, B1); PG8_BAR;
            PG8_LDB(B0, 1, 0); PG8_SCHED; PG8_LDA(At, 1, 0); PG8_STAGE(PG8_SA(0, 1), a2 + hstep, voffA);
            PG8_WAIT_L(8); PG8_BAR; PG8_WAIT_L(0); PG8_MMA(0, 0, At, B0); PG8_BAR; PG8_SCHED;
            PG8_LDB(B1, 1, 1); PG8_STAGE(PG8_SB(1, 0), b3, voffB);
            PG8_BAR; PG8_WAIT_L(0); PG8_MMA(0, 1, At, B1); PG8_BAR;
            PG8_LDA(At, 1, 1); PG8_STAGE(PG8_SA(1, 0), a3, voffA);
            PG8_BAR; PG8_WAIT_L(0); PG8_MMA(1, 0, At, B0); PG8_BAR; PG8_SCHED;
            PG8_STAGE(PG8_SB(1, 1), b3 + hstep, voffB);
            PG8_WAIT_V(6); PG8_BAR; PG8_MMA(1, 1, At, B1); PG8_BAR;
            }
        }
        if constexpr (ALIGN_EPI) { if (wr == 0) PG8_BAR; }
        if constexpr (Epi::RSTD) { if (cur.pm != rs_pm) { E.stage(cur.pm, tid); rs_pm = cur.pm; } }
        bool keep_acc = false;
        if constexpr (Epi::CARRY) { keep_acc = E.carry(acc, cur, wr, wc, fr, fq); S.done(cur); }
        else if constexpr (!Epi::AFTER_DRAIN) { E(acc, cur, wr, wc, fr, fq);
#ifdef REP_EPI
            if constexpr (Epi::RSTD) { asm volatile("" ::: "memory"); E(acc, cur, wr, wc, fr, fq); }
#endif
            S.done(cur); }
        if (!has_next) break;
        if (!keep_acc)
#pragma unroll
        for (int a = 0; a < 2; ++a)
#pragma unroll
            for (int b = 0; b < 2; ++b)
#pragma unroll
                for (int m = 0; m < 4; ++m)
#pragma unroll
                    for (int n = 0; n < 2; ++n) acc[a][b][m][n] = (f32x4){0.f, 0.f, 0.f, 0.f};
        cur = nxt; cA = nA; cB = nB; ++ui;
        if constexpr (ALIGN_EPI) { if (wr == 1) PG8_BAR; }
    }
    PG8_WAIT_V(0);
    if constexpr (!ALIGN_EPI) { if (wr == 0) PG8_BAR; }
    PG8_BAR;
    if constexpr (Epi::AFTER_DRAIN) { E.fused(acc, cur, wr, wc, fr, fq, lds, wid, lane); S.done(cur); }
#undef PG8_SA
#undef PG8_SB
#undef PG8_STAGE
#undef PG8_LDA
#undef PG8_LDB
#undef PG8_MMA
#undef PG8_WAIT_V
#undef PG8_WAIT_L
#undef PG8_BAR
#undef PG8_SCHED
}
}

namespace att {
#define ATT_LAS __attribute__((address_space(3)))
#define ATT_GAS __attribute__((address_space(1)))
typedef unsigned short bf16_t;
typedef short bf16x8 __attribute__((ext_vector_type(8)));
typedef short s16x4 __attribute__((ext_vector_type(4)));
typedef float f32x16 __attribute__((ext_vector_type(16)));
typedef float f32x4 __attribute__((ext_vector_type(4)));
typedef unsigned u32x4 __attribute__((ext_vector_type(4)));
typedef unsigned u32x2 __attribute__((ext_vector_type(2)));
typedef float f32x2_t __attribute__((ext_vector_type(2)));
typedef __bf16 bf16x2_t __attribute__((ext_vector_type(2)));
typedef short v4i16_t __attribute__((ext_vector_type(4)));
typedef ATT_LAS unsigned char* lptr;
#define ADI __device__ __forceinline__
constexpr float LOG2E = 1.4426950408889634f;
constexpr float NEG_BIG = -1e30f;

ADI int crow(int r, int hi) { return (r & 3) + 8 * (r >> 2) + 4 * hi; }
ADI unsigned cvtpk(float lo, float hi) { f32x2_t v = {lo, hi}; bf16x2_t b = __builtin_convertvector(v, bf16x2_t); return __builtin_bit_cast(unsigned, b); }
ADI float swapmax(float v) { auto rr = __builtin_amdgcn_permlane32_swap(__float_as_uint(v), __float_as_uint(v), false, false); return fmaxf(__uint_as_float(rr[0]), __uint_as_float(rr[1])); }
ADI float swapsum(float v) { auto rr = __builtin_amdgcn_permlane32_swap(__float_as_uint(v), __float_as_uint(v), false, false); return __uint_as_float(rr[0]) + __uint_as_float(rr[1]); }
ADI f32x16 splat16(float v) { f32x16 r;
#pragma unroll
  for (int i = 0; i < 16; ++i) r[i] = v; return r; }
ADI float bf2f(bf16_t b) { return __uint_as_float((unsigned)b << 16); }

ADI u32x4 ldg16(const bf16_t* p) { return *(const ATT_GAS u32x4*)p; }
ADI void k_map(int tid, int& key, int& chunk) { const int w = tid >> 6, lane = tid & 63; key = 32 * (w & 1) + (lane & 31); chunk = 2 * (w >> 1) + (lane >> 5); }
ADI int k_lds_off(int key, int chunk) { return chunk * 1024 + key * 16; }
ADI void v_map(int tid, int& key, int& dc) { key = tid >> 3; dc = tid & 7; }
ADI int v_lds_off(int key, int dc) { return ((dc >> 2) * 4 + (key >> 4)) * 1024 + (key & 15) * 64 + (dc & 3) * 16; }

ADI void qk_tile(f32x16& p0, f32x16& p1, lptr kimg, const bf16x8 (&qr)[4], int r32, int hi) {
#pragma unroll
  for (int d0 = 0; d0 < 4; ++d0) {
    const bf16x8 b0 = *(const ATT_LAS bf16x8*)(kimg + (2 * d0 + hi) * 1024 + r32 * 16);
    const bf16x8 b1 = *(const ATT_LAS bf16x8*)(kimg + (2 * d0 + hi) * 1024 + r32 * 16 + 512);
    p0 = __builtin_amdgcn_mfma_f32_32x32x16_bf16(b0, qr[d0], p0, 0, 0, 0);
    p1 = __builtin_amdgcn_mfma_f32_32x32x16_bf16(b1, qr[d0], p1, 0, 0, 0);
  }
}
template <int NO> ADI void softmax_step(f32x16& p0, f32x16& p1, float& m, float& l, f32x16 (&o)[NO]) {
  float mx = fmaxf(p0[0], p1[0]);
#pragma unroll
  for (int r = 1; r < 16; ++r) mx = fmaxf(mx, fmaxf(p0[r], p1[r]));
  mx = swapmax(mx);
  const float mn = fmaxf(m, mx), alpha = __builtin_amdgcn_exp2f(m - mn); m = mn;
  float ps = 0.f;
#pragma unroll
  for (int r = 0; r < 16; ++r) { p0[r] = __builtin_amdgcn_exp2f(p0[r] - mn); p1[r] = __builtin_amdgcn_exp2f(p1[r] - mn); ps += p0[r] + p1[r]; }
  ps = swapsum(ps); l = l * alpha + ps;
  if (!__all(alpha == 1.0f)) {
#pragma unroll
    for (int i = 0; i < NO; ++i) o[i] *= alpha;
  }
}
ADI s16x4 vtr(lptr p) { return __builtin_bit_cast(s16x4, __builtin_amdgcn_ds_read_tr16_b64_v4i16((ATT_LAS v4i16_t*)p)); }
template <int NDH> ADI void pv_tile(f32x16 (&o)[NDH], lptr vimg, const f32x16& p0, const f32x16& p1, int lane) {
  bf16x8 pf[4];
  { u32x4 w;
    w.x = cvtpk(p0[0], p0[1]); w.y = cvtpk(p0[2], p0[3]); w.z = cvtpk(p0[4], p0[5]); w.w = cvtpk(p0[6], p0[7]); pf[0] = __builtin_bit_cast(bf16x8, w);
    w.x = cvtpk(p0[8], p0[9]); w.y = cvtpk(p0[10], p0[11]); w.z = cvtpk(p0[12], p0[13]); w.w = cvtpk(p0[14], p0[15]); pf[1] = __builtin_bit_cast(bf16x8, w);
    w.x = cvtpk(p1[0], p1[1]); w.y = cvtpk(p1[2], p1[3]); w.z = cvtpk(p1[4], p1[5]); w.w = cvtpk(p1[6], p1[7]); pf[2] = __builtin_bit_cast(bf16x8, w);
    w.x = cvtpk(p1[8], p1[9]); w.y = cvtpk(p1[10], p1[11]); w.z = cvtpk(p1[12], p1[13]); w.w = cvtpk(p1[14], p1[15]); pf[3] = __builtin_bit_cast(bf16x8, w); }
  const int vb = ((lane >> 4) & 1) * 32 + (lane & 3) * 8 + (4 * (lane >> 5) + ((lane & 15) >> 2)) * 64;
#pragma unroll
  for (int dh = 0; dh < NDH; ++dh) {
#pragma unroll
    for (int kg = 0; kg < 4; ++kg) {
      lptr p = vimg + (dh >> 1) * 8192 + ((dh & 1) * 4 + kg) * 1024 + vb;
      const s16x4 lo = vtr(p), hi = vtr(p + 512);
      const bf16x8 vf = {lo[0], lo[1], lo[2], lo[3], hi[0], hi[1], hi[2], hi[3]};
      o[dh] = __builtin_amdgcn_mfma_f32_32x32x16_bf16(vf, pf[kg], o[dh], 0, 0, 0);
    }
  }
}
template <int NDH> ADI void store_o(bf16_t* orow, const f32x16 (&o)[NDH], float sc, int hi) {
#pragma unroll
  for (int dh = 0; dh < NDH; ++dh)
#pragma unroll
    for (int g = 0; g < 4; ++g) { u32x2 w; w.x = cvtpk(o[dh][4 * g] * sc, o[dh][4 * g + 1] * sc); w.y = cvtpk(o[dh][4 * g + 2] * sc, o[dh][4 * g + 3] * sc);
      *(ATT_GAS u32x2*)(orow + 32 * dh + 8 * g + 4 * hi) = w; }
}

ADI void glds16(const void* gsrc, unsigned lds_dst) { unsigned keep;
  asm volatile("s_mov_b32 %0, m0\n\ts_mov_b32 m0, %2\n\ts_nop 0\n\tglobal_load_lds_dwordx4 %1, off\n\ts_mov_b32 m0, %0" : "=&s"(keep) : "v"(gsrc), "s"(lds_dst) : "memory"); }
ADI void glds4(const void* gsrc, unsigned lds_dst) { unsigned keep;
  asm volatile("s_mov_b32 %0, m0\n\ts_mov_b32 m0, %2\n\ts_nop 0\n\tglobal_load_lds_dword %1, off\n\ts_mov_b32 m0, %0" : "=&s"(keep) : "v"(gsrc), "s"(lds_dst) : "memory"); }
template <int N> ADI void wait_bar() { asm volatile("s_waitcnt vmcnt(%0) lgkmcnt(0)\n\ts_barrier" :: "n"(N) : "memory"); }
#define MX3(a, b, c) __builtin_fmaxf(__builtin_fmaxf((a), (b)), (c))
constexpr float THR = 8.0f;
template <int NO> ADI void sm_decide(f32x16& c0, f32x16& c1, float& mref, float& l, f32x16 (&o)[NO]) {
  float a = MX3(c0[0], c0[1], c1[0]), b = MX3(c0[2], c0[3], c1[1]); a = MX3(a, c1[2], c1[3]);
#pragma unroll
  for (int r = 4; r < 16; r += 4) { a = MX3(a, c0[r], c0[r + 1]); b = MX3(b, c0[r + 2], c0[r + 3]); a = MX3(a, c1[r], c1[r + 1]); b = MX3(b, c1[r + 2], c1[r + 3]); }
  const float rm = swapmax(fmaxf(a, b));
  if (__builtin_expect(__any(rm > THR), 0)) {
    const float dl = fmaxf(rm, 0.f), f = __builtin_amdgcn_exp2f(-dl);
    mref += dl; l *= f;
#pragma unroll
    for (int r = 0; r < 16; ++r) { c0[r] -= dl; c1[r] -= dl; }
#pragma unroll
    for (int i = 0; i < NO; ++i) o[i] *= f;
  }
}
ADI void sm_exp_sum(f32x16& c0, f32x16& c1, float& l) {
  float s0 = 0.f, s1 = 0.f;
#pragma unroll
  for (int r = 0; r < 16; ++r) { c0[r] = __builtin_amdgcn_exp2f(c0[r]); c1[r] = __builtin_amdgcn_exp2f(c1[r]); s0 += c0[r]; s1 += c1[r]; }
  l += s0 + s1;
}

struct UnitArgs {
  const bf16_t* Q; int ldq; const bf16_t* K; const bf16_t* V; int ldkv; bf16_t* O; int ldo;
  int q0;
  int t0, t1;
  const float* relb;
  const unsigned* mask;
  bool nomask;
};
template <int MODE> ADI void attn_unit(lptr lds, const UnitArgs& a, int tid_in) {
  int tid_l = tid_in; asm volatile("" : "+v"(tid_l));
  const int tid = tid_l, lane = tid & 63, r32 = lane & 31, hi = lane >> 5, w = __builtin_amdgcn_readfirstlane(tid >> 6);
  constexpr int SLOT = 16384, P = (MODE == 1) ? 3 : 2;
  constexpr int MSK_OFF = 4 * SLOT, TAB_OFF = MSK_OFF + 4 * 2048;
  const unsigned lds0 = (unsigned)(size_t)lds;
  ATT_LAS float* tab = (ATT_LAS float*)(lds + TAB_OFF);
  if (MODE == 0) { for (int i = tid; i < 320; i += 512) tab[i] = ((const ATT_GAS float*)a.relb)[i] * LOG2E; }
  const int qloc = a.q0 + 32 * w + r32;
  const int cq = (a.q0 + 32 * w) >> 6;
  bf16x8 qr[4];
  { const bf16_t* qp = a.Q + (size_t)qloc * a.ldq + 8 * hi;
#pragma unroll
    for (int d0 = 0; d0 < 4; ++d0) qr[d0] = __builtin_bit_cast(bf16x8, ldg16(qp + 16 * d0)); }
  const bf16_t* ksrc = a.K + (size_t)lane * a.ldkv + w * 8;
  const bf16_t* vsrc = a.V + (size_t)(16 * (w & 3) + (lane >> 2)) * a.ldkv + (w >> 2) * 32 + (lane & 3) * 8;
  const unsigned* msrc = a.mask + (size_t)(a.q0 + 32 * w) * 2 + lane;
  const size_t tstep = (size_t)64 * a.ldkv;
#define ATT_DMA(t) do { const unsigned sb_ = lds0 + (unsigned)(((t) & 3) * SLOT + w * 1024); \
    glds16(ksrc + (size_t)(t) * tstep, (unsigned)__builtin_amdgcn_readfirstlane(sb_)); glds16(vsrc + (size_t)(t) * tstep, (unsigned)__builtin_amdgcn_readfirstlane(sb_ + 8192u)); \
    if (MODE == 1) glds4(msrc + (size_t)(t) * 8192, (unsigned)__builtin_amdgcn_readfirstlane(lds0 + (unsigned)(MSK_OFF + ((t) & 3) * 2048 + w * 256))); } while (0)
#define ATT_ACTIVE(t) ((MODE == 0) ? ((t) <= cq && (t) + 8 >= cq) : (MODE == 1) ? ((t) <= cq) : true)
#define ATT_INIT(P0, P1, t) do { if (MODE == 0) { const int dch_ = cq - (t); \
      if (dch_ >= 5) { const float c_ = tab[319] - mref; P0 = splat16(c_); P1 = splat16(c_); } \
      else { const int base_ = 64 * dch_ + (qloc & 63) + 63; \
        _Pragma("unroll") for (int r = 0; r < 16; ++r) { const int i0 = base_ - crow(r, hi); P0[r] = tab[i0 < 319 ? i0 : 319] - mref; const int i1 = i0 - 32; P1[r] = tab[i1 < 319 ? i1 : 319] - mref; } } \
    } else { P0 = splat16(-mref); P1 = splat16(-mref); } } while (0)
#define ATT_MASK(P0, P1, t) do { if (MODE == 1) { if (!a.nomask) { const unsigned mw_ = *(const ATT_LAS unsigned*)(lds + MSK_OFF + ((t) & 3) * 2048 + w * 256 + (r32 * 2 + hi) * 4); \
      _Pragma("unroll") for (int r = 0; r < 16; ++r) { P0[r] = ((int)(mw_ << (31 - r)) < 0) ? P0[r] : -INFINITY; P1[r] = ((int)(mw_ << (15 - r)) < 0) ? P1[r] : -INFINITY; } } } } while (0)
  float mref = 0.f, l = 0.f; f32x16 o[2]; o[0] = splat16(0.f); o[1] = splat16(0.f);
  ATT_DMA(a.t0); if (a.t0 + 1 <= a.t1) ATT_DMA(a.t0 + 1); if (a.t0 + 2 <= a.t1) ATT_DMA(a.t0 + 2);
  wait_bar<0>();
  f32x16 c0 = splat16(0.f), c1 = splat16(0.f);
  bool act_cur = ATT_ACTIVE(a.t0);
  if (act_cur) { ATT_INIT(c0, c1, a.t0); qk_tile(c0, c1, lds + (a.t0 & 3) * SLOT, qr, r32, hi); }
  for (int t = a.t0; t <= a.t1; ++t) {
    if (t > a.t0) { if (t + 2 <= a.t1) wait_bar<P>(); else wait_bar<0>(); }
    if (t + 3 <= a.t1) ATT_DMA(t + 3);
    const bool act_next = (t + 1 <= a.t1) && ATT_ACTIVE(t + 1);
    f32x16 n0 = splat16(0.f), n1 = splat16(0.f);
    lptr slot_c = lds + (t & 3) * SLOT, slot_n = lds + ((t + 1) & 3) * SLOT;
    if (act_cur && act_next) {
      ATT_MASK(c0, c1, t);
      sm_decide<2>(c0, c1, mref, l, o);
      ATT_INIT(n0, n1, t + 1);
      qk_tile(n0, n1, slot_n, qr, r32, hi);
      sm_exp_sum(c0, c1, l);
      pv_tile<2>(o, slot_c + 8192, c0, c1, lane);
    } else if (act_cur) {
      ATT_MASK(c0, c1, t);
      sm_decide<2>(c0, c1, mref, l, o);
      sm_exp_sum(c0, c1, l);
      pv_tile<2>(o, slot_c + 8192, c0, c1, lane);
    } else if (act_next) {
      ATT_INIT(n0, n1, t + 1);
      qk_tile(n0, n1, slot_n, qr, r32, hi);
    }
    c0 = n0; c1 = n1; act_cur = act_next;
  }
  asm volatile("s_waitcnt lgkmcnt(0)\n\ts_barrier" ::: "memory");
  l = swapsum(l);
  store_o<2>(a.O + (size_t)qloc * a.ldo, o, __builtin_amdgcn_rcpf(l), hi);
#undef ATT_DMA
#undef ATT_ACTIVE
#undef ATT_INIT
#undef ATT_MASK
}

constexpr int TOPK = 256;
ADI void idx_kload(const bf16_t* ki0, int s, unsigned loff, bf16x8 (&kf)[4]) {
  const ATT_GAS char* bs = (const ATT_GAS char*)(ki0 + (size_t)s * (32 * 256));
#pragma unroll
  for (int d0 = 0; d0 < 4; ++d0) kf[d0] = __builtin_bit_cast(bf16x8, *(const ATT_GAS u32x4*)(bs + (loff + 32u * d0)));
}
ADI void idx_park(unsigned* kscr, int s, int lane, const unsigned (&u)[16]) {
  ATT_GAS u32x4* p = (ATT_GAS u32x4*)(kscr + (size_t)s * 1024) + lane;
#pragma unroll
  for (int j = 0; j < 4; ++j) { u32x4 v = {u[4 * j], u[4 * j + 1], u[4 * j + 2], u[4 * j + 3]}; p[64 * j] = v; }
}
ADI void idx_fetch(const unsigned* kscr, int s, int lane, unsigned (&u)[16]) {
  const ATT_GAS u32x4* p = (const ATT_GAS u32x4*)(kscr + (size_t)s * 1024) + lane;
#pragma unroll
  for (int j = 0; j < 4; ++j) { const u32x4 v = p[64 * j]; u[4 * j] = v.x; u[4 * j + 1] = v.y; u[4 * j + 2] = v.z; u[4 * j + 3] = v.w; }
}
ADI void idx_scores2(const bf16x8 (&kA)[4], const bf16x8 (&kB)[4], lptr qimg, const float (&wv)[4], unsigned (&uA)[16], unsigned (&uB)[16], unsigned zA, unsigned zB) {
  float sA[16], sB[16];
#pragma unroll
  for (int hp = 0; hp < 2; ++hp) {
    bf16x8 q0[4], q1[4];
#pragma unroll
    for (int d0 = 0; d0 < 4; ++d0) { q0[d0] = *(const ATT_LAS bf16x8*)(qimg + ((2 * hp) * 4 + d0) * 1024); q1[d0] = *(const ATT_LAS bf16x8*)(qimg + ((2 * hp + 1) * 4 + d0) * 1024); }
    f32x16 a0 = splat16(0.f), a1 = splat16(0.f), b0 = splat16(0.f), b1 = splat16(0.f);
#pragma unroll
    for (int d0 = 0; d0 < 4; ++d0) {
      a0 = __builtin_amdgcn_mfma_f32_32x32x16_bf16(kA[d0], q0[d0], a0, 0, 0, 0); b0 = __builtin_amdgcn_mfma_f32_32x32x16_bf16(kB[d0], q0[d0], b0, 0, 0, 0);
      a1 = __builtin_amdgcn_mfma_f32_32x32x16_bf16(kA[d0], q1[d0], a1, 0, 0, 0); b1 = __builtin_amdgcn_mfma_f32_32x32x16_bf16(kB[d0], q1[d0], b1, 0, 0, 0); }
#pragma unroll
    for (int r = 0; r < 16; ++r) {
      const float ra0 = __int_as_float(max(__float_as_int(a0[r]), 0)), ra1 = __int_as_float(max(__float_as_int(a1[r]), 0));
      const float rb0 = __int_as_float(max(__float_as_int(b0[r]), 0)), rb1 = __int_as_float(max(__float_as_int(b1[r]), 0));
      sA[r] = __builtin_fmaf(ra0, wv[2 * hp], hp == 0 ? 0.0f : sA[r]); sA[r] = __builtin_fmaf(ra1, wv[2 * hp + 1], sA[r]);
      sB[r] = __builtin_fmaf(rb0, wv[2 * hp], hp == 0 ? 0.0f : sB[r]); sB[r] = __builtin_fmaf(rb1, wv[2 * hp + 1], sB[r]);
    }
  }
#pragma unroll
  for (int r = 0; r < 16; ++r) {
    const unsigned ba = __float_as_uint(sA[r]), bb = __float_as_uint(sB[r]);
    const unsigned kk = (unsigned)(((r & 3) + 8 * (r >> 2)) << 11);
    unsigned ka = ((int)ba < 0) ? ~ba : ba + 0x80800000u, kb = ((int)bb < 0) ? ~bb : bb + 0x80800000u;
    uA[r] = (ba == 0u) ? zA - kk : ka; uB[r] = (bb == 0u) ? zB - kk : kb;
  }
}
ADI unsigned wave_excl_scan(unsigned v, int lane) {
  unsigned x = v;
#pragma unroll
  for (int d = 1; d < 64; d <<= 1) { const unsigned t = __shfl_up(x, d); if (lane >= d) x += t; }
  return x - v;
}
#define IDX_DPP_SHR(x, n) ((unsigned)__builtin_amdgcn_update_dpp(0, (int)(x), 0x110 + (n), 0xf, 0xf, true))
ADI void hist_scan4(ATT_LAS unsigned* hist, ATT_LAS unsigned* res, int w, int lane_in) {
  int lane = lane_in; asm volatile("" : "+v"(lane));
  const int rho = lane >> 4, q = 4 * w + rho, li = lane & 15;
  const unsigned k = res[q * 4 + 1];
  ATT_LAS unsigned* hq = hist + q * 1024;
  const int p0 = 1023 - 64 * li;
  unsigned T = 0;
#pragma unroll 16
  for (int t = 0; t < 64; ++t) { const unsigned o = (unsigned)(t + 4 * li + rho) & 63u; const unsigned wd = hq[(unsigned)(p0 - (int)o) ^ (unsigned)q]; T += (wd & 0xffffu) + (wd >> 16); }
  unsigned x = T;
  x += IDX_DPP_SHR(x, 1); x += IDX_DPP_SHR(x, 2); x += IDX_DPP_SHR(x, 4); x += IDX_DPP_SHR(x, 8);
  const unsigned E = x - T;
  if (E < k && k <= E + T) { res[q * 4 + 3] = (unsigned)p0; res[q * 4 + 2] = E; }
  asm volatile("s_waitcnt lgkmcnt(0)" ::: "memory");
  const int pL = (int)res[q * 4 + 3]; const unsigned EL = res[q * 4 + 2];
  unsigned wd4[4]; unsigned s4 = 0;
#pragma unroll
  for (int j = 0; j < 4; ++j) { wd4[j] = hq[(unsigned)(pL - 4 * li - j) ^ (unsigned)q]; s4 += (wd4[j] & 0xffffu) + (wd4[j] >> 16); }
  unsigned y = s4;
  y += IDX_DPP_SHR(y, 1); y += IDX_DPP_SHR(y, 2); y += IDX_DPP_SHR(y, 4); y += IDX_DPP_SHR(y, 8);
  const unsigned E2 = EL + (y - s4);
  asm volatile("s_waitcnt lgkmcnt(0)" ::: "memory");
  if (E2 < k && k <= E2 + s4) {
    unsigned cum = E2, fbin = 0, frem = 0, fcnt = 0;
#pragma unroll
    for (int j = 0; j < 4; ++j) {
      const unsigned p = (unsigned)(pL - 4 * li - j), chi = wd4[j] >> 16, clo = wd4[j] & 0xffffu;
      if (cum < k && k <= cum + chi) { fbin = 2 * p + 1; frem = k - cum; fcnt = chi; }
      cum += chi;
      if (cum < k && k <= cum + clo) { fbin = 2 * p; frem = k - cum; fcnt = clo; }
      cum += clo;
    }
    res[q * 4 + 0] = fbin; res[q * 4 + 1] = frem; res[q * 4 + 2] = fcnt;
  }
}
#define IDX_PREF0() do { if (w < NS) { idx_kload(KI, w, loff, kA_); idx_kload(KI, (w + 8 < NS) ? w + 8 : w, loff, kB_); } } while (0)
#define IDX_LOOP0(BODY) do { \
    for (int s_ = w; s_ < NS; s_ += 16) { const bool hb_ = s_ + 8 < NS; \
      unsigned pA_[16], pB_[16]; { const unsigned zA_ = 0x80000000u + ((4095u - 32u * (unsigned)s_ - 4u * (unsigned)hi) << 11); idx_scores2(kA_, kB_, qimg, wv, pA_, pB_, zA_, zA_ - (256u << 11)); } \
      if (s_ + 16 < NS) { idx_kload(KI, s_ + 16, loff, kA_); idx_kload(KI, (s_ + 24 < NS) ? s_ + 24 : s_ + 16, loff, kB_); } \
      { unsigned (&u)[16] = pA_; idx_park(kscr, s_, lane, u); BODY(s_); } \
      if (hb_) { unsigned (&u)[16] = pB_; idx_park(kscr, s_ + 8, lane, u); BODY(s_ + 8); } } } while (0)
#define IDX_SWEEP0(BODY) do { IDX_PREF0(); IDX_LOOP0(BODY); } while (0)
#define IDX_PREF() do { if (w < NS) idx_fetch(kscr, w, lane, uA_); if (w + 8 < NS) idx_fetch(kscr, w + 8, lane, uB_); if (w + 16 < NS) idx_fetch(kscr, w + 16, lane, uC_); } while (0)
#define IDX_LOOP(BODY) do { \
    for (int s_ = w; s_ < NS; s_ += 32) { \
      if (s_ + 24 < NS) idx_fetch(kscr, s_ + 24, lane, uD_); { unsigned (&u)[16] = uA_; BODY(s_); } \
      if (s_ + 8 < NS) { if (s_ + 32 < NS) idx_fetch(kscr, s_ + 32, lane, uA_); unsigned (&u)[16] = uB_; BODY(s_ + 8); } \
      if (s_ + 16 < NS) { if (s_ + 40 < NS) idx_fetch(kscr, s_ + 40, lane, uB_); unsigned (&u)[16] = uC_; BODY(s_ + 16); } \
      if (s_ + 24 < NS) { if (s_ + 48 < NS) idx_fetch(kscr, s_ + 48, lane, uC_); unsigned (&u)[16] = uD_; BODY(s_ + 24); } } } while (0)
#define IDX_SWEEP(BODY) do { IDX_PREF(); IDX_LOOP(BODY); } while (0)
#define IDX_ADD(bin) do { unsigned sh_; asm("v_mad_u32_u24 %0, %1, %2, 1" : "=v"(sh_) : "v"((bin) & 1u), "s"(c16_));   \
    __hip_atomic_fetch_add(hist + r32 * 1024 + (((bin) >> 1) ^ (unsigned)r32), sh_, __ATOMIC_RELAXED, __HIP_MEMORY_SCOPE_WORKGROUP); \
    if (IDX_PROBE_DUP) __hip_atomic_fetch_add((ATT_LAS unsigned*)(lds + 148736) + (r32 * 32 + ((((bin) >> 1) ^ (unsigned)r32) & 31u)), sh_, __ATOMIC_RELAXED, __HIP_MEMORY_SCOPE_WORKGROUP); } while (0)
#ifndef IDX_PROBE_DUP
#define IDX_PROBE_DUP 0
#endif
#ifndef IDX_PROBE_P0
#define IDX_PROBE_P0 0
#endif
#ifndef IDX_PROBE_SCAN
#define IDX_PROBE_SCAN 0
#endif
#ifndef IDX_PROBE_P1
#define IDX_PROBE_P1 0
#endif
constexpr int IDX_QOFF = 132352;
constexpr unsigned IDX_CAP = 16;
ADI void idx_unit(lptr lds, const bf16_t* QI, const bf16_t* KI, unsigned short* mask16, unsigned* kscr, int n, int half, int tid_in) {
  int tid_l = tid_in; asm volatile("" : "+v"(tid_l));
#define IDX_BAR() do { asm volatile("s_waitcnt lgkmcnt(0)" ::: "memory"); __builtin_amdgcn_s_barrier(); asm volatile("" ::: "memory"); } while (0)
  const int tid = tid_l, lane = tid & 63, r32 = lane & 31, hi = lane >> 5, w = __builtin_amdgcn_readfirstlane(tid >> 6);
  ATT_LAS unsigned* hist = (ATT_LAS unsigned*)lds;
  ATT_LAS unsigned* res = (ATT_LAS unsigned*)(lds + 131072);
  const int qpos = 64 * n + 32 * half + r32;
  const int NS = 2 * (n + 1);
  const unsigned loff = (unsigned)(r32 * 512 + hi * 16);
  unsigned uA_[16], uB_[16], uC_[16], uD_[16]; bf16x8 kA_[4], kB_[4];
  IDX_PREF0();
  u32x4 qst_[2];
  { const int q0row = 64 * n + 32 * half;
#pragma unroll
    for (int i = 0; i < 2; ++i) { const int p = tid + 512 * i, q = p >> 5, c16 = p & 31; qst_[i] = ldg16(QI + (size_t)(q0row + q) * 256 + c16 * 8); } }
  lptr qimg = lds + IDX_QOFF + hi * 512 + r32 * 16;
  float wv[4];
  { const u32x2 ww = *(const ATT_GAS u32x2*)(KI + (size_t)qpos * 256 + 64);
    wv[0] = __uint_as_float(ww.x << 16) * 0.0625f; wv[1] = __uint_as_float(ww.x & 0xffff0000u) * 0.0625f; wv[2] = __uint_as_float(ww.y << 16) * 0.0625f; wv[3] = __uint_as_float(ww.y & 0xffff0000u) * 0.0625f; }
  const unsigned moff = (unsigned)(qpos * 8 + hi * 4);
  if (tid < 32) res[tid * 4 + 1] = TOPK;
  if (tid == 32 || tid == 33) res[128 + (tid - 32)] = 0u;
  unsigned pre = 0u, thr = 0u, cut = 0xffffu; bool needtie = false;
  unsigned c16_ = 0xffffu; asm volatile("" : "+s"(c16_));
#define IDX_ZERO() do { const u32x4 z_ = {0u, 0u, 0u, 0u}; _Pragma("unroll") for (int i = 0; i < 16; ++i) *(ATT_LAS u32x4*)(lds + (size_t)(i * 512 + tid) * 16) = z_; IDX_BAR(); } while (0)
#define IDX_SCAN() do { IDX_BAR(); hist_scan4(hist, res, w, lane); IDX_BAR(); } while (0)
  { const u32x4 z_ = {0u, 0u, 0u, 0u};
#pragma unroll
    for (int i = 0; i < 16; ++i) *(ATT_LAS u32x4*)(lds + (size_t)(i * 512 + tid) * 16) = z_;
#pragma unroll
    for (int i = 0; i < 2; ++i) { const int p = tid + 512 * i, q = p >> 5, c16 = p & 31; *(ATT_LAS u32x4*)(lds + IDX_QOFF + c16 * 512 + q * 16) = qst_[i]; }
    IDX_BAR(); }
#define IDX_B0(s) do { _Pragma("unroll") for (int r = 0; r < 16; ++r) IDX_ADD(u[r] >> 21); } while (0)
#define IDX_B0_(s) IDX_B0(s)
#if IDX_PROBE_P0
  { IDX_SWEEP0(IDX_B0_); IDX_BAR(); IDX_ZERO(); }
#endif
  IDX_LOOP0(IDX_B0);
#if IDX_PROBE_SCAN
  { ATT_LAS unsigned* res2 = (ATT_LAS unsigned*)(lds + 149760); if (tid < 32) res2[tid * 4 + 1] = TOPK; IDX_BAR(); hist_scan4(hist, res2, w, lane); IDX_BAR(); }
#endif
  IDX_BAR();
  IDX_PREF();
  hist_scan4(hist, res, w, lane); IDX_BAR();
  pre = res[r32 * 4 + 0];
  IDX_ZERO();
#define IDX_B1D(s) do { _Pragma("unroll") for (int r = 0; r < 16; ++r) { if ((u[r] >> 21) == pre) __hip_atomic_fetch_add((ATT_LAS unsigned*)(lds + 148736) + (r32 * 32 + (((u[r] >> 11) ^ (unsigned)r32) & 31u)), 1u, __ATOMIC_RELAXED, __HIP_MEMORY_SCOPE_WORKGROUP); } } while (0)
#define IDX_B1(s) do { _Pragma("unroll") for (int r = 0; r < 16; ++r) { if ((u[r] >> 21) == pre) IDX_ADD((u[r] >> 10) & 2047u); } } while (0)
#if IDX_PROBE_P1
  { IDX_SWEEP(IDX_B1D); IDX_BAR(); }
#endif
  IDX_LOOP(IDX_B1);
  IDX_PREF();
  IDX_SCAN();
  unsigned krem;
  { const unsigned fbin = res[r32 * 4 + 0], fcnt = res[r32 * 4 + 2]; krem = res[r32 * 4 + 1]; pre = (pre << 11) | fbin; if (fcnt > IDX_CAP) res[129] = 1u; }
  IDX_BAR();
  if (res[129] == 0u) {
    ATT_LAS unsigned* cand = (ATT_LAS unsigned*)lds;
    ATT_LAS unsigned* ccnt = (ATT_LAS unsigned*)(lds + 4096);
    if (tid < 32) ccnt[tid] = 0u;
    IDX_BAR();
#define IDX_BM(s) do { unsigned bits_ = 0u; _Pragma("unroll") for (int r = 15; r >= 0; --r) { const unsigned p_ = u[r] >> 10; bits_ = (bits_ << 1) | (p_ > pre ? 1u : 0u); \
        if (p_ == pre) { const unsigned pos_ = __hip_atomic_fetch_add(ccnt + r32, 1u, __ATOMIC_RELAXED, __HIP_MEMORY_SCOPE_WORKGROUP); cand[r32 * IDX_CAP + (pos_ & (IDX_CAP - 1))] = ((u[r] & 1023u) << 12) | (4095u - (unsigned)(32 * (s) + crow(r, hi))); } } \
      *(ATT_GAS unsigned short*)((ATT_GAS char*)(mask16 + (size_t)((s) >> 1) * 16384 + ((s) & 1)) + moff) = (unsigned short)bits_; } while (0)
    IDX_LOOP(IDX_BM);
    asm volatile("s_waitcnt vmcnt(0)" ::: "memory");
    IDX_BAR();
    if (tid < 32) {
      const unsigned q = (unsigned)tid, cnt = ccnt[q], need = res[q * 4 + 1];
      const int qp = 64 * n + 32 * half + (int)q;
      for (unsigned j = 0; j < need && j < cnt; ++j) {
        unsigned best = 0u, bi = 0u;
        for (unsigned i = 0; i < cnt; ++i) { const unsigned c = cand[q * IDX_CAP + i]; if (c >= best) { best = c; bi = i; } }
        cand[q * IDX_CAP + bi] = 0u;
        if (j + 1 == need || true) { const unsigned kidx = 4095u - (best & 4095u), s2 = kidx >> 5, wi = kidx & 31u, hc = (wi >> 2) & 1u, rr = (wi & 3u) + 4u * (wi >> 3);
          __hip_atomic_fetch_or((ATT_GAS unsigned*)mask16 + (((size_t)(s2 >> 1) * 4096 + qp) * 2 + hc), 1u << (16u * (s2 & 1u) + rr), __ATOMIC_RELAXED, __HIP_MEMORY_SCOPE_AGENT); }
      }
    }
    (void)krem;
  } else {
    IDX_ZERO();
#define IDX_B2(s) do { _Pragma("unroll") for (int r = 0; r < 16; ++r) { if ((u[r] >> 10) == pre) IDX_ADD(u[r] & 1023u); } } while (0)
    IDX_LOOP(IDX_B2);
    IDX_SCAN();
    { const unsigned fbin = res[r32 * 4 + 0], frem = res[r32 * 4 + 1], fcnt = res[r32 * 4 + 2]; thr = (pre << 10) | fbin; needtie = frem < fcnt; if (needtie) res[128] = 1u; }
    IDX_BAR();
    if (res[128] != 0u) {
      IDX_ZERO();
#define IDX_B3(s) do { _Pragma("unroll") for (int r = 0; r < 16; ++r) { if (u[r] == thr) IDX_ADD(2047u - (unsigned)((32 * (s) + crow(r, hi)) >> 1)); } } while (0)
      IDX_SWEEP(IDX_B3);
      IDX_SCAN();
      { const unsigned fbin = res[r32 * 4 + 0], frem = res[r32 * 4 + 1], fcnt = res[r32 * 4 + 2]; const unsigned bt = 2047u - fbin; if (needtie) cut = (frem == 1u && fcnt == 2u) ? 2u * bt : 2u * bt + 1u; }
      IDX_BAR();
    }
#define IDX_BS(s) do { unsigned bits_ = 0u; _Pragma("unroll") for (int r = 15; r >= 0; --r) { const unsigned kidx_ = (unsigned)(32 * (s) + crow(r, hi)); const bool sel_ = (u[r] > thr) || (u[r] == thr && kidx_ <= cut); bits_ = (bits_ << 1) | (sel_ ? 1u : 0u); } \
      *(ATT_GAS unsigned short*)((ATT_GAS char*)(mask16 + (size_t)((s) >> 1) * 16384 + ((s) & 1)) + moff) = (unsigned short)bits_; } while (0)
    IDX_SWEEP(IDX_BS);
  }
#undef IDX_BAR
#undef IDX_ZERO
#undef IDX_SCAN
#undef IDX_B0
#undef IDX_B1
#undef IDX_B2
#undef IDX_B3
#undef IDX_BM
#undef IDX_BS
}
#undef IDX_SWEEP
#undef IDX_SWEEP0
#undef IDX_PREF
#undef IDX_PREF0
#undef IDX_LOOP
#undef IDX_LOOP0
#undef IDX_ADD
}

namespace attx {
using bf16=__hip_bfloat16;
using bf16x8=__attribute__((ext_vector_type(8)))short;
using s16x4=__attribute__((ext_vector_type(4)))short;
using f32x16=__attribute__((ext_vector_type(16)))float;
using u32x4=__attribute__((ext_vector_type(4)))unsigned;
using f32x4v=__attribute__((ext_vector_type(4)))float;
constexpr int D=64,NW=8,QBLK=32,QB=QBLK*NW,KVBLK=64;
__device__ __forceinline__ int crow(int r,int hi){return (r&3)+8*(r>>2)+4*hi;}
#define SBAR() __builtin_amdgcn_sched_barrier(0)
constexpr int NSLOT=3, SLOTB=8192;
constexpr int LDS_K=0, LDS_V=NSLOT*SLOTB, LDS_WS=2*NSLOT*SLOTB, LDS_OST=LDS_WS+NW*64*4, LDS_MSK=LDS_OST+NW*4096, LDS_TAB=LDS_MSK+4*2048, LDS_BYTES=LDS_TAB+384*4;
__device__ __forceinline__ void glds16(const void*gsrc,unsigned lds_dst){unsigned keep;
  asm volatile("s_mov_b32 %0, m0\n\ts_mov_b32 m0, %2\n\ts_nop 0\n\tglobal_load_lds_dwordx4 %1, off\n\ts_mov_b32 m0, %0":"=&s"(keep):"v"(gsrc),"s"(lds_dst):"memory");}
__device__ __forceinline__ void glds4(const void*gsrc,unsigned lds_dst){unsigned keep;
  asm volatile("s_mov_b32 %0, m0\n\ts_mov_b32 m0, %2\n\ts_nop 0\n\tglobal_load_lds_dword %1, off\n\ts_mov_b32 m0, %0":"=&s"(keep):"v"(gsrc),"s"(lds_dst):"memory");}
__device__ __forceinline__ float max3f(float a,float b,float c){float r;asm("v_max3_f32 %0, %1, %2, %3":"=v"(r):"v"(a),"v"(b),"v"(c));return r;}
__device__ __forceinline__ float max2f(float a,float b){float r;asm("v_max_f32_e32 %0, %1, %2":"=v"(r):"v"(a),"v"(b));return r;}
__device__ __forceinline__ float fadd_s(float a,float b){float r;asm("v_add_f32_e32 %0, %1, %2":"=v"(r):"v"(a),"v"(b));return r;}
__device__ __forceinline__ float fsub_s(float a,float b){float r;asm("v_sub_f32_e32 %0, %1, %2":"=v"(r):"v"(a),"v"(b));return r;}
typedef float f32x2_t __attribute__((ext_vector_type(2))); typedef __bf16 bf16x2_t __attribute__((ext_vector_type(2)));
__device__ __forceinline__ unsigned cvtpk_s(float lo,float hi){f32x2_t v={lo,hi};bf16x2_t b=__builtin_convertvector(v,bf16x2_t);return __builtin_bit_cast(unsigned,b);}
#define WAIT_BAR(N) asm volatile("s_waitcnt vmcnt(" #N ") lgkmcnt(0)\n\ts_barrier":::"memory")
__device__ __forceinline__ void qkt(f32x16&p0,f32x16&p1,const char*Kslot,const bf16x8*qr,const f32x16&negm,int r32,int hi){
  const char*kb=Kslot+hi*1024+r32*16;
  #pragma unroll
  for(int d0=0;d0<4;++d0){
    const bf16x8 b0=*reinterpret_cast<const bf16x8*>(kb+d0*2048);
    const bf16x8 b1=*reinterpret_cast<const bf16x8*>(kb+d0*2048+512);
    if(d0==0){p0=__builtin_amdgcn_mfma_f32_32x32x16_bf16(b0,qr[0],negm,0,0,0);p1=__builtin_amdgcn_mfma_f32_32x32x16_bf16(b1,qr[0],negm,0,0,0);}
    else{p0=__builtin_amdgcn_mfma_f32_32x32x16_bf16(b0,qr[d0],p0,0,0,0);p1=__builtin_amdgcn_mfma_f32_32x32x16_bf16(b1,qr[d0],p1,0,0,0);}}
}
typedef __attribute__((address_space(3))) const char* lds_cptr;
typedef short v4i16_t __attribute__((ext_vector_type(4)));
__device__ __forceinline__ void kload8(bf16x8*kf,lds_cptr kp){
  kf[0]=*(const __attribute__((address_space(3))) bf16x8*)(kp);      kf[1]=*(const __attribute__((address_space(3))) bf16x8*)(kp+512);
  kf[2]=*(const __attribute__((address_space(3))) bf16x8*)(kp+2048); kf[3]=*(const __attribute__((address_space(3))) bf16x8*)(kp+2560);
  kf[4]=*(const __attribute__((address_space(3))) bf16x8*)(kp+4096); kf[5]=*(const __attribute__((address_space(3))) bf16x8*)(kp+4608);
  kf[6]=*(const __attribute__((address_space(3))) bf16x8*)(kp+6144); kf[7]=*(const __attribute__((address_space(3))) bf16x8*)(kp+6656);
}
__device__ __forceinline__ void kload2(bf16x8*kf,lds_cptr kp,int j){ kf[2*j]=*(const __attribute__((address_space(3))) bf16x8*)(kp+j*2048); kf[2*j+1]=*(const __attribute__((address_space(3))) bf16x8*)(kp+j*2048+512); }
__device__ __forceinline__ s16x4 vtr(lds_cptr p){ return __builtin_bit_cast(s16x4,__builtin_amdgcn_ds_read_tr16_b64_v4i16((__attribute__((address_space(3))) v4i16_t*)p)); }
__device__ __forceinline__ float rowmax(const f32x16&p0,const f32x16&p1){
  float a=max3f(p0[0],p0[1],p1[0]),b=max3f(p0[2],p0[3],p1[1]);a=max3f(a,p1[2],p1[3]);
  #pragma unroll
  for(int r=4;r<16;r+=4){a=max3f(a,p0[r],p0[r+1]);b=max3f(b,p0[r+2],p0[r+3]);a=max3f(a,p1[r],p1[r+1]);b=max3f(b,p1[r+2],p1[r+3]);}
  const float m=max2f(a,b);
  auto rr=__builtin_amdgcn_permlane32_swap(__float_as_uint(m),__float_as_uint(m),false,false);
  return max2f(__uint_as_float(rr[0]),__uint_as_float(rr[1]));
}
__device__ __forceinline__ void pv(f32x16*o,int vb,bf16x8 pa0,bf16x8 pa1,bf16x8 pa2,bf16x8 pa3){
  #pragma unroll
  for(int d0=0;d0<2;++d0){s16x4 lo[4],hi[4];
    #pragma unroll
    for(int ks=0;ks<4;++ks){
      asm volatile("ds_read_b64_tr_b16 %0,%1 offset:%c2":"=&v"(lo[ks]):"v"(vb),"i"(d0*4096+ks*1024):"memory");
      asm volatile("ds_read_b64_tr_b16 %0,%1 offset:%c2":"=&v"(hi[ks]):"v"(vb),"i"(d0*4096+ks*1024+512):"memory");}
    asm volatile("s_waitcnt lgkmcnt(0)":::"memory");SBAR();
    #define PK(k) (bf16x8){lo[k][0],lo[k][1],lo[k][2],lo[k][3],hi[k][0],hi[k][1],hi[k][2],hi[k][3]}
    o[d0]=__builtin_amdgcn_mfma_f32_32x32x16_bf16(pa0,PK(0),o[d0],0,0,0);
    o[d0]=__builtin_amdgcn_mfma_f32_32x32x16_bf16(pa1,PK(1),o[d0],0,0,0);
    o[d0]=__builtin_amdgcn_mfma_f32_32x32x16_bf16(pa2,PK(2),o[d0],0,0,0);
    o[d0]=__builtin_amdgcn_mfma_f32_32x32x16_bf16(pa3,PK(3),o[d0],0,0,0);
    #undef PK
  }
}
struct UA {
  const bf16* Qw0; int ldq;
  const bf16* Kh; const bf16* Vh; int ldkv;
  bf16* Ow0; int ldo;
  int NT;
  int tabs0;
  int cq0;
  const float* relb;
  const unsigned* msk;
  int nomask;
};
#ifndef ATTN_STORE16
#define ATTN_STORE16(p,v) (*(__attribute__((address_space(1))) u32x4*)(p)=(v))
#endif
template<int MODE,int THRL> __device__ __forceinline__ void attn_unit(const UA& a,char*shm,int tid_in){
  int tid_l=tid_in; asm volatile("":"+v"(tid_l));
  const int tid=tid_l,lane=tid&63,r32=lane&31,hi=lane>>5; const int wid=__builtin_amdgcn_readfirstlane(tid>>6);
  const long ldq=a.ldq, ldkv=a.ldkv, ldo=a.ldo;
  const bf16*Qw=a.Qw0+(long)(wid*QBLK)*ldq;
  const bf16*Kh=a.Kh,*Vh=a.Vh;
  const unsigned lds0=(unsigned)(uintptr_t)shm;
  float*wsf=(float*)(shm+LDS_WS)+wid*64;
  const bf16*ksrc=Kh+(long)lane*ldkv+wid*8;
  const bf16*vsrc=Vh+(long)(16*(wid&3)+(lane>>2))*ldkv+(wid>>2)*32+(lane&3)*8;
  const unsigned kdst=lds0+LDS_K+wid*1024, vdst=lds0+LDS_V+wid*1024;
  const int cq=a.cq0+(wid>>1);
  const unsigned* msrc=a.msk+((long)a.cq0*64+wid*32)*2+lane;
  const unsigned mdst=lds0+LDS_MSK+wid*256;
  const __attribute__((address_space(3))) float* tab=(const __attribute__((address_space(3))) float*)(__attribute__((address_space(3))) char*)(shm+LDS_TAB);
  if(MODE==0){ __attribute__((address_space(3))) float* tw=(__attribute__((address_space(3))) float*)(__attribute__((address_space(3))) char*)(shm+LDS_TAB);
    for(int i=tid;i<384;i+=512) tw[i]=((const __attribute__((address_space(1))) float*)a.relb)[i<319?i:319]*1.4426950408889634f; }
  #define DMA_K(t,slot) glds16(ksrc+(long)(t)*KVBLK*ldkv,(unsigned)__builtin_amdgcn_readfirstlane(kdst+(slot)))
  #define DMA_V(t,slot) glds16(vsrc+(long)(t)*KVBLK*ldkv,(unsigned)__builtin_amdgcn_readfirstlane(vdst+(slot)))
  #define DMA_M(t) do{ if(MODE==1) glds4(msrc+(long)(a.tabs0+(t))*8192,(unsigned)__builtin_amdgcn_readfirstlane(mdst+(((t)&3)*2048))); }while(0)
  const int vb0=(int)(lds0+LDS_V)+((lane>>4)&1)*32+(lane&3)*8+(4*hi+((lane&15)>>2))*64;
  const char*Kbase=shm+LDS_K; bf16x8 kf[8];
  const lds_cptr shm3=(lds_cptr)shm; const lds_cptr kp0=shm3+LDS_K+hi*1024+r32*16; const lds_cptr vp0=shm3+LDS_V+((lane>>4)&1)*32+(lane&3)*8+(4*hi+((lane&15)>>2))*64;
  const lds_cptr mp0=shm3+LDS_MSK+wid*256+(r32*2+hi)*4;
  const int NT=a.NT;
  DMA_K(0,0);DMA_V(0,0);DMA_K(1,SLOTB);DMA_M(0);DMA_M(1);
  bf16x8 qr[4];
  #pragma unroll
  for(int d0=0;d0<4;++d0)qr[d0]=*(const __attribute__((address_space(1))) bf16x8*)(&Qw[(long)r32*ldq+d0*16+hi*8]);
  float mhat=0.f,l_reg=0.f;f32x16 o[2];o[0]=f32x16{};o[1]=f32x16{};f32x16 negm=f32x16{};asm volatile("":"+v"(negm));
  const int qi=(wid&1)*32+r32;
  #define HOOK(P0,P1,tl) do{ const int ta_=a.tabs0+(tl); \
    if(MODE==0){ const int dch_=cq-ta_; \
      if(dch_<0||dch_>8){ _Pragma("unroll") for(int r=0;r<16;++r){P0[r]=-INFINITY;P1[r]=-INFINITY;} } \
      else if(dch_>=5){ const float c_=tab[319]; _Pragma("unroll") for(int r=0;r<16;++r){P0[r]+=c_;P1[r]+=c_;} } \
      else{ int ll_=lane; asm volatile("":"+v"(ll_)); const __attribute__((address_space(3))) float* tp_=tab+(64*dch_+(wid&1)*32+(ll_&31)+4-4*(ll_>>5)); _Pragma("unroll") for(int r=0;r<16;++r){ P0[r]+=tp_[59-((r&3)+8*(r>>2))]; P1[r]+=tp_[27-((r&3)+8*(r>>2))]; } } } \
    else if(MODE==1){ \
      if(ta_>cq){ _Pragma("unroll") for(int r=0;r<16;++r){P0[r]=-INFINITY;P1[r]=-INFINITY;} } \
      else if(!a.nomask){ const unsigned mw_=*(const __attribute__((address_space(3))) unsigned*)(mp0+(((tl)&3)*2048)); \
        _Pragma("unroll") for(int r=0;r<16;++r){ P0[r]=((int)(mw_<<(31-r))<0)?P0[r]:-INFINITY; P1[r]=((int)(mw_<<(15-r))<0)?P1[r]:-INFINITY; } } } \
    else if(MODE==3){ if(ta_>cq){ _Pragma("unroll") for(int r=0;r<16;++r){P0[r]=-INFINITY;P1[r]=-INFINITY;} } } \
  }while(0)
  bool resc=false;
  #define START(P0,P1) do{ const float rm=rowmax(P0,P1); resc=false; \
    { const float dl=(rm>-1e30f)?rm:0.f; mhat=fadd_s(mhat,dl); \
      _Pragma("unroll") for(int r=0;r<16;++r){P0[r]=fsub_s(P0[r],dl);P1[r]=fsub_s(P1[r],dl);} \
      _Pragma("unroll") for(int r=0;r<16;++r)negm[r]=-mhat; asm volatile("":"+v"(negm)); } \
    _Pragma("unroll") for(int r=0;r<16;++r)P0[r]=__builtin_amdgcn_exp2f(P0[r]); }while(0)
  #define RESC() do{ if(resc){ asm volatile("s_waitcnt lgkmcnt(0)":::"memory"); int hl_=lane>>5; asm volatile("":"+v"(hl_)); const float* wq_=(const float*)(shm+LDS_WS)+wid*64+4*hl_; \
      _Pragma("unroll") for(int d_=0;d_<2;++d_) _Pragma("unroll") for(int r=0;r<16;++r)o[d_][r]*=wq_[(r&3)+8*(r>>2)]; } }while(0)
  f32x16 pA0,pA1,pB0,pB1;
  int sl_prev=0,sl_cur=0,sl_next=SLOTB;
  #define ROT() do{sl_prev=sl_cur;sl_cur=sl_next;sl_next=(sl_next==(NSLOT-1)*SLOTB)?0:sl_next+SLOTB;}while(0)
  DMA_K(2,2*SLOTB);
  WAIT_BAR(0);
  qkt(pA0,pA1,Kbase,qr,negm,r32,hi);asm volatile("s_nop 15\n\ts_nop 7":"+v"(pA0),"+v"(pA1));HOOK(pA0,pA1,0);
  START(pA0,pA1);
  _Pragma("unroll") for(int r=0;r<16;++r)pA1[r]=__builtin_amdgcn_exp2f(pA1[r]);
  WAIT_BAR(0);
  DMA_K(3,0);DMA_V(1,SLOTB);DMA_M(2);
  ROT();
  kload8(kf,kp0+sl_cur);
  if(MODE==1){WAIT_BAR(3);}else{WAIT_BAR(2);}
  s16x4 vlo[8],vhi[8]; u32x4 pw0,pw1,pw2,pw3;
  #define PKW(P,B) cvtpk_s(P[B],P[B+1])
  #define PAF(k) __builtin_bit_cast(bf16x8,pw##k)
  #define VFR(i) (bf16x8){vlo[i][0],vlo[i][1],vlo[i][2],vlo[i][3],vhi[i][0],vhi[i][1],vhi[i][2],vhi[i][3]}
  #define PIN(x) asm volatile("":"+v"(x))
  #define MX3(a,b,c) __builtin_fmaxf(__builtin_fmaxf((a),(b)),(c))
  #define GAPA(MF,A0,A1,A2,A3,W0,W1,PW) do{ MF; sacc+=A0; sacc+=A1; sacc+=A2; sacc+=A3; PIN(sacc); W0; W1; PIN(PW); SBAR(); }while(0)
  #define EX(v) __builtin_amdgcn_exp2f(v)
  #define GAPB(MF,X,B) do{ MF; X[B]=EX(X[B]); X[B+1]=EX(X[B+1]); X[B+2]=EX(X[B+2]); X[B+3]=EX(X[B+3]); PIN(X); SBAR(); }while(0)
  #define VRD(i) do{ vlo[i]=vtr(vp_+(((i)>>2)*4096+((i)&3)*1024)); vhi[i]=vtr(vp_+(((i)>>2)*4096+((i)&3)*1024+512)); }while(0)
  #define KRD(G,j) do{ if(G){ kload2(kf,kp0+sl_next,j); SBAR(); } }while(0)
  #define STEP(C0,C1,P0,P1,t,GK,GV,GL,GM) do{ SBAR(); \
    const lds_cptr vp_=vp0+sl_prev; \
    VRD(0); SBAR(); float sacc=(P0[0]+P0[1]); \
    GAPA(C0=__builtin_amdgcn_mfma_f32_32x32x16_bf16(kf[0],qr[0],negm,0,0,0), P0[2],P0[3],P0[4],P0[5],     pw0[0]=PKW(P0,0), pw0[1]=PKW(P0,2), pw0); \
    VRD(4); SBAR(); GAPA(C1=__builtin_amdgcn_mfma_f32_32x32x16_bf16(kf[1],qr[0],negm,0,0,0), P0[6],P0[7],P0[8],P0[9],     pw0[2]=PKW(P0,4), pw0[3]=PKW(P0,6), pw0); \
    VRD(1); SBAR(); GAPA(C0=__builtin_amdgcn_mfma_f32_32x32x16_bf16(kf[2],qr[1],C0,0,0,0),   P0[10],P0[11],P0[12],P0[13], pw1[0]=PKW(P0,8), pw1[1]=PKW(P0,10), pw1); \
    VRD(5); SBAR(); GAPA(C1=__builtin_amdgcn_mfma_f32_32x32x16_bf16(kf[3],qr[1],C1,0,0,0),   P0[14],P0[15],P1[0],P1[1],   pw1[2]=PKW(P0,12),pw1[3]=PKW(P0,14), pw1); \
    VRD(2); SBAR(); GAPA(C0=__builtin_amdgcn_mfma_f32_32x32x16_bf16(kf[4],qr[2],C0,0,0,0),   P1[2],P1[3],P1[4],P1[5],     pw2[0]=PKW(P1,0), pw2[1]=PKW(P1,2), pw2); \
    VRD(6); SBAR(); GAPA(C1=__builtin_amdgcn_mfma_f32_32x32x16_bf16(kf[5],qr[2],C1,0,0,0),   P1[6],P1[7],P1[8],P1[9],     pw2[2]=PKW(P1,4), pw2[3]=PKW(P1,6), pw2); \
    VRD(3); SBAR(); GAPA(C0=__builtin_amdgcn_mfma_f32_32x32x16_bf16(kf[6],qr[3],C0,0,0,0),   P1[10],P1[11],P1[12],P1[13], pw3[0]=PKW(P1,8), pw3[1]=PKW(P1,10), pw3); \
    VRD(7); SBAR(); GAPA(C1=__builtin_amdgcn_mfma_f32_32x32x16_bf16(kf[7],qr[3],C1,0,0,0),   P1[14],P1[15],0.f,0.f,       pw3[2]=PKW(P1,12),pw3[3]=PKW(P1,14), pw3); \
    l_reg+=sacc; \
    if(GK){DMA_K((t)+3,sl_cur);} if(GV){DMA_V((t)+1,sl_next);} if(GM){DMA_M((t)+2);} \
    HOOK(C0,C1,t); \
    { float a_=MX3(C0[0],C0[1],C1[0]),b_=MX3(C0[2],C0[3],C1[1]); a_=MX3(a_,C1[2],C1[3]); \
      _Pragma("unroll") for(int r=4;r<16;r+=4){a_=MX3(a_,C0[r],C0[r+1]);b_=MX3(b_,C0[r+2],C0[r+3]);a_=MX3(a_,C1[r],C1[r+1]);b_=MX3(b_,C1[r+2],C1[r+3]);} \
      float rm=__builtin_fmaxf(a_,b_); { auto rr=__builtin_amdgcn_permlane32_swap(__float_as_uint(rm),__float_as_uint(rm),false,false); rm=__builtin_fmaxf(__uint_as_float(rr[0]),__uint_as_float(rr[1])); } \
      resc=false; \
      if(__builtin_expect(__any(rm>(float)THRL),0)){ const float dl=__builtin_fmaxf(rm,0.f); mhat+=dl; \
        _Pragma("unroll") for(int r=0;r<16;++r){C0[r]-=dl;C1[r]-=dl;} \
        _Pragma("unroll") for(int r=0;r<16;++r)negm[r]=-mhat; asm volatile("":"+v"(negm)); \
        const float f=__builtin_amdgcn_exp2f(-dl); l_reg*=f; { int rl_=lane; asm volatile("":"+v"(rl_)); if(rl_<32)((float*)(shm+LDS_WS))[wid*64+rl_]=f; } resc=true; } } \
    SBAR(); \
    GAPB(o[0]=__builtin_amdgcn_mfma_f32_32x32x16_bf16(PAF(0),VFR(0),o[0],0,0,0), C0,0); \
    GAPB(o[1]=__builtin_amdgcn_mfma_f32_32x32x16_bf16(PAF(0),VFR(4),o[1],0,0,0), C0,4); \
    KRD(GL,0); GAPB(o[0]=__builtin_amdgcn_mfma_f32_32x32x16_bf16(PAF(1),VFR(1),o[0],0,0,0), C0,8); \
    KRD(GL,1); GAPB(o[1]=__builtin_amdgcn_mfma_f32_32x32x16_bf16(PAF(1),VFR(5),o[1],0,0,0), C0,12); \
    KRD(GL,2); GAPB(o[0]=__builtin_amdgcn_mfma_f32_32x32x16_bf16(PAF(2),VFR(2),o[0],0,0,0), C1,0); \
    KRD(GL,3); GAPB(o[1]=__builtin_amdgcn_mfma_f32_32x32x16_bf16(PAF(2),VFR(6),o[1],0,0,0), C1,4); \
    GAPB(o[0]=__builtin_amdgcn_mfma_f32_32x32x16_bf16(PAF(3),VFR(3),o[0],0,0,0), C1,8); \
    GAPB(o[1]=__builtin_amdgcn_mfma_f32_32x32x16_bf16(PAF(3),VFR(7),o[1],0,0,0), C1,12); \
    }while(0)
  #define WSTD() do{ if(MODE==1){WAIT_BAR(3);}else{WAIT_BAR(2);} }while(0)
  #define ENDW(tt) do{ if((tt)+3<NT){WSTD();} else if((tt)+2<NT){ if(MODE==1){WAIT_BAR(2);}else{WAIT_BAR(1);} } else {WAIT_BAR(0);} }while(0)
  int t=1;
  for(;t+5<NT;t+=2){
    STEP(pB0,pB1,pA0,pA1,t,true,true,true,true);     WSTD(); RESC(); ROT();
    STEP(pA0,pA1,pB0,pB1,t+1,true,true,true,true);   WSTD(); RESC(); ROT();
  }
  for(;t+1<NT;t+=2){
    STEP(pB0,pB1,pA0,pA1,t,(t+3<NT),(t+1<NT),(t+1<NT),(t+2<NT));       ENDW(t);   RESC(); ROT();
    STEP(pA0,pA1,pB0,pB1,t+1,(t+4<NT),(t+2<NT),(t+2<NT),(t+3<NT));     ENDW(t+1); RESC(); ROT();
  }
  STEP(pB0,pB1,pA0,pA1,NT-1,false,false,false,false); RESC();
  { float sacc=pB0[0]+pB0[1]; _Pragma("unroll") for(int r=2;r<16;++r)sacc+=pB0[r]; _Pragma("unroll") for(int r=0;r<16;++r)sacc+=pB1[r]; l_reg+=sacc;
    pw0=(u32x4){PKW(pB0,0),PKW(pB0,2),PKW(pB0,4),PKW(pB0,6)};pw1=(u32x4){PKW(pB0,8),PKW(pB0,10),PKW(pB0,12),PKW(pB0,14)};pw2=(u32x4){PKW(pB1,0),PKW(pB1,2),PKW(pB1,4),PKW(pB1,6)};pw3=(u32x4){PKW(pB1,8),PKW(pB1,10),PKW(pB1,12),PKW(pB1,14)};
    SBAR(); pv(o,vb0+sl_cur,PAF(0),PAF(1),PAF(2),PAF(3)); }
  #undef PKW
  #undef PAF
  #undef VFR
  #undef PIN
  #undef MX3
  #undef GAPA
  #undef GAPB
  #undef EX
  #undef VRD
  #undef KRD
  #undef STEP
  #undef ENDW
  #undef WSTD
  {auto rr=__builtin_amdgcn_permlane32_swap(__float_as_uint(l_reg),__float_as_uint(l_reg),false,false);l_reg=__uint_as_float(rr[0])+__uint_as_float(rr[1]);}
  if(hi==0)wsf[32+r32]=l_reg;asm volatile("s_waitcnt lgkmcnt(0)":::"memory");
  float rli[16];
  #pragma unroll
  for(int r=0;r<16;++r)rli[r]=__builtin_amdgcn_rcpf(wsf[32+crow(r,hi)]);
  bf16*Ow=a.Ow0+(long)(wid*QBLK)*ldo;
  { bf16*stg=(bf16*)(shm+LDS_OST)+wid*2048;
    #pragma unroll
    for(int r=0;r<16;++r){const int orow=crow(r,hi);
      #pragma unroll
      for(int d0=0;d0<2;++d0)stg[orow*64+d0*32+r32]=__float2bfloat16(o[d0][r]*rli[r]);}
    asm volatile("s_waitcnt lgkmcnt(0)":::"memory");
    #pragma unroll
    for(int i=0;i<4;++i){const int row=i*8+(lane>>3),ch=lane&7; const u32x4 v=*(const u32x4*)(stg+row*64+ch*8); ATTN_STORE16(Ow+(long)row*ldo+ch*8,v);} }
  asm volatile("s_waitcnt lgkmcnt(0)\n\ts_barrier":::"memory");
  #undef DMA_K
  #undef DMA_V
  #undef DMA_M
  #undef HOOK
  #undef START
  #undef RESC
  #undef ROT
}

struct UB { const bf16* Q; const bf16* K; const bf16* V; bf16* O;
  int qt;
  const float* subln; float lam, oscale; };
constexpr int B_SLOT=16384, B_LDS_K=0, B_LDS_V=3*B_SLOT, B_LDS_WS=6*B_SLOT, B_XROW=132;
template<int THRL> __device__ __forceinline__ void attn_unit_b2(const UB& a,char*shm,int tid_in){
  int tid_l=tid_in; asm volatile("":"+v"(tid_l));
  const int tid=tid_l,lane=tid&63,r32=lane&31,hi=lane>>5; const int wid=__builtin_amdgcn_readfirstlane(tid>>6);
  const int c=wid>>2, wq=wid&3;
  const int q0=128*a.qt;
  const int NT=(2*a.qt+2<4)?4:2*a.qt+2;
  const int cq=2*a.qt+(wq>>1);
  const bf16*Qw=a.Q+(long)(q0+32*wq)*512+c*64;
  const unsigned lds0=(unsigned)(uintptr_t)shm;
  float*wsf=(float*)(shm+B_LDS_WS)+wid*64;
  const bf16*ksrc=a.K+(long)lane*512+wid*8;
  const bf16*vsrc=a.V+(long)(16*(wid&3)+(lane>>2))*512+(wid>>2)*32+(lane&3)*8;
  const unsigned kdst=lds0+B_LDS_K+wid*1024, vdst=lds0+B_LDS_V+wid*1024;
  #define DMA_K(t,slot) do{ glds16(ksrc+(long)(t)*KVBLK*512,(unsigned)__builtin_amdgcn_readfirstlane(kdst+(slot))); glds16(ksrc+(long)(t)*KVBLK*512+64,(unsigned)__builtin_amdgcn_readfirstlane(kdst+(slot)+8192u)); }while(0)
  #define DMA_V(t,slot) do{ glds16(vsrc+(long)(t)*KVBLK*512,(unsigned)__builtin_amdgcn_readfirstlane(vdst+(slot))); glds16(vsrc+(long)(t)*KVBLK*512+64,(unsigned)__builtin_amdgcn_readfirstlane(vdst+(slot)+8192u)); }while(0)
  const int vb0=(int)(lds0+B_LDS_V)+((lane>>4)&1)*32+(lane&3)*8+(4*hi+((lane&15)>>2))*64;
  const char*Kbase=shm+B_LDS_K+c*8192; bf16x8 kf[8];
  const lds_cptr shm3=(lds_cptr)shm; const lds_cptr kp0=shm3+B_LDS_K+c*8192+hi*1024+r32*16; const lds_cptr vp0=shm3+B_LDS_V+((lane>>4)&1)*32+(lane&3)*8+(4*hi+((lane&15)>>2))*64;
  DMA_K(0,0);DMA_V(0,0);DMA_K(1,B_SLOT);
  bf16x8 qr[4];
  #pragma unroll
  for(int d0=0;d0<4;++d0)qr[d0]=*(const __attribute__((address_space(1))) bf16x8*)(&Qw[(long)r32*512+d0*16+hi*8]);
  float mhat=0.f,l_reg=0.f;f32x16 o[4];o[0]=f32x16{};o[1]=f32x16{};o[2]=f32x16{};o[3]=f32x16{};f32x16 negm=f32x16{};asm volatile("":"+v"(negm));
  #define HOOK(P0,P1,tl) do{ if((tl)>cq){ _Pragma("unroll") for(int r=0;r<16;++r){P0[r]=-INFINITY;P1[r]=-INFINITY;} } }while(0)
  bool resc=false;
  #define START(P0,P1) do{ const float rm=rowmax(P0,P1); resc=false; \
    { const float dl=(rm>-1e30f)?rm:0.f; mhat=fadd_s(mhat,dl); \
      _Pragma("unroll") for(int r=0;r<16;++r){P0[r]=fsub_s(P0[r],dl);P1[r]=fsub_s(P1[r],dl);} \
      _Pragma("unroll") for(int r=0;r<16;++r)negm[r]=-mhat; asm volatile("":"+v"(negm)); } \
    _Pragma("unroll") for(int r=0;r<16;++r)P0[r]=__builtin_amdgcn_exp2f(P0[r]); }while(0)
  #define RESC() do{ if(resc){ asm volatile("s_waitcnt lgkmcnt(0)":::"memory"); int hl_=lane>>5; asm volatile("":"+v"(hl_)); const float* wq_=(const float*)(shm+B_LDS_WS)+wid*64+4*hl_; \
      _Pragma("unroll") for(int d_=0;d_<4;++d_) _Pragma("unroll") for(int r=0;r<16;++r)o[d_][r]*=wq_[(r&3)+8*(r>>2)]; } }while(0)
  f32x16 pA0,pA1,pB0,pB1;
  int sl_prev=0,sl_cur=0,sl_next=B_SLOT;
  #define ROT() do{sl_prev=sl_cur;sl_cur=sl_next;sl_next=(sl_next==2*B_SLOT)?0:sl_next+B_SLOT;}while(0)
  DMA_K(2,2*B_SLOT);
  WAIT_BAR(0);
  qkt(pA0,pA1,Kbase,qr,negm,r32,hi);asm volatile("s_nop 15\n\ts_nop 7":"+v"(pA0),"+v"(pA1));HOOK(pA0,pA1,0);
  START(pA0,pA1);
  _Pragma("unroll") for(int r=0;r<16;++r)pA1[r]=__builtin_amdgcn_exp2f(pA1[r]);
  WAIT_BAR(0);
  DMA_K(3,0);DMA_V(1,B_SLOT);
  ROT();
  kload8(kf,kp0+sl_cur);
  WAIT_BAR(4);
  s16x4 valo,vahi,vblo,vbhi; u32x4 pw0,pw1,pw2,pw3;
  #define PKW(P,B) cvtpk_s(P[B],P[B+1])
  #define PAF(k) __builtin_bit_cast(bf16x8,pw##k)
  #define PIN(x) asm volatile("":"+v"(x))
  #define MX3(a,b,c) __builtin_fmaxf(__builtin_fmaxf((a),(b)),(c))
  #define GAPA(MF,A0,A1,A2,A3,W0,W1,PW) do{ MF; sacc+=A0; sacc+=A1; sacc+=A2; sacc+=A3; PIN(sacc); W0; W1; PIN(PW); SBAR(); }while(0)
  #define EX(v) __builtin_amdgcn_exp2f(v)
  #define VOFF(m) (((((m)&3)>>1)*8192)+((((m)&3)&1)*4+((m)>>2))*1024)
  #define VLDA(m) do{ valo=vtr(vp_+VOFF(m)); vahi=vtr(vp_+VOFF(m)+512); }while(0)
  #define VLDB(m) do{ vblo=vtr(vp_+VOFF(m)); vbhi=vtr(vp_+VOFF(m)+512); }while(0)
  #define VFA (bf16x8){valo[0],valo[1],valo[2],valo[3],vahi[0],vahi[1],vahi[2],vahi[3]}
  #define VFB (bf16x8){vblo[0],vblo[1],vblo[2],vblo[3],vbhi[0],vbhi[1],vbhi[2],vbhi[3]}
  #define GAPB2(MF,X,B) do{ MF; X[B]=EX(X[B]); X[B+1]=EX(X[B+1]); PIN(X); SBAR(); }while(0)
  #define KRD(G,j) do{ if(G){ kload2(kf,kp0+sl_next,j); SBAR(); } }while(0)
  #define PVE(m,PA,X,B) do{ VLDB((m)+1); SBAR(); GAPB2(o[(m)&3]=__builtin_amdgcn_mfma_f32_32x32x16_bf16(PA,VFA,o[(m)&3],0,0,0),X,B); }while(0)
  #define PVO(m,PA,X,B,LAST) do{ if(!(LAST)){VLDA((m)+1);} SBAR(); GAPB2(o[(m)&3]=__builtin_amdgcn_mfma_f32_32x32x16_bf16(PA,VFB,o[(m)&3],0,0,0),X,B); }while(0)
  #define STEP(C0,C1,P0,P1,t,GK,GV,GL) do{ SBAR(); \
    const lds_cptr vp_=vp0+sl_prev; \
    float sacc=(P0[0]+P0[1]); \
    GAPA(C0=__builtin_amdgcn_mfma_f32_32x32x16_bf16(kf[0],qr[0],negm,0,0,0), P0[2],P0[3],P0[4],P0[5],     pw0[0]=PKW(P0,0), pw0[1]=PKW(P0,2), pw0); \
    GAPA(C1=__builtin_amdgcn_mfma_f32_32x32x16_bf16(kf[1],qr[0],negm,0,0,0), P0[6],P0[7],P0[8],P0[9],     pw0[2]=PKW(P0,4), pw0[3]=PKW(P0,6), pw0); \
    GAPA(C0=__builtin_amdgcn_mfma_f32_32x32x16_bf16(kf[2],qr[1],C0,0,0,0),   P0[10],P0[11],P0[12],P0[13], pw1[0]=PKW(P0,8), pw1[1]=PKW(P0,10), pw1); \
    GAPA(C1=__builtin_amdgcn_mfma_f32_32x32x16_bf16(kf[3],qr[1],C1,0,0,0),   P0[14],P0[15],P1[0],P1[1],   pw1[2]=PKW(P0,12),pw1[3]=PKW(P0,14), pw1); \
    GAPA(C0=__builtin_amdgcn_mfma_f32_32x32x16_bf16(kf[4],qr[2],C0,0,0,0),   P1[2],P1[3],P1[4],P1[5],     pw2[0]=PKW(P1,0), pw2[1]=PKW(P1,2), pw2); \
    GAPA(C1=__builtin_amdgcn_mfma_f32_32x32x16_bf16(kf[5],qr[2],C1,0,0,0),   P1[6],P1[7],P1[8],P1[9],     pw2[2]=PKW(P1,4), pw2[3]=PKW(P1,6), pw2); \
    GAPA(C0=__builtin_amdgcn_mfma_f32_32x32x16_bf16(kf[6],qr[3],C0,0,0,0),   P1[10],P1[11],P1[12],P1[13], pw3[0]=PKW(P1,8), pw3[1]=PKW(P1,10), pw3); \
    VLDA(0); SBAR(); \
    GAPA(C1=__builtin_amdgcn_mfma_f32_32x32x16_bf16(kf[7],qr[3],C1,0,0,0),   P1[14],P1[15],0.f,0.f,       pw3[2]=PKW(P1,12),pw3[3]=PKW(P1,14), pw3); \
    l_reg+=sacc; \
    if(GK){DMA_K((t)+3,sl_cur);} if(GV){DMA_V((t)+1,sl_next);} \
    HOOK(C0,C1,t); \
    { float a_=MX3(C0[0],C0[1],C1[0]),b_=MX3(C0[2],C0[3],C1[1]); a_=MX3(a_,C1[2],C1[3]); \
      _Pragma("unroll") for(int r=4;r<16;r+=4){a_=MX3(a_,C0[r],C0[r+1]);b_=MX3(b_,C0[r+2],C0[r+3]);a_=MX3(a_,C1[r],C1[r+1]);b_=MX3(b_,C1[r+2],C1[r+3]);} \
      float rm=__builtin_fmaxf(a_,b_); { auto rr=__builtin_amdgcn_permlane32_swap(__float_as_uint(rm),__float_as_uint(rm),false,false); rm=__builtin_fmaxf(__uint_as_float(rr[0]),__uint_as_float(rr[1])); } \
      resc=false; \
      if(__builtin_expect(__any(rm>(float)THRL),0)){ const float dl=__builtin_fmaxf(rm,0.f); mhat+=dl; \
        _Pragma("unroll") for(int r=0;r<16;++r){C0[r]-=dl;C1[r]-=dl;} \
        _Pragma("unroll") for(int r=0;r<16;++r)negm[r]=-mhat; asm volatile("":"+v"(negm)); \
        const float f=__builtin_amdgcn_exp2f(-dl); l_reg*=f; { int rl_=lane; asm volatile("":"+v"(rl_)); if(rl_<32)((float*)(shm+B_LDS_WS))[wid*64+rl_]=f; } resc=true; } } \
    SBAR(); \
    PVE(0,PAF(0),C0,0);  PVO(1,PAF(0),C0,2,false);  PVE(2,PAF(0),C0,4);  PVO(3,PAF(0),C0,6,false); \
    KRD(GL,0); PVE(4,PAF(1),C0,8);  PVO(5,PAF(1),C0,10,false); KRD(GL,1); PVE(6,PAF(1),C0,12); PVO(7,PAF(1),C0,14,false); \
    KRD(GL,2); PVE(8,PAF(2),C1,0);  PVO(9,PAF(2),C1,2,false);  KRD(GL,3); PVE(10,PAF(2),C1,4); PVO(11,PAF(2),C1,6,false); \
    PVE(12,PAF(3),C1,8); PVO(13,PAF(3),C1,10,false); PVE(14,PAF(3),C1,12); PVO(15,PAF(3),C1,14,true); \
    }while(0)
  #define ENDW(tt) do{ if((tt)+3<NT){WAIT_BAR(4);} else if((tt)+2<NT){WAIT_BAR(2);} else {WAIT_BAR(0);} }while(0)
  int t=1;
  for(;t+5<NT;t+=2){
    STEP(pB0,pB1,pA0,pA1,t,true,true,true);     WAIT_BAR(4); RESC(); ROT();
    STEP(pA0,pA1,pB0,pB1,t+1,true,true,true);   WAIT_BAR(4); RESC(); ROT();
  }
  for(;t+1<NT;t+=2){
    STEP(pB0,pB1,pA0,pA1,t,(t+3<NT),(t+1<NT),(t+1<NT));       ENDW(t);   RESC(); ROT();
    STEP(pA0,pA1,pB0,pB1,t+1,(t+4<NT),(t+2<NT),(t+2<NT));     ENDW(t+1); RESC(); ROT();
  }
  STEP(pB0,pB1,pA0,pA1,NT-1,false,false,false); RESC();
  { float sacc=pB0[0]+pB0[1]; _Pragma("unroll") for(int r=2;r<16;++r)sacc+=pB0[r]; _Pragma("unroll") for(int r=0;r<16;++r)sacc+=pB1[r]; l_reg+=sacc;
    pw0=(u32x4){PKW(pB0,0),PKW(pB0,2),PKW(pB0,4),PKW(pB0,6)};pw1=(u32x4){PKW(pB0,8),PKW(pB0,10),PKW(pB0,12),PKW(pB0,14)};pw2=(u32x4){PKW(pB1,0),PKW(pB1,2),PKW(pB1,4),PKW(pB1,6)};pw3=(u32x4){PKW(pB1,8),PKW(pB1,10),PKW(pB1,12),PKW(pB1,14)};
    SBAR(); pv(o,vb0+sl_cur,PAF(0),PAF(1),PAF(2),PAF(3)); pv(o+2,vb0+sl_cur+8192,PAF(0),PAF(1),PAF(2),PAF(3)); }
  #undef PKW
  #undef PAF
  #undef PIN
  #undef MX3
  #undef GAPA
  #undef EX
  #undef VOFF
  #undef VLDA
  #undef VLDB
  #undef VFA
  #undef VFB
  #undef GAPB2
  #undef KRD
  #undef PVE
  #undef PVO
  #undef STEP
  #undef ENDW
  {auto rr=__builtin_amdgcn_permlane32_swap(__float_as_uint(l_reg),__float_as_uint(l_reg),false,false);l_reg=__uint_as_float(rr[0])+__uint_as_float(rr[1]);}
  if(hi==0)wsf[32+r32]=l_reg;asm volatile("s_waitcnt lgkmcnt(0)":::"memory");
  float rli[16];
  #pragma unroll
  for(int r=0;r<16;++r)rli[r]=__builtin_amdgcn_rcpf(wsf[32+crow(r,hi)]);
  asm volatile("s_waitcnt lgkmcnt(0)\n\ts_barrier":::"memory");
  float*xw=(float*)shm+(long)wq*32*B_XROW;
  if(c==1){
    #pragma unroll
    for(int r=0;r<16;++r){const int row=crow(r,hi);
      #pragma unroll
      for(int d=0;d<4;++d)xw[row*B_XROW+32*d+r32]=o[d][r]*rli[r];}
  }
  asm volatile("s_waitcnt lgkmcnt(0)\n\ts_barrier":::"memory");
  if(c==0){
    #pragma unroll
    for(int r=0;r<16;++r){const int row=crow(r,hi);
      #pragma unroll
      for(int d=0;d<4;++d){float*p=xw+row*B_XROW+32*d+r32; *p=o[d][r]*rli[r]-a.lam*(*p);} }
    asm volatile("s_waitcnt lgkmcnt(0)":::"memory");
    const int row=lane>>1, hf=lane&1; const float*rp=xw+row*B_XROW+64*hf;
    f32x4v dv[16]; float ss=0.f;
    #pragma unroll
    for(int j=0;j<16;++j){dv[j]=*(const f32x4v*)(rp+4*j); ss+=(dv[j][0]*dv[j][0]+dv[j][1]*dv[j][1])+(dv[j][2]*dv[j][2]+dv[j][3]*dv[j][3]);}
    ss+=__shfl_xor(ss,1);
    const float rs=1.0f/sqrtf(ss*(1.0f/128.0f)+1e-6f);
    bf16*orow=a.O+(long)(q0+32*wq+row)*512+64*hf;
    #pragma unroll
    for(int j=0;j<8;++j){
      u32x4 w; w.x=cvtpk_s(dv[2*j][0]*rs,dv[2*j][1]*rs); w.y=cvtpk_s(dv[2*j][2]*rs,dv[2*j][3]*rs); w.z=cvtpk_s(dv[2*j+1][0]*rs,dv[2*j+1][1]*rs); w.w=cvtpk_s(dv[2*j+1][2]*rs,dv[2*j+1][3]*rs);
      ATTN_STORE16(orow+8*j,w); }
  }
  asm volatile("s_waitcnt lgkmcnt(0)\n\ts_barrier":::"memory");
  #undef DMA_K
  #undef DMA_V
  #undef HOOK
  #undef START
  #undef RESC
  #undef ROT
}
#undef SBAR
#undef WAIT_BAR
}

constexpr int NWAVES = 8;
constexpr int NB = 16, SEQ = 4096, DM = 1024, DEPTH = 4, R = NB * SEQ;
constexpr int GB = 8, RG = GB * SEQ, NGRP = NB / GB;
constexpr int NIN = 8004, NINP = 8192, DFF = 2816, MEMLEN = 256;
constexpr float RMS_EPS = 1e-6f;
constexpr float QSCALE = 0.125f * 1.4426950408889634f;
constexpr size_t MiB = 1u << 20;
constexpr size_t WS_CTL = 0, CTL_ZERO_BYTES = 1 * MiB;
constexpr size_t WS_ROPE = 1 * MiB;
constexpr size_t WS_SCAL = 2 * MiB;
constexpr size_t WS_WKV = 3 * MiB;
constexpr size_t WS_MN = 7 * MiB;
constexpr size_t WS_KVX = 15 * MiB;
constexpr size_t WS_WL = 32 * MiB;
constexpr size_t WL_WIN = 0, WL_WUP = 16 * MiB, WL_WOUT = 19 * MiB, WL_WQX = 21 * MiB, WL_WOX = 21 * MiB + 512 * 1024, WL_WGU = 22 * MiB, WL_WDN = 33 * MiB;
constexpr size_t WS_XN = 72 * MiB;
constexpr size_t WS_MIX = 200 * MiB;
constexpr size_t WS_QKV = WS_MIX;
constexpr size_t QKV_STRIDE = (size_t)RG * 512;
constexpr size_t WS_QI = WS_MIX + 288 * MiB, WS_KI = WS_MIX + 304 * MiB;
constexpr size_t WS_GATES = WS_MIX + 320 * MiB;
constexpr size_t WS_Y = WS_MIX + 512 * MiB;
constexpr size_t WS_MASK = WS_MIX + 576 * MiB;
constexpr size_t WS_H = WS_MIX;
constexpr size_t WS_QX = WS_MIX + 400 * MiB;
constexpr size_t WS_OBUF = WS_MIX + 592 * MiB;
constexpr size_t WS_SS = WS_MIX + 688 * MiB;
constexpr size_t WS_XS = WS_MIX + 692 * MiB;
constexpr size_t WS_END = WS_MIX + 820 * MiB;
static_assert(WS_WL + WL_WDN + (size_t)1024 * DFF * 2 <= WS_XN && WS_XN + (size_t)R * DM * 2 <= WS_MIX && WS_H + (size_t)R * DFF * 2 <= WS_QX && WS_MASK + (size_t)GB * 64 * 4096 * 8 <= WS_OBUF && WS_OBUF + 3 * (size_t)RG * 512 * 2 <= WS_SS && WS_SS + (size_t)R * 64 <= WS_XS && WS_XS + (size_t)256 * 524288 <= WS_END && WS_END <= 1024 * MiB, "d_ws map");
constexpr int CW_BAR = 4096, CW_QUEUE = 8192;
constexpr int RING_BYTES = 131072, XRES_OFF = 131072, LDSCTL_OFF = 132096, LDS_BYTES = 155648;

#define GAS __attribute__((address_space(1)))
#define LAS __attribute__((address_space(3)))
typedef unsigned short bf16;
typedef unsigned v4u __attribute__((ext_vector_type(4)));
typedef float f32x4 __attribute__((ext_vector_type(4)));
typedef GAS unsigned gu32;
#define RLX_AGENT __ATOMIC_RELAXED, __HIP_MEMORY_SCOPE_AGENT
#define LDS_WAIT() asm volatile("s_waitcnt lgkmcnt(0)" ::: "memory")
__device__ __forceinline__ unsigned f2bf(float f) { unsigned u = __builtin_bit_cast(unsigned, f); return (u + 0x7fffu + ((u >> 16) & 1u)) >> 16; }
__device__ __forceinline__ unsigned pk2(float lo, float hi) { return f2bf(lo) | (f2bf(hi) << 16); }
#define XB_TMO      128
#define XB_XCNT(j)  (256  + 64 * (j))
#define XB_XSUB(j)  (1280 + 64 * (j))
#define XB_XGEN(j)  (2304 + 64 * (j))
#define XB_TOP      3328
#define XB_TOPGEN   3392
#define XCD_BAR_WORDS 3456
#define XB_SPIN_CAP (1u << 18)

__device__ __forceinline__ unsigned xb_ld(unsigned* p)              { return __hip_atomic_load(p, __ATOMIC_RELAXED, __HIP_MEMORY_SCOPE_AGENT); }
__device__ __forceinline__ unsigned xb_add(unsigned* p, unsigned v) { asm volatile("" : "+v"(v)); return __hip_atomic_fetch_add(p, v, __ATOMIC_RELAXED, __HIP_MEMORY_SCOPE_AGENT); }
__device__ __forceinline__ unsigned xb_xcc_id() { return (unsigned)__builtin_amdgcn_s_getreg((3 << 11) | 20) & 0xFu; }
#define XB_SPIN(cond, bar) do { unsigned _sp = 0; while (cond) { __builtin_amdgcn_s_sleep(1); \
    if ((++_sp & 255u) == 0u) { if (xb_ld(&(bar)[XB_TMO])) break; if (_sp > XB_SPIN_CAP) { atomicAdd(&(bar)[XB_TMO], 1u); break; } } } } while (0)

struct XcdBarrier {
    unsigned* bar; unsigned x;
    volatile LAS unsigned* st;
};

__device__ __forceinline__ XcdBarrier xcd_barrier_post(unsigned* bar, volatile LAS unsigned* st) {
    XcdBarrier b; b.bar = bar; b.x = xb_xcc_id(); b.st = st;
    if (threadIdx.x == 0) (void)xb_add(&bar[XB_XCNT(b.x)], 1u);
    return b;
}
__device__ __forceinline__ void xcd_barrier_complete(unsigned* bar, unsigned x, unsigned& nloc, unsigned& nx) {
    const unsigned G = gridDim.x * gridDim.y * gridDim.z; asm volatile("" : "+s"(x));
    unsigned sum, cnt, mine, sp = 0u;
    for (;;) {
        sum = 0u; cnt = 0u; mine = 0u;
#pragma unroll
        for (unsigned j = 0; j < 16; ++j) { const unsigned c = xb_ld(&bar[XB_XCNT(j)]); sum += c; cnt += (c > 0u) ? 1u : 0u; mine = (j == x) ? c : mine; }
        if (sum == G) break;
        __builtin_amdgcn_s_sleep(1);
        if ((++sp & 255u) == 0u) { if (xb_ld(&bar[XB_TMO])) break; if (sp > XB_SPIN_CAP) { atomicAdd(&bar[XB_TMO], 1u); break; } }
    }
    nloc = mine > 0u ? mine : 1u; nx = cnt > 0u ? cnt : 1u;
}

__device__ __forceinline__ void xcd_barrier(const XcdBarrier& b, int tid_in) {
    asm volatile("s_waitcnt vmcnt(0)" ::: "memory");
    __syncthreads();
    if (tid_in == 0) {
        unsigned* bar = b.bar; asm volatile("" : "+s"(bar));
        __builtin_amdgcn_s_waitcnt(0);
        unsigned nloc = b.st[0], nx = b.st[1];
        if (nloc == 0u) { xcd_barrier_complete(bar, b.x, nloc, nx); b.st[0] = nloc; b.st[1] = nx; }
        const unsigned old = xb_add(&bar[XB_XSUB(b.x)], 1u);
        const unsigned gen = old / nloc;
        if (old + 1u == (gen + 1u) * nloc) {
            __builtin_amdgcn_fence(__ATOMIC_RELEASE, "agent");
            asm volatile("s_waitcnt vmcnt(0)" ::: "memory");
            const unsigned og = xb_add(&bar[XB_TOP], 1u);
            const unsigned tg = og / nx;
            if (og + 1u == (tg + 1u) * nx) xb_add(&bar[XB_TOPGEN], 1u);
            else XB_SPIN(xb_ld(&bar[XB_TOPGEN]) == tg, bar);
            __builtin_amdgcn_fence(__ATOMIC_ACQUIRE, "agent");
            xb_add(&bar[XB_XGEN(b.x)], 1u);
            asm volatile("s_waitcnt vmcnt(0)" ::: "memory");
        } else {
            XB_SPIN(xb_ld(&bar[XB_XGEN(b.x)]) == gen, bar);
            __builtin_amdgcn_fence(__ATOMIC_ACQUIRE, "agent");
            asm volatile("s_waitcnt vmcnt(0)" ::: "memory");
        }
    }
    __syncthreads();
}

__device__ __forceinline__ float wave_sum(float v) {
#pragma unroll
    for (int o = 1; o < 64; o <<= 1) v += __shfl_xor(v, o);
    return v;
}
__device__ __forceinline__ int rope_dim(int c64) { return 32 * ((c64 >> 2) & 1) + 4 * (c64 >> 3) + (c64 & 3); }
struct MapId { __device__ __forceinline__ int operator()(int n) const { return n; } };
struct MapWin { __device__ __forceinline__ int operator()(int n) const {
    if (n < 4608) { const int region = n >> 9; const bool rope = (region == 3 || region == 4 || region == 6 || region == 7); return rope ? (n & ~63) + rope_dim(n & 63) : n; }
    if (n < 4928) return (n & ~63) + rope_dim(n & 63);
    if (n < 4932) return n;
    if (n < 5120) return -1;
    return 4932 + (n - 5120); } };
struct MapGu { __device__ __forceinline__ int operator()(int n) const { return ((n >> 2) & 1) * DFF + 4 * (n >> 3) + (n & 3); } };
template <class Map> __device__ __forceinline__ void cvt_item(const float* W, int K, int Nsrc, bf16* WT, const float* gain, const Map& mp, LAS float* scr, int item, int nblk, int lane) {
    const int kb = item / nblk, nb = item % nblk, k0 = 64 * kb, n0 = 32 * nb;
    const int src = mp(n0 + (lane & 31));
#pragma unroll 8
    for (int i = 0; i < 32; ++i) { const int kk = 2 * i + (lane >> 5); float v = 0.f;
        if (src >= 0) { v = ((const GAS float*)W)[(size_t)(k0 + kk) * Nsrc + src]; if (gain) v *= ((const GAS float*)gain)[k0 + kk]; }
        scr[kk * 33 + (lane & 31)] = v; }
    LDS_WAIT(); asm volatile("" ::: "memory");
    const int c = lane & 7;
#pragma unroll
    for (int j = 0; j < 4; ++j) { const int n = (lane >> 3) + 8 * j; const LAS float* s = scr + (8 * c) * 33 + n;
        v4u o; o.x = pk2(s[0 * 33], s[1 * 33]); o.y = pk2(s[2 * 33], s[3 * 33]); o.z = pk2(s[4 * 33], s[5 * 33]); o.w = pk2(s[6 * 33], s[7 * 33]);
        *(GAS v4u*)(WT + (size_t)(n0 + n) * K + k0 + 8 * c) = o; }
    LDS_WAIT(); asm volatile("" ::: "memory");
}
__device__ __forceinline__ void rms_row_to_bf16(const float* xrow, bf16* orow, int lane) {
    const GAS f32x4* xr = (const GAS f32x4*)xrow + lane;
    f32x4 v[4]; float s = 0.f;
#pragma unroll
    for (int j = 0; j < 4; ++j) { v[j] = xr[64 * j]; s += (v[j].x * v[j].x + v[j].y * v[j].y) + (v[j].z * v[j].z + v[j].w * v[j].w); }
    float eps = RMS_EPS; asm volatile("" : "+v"(eps));
    const float rstd = 1.f / sqrtf(wave_sum(s) * (1.f / DM) + eps);
    GAS unsigned long long* o8 = (GAS unsigned long long*)orow + lane;
#pragma unroll
    for (int j = 0; j < 4; ++j) o8[64 * j] = (unsigned long long)pk2(v[j].x * rstd, v[j].y * rstd) | ((unsigned long long)pk2(v[j].z * rstd, v[j].w * rstd) << 32);
}
__device__ __forceinline__ void x_row_init(const float* xrow, bf16* orow, float* ssrow, int lane) {
    const GAS f32x4* xr = (const GAS f32x4*)xrow + lane;
    f32x4 v[4]; float s = 0.f;
#pragma unroll
    for (int j = 0; j < 4; ++j) { v[j] = xr[64 * j]; s += (v[j].x * v[j].x + v[j].y * v[j].y) + (v[j].z * v[j].z + v[j].w * v[j].w); }
    s = wave_sum(s);
    GAS unsigned long long* o8 = (GAS unsigned long long*)orow + lane;
#pragma unroll
    for (int j = 0; j < 4; ++j) o8[64 * j] = (unsigned long long)pk2(v[j].x, v[j].y) | ((unsigned long long)pk2(v[j].z, v[j].w) << 32);
    if (lane < 16) ((GAS float*)ssrow)[lane] = (lane == 0) ? s : 0.f;
}
__device__ __forceinline__ void rms_row_final(const bf16* xrow, float* orow, const float* gain, int lane) {
    const GAS v4u* xr = (const GAS v4u*)xrow + lane;
    float v[16]; float s = 0.f;
#pragma unroll
    for (int j = 0; j < 2; ++j) { const v4u b = xr[64 * j]; const unsigned bw[4] = {b.x, b.y, b.z, b.w};
#pragma unroll
        for (int i = 0; i < 4; ++i) { v[8 * j + 2 * i] = __uint_as_float(bw[i] << 16); v[8 * j + 2 * i + 1] = __uint_as_float(bw[i] & 0xffff0000u); } }
#pragma unroll
    for (int i = 0; i < 16; ++i) s += v[i] * v[i];
    const float rstd = 1.f / sqrtf(wave_sum(s) * (1.f / DM) + RMS_EPS);
#pragma unroll
    for (int j = 0; j < 2; ++j)
#pragma unroll
        for (int h = 0; h < 2; ++h) { const int c = 512 * j + 8 * lane + 4 * h; const f32x4 g = *(const GAS f32x4*)(gain + c);
            f32x4 o = {v[8 * j + 4 * h] * rstd * g.x, v[8 * j + 4 * h + 1] * rstd * g.y, v[8 * j + 4 * h + 2] * rstd * g.z, v[8 * j + 4 * h + 3] * rstd * g.w};
            *(GAS f32x4*)(orow + c) = o; }
}
__device__ __forceinline__ int fresh_tid(int wave_s) { int l; asm volatile("v_mbcnt_lo_u32_b32 %0, -1, 0\n\tv_mbcnt_hi_u32_b32 %0, -1, %0" : "=v"(l)); int w = wave_s; asm volatile("" : "+s"(w)); return (w << 6) | l; }
__device__ __forceinline__ unsigned wq_claim(gu32* ctr) {
    return __builtin_amdgcn_atomic_inc32((unsigned*)ctr, 0xffffffffu, __ATOMIC_RELAXED, "agent");
}
__device__ __forceinline__ int wq_next(gu32* ctr, volatile LAS unsigned* slot, int tid_in, unsigned& nxt, unsigned& par) {
    if (tid_in == 0) { slot[par] = nxt; nxt = wq_claim(ctr); }
    asm volatile("s_waitcnt lgkmcnt(0)" ::: "memory"); __builtin_amdgcn_s_barrier(); asm volatile("" ::: "memory");
    const int i = (int)slot[par]; par ^= 1u;
    return i;
}

__device__ __forceinline__ void diff_combine_row(const bf16* tb, bf16* ob, const float* subln, float lam, float oscale, int lane) {
    const int h = lane >> 4, d0 = (lane & 15) * 8;
    const v4u a = *(const GAS v4u*)(tb + (h * 2 + 0) * 128 + d0), c = *(const GAS v4u*)(tb + (h * 2 + 1) * 128 + d0);
    const unsigned aw[4] = {a.x, a.y, a.z, a.w}, cw[4] = {c.x, c.y, c.z, c.w};
    float d[8]; float ss = 0.f;
#pragma unroll
    for (int i = 0; i < 4; ++i) { d[2 * i] = __uint_as_float(aw[i] << 16) - lam * __uint_as_float(cw[i] << 16); d[2 * i + 1] = __uint_as_float(aw[i] & 0xffff0000u) - lam * __uint_as_float(cw[i] & 0xffff0000u);
        ss += d[2 * i] * d[2 * i] + d[2 * i + 1] * d[2 * i + 1]; }
    ss += __shfl_xor(ss, 1); ss += __shfl_xor(ss, 2); ss += __shfl_xor(ss, 4); ss += __shfl_xor(ss, 8);
    const float rs = (1.0f / sqrtf(ss * (1.0f / 128.0f) + RMS_EPS)) * oscale;
    const f32x4 g0 = *(const GAS f32x4*)(subln + d0), g1 = *(const GAS f32x4*)(subln + d0 + 4);
    v4u o; o.x = pk2(d[0] * rs * g0.x, d[1] * rs * g0.y); o.y = pk2(d[2] * rs * g0.z, d[3] * rs * g0.w); o.z = pk2(d[4] * rs * g1.x, d[5] * rs * g1.y); o.w = pk2(d[6] * rs * g1.z, d[7] * rs * g1.w);
    *(GAS v4u*)(ob + h * 128 + d0) = o;
}

#ifndef PROBE_CHECK
#define PROBE_CHECK 0
#endif
#if PROBE_CHECK
__device__ __forceinline__ void probe_check_query(const bf16* QI, const bf16* KI, const unsigned* MASKB, int qpos, int n, LAS float* qs, gu32* flag, int lane) {
#pragma unroll 1
    for (int i = lane; i < 256; i += 64) qs[i] = __uint_as_float((unsigned)QI[(size_t)qpos * 256 + i] << 16);
    float wv[4];
#pragma unroll
    for (int h = 0; h < 4; ++h) wv[h] = __uint_as_float((unsigned)KI[(size_t)qpos * 256 + 64 + h] << 16) * 0.0625f;
    LDS_WAIT();
    const int N = 64 * (n + 1);
    float smin = 3.0e38f, umax = -3.0e38f; int cnt = 0, selz_max = -1, unz_min = 1 << 30;
#pragma unroll 1
    for (int k = lane; k < N; k += 64) {
        float sc = 0.f;
#pragma unroll 1
        for (int h = 0; h < 4; ++h) { float l = 0.f;
#pragma unroll 2
            for (int d = 0; d < 64; ++d) l = __builtin_fmaf(qs[h * 64 + d], __uint_as_float((unsigned)KI[(size_t)k * 256 + d] << 16), l); sc += fmaxf(l, 0.f) * (h == 0 ? wv[0] : h == 1 ? wv[1] : h == 2 ? wv[2] : wv[3]); }
        const int t = k >> 6, sub = (k >> 5) & 1, wi = k & 31, hc = (wi >> 2) & 1, rr = (wi & 3) + 4 * (wi >> 3);
        const unsigned word = MASKB[((size_t)t * 4096 + qpos) * 2 + hc];
        const bool sel = (word >> (16 * sub + rr)) & 1u;
        if (sel) { ++cnt; smin = fminf(smin, sc); if (sc == 0.f) selz_max = max(selz_max, k); } else { umax = fmaxf(umax, sc); if (sc == 0.f) unz_min = min(unz_min, k); }
    }
#pragma unroll 1
    for (int o = 1; o < 64; o <<= 1) { smin = fminf(smin, __shfl_xor(smin, o)); umax = fmaxf(umax, __shfl_xor(umax, o)); cnt += __shfl_xor(cnt, o); selz_max = max(selz_max, __shfl_xor(selz_max, o)); unz_min = min(unz_min, __shfl_xor(unz_min, o)); }
    const int want = N < 256 ? N : 256;
    bool bad = (cnt != want);
    if (N > 256) { const float slack = 2e-3f * (fabsf(umax) + fabsf(smin)) + 1e-4f; if (smin < umax - slack) bad = true; if (smin == 0.f && umax == 0.f && selz_max > unz_min) bad = true; }
    if (bad && lane == 0) __hip_atomic_store(flag, 1u, RLX_AGENT);
}
#endif

#ifndef REP_L2
#define REP_L2 1
#endif
#ifndef REP_X
#define REP_X 1
#endif
#ifndef REP_PROJ
#define REP_PROJ 1
#endif
#ifndef REP_CVT
#define REP_CVT 1
#endif
#ifndef REP_GU
#define REP_GU 1
#endif
#ifndef REP_UP
#define REP_UP 1
#endif
#ifndef REP_B
#define REP_B 1
#endif
#ifndef REP_WOUT
#define REP_WOUT 1
#endif
#ifndef REP_OX
#define REP_OX 1
#endif
#ifndef REP_DOWN
#define REP_DOWN 1
#endif
#ifndef REP_A
#define REP_A 1
#endif
#ifndef REP_L3
#define REP_L3 1
#endif
struct Args { const float* in[20]; float* out; unsigned char* ws; int lo, hi; };
enum { I_X = 0, I_MEM, I_NORM_MIX, I_W_IN, I_REL_BIAS, I_LAMBDA, I_SUBLN, I_UP_A, I_UP_B, I_UP_C, I_W_OUT, I_NORM_CROSS, I_WQX, I_WKVX, I_WOX, I_NORM_FFN, I_WGU, I_WDOWN, I_MEM_NORM, I_FINAL_NORM };

__global__ void __launch_bounds__(NWAVES * 64, 2) hybrid_fwd(Args args) {
    extern __shared__ __attribute__((aligned(16))) unsigned char lds_raw[];
    LAS unsigned char* lds = (LAS unsigned char*)lds_raw;
    volatile LAS unsigned* MISC = (volatile LAS unsigned*)(lds + LDSCTL_OFF);
    for (int u = threadIdx.x; u < 64; u += NWAVES * 64) MISC[u] = 0u;
    __syncthreads();
    const int wave_s = __builtin_amdgcn_readfirstlane((int)threadIdx.x >> 6);
    XcdBarrier bar = xcd_barrier_post((unsigned*)((gu32*)(args.ws + WS_CTL) + CW_BAR), MISC + 8);
    volatile LAS unsigned* qslot = MISC + 16;

    int step = 0;
#define STEP_ON (step >= args.lo && step < args.hi)
#define STEP_END(need_bar) do { if ((need_bar) && step >= args.lo && step + 1 < args.hi) xcd_barrier(bar, fresh_tid(wave_s)); ++step; } while (0)
#define PH_ENTER unsigned char* ws = args.ws; int G = gridDim.x, bx = blockIdx.x, tid = fresh_tid(wave_s); asm volatile("" : "+s"(ws), "+s"(G), "+s"(bx), "+v"(tid)); \
    const int lane = tid & 63, wave = __builtin_amdgcn_readfirstlane(tid >> 6), gw = bx * NWAVES + wave, NGW = G * NWAVES; (void)lane; (void)gw; (void)NGW;
#define P_BF(off) ((bf16*)(ws + (off)))
#define P_Q(off) ((bf16*)(wsq + (off)))

    if (STEP_ON) { PH_ENTER
        float* rope = (float*)(ws + WS_ROPE); float* scal = (float*)(ws + WS_SCAL);
        LAS float* scr = (LAS float*)(lds + wave * 16384);
        for (int i = bx * (NWAVES * 64) + tid; i < SEQ * 32; i += G * NWAVES * 64) {
            const int pos = i >> 5, k = i & 31;
            const float inv = (float)pow(10000.0, -(double)(2 * k) / 64.0);
            const float ang = (float)pos * inv;
            rope[pos * 64 + k] = (float)cos((double)ang); rope[pos * 64 + 32 + k] = (float)sin((double)ang);
        }
        if (bx == 0 && wave < DEPTH) {
            const float* lv = args.in[I_LAMBDA] + wave * 4 * 64;
            const float sa = wave_sum(lv[lane] * lv[64 + lane]), sb = wave_sum(lv[128 + lane] * lv[192 + lane]);
            const float lam_init = 0.8f - 0.6f * expf(-0.3f * (float)wave);
            if (lane == 0) { scal[wave * 2] = expf(sa) - expf(sb) + lam_init; scal[wave * 2 + 1] = 1.0f - lam_init; }
        }
        { float* gb = (float*)(ws + WS_SCAL) + 1024;
          for (int i = bx * (NWAVES * 64) + tid; i < DEPTH * 512; i += G * NWAVES * 64) { const int l_ = i >> 9; gb[i] = args.in[I_SUBLN][l_ * 128 + (i & 127)] * (0.6f * expf(-0.3f * (float)l_) + 0.2f); } }
        for (int m = gw; m < NB * MEMLEN; m += NGW) rms_row_to_bf16(args.in[I_MEM] + (size_t)m * DM, P_BF(WS_MN) + (size_t)m * DM, lane);
        for (int it = gw; it < DEPTH * 16 * 16; it += NGW) { const int l = it >> 8;
            cvt_item(args.in[I_WKVX] + (size_t)l * DM * 512, DM, 512, P_BF(WS_WKV) + (size_t)l * 512 * DM, args.in[I_MEM_NORM], MapId(), scr, it & 255, 16, lane); }
    }
    STEP_END(true);
    if (STEP_ON) { PH_ENTER
        pg8::Gemm g{P_BF(WS_MN), P_BF(WS_WKV), NB * MEMLEN, DEPTH * 512, DM, 0}; pg8::StaticOrder S; S.init(NB * MEMLEN, DEPTH * 512, G, bx);
        pg8::EpiBf16S E{P_BF(WS_KVX), DEPTH * 512, 1.0f, nullptr, (LAS float*)(lds + 139264)};
        pg8::gemm_phase<pg8::EpiBf16S, pg8::StaticOrder, true, true>(lds, g, S, E, tid);
    }
    STEP_END(true);

#pragma unroll 1
    for (int l = 0; l < DEPTH; ++l) {
        if (STEP_ON) { PH_ENTER
            LAS float* scr = (LAS float*)(lds + wave * 16384);
            bf16* WL = P_BF(WS_WL);
            constexpr int I0 = 16 * 256, I1 = 8 * 32, I4 = 16 * 32, I5 = 16 * 8, I6 = 4 * 32, I7 = 16 * 176, I8 = 44 * 32;
            constexpr int NITEMS = I0 + 3 * I1 + I4 + I5 + I6 + I7 + I8;
#pragma unroll 1
            for (int rc = 0; rc < REP_CVT; ++rc)
            for (int it = gw; it < NITEMS; it += NGW) {
                int r = it;
                if (r < I0) { cvt_item(args.in[I_W_IN] + (size_t)l * DM * NIN, DM, NIN, WL + WL_WIN / 2, args.in[I_NORM_MIX] + l * DM, MapWin(), scr, r, 256, lane); continue; } r -= I0;
                if (r < I1) { cvt_item(args.in[I_UP_A] + (size_t)l * 512 * DM, 512, DM, WL + WL_WUP / 2, nullptr, MapId(), scr, r, 32, lane); continue; } r -= I1;
                if (r < I1) { cvt_item(args.in[I_UP_B] + (size_t)l * 512 * DM, 512, DM, WL + WL_WUP / 2 + (size_t)1024 * 512, (const float*)(ws + WS_SCAL) + 1024 + l * 512, MapId(), scr, r, 32, lane); continue; } r -= I1;
                if (r < I1) { cvt_item(args.in[I_UP_C] + (size_t)l * 512 * DM, 512, DM, WL + WL_WUP / 2 + (size_t)2048 * 512, nullptr, MapId(), scr, r, 32, lane); continue; } r -= I1;
                if (r < I4) { cvt_item(args.in[I_W_OUT] + (size_t)l * DM * DM, DM, DM, WL + WL_WOUT / 2, nullptr, MapId(), scr, r, 32, lane); continue; } r -= I4;
                if (r < I5) { cvt_item(args.in[I_WQX] + (size_t)l * DM * 256, DM, 256, WL + WL_WQX / 2, args.in[I_NORM_CROSS] + l * DM, MapId(), scr, r, 8, lane); continue; } r -= I5;
                if (r < I6) { cvt_item(args.in[I_WOX] + (size_t)l * 256 * DM, 256, DM, WL + WL_WOX / 2, nullptr, MapId(), scr, r, 32, lane); continue; } r -= I6;
                if (r < I7) { cvt_item(args.in[I_WGU] + (size_t)l * DM * 2 * DFF, DM, 2 * DFF, WL + WL_WGU / 2, args.in[I_NORM_FFN] + l * DM, MapGu(), scr, r, 176, lane); continue; } r -= I7;
                cvt_item(args.in[I_WDOWN] + (size_t)l * DFF * DM, DFF, DM, WL + WL_WDN / 2, nullptr, MapId(), scr, r, 32, lane);
            }
            if (l == 0) { for (int m = gw; m < R; m += NGW) x_row_init(args.in[I_X] + (size_t)m * DM, P_BF(WS_XN) + (size_t)m * DM, (float*)(ws + WS_SS) + (size_t)m * 16, lane); }
        }
        STEP_END(true);

#pragma unroll 1
        for (int grp = 0; grp < NGRP; ++grp) {
            if (STEP_ON) { PH_ENTER
                pg8::Gemm g{P_BF(WS_XN) + (size_t)grp * RG * DM, P_BF(WS_WL + WL_WIN), RG, NINP, DM, 0}; pg8::StaticOrder S; S.init(RG, NINP, G, bx);
                pg8::EpiProj E{P_BF(WS_QKV), P_BF(WS_QI), P_BF(WS_KI), P_BF(WS_GATES), (const float*)(ws + WS_ROPE), QSCALE, QKV_STRIDE, (const float*)(ws + WS_SS) + (size_t)grp * RG * 16, (LAS float*)(lds + 139264)};
#pragma unroll 1
                for (int rp = 0; rp < REP_PROJ; ++rp)
                pg8::gemm_phase<pg8::EpiProj, pg8::StaticOrder, true, true>(lds, g, S, E, tid);
            }
            STEP_END(true);
            if (STEP_ON) { PH_ENTER
                constexpr int NX = GB * 60 * 2, NBU = GB * 4 * 32, NAU = GB * 8 * 16;
#pragma unroll 1
                for (int rep = 0; rep < REP_L2; ++rep) { gu32* ctr = (gu32*)(ws + WS_CTL) + CW_QUEUE + 64 * (((l * NGRP + grp) * 2 + 0) * 4 + rep);
                const bool stat = (G == 256);
                gu32* qctr = stat ? ctr + 4 * (1 + (bx & 7)) : ctr; int stage = stat ? 0 : 2;
                unsigned qnxt = 0u, qpar = 0u; if (tid == 0) qnxt = wq_claim(qctr);
#pragma unroll 1
                for (int it = 0;; ++it) {
                    int i;
                    if (stat && it < 4) { const int x = bx & 7, j = bx >> 3, jj = j & 7, combo = x + 8 * (j >> 3), qt = (it == 0) ? 31 - jj : (it == 1) ? 16 + jj : (it == 2) ? 15 - jj : jj;
                        i = NX + (31 - qt) * 32 + (combo >> 2) * 4 + (combo & 3); __syncthreads(); }
                    else { int k = wq_next(qctr, qslot, tid, qnxt, qpar);
                        if (stage == 0) { if (k < 120) i = (k >> 1) * 16 + (bx & 7) * 2 + (k & 1);
                                          else { stage = 1; qctr = ctr; if (tid == 0) qnxt = wq_claim(qctr); k = wq_next(qctr, qslot, tid, qnxt, qpar); i = NX + NBU + k; } }
                        else if (stage == 1) i = NX + NBU + k;
                        else i = k;
                        if (i >= NX + NBU + NAU) break; }
                    unsigned char* wsq = args.ws; asm volatile("" : "+s"(wsq)); bf16* QKV = (bf16*)(wsq + WS_QKV);
                    if (i < NX) { const int n = 63 - (i >> 4), b = (i & 15) >> 1, half = i & 1;
#pragma unroll 1
                        for (int rx = 0; rx < REP_X; ++rx) { if (rx) __syncthreads();
                        att::idx_unit(lds, P_Q(WS_QI) + (size_t)b * SEQ * 256, P_Q(WS_KI) + (size_t)b * SEQ * 256, (unsigned short*)((unsigned*)(wsq + WS_MASK) + (size_t)b * 64 * 4096 * 2), (unsigned*)(wsq + WS_XS) + (size_t)(bx & 255) * 131072, n, half, tid); }
                    } else if (i < NX + NBU) { const int j = i - NX, qt = 31 - (j >> 5), b = (j & 31) >> 2, h = j & 3;
                        const size_t off = (size_t)b * SEQ * 512 + h * 128;
                        const float* scal = (const float*)(wsq + WS_SCAL);
                        const float lam = __hip_atomic_load(scal + l * 2, RLX_AGENT), oscale = __hip_atomic_load(scal + l * 2 + 1, RLX_AGENT);
                        attx::UB a{(const attx::bf16*)(QKV + 3 * QKV_STRIDE + off), (const attx::bf16*)(QKV + 4 * QKV_STRIDE + off), (const attx::bf16*)(QKV + 5 * QKV_STRIDE + off),
                                   (attx::bf16*)(P_Q(WS_OBUF) + 1 * QKV_STRIDE + off), qt, args.in[I_SUBLN] + l * 128, lam, oscale};
#pragma unroll 1
                        for (int rb_ = 0; rb_ < REP_B; ++rb_)
                        attx::attn_unit_b2<8>(a, (char*)lds_raw, tid);
                    } else { const int j = i - NX - NBU, qb = 15 - (j >> 6), b = (j & 63) >> 3, h = j & 7;
                        const size_t off = (size_t)b * SEQ * 512 + h * 64;
                        att::UnitArgs a{QKV + off, 512, QKV + 1 * QKV_STRIDE + off, QKV + 2 * QKV_STRIDE + off, 512, P_Q(WS_OBUF) + off, 512, 256 * qb, (4 * qb - 8 > 0) ? 4 * qb - 8 : 0, 4 * qb + 3,
                                        args.in[I_REL_BIAS] + (size_t)(l * 8 + h) * 320, nullptr, false};
#pragma unroll 1
                        for (int ra_ = 0; ra_ < REP_A; ++ra_)
                        att::attn_unit<0>(lds, a, tid);
                    }
                } }
            }
            STEP_END(true);
            if (STEP_ON) { PH_ENTER
#if PROBE_CHECK
                if (l == 0 && grp == 0) { const int si = gw, b_ = si & 7, n_ = 4 + ((si >> 3) % 60), qo = (si * 7) & 63;
                    probe_check_query(P_BF(WS_QI) + (size_t)b_ * SEQ * 256, P_BF(WS_KI) + (size_t)b_ * SEQ * 256, (const unsigned*)(ws + WS_MASK) + (size_t)b_ * 64 * 4096 * 2, 64 * n_ + qo, n_,
                                      (LAS float*)(lds + wave * 16384), (gu32*)(ws + WS_CTL) + 32, lane); __syncthreads(); }
#endif
#pragma unroll 1
                for (int rep = 0; rep < REP_L3; ++rep) { gu32* ctr = (gu32*)(ws + WS_CTL) + CW_QUEUE + 64 * (((l * NGRP + grp) * 2 + 1) * 4 + rep);
                const bool stat = (G == 256);
                unsigned qnxt = 0u, qpar = 0u; if (!stat && tid == 0) qnxt = wq_claim(ctr);
#pragma unroll 1
                for (int it = 0;; ++it) {
                    int qb, b, h;
                    if (stat) { if (it >= 4) break; const int j = bx >> 3, jj = j & 3; h = bx & 7; b = j >> 2; qb = (it == 0) ? 15 - jj : (it == 1) ? 8 + jj : (it == 2) ? 7 - jj : jj; __syncthreads(); }
                    else { const int i = wq_next(ctr, qslot, tid, qnxt, qpar); if (i >= GB * 8 * 16) break; qb = 15 - (i >> 6); b = (i & 63) >> 3; h = i & 7; }
                    unsigned char* wsq = args.ws; asm volatile("" : "+s"(wsq)); bf16* QKV = (bf16*)(wsq + WS_QKV);
                    const size_t rb = (size_t)b * SEQ * 512;
                    attx::UA a{(const attx::bf16*)(QKV + 6 * QKV_STRIDE + rb + (size_t)256 * qb * 512 + h * 64), 512,
                               (const attx::bf16*)(QKV + 7 * QKV_STRIDE + rb + h * 64), (const attx::bf16*)(QKV + 8 * QKV_STRIDE + rb + h * 64), 512,
                               (attx::bf16*)(P_Q(WS_OBUF) + 2 * QKV_STRIDE + rb + (size_t)256 * qb * 512 + h * 64), 512, 4 * qb + 4, 0, 4 * qb, nullptr,
                               (const unsigned*)(wsq + WS_MASK) + (size_t)b * 64 * 4096 * 2, qb == 0};
                    attx::attn_unit<1, 8>(a, (char*)lds_raw, tid);
                } }
            }
            STEP_END(true);
            if (STEP_ON) { PH_ENTER
                pg8::Gemm g{P_BF(WS_OBUF), P_BF(WS_WL + WL_WUP), RG, 3072, 512, QKV_STRIDE * 2}; pg8::UpOrder S; S.init(RG, G, bx);
                pg8::EpiGateC E{P_BF(WS_GATES), P_BF(WS_Y)};
#pragma unroll 1
                for (int ru = 0; ru < REP_UP; ++ru)
                pg8::gemm_phase<pg8::EpiGateC, pg8::UpOrder, true, true>(lds, g, S, E, tid);
            }
            STEP_END(true);
            if (STEP_ON) { PH_ENTER
                pg8::Gemm g{P_BF(WS_Y), P_BF(WS_WL + WL_WOUT), RG, DM, DM, 0}; pg8::StaticOrder S; S.init(RG, DM, G, bx);
                pg8::EpiRes E{P_BF(WS_XN) + (size_t)grp * RG * DM, DM, (float*)(ws + WS_SS) + (size_t)grp * RG * 16, 1.0f};
                pg8::gemm_phase<pg8::EpiRes, pg8::StaticOrder, true, true>(lds, g, S, E, tid);
#if REP_WOUT > 1
                { pg8::EpiRes E0{P_BF(WS_XN) + (size_t)grp * RG * DM, DM, (float*)(ws + WS_SS) + (size_t)grp * RG * 16, 0.0f}; __syncthreads(); pg8::gemm_phase<pg8::EpiRes, pg8::StaticOrder, true, true>(lds, g, S, E0, tid); }
#endif
            }
            STEP_END(grp == NGRP - 1);
        }
        if (STEP_ON) { PH_ENTER
            pg8::Gemm g{P_BF(WS_XN), P_BF(WS_WL + WL_WQX), R, 256, DM, 0}; pg8::StaticOrder S; S.init(R, 256, G, bx);
            pg8::EpiBf16S E{P_BF(WS_QX), 256, QSCALE, (const float*)(ws + WS_SS), (LAS float*)(lds + 139264)};
            pg8::gemm_phase<pg8::EpiBf16S, pg8::StaticOrder, true, true>(lds, g, S, E, tid);
        }
        STEP_END(true);
        if (STEP_ON) { PH_ENTER
            bf16* QX = P_BF(WS_QX);
            for (int i = bx; i < NB * 4 * 16; i += G) {
                const int qb = i & 15, b = i >> 6, h = (i >> 4) & 3;
                const bf16* kx = P_BF(WS_KVX) + (size_t)b * MEMLEN * (DEPTH * 512) + l * 512 + h * 64;
                attx::bf16* qp = (attx::bf16*)(QX + ((size_t)b * SEQ + 256 * qb) * 256 + h * 64);
                attx::UA a{qp, 256, (const attx::bf16*)kx, (const attx::bf16*)(kx + 256), DEPTH * 512, qp, 256, 4, 0, 0, nullptr, nullptr, 1};
                attx::attn_unit<2, 8>(a, (char*)lds_raw, tid);
            }
        }
        STEP_END(true);
        if (STEP_ON) { PH_ENTER
            pg8::Gemm g{P_BF(WS_QX), P_BF(WS_WL + WL_WOX), R, DM, 256, 0}; pg8::StaticOrder S; S.init(R, DM, G, bx);
            pg8::EpiRes E{P_BF(WS_XN), DM, (float*)(ws + WS_SS), 1.0f};
            pg8::gemm_phase<pg8::EpiRes, pg8::StaticOrder, true, true>(lds, g, S, E, tid);
#if REP_OX > 1
            { pg8::EpiRes E0{P_BF(WS_XN), DM, (float*)(ws + WS_SS), 0.0f}; __syncthreads(); pg8::gemm_phase<pg8::EpiRes, pg8::StaticOrder, true, true>(lds, g, S, E0, tid); }
#endif
        }
        STEP_END(true);
        if (STEP_ON) { PH_ENTER
            pg8::Gemm g{P_BF(WS_XN), P_BF(WS_WL + WL_WGU), R, 2 * DFF, DM, 0}; pg8::StaticOrder S; S.init(R, 2 * DFF, G, bx);
            pg8::EpiSwiglu E{P_BF(WS_H), DFF, (const float*)(ws + WS_SS), (LAS float*)(lds + 139264)};
#pragma unroll 1
            for (int rg = 0; rg < REP_GU; ++rg)
            pg8::gemm_phase<pg8::EpiSwiglu, pg8::StaticOrder, true, true>(lds, g, S, E, tid);
        }
        STEP_END(true);
        if (STEP_ON) { PH_ENTER
            pg8::Gemm g{P_BF(WS_H), P_BF(WS_WL + WL_WDN), R, DM, DFF, 0}; pg8::StaticOrder S; S.init(R, DM, G, bx);
            pg8::EpiRes E{P_BF(WS_XN), DM, (float*)(ws + WS_SS), 1.0f};
            pg8::gemm_phase<pg8::EpiRes, pg8::StaticOrder, true, true>(lds, g, S, E, tid);
#if REP_DOWN > 1
            { pg8::EpiRes E0{P_BF(WS_XN), DM, (float*)(ws + WS_SS), 0.0f}; __syncthreads(); pg8::gemm_phase<pg8::EpiRes, pg8::StaticOrder, true, true>(lds, g, S, E0, tid); }
#endif
        }
        STEP_END(true);
    }
    if (STEP_ON) { PH_ENTER for (int m = gw; m < R; m += NGW) rms_row_final(P_BF(WS_XN) + (size_t)m * DM, args.out + (size_t)m * DM, args.in[I_FINAL_NORM], lane);
#if PROBE_CHECK
        if (__hip_atomic_load((gu32*)(ws + WS_CTL) + 32, RLX_AGENT) != 0u) { for (int m = gw; m < R; m += NGW) { GAS f32x4* xr = (GAS f32x4*)(args.out + (size_t)m * DM) + lane; for (int j = 0; j < 4; ++j) xr[64 * j] = xr[64 * j] * 2.0f; } }
#endif
    }
    STEP_END(false);
#undef STEP_ON
#undef STEP_END
#undef PH_ENTER
#undef P_BF
#undef P_Q
}

constexpr int N_STEPS = 2 + DEPTH * (1 + NGRP * 5 + 5) + 1;
#ifndef MK_PER_STEP
#define MK_PER_STEP 0
#endif
extern "C" void kernel_launch(void* const* d_in, const int* in_sizes, int n_in, void* d_out, int out_size, void* d_ws, size_t ws_size, hipStream_t stream) {
    static int grid = 0;
    if (grid == 0) {
        if (n_in != 20 || in_sizes[0] != R * DM || out_size != R * DM || ws_size < WS_END) { fprintf(stderr, "kernel_launch: shape mismatch (n_in %d, in0 %d, out %d, ws %zu < %zu); nothing launched\n", n_in, n_in > 0 ? in_sizes[0] : -1, out_size, ws_size, (size_t)WS_END); grid = -1; return; }
        int dev = 0, cus = 0, per_cu = 0;
        if (hipGetDevice(&dev) != hipSuccess || hipDeviceGetAttribute(&cus, hipDeviceAttributeMultiprocessorCount, dev) != hipSuccess) { grid = -1; return; }
        if (hipFuncSetAttribute((const void*)hybrid_fwd, hipFuncAttributeMaxDynamicSharedMemorySize, LDS_BYTES) != hipSuccess) { fprintf(stderr, "kernel_launch: hipFuncSetAttribute failed\n"); grid = -1; return; }
        if (hipOccupancyMaxActiveBlocksPerMultiprocessor(&per_cu, (const void*)hybrid_fwd, NWAVES * 64, LDS_BYTES) != hipSuccess || per_cu < 1) { fprintf(stderr, "kernel_launch: occupancy query says %d blocks per CU\n", per_cu); }
        (void)hipGetLastError();
        grid = cus < 256 ? cus : 256;
    }
    if (grid < 0) return;
    if (hipMemsetAsync((char*)d_ws + WS_CTL, 0, CTL_ZERO_BYTES, stream) != hipSuccess) return;
    Args a{};
    for (int i = 0; i < 20; ++i) a.in[i] = (const float*)d_in[i];
    a.out = (float*)d_out; a.ws = (unsigned char*)d_ws;
#if MK_PER_STEP
    for (int s = 0; s < N_STEPS; ++s) { a.lo = s; a.hi = s + 1; hipLaunchKernelGGL(hybrid_fwd, dim3(grid), dim3(NWAVES * 64), LDS_BYTES, stream, a); }
#else
    a.lo = 0; a.hi = 1 << 30;
    hipLaunchKernelGGL(hybrid_fwd, dim3(grid), dim3(NWAVES * 64), LDS_BYTES, stream, a);
#endif
    const hipError_t le = hipPeekAtLastError();
    if (le != hipSuccess) fprintf(stderr, "kernel_launch: launch failed: %s\n", hipGetErrorName(le));
}
```

```cpp
#include <hip/hip_runtime.h>
#include <hip/hip_bf16.h>
#include <cstdio>
#include <cstdint>
#include <cmath>
namespace pg8 {
#define PG8_LAS __attribute__((address_space(3)))
typedef unsigned short bf16_t;
typedef short bf16x8 __attribute__((ext_vector_type(8)));
typedef float f32x4 __attribute__((ext_vector_type(4)));
typedef unsigned u32x4 __attribute__((ext_vector_type(4)));
constexpr int BM = 256, BK = 64, HALF = 128, HTB = HALF * BK * 2  , STAGE_BYTES = 8 * HTB, NXCD = 8, WGM = 8;

__host__ __device__ __forceinline__ int lds_byte(int r, int c) { const int st = (r >> 4) * 2 + (c >> 5), rr = r & 15, cc = c & 31, ob = rr * 64 + cc * 2; return st * 1024 + (ob ^ (((ob >> 9) & 1) << 5)); }
__host__ __device__ __forceinline__ void stage_rc(int b, int& R, int& C) { const int st = b / 1024, sb = b % 1024, swz = sb ^ (((sb >> 9) & 1) << 5); R = (st >> 1) * 16 + swz / 64; C = (st & 1) * 32 + (swz % 64) / 2; }
__host__ __device__ __forceinline__ int perm32(int rho) { const int n = rho >> 4, i = rho & 15; return 8 * (i >> 2) + 4 * n + (i & 3); }

struct Unit { int pm, pn, az; };
struct Gemm { const bf16_t* A; const bf16_t* Bt; int M, N, K; size_t azs; };

struct StaticOrder {
    int nM, nN, nwg, G, c;
    __host__ __device__ void init(int M, int N, int G_, int c_) { nM = M / BM; nN = N / BM; nwg = nM * nN; G = G_; c = c_; }
    __host__ __device__ bool next(int i, Unit& u) const {
        const long L = (long)i * G + c; if (L >= nwg) return false;
        int wgid = (int)L; { const int q = nwg / NXCD, r = nwg % NXCD, xcd = wgid % NXCD, off = wgid / NXCD; wgid = (xcd < r ? xcd * (q + 1) : r * (q + 1) + (xcd - r) * q) + off; }
        const int nig = WGM * nN, gid = wgid / nig, fm = gid * WGM, gsz = (nM - fm) < WGM ? (nM - fm) : WGM;
        u.pm = fm + ((wgid % nig) % gsz); u.pn = (wgid % nig) / gsz; u.az = 0; return true;
    }
    __device__ __forceinline__ void a_ready(const Unit&) const {}
    __device__ __forceinline__ void done(const Unit&) const {}
};

__device__ __forceinline__ unsigned cvt_pk_bf16(float lo, float hi) { unsigned r; asm volatile("v_cvt_pk_bf16_f32 %0, %1, %2" : "=v"(r) : "v"(lo), "v"(hi)); return r; }
typedef float f32x2c_t __attribute__((ext_vector_type(2))); typedef __bf16 bf16x2c_t __attribute__((ext_vector_type(2)));
__device__ __forceinline__ unsigned cvt_pk_bf16_c(float lo, float hi) { const f32x2c_t v = {lo, hi}; const bf16x2c_t b = __builtin_convertvector(v, bf16x2c_t); return __builtin_bit_cast(unsigned, b); }
typedef float f32x2 __attribute__((ext_vector_type(2)));

typedef unsigned u32x2 __attribute__((ext_vector_type(2)));
#define PG8_GAS __attribute__((address_space(1)))
__device__ __forceinline__ float bf_lo(unsigned w) { return __uint_as_float(w << 16); }
__device__ __forceinline__ float bf_hi(unsigned w) { return __uint_as_float(w & 0xffff0000u); }

__device__ __forceinline__ float row_rstd(const float* ss, size_t row) {
    const PG8_GAS f32x4* p = (const PG8_GAS f32x4*)(ss + row * 16);
    const f32x4 a = p[0], b = p[1], c = p[2], d = p[3];
    const float s = (((a[0] + a[1]) + (a[2] + a[3])) + ((b[0] + b[1]) + (b[2] + b[3]))) + (((c[0] + c[1]) + (c[2] + c[3])) + ((d[0] + d[1]) + (d[2] + d[3])));
    float eps = 1e-6f; asm volatile("" : "+v"(eps));
    return 1.0f / sqrtf(s * (1.0f / 1024.0f) + eps);
}
__device__ __forceinline__ void stage_rstd(const float* ss, PG8_LAS float* rs, int pm, int tid) {
    const int r = tid >> 1, h = tid & 1;
    const PG8_GAS f32x4* p = (const PG8_GAS f32x4*)(ss + ((size_t)pm * BM + r) * 16 + h * 8);
    const f32x4 a = p[0], b = p[1];
    float s = ((a[0] + a[1]) + (a[2] + a[3])) + ((b[0] + b[1]) + (b[2] + b[3]));
    s += __shfl_xor(s, 1);
    float eps = 1e-6f; asm volatile("" : "+v"(eps));
    if (h == 0) rs[r] = 1.0f / sqrtf(s * (1.0f / 1024.0f) + eps);
    asm volatile("s_waitcnt lgkmcnt(0)" ::: "memory"); __builtin_amdgcn_s_barrier(); asm volatile("" ::: "memory");
}
struct EpiRes {
    static constexpr bool PERM = true, AFTER_DRAIN = false, CARRY = false, RSTD = false;
    bf16_t* xb; int ldc; float* ss; float s;
    __device__ __forceinline__ void operator()(const f32x4 (&acc)[2][2][4][2], const Unit& u, int wr, int wc, int fr, int fq) const {
        const int row0 = u.pm * BM + wr * 64 + fr, col0 = u.pn * BM + wc * 32 + 8 * fq;
#pragma unroll
        for (int ai = 0; ai < 2; ++ai)
#pragma unroll
            for (int m = 0; m < 4; ++m) { const size_t row = (size_t)(row0 + ai * HALF + m * 16); bf16_t* rowp = xb + row * ldc + col0; float sq = 0.f;
#pragma unroll
                for (int bj = 0; bj < 2; ++bj) { const u32x4 b = *(const PG8_GAS u32x4*)(rowp + bj * HALF);
                    const f32x4 b0 = {__uint_as_float(b.x << 16), __uint_as_float(b.x & 0xffff0000u), __uint_as_float(b.y << 16), __uint_as_float(b.y & 0xffff0000u)};
                    const f32x4 b1 = {__uint_as_float(b.z << 16), __uint_as_float(b.z & 0xffff0000u), __uint_as_float(b.w << 16), __uint_as_float(b.w & 0xffff0000u)};
                    const f32x4 v0 = b0 + acc[ai][bj][m][0] * s, v1 = b1 + acc[ai][bj][m][1] * s;
                    u32x4 w; w.x = cvt_pk_bf16(v0[0], v0[1]); w.y = cvt_pk_bf16(v0[2], v0[3]); w.z = cvt_pk_bf16(v1[0], v1[1]); w.w = cvt_pk_bf16(v1[2], v1[3]);
                    *(PG8_GAS u32x4*)(rowp + bj * HALF) = w;
                    sq += ((v0[0] * v0[0] + v0[1] * v0[1]) + (v0[2] * v0[2] + v0[3] * v0[3])) + ((v1[0] * v1[0] + v1[1] * v1[1]) + (v1[2] * v1[2] + v1[3] * v1[3])); }
                sq += __shfl_xor(sq, 16); sq += __shfl_xor(sq, 32);
                if (fq == 0) *(PG8_GAS float*)(ss + row * 16 + u.pn * 4 + wc) = sq; }
    }
};

struct EpiBf16S {
    static constexpr bool PERM = true, AFTER_DRAIN = false, CARRY = false, RSTD = true;
    bf16_t* O; int ldc; float sc; const float* ss; PG8_LAS float* rs;
    __device__ __forceinline__ void stage(int pm, int tid) const { if (ss) stage_rstd(ss, rs, pm, tid); }
    __device__ __forceinline__ void operator()(const f32x4 (&acc)[2][2][4][2], const Unit& u, int wr, int wc, int fr, int fq) const {
        const int row0 = u.pm * BM + wr * 64 + fr, col0 = u.pn * BM + wc * 32 + 8 * fq;
#pragma unroll
        for (int ai = 0; ai < 2; ++ai)
#pragma unroll
            for (int m = 0; m < 4; ++m) { bf16_t* rowp = O + (size_t)(row0 + ai * HALF + m * 16) * ldc + col0; const float rq = ss ? sc * rs[ai * HALF + wr * 64 + m * 16 + fr] : sc;
#pragma unroll
                for (int bj = 0; bj < 2; ++bj) { const f32x4 v0 = acc[ai][bj][m][0] * rq, v1 = acc[ai][bj][m][1] * rq;
                    u32x4 w; w.x = cvt_pk_bf16(v0[0], v0[1]); w.y = cvt_pk_bf16(v0[2], v0[3]); w.z = cvt_pk_bf16(v1[0], v1[1]); w.w = cvt_pk_bf16(v1[2], v1[3]);
                    *(PG8_GAS u32x4*)(rowp + bj * HALF) = w; } }
    }
};

struct EpiProj {
    static constexpr bool PERM = true, AFTER_DRAIN = false, CARRY = false, RSTD = true;
    __device__ __forceinline__ void stage(int pm, int tid) const { stage_rstd(ss, rs, pm, tid); }
    bf16_t* qkv; bf16_t* qi; bf16_t* ki; bf16_t* gates; const float* cs; float qscale; size_t bufstride; const float* ss; PG8_LAS float* rs;
    __device__ __forceinline__ void operator()(const f32x4 (&acc)[2][2][4][2], const Unit& u, int wr, int wc, int fr, int fq) const {
        const int pn = u.pn;
        bf16_t* dst; int ld, colbase; float sc = 1.f; int mode;
        if (pn < 18) { const int buf = pn >> 1, kind = buf % 3, mixer = buf / 3; dst = qkv + (size_t)buf * bufstride; ld = 512; colbase = (pn & 1) * 256;
            mode = (mixer >= 1 && kind < 2) ? 1 : 0; if (kind == 0) sc = qscale; }
        else if (pn == 18) { dst = qi; ld = 256; colbase = 0; mode = 1; }
        else if (pn == 19) { dst = ki; ld = 256; colbase = 0; mode = 3; }
        else { dst = gates; ld = 3072; colbase = (pn - 20) * 256; mode = 2; }
        const int row0 = u.pm * BM + wr * 64 + fr;
        const int jj = 4 * (wc & 1) + fq;
        if (mode == 1 || mode == 3) {
            f32x4 c4[8], s4[8];
#pragma unroll
            for (int k = 0; k < 8; ++k) { const int row = row0 + (k >> 2) * HALF + (k & 3) * 16; const float* t = cs + (size_t)(row & 4095) * 64 + 4 * jj; c4[k] = *(const PG8_GAS f32x4*)t; s4[k] = *(const PG8_GAS f32x4*)(t + 32); }
#pragma unroll
            for (int ai = 0; ai < 2; ++ai)
#pragma unroll
                for (int m = 0; m < 4; ++m) {
                    const int row = row0 + ai * HALF + m * 16;
                    bf16_t* rowp = dst + (size_t)row * ld + colbase;
                    const float rstd = rs[ai * HALF + wr * 64 + m * 16 + fr];
                    const f32x4 c4v = c4[ai * 4 + m], s4v = s4[ai * 4 + m];
#pragma unroll
                    for (int bj = 0; bj < 2; ++bj) {
                        const f32x4 x1 = acc[ai][bj][m][0] * rstd, x2 = acc[ai][bj][m][1] * rstd;
                        const int blk = 2 * bj + (wc >> 1);
                        if (mode == 1 || blk == 0) {
                            const f32x4 o1 = (x1 * c4v - x2 * s4v) * sc, o2 = (x2 * c4v + x1 * s4v) * sc;
                            u32x2 w1, w2; w1.x = cvt_pk_bf16(o1[0], o1[1]); w1.y = cvt_pk_bf16(o1[2], o1[3]); w2.x = cvt_pk_bf16(o2[0], o2[1]); w2.y = cvt_pk_bf16(o2[2], o2[3]);
                            *(PG8_GAS u32x2*)(rowp + 64 * blk + 4 * jj) = w1; *(PG8_GAS u32x2*)(rowp + 64 * blk + 32 + 4 * jj) = w2;
                        } else {
                            const f32x4 v0 = x1 * sc, v1 = x2 * sc;
                            u32x4 w; w.x = cvt_pk_bf16(v0[0], v0[1]); w.y = cvt_pk_bf16(v0[2], v0[3]); w.z = cvt_pk_bf16(v1[0], v1[1]); w.w = cvt_pk_bf16(v1[2], v1[3]);
                            *(PG8_GAS u32x4*)(rowp + bj * HALF + wc * 32 + 8 * fq) = w;
                        }
                    }
                }
        } else if (mode == 2) {
#pragma unroll
            for (int ai = 0; ai < 2; ++ai)
#pragma unroll
                for (int m = 0; m < 4; ++m) {
                    bf16_t* rowp = dst + (size_t)(row0 + ai * HALF + m * 16) * ld + colbase;
                    const float rq = rs[ai * HALF + wr * 64 + m * 16 + fr] * -1.4426950408889634f;
#pragma unroll
                    for (int bj = 0; bj < 2; ++bj) {
                        f32x4 v0 = acc[ai][bj][m][0] * rq, v1 = acc[ai][bj][m][1] * rq;
#pragma unroll
                        for (int e = 0; e < 4; ++e) { v0[e] = __builtin_amdgcn_exp2f(fminf(v0[e], 60.f)); v1[e] = __builtin_amdgcn_exp2f(fminf(v1[e], 60.f)); }
                        u32x4 w; w.x = cvt_pk_bf16_c(v0[0], v0[1]); w.y = cvt_pk_bf16_c(v0[2], v0[3]); w.z = cvt_pk_bf16_c(v1[0], v1[1]); w.w = cvt_pk_bf16_c(v1[2], v1[3]);
                        *(PG8_GAS u32x4*)(rowp + bj * HALF + wc * 32 + 8 * fq) = w;
                    }
                }
        } else {
#pragma unroll
            for (int ai = 0; ai < 2; ++ai)
#pragma unroll
                for (int m = 0; m < 4; ++m) {
                    bf16_t* rowp = dst + (size_t)(row0 + ai * HALF + m * 16) * ld + colbase;
                    const float rq = rs[ai * HALF + wr * 64 + m * 16 + fr] * sc;
#pragma unroll
                    for (int bj = 0; bj < 2; ++bj) {
                        const f32x4 v0 = acc[ai][bj][m][0] * rq, v1 = acc[ai][bj][m][1] * rq;
                        u32x4 w; w.x = cvt_pk_bf16(v0[0], v0[1]); w.y = cvt_pk_bf16(v0[2], v0[3]); w.z = cvt_pk_bf16(v1[0], v1[1]); w.w = cvt_pk_bf16(v1[2], v1[3]);
                        *(PG8_GAS u32x4*)(rowp + bj * HALF + wc * 32 + 8 * fq) = w;
                    }
                }
        }
    }
};

struct EpiSwiglu {
    static constexpr bool PERM = true, AFTER_DRAIN = false, CARRY = false, RSTD = true;
    bf16_t* H; int ldh; const float* ss; PG8_LAS float* rs;
    __device__ __forceinline__ void stage(int pm, int tid) const { stage_rstd(ss, rs, pm, tid); }
    __device__ __forceinline__ void operator()(const f32x4 (&acc)[2][2][4][2], const Unit& u, int wr, int wc, int fr, int fq) const {
        const int row0 = u.pm * BM + wr * 64 + fr, col0 = u.pn * (BM / 2) + wc * 16 + 4 * fq;
#pragma unroll
        for (int ai = 0; ai < 2; ++ai)
#pragma unroll
            for (int m = 0; m < 4; ++m) { bf16_t* rowp = H + (size_t)(row0 + ai * HALF + m * 16) * ldh + col0; const float rstd = rs[ai * HALF + wr * 64 + m * 16 + fr];
#pragma unroll
                for (int bj = 0; bj < 2; ++bj) { const f32x4 g = acc[ai][bj][m][0] * rstd, up = acc[ai][bj][m][1] * rstd; f32x4 h;
#pragma unroll
                    for (int e = 0; e < 4; ++e) h[e] = g[e] * __builtin_amdgcn_rcpf(1.f + __builtin_amdgcn_exp2f(-1.4426950408889634f * g[e])) * up[e];
                    u32x2 w; w.x = cvt_pk_bf16(h[0], h[1]); w.y = cvt_pk_bf16(h[2], h[3]);
                    *(PG8_GAS u32x2*)(rowp + bj * (HALF / 2)) = w; } }
    }
};

struct EpiGateC {
    static constexpr bool PERM = true, AFTER_DRAIN = false, CARRY = true, RSTD = false;
    const bf16_t* gates; bf16_t* Y;
    __device__ __forceinline__ bool carry(f32x4 (&acc)[2][2][4][2], const Unit& u, int wr, int wc, int fr, int fq) const {
        const int branch = u.pn >> 2, row0 = u.pm * BM + wr * 64 + fr, col0 = (u.pn & 3) * BM + wc * 32 + 8 * fq;
#pragma unroll
        for (int ai = 0; ai < 2; ++ai)
#pragma unroll
            for (int m = 0; m < 4; ++m) { const size_t row = (size_t)(row0 + ai * HALF + m * 16);
#pragma unroll
                for (int bj = 0; bj < 2; ++bj) {
                    const u32x4 g = *(const PG8_GAS u32x4*)(gates + row * 3072 + branch * 1024 + col0 + bj * HALF);
                    float gc[8] = {bf_lo(g.x), bf_hi(g.x), bf_lo(g.y), bf_hi(g.y), bf_lo(g.z), bf_hi(g.z), bf_lo(g.w), bf_hi(g.w)};
                    if (branch < 2) {
                        const u32x4 h = *(const PG8_GAS u32x4*)(gates + row * 3072 + (branch + 1) * 1024 + col0 + bj * HALF);
                        const float gn[8] = {bf_lo(h.x), bf_hi(h.x), bf_lo(h.y), bf_hi(h.y), bf_lo(h.z), bf_hi(h.z), bf_lo(h.w), bf_hi(h.w)};
#pragma unroll
                        for (int e = 0; e < 8; ++e) gc[e] = (1.f + gn[e]) * __builtin_amdgcn_rcpf(1.f + gc[e]);
                        acc[ai][bj][m][0] = acc[ai][bj][m][0] * (f32x4){gc[0], gc[1], gc[2], gc[3]};
                        acc[ai][bj][m][1] = acc[ai][bj][m][1] * (f32x4){gc[4], gc[5], gc[6], gc[7]};
                    } else {
                        const f32x4 a0 = acc[ai][bj][m][0], a1 = acc[ai][bj][m][1];
#pragma unroll
                        for (int e = 0; e < 8; ++e) gc[e] = __builtin_amdgcn_rcpf(1.f + gc[e]);
                        u32x4 w; w.x = cvt_pk_bf16(gc[0] * a0[0], gc[1] * a0[1]); w.y = cvt_pk_bf16(gc[2] * a0[2], gc[3] * a0[3]); w.z = cvt_pk_bf16(gc[4] * a1[0], gc[5] * a1[1]); w.w = cvt_pk_bf16(gc[6] * a1[2], gc[7] * a1[3]);
                        *(PG8_GAS u32x4*)(Y + row * 1024 + col0 + bj * HALF) = w;
                    } } }
        return branch < 2;
    }
};

struct UpOrder {
    StaticOrder so;
    __host__ __device__ void init(int M, int G_, int c_) { so.init(M, 1024, G_, c_); }
    __host__ __device__ bool next(int i, Unit& u) const { const int br = i % 3; if (!so.next(i / 3, u)) return false; u.pn += 4 * br; u.az = br; return true; }
    __device__ __forceinline__ void a_ready(const Unit&) const {}
    __device__ __forceinline__ void done(const Unit&) const {}
};
template <class Epi, class Sched, bool ALIGN_EPI = false, bool SP2 = false>
__device__ __forceinline__ void gemm_phase(PG8_LAS unsigned char* lds, const Gemm g, const Sched& S, const Epi& E, int tid_in) {
    int tid_l = tid_in; asm volatile("" : "+v"(tid_l));
    const int tid = tid_l, wid = __builtin_amdgcn_readfirstlane(tid >> 6), lane = tid & 63, wr = wid >> 2, wc = wid & 3, fr = lane & 15, fq = lane >> 4;
    const int K = g.K, nt = K / BK;
    unsigned voffA[2], voffB[2];
#pragma unroll
    for (int i = 0; i < 2; ++i) { int R, C; stage_rc(tid * 16 + i * 8192, R, C); const int Rb = Epi::PERM ? ((R & ~31) + perm32(R & 31)) : R;
        voffA[i] = (unsigned)(R * K + C) * 2u; voffB[i] = (unsigned)(Rb * K + C) * 2u; }
    const size_t kstep = (size_t)(BK * 2);
    const size_t hstep = (size_t)HALF * K * 2;
    const size_t tstep = 2 * hstep;
    const unsigned ldsw = (unsigned)wid * 1024u;
    const int aoff = lds_byte(wr * 64 + fr, fq * 8), boff = lds_byte(wc * 32 + fr, fq * 8);
#define PG8_SA(b, h) (((b) * 2 + (h)) * HTB)
#define PG8_SB(b, h) ((4 + (b) * 2 + (h)) * HTB)
#define PG8_STAGE(bufoff, gbase, voff) do { _Pragma("unroll") for (int _i = 0; _i < 2; ++_i) \
        __builtin_amdgcn_global_load_lds((const unsigned*)((const char*)(gbase) + (voff)[_i]), (PG8_LAS unsigned*)(lds + (bufoff) + ldsw + _i * 8192), 16, 0, 0); } while (0)
#define PG8_LDA(dst, b, h) do { _Pragma("unroll") for (int m = 0; m < 4; ++m) _Pragma("unroll") for (int k = 0; k < 2; ++k) dst[m][k] = *(const PG8_LAS bf16x8*)(lds + PG8_SA(b, h) + aoff + m * 2048 + k * 1024); } while (0)
#define PG8_LDB(dst, b, h) do { _Pragma("unroll") for (int n = 0; n < 2; ++n) _Pragma("unroll") for (int k = 0; k < 2; ++k) dst[n][k] = *(const PG8_LAS bf16x8*)(lds + PG8_SB(b, h) + boff + n * 2048 + k * 1024); } while (0)
#define PG8_MMA(ai, bj, At, Bt) do { __builtin_amdgcn_s_setprio(1); _Pragma("unroll") for (int m = 0; m < 4; ++m) _Pragma("unroll") for (int n = 0; n < 2; ++n) _Pragma("unroll") for (int k = 0; k < 2; ++k) \
        acc[ai][bj][m][n] = __builtin_amdgcn_mfma_f32_16x16x32_bf16(Bt[n][k], At[m][k], acc[ai][bj][m][n], 0, 0, 0); __builtin_amdgcn_s_setprio(0); } while (0)
#define PG8_WAIT_V(n) asm volatile("s_waitcnt vmcnt(" #n ")" ::: "memory")
#define PG8_WAIT_L(n) asm volatile("s_waitcnt lgkmcnt(" #n ")" ::: "memory")
#define PG8_BAR __builtin_amdgcn_s_barrier()
#define PG8_SCHED __builtin_amdgcn_sched_barrier(0)
    Unit cur, nxt; int ui = 0; int rs_pm = -1;
    if (!S.next(0, cur)) return;
    f32x4 acc[2][2][4][2];
#pragma unroll
    for (int a = 0; a < 2; ++a)
#pragma unroll
        for (int b = 0; b < 2; ++b)
#pragma unroll
            for (int m = 0; m < 4; ++m)
#pragma unroll
                for (int n = 0; n < 2; ++n) acc[a][b][m][n] = (f32x4){0.f, 0.f, 0.f, 0.f};
    bf16x8 At[4][2], B0[2][2], B1[2][2];
    const char* cA = (const char*)g.A + (size_t)cur.pm * tstep + (size_t)cur.az * g.azs; const char* cB = (const char*)g.Bt + (size_t)cur.pn * tstep;
    S.a_ready(cur);
    if constexpr (SP2) {
        PG8_STAGE(PG8_SB(0, 0), cB, voffB); PG8_STAGE(PG8_SB(0, 1), cB + hstep, voffB); PG8_STAGE(PG8_SA(0, 0), cA, voffA); PG8_STAGE(PG8_SA(0, 1), cA + hstep, voffA);
        if (wr == 1) PG8_BAR;
        PG8_WAIT_V(2); PG8_BAR;
        PG8_STAGE(PG8_SB(1, 0), cB + kstep, voffB); PG8_STAGE(PG8_SA(1, 0), cA + kstep, voffA); PG8_STAGE(PG8_SB(1, 1), cB + hstep + kstep, voffB);
        PG8_WAIT_V(6); PG8_BAR;
    } else {
        PG8_STAGE(PG8_SB(0, 0), cB, voffB); PG8_STAGE(PG8_SA(0, 0), cA, voffA); PG8_STAGE(PG8_SB(0, 1), cB + hstep, voffB); PG8_STAGE(PG8_SA(0, 1), cA + hstep, voffA);
        if (wr == 1) PG8_BAR;
        PG8_WAIT_V(4); PG8_BAR;
        PG8_STAGE(PG8_SB(1, 0), cB + kstep, voffB); PG8_STAGE(PG8_SA(1, 0), cA + kstep, voffA); PG8_STAGE(PG8_SB(1, 1), cB + hstep + kstep, voffB);
        PG8_WAIT_V(6); PG8_BAR;
    }
    for (;;) {
        const bool has_next = S.next(ui + 1, nxt);
        const char* nA = has_next ? (const char*)g.A + (size_t)nxt.pm * tstep + (size_t)nxt.az * g.azs : cA; const char* nB = has_next ? (const char*)g.Bt + (size_t)nxt.pn * tstep : cB;
        for (int t = 0; t < nt; t += 2) {
            const bool last = (t == nt - 2);
            const char* a1 = cA + (size_t)(t + 1) * kstep;
            const char* a2 = last ? nA : cA + (size_t)(t + 2) * kstep; const char* b2 = last ? nB : cB + (size_t)(t + 2) * kstep;
            const char* a3 = a2 + kstep; const char* b3 = b2 + kstep;
            if (last && has_next) S.a_ready(nxt);
            if constexpr (SP2) {
            PG8_LDB(B0, 0, 0); PG8_LDB(B1, 0, 1); PG8_SCHED; PG8_LDA(At, 0, 0); PG8_STAGE(PG8_SA(1, 1), a1 + hstep, voffA);
            PG8_WAIT_V(8); PG8_WAIT_L(0); PG8_BAR; PG8_MMA(0, 0, At, B0); PG8_MMA(0, 1, At, B1); PG8_BAR; PG8_SCHED;
            PG8_LDA(At, 0, 1); PG8_STAGE(PG8_SB(0, 0), b2, voffB); PG8_STAGE(PG8_SB(0, 1), b2 + hstep, voffB); PG8_STAGE(PG8_SA(0, 0), a2, voffA);
            PG8_WAIT_V(8); PG8_WAIT_L(0); PG8_BAR; PG8_MMA(1, 0, At, B0); PG8_MMA(1, 1, At, B1); PG8_BAR; PG8_SCHED;
            PG8_LDB(B0, 1, 0); PG8_LDB(B1, 1, 1); PG8_SCHED; PG8_LDA(At, 1, 0); PG8_STAGE(PG8_SA(0, 1), a2 + hstep, voffA);
            PG8_WAIT_V(8); PG8_WAIT_L(0); PG8_BAR; PG8_MMA(0, 0, At, B0); PG8_MMA(0, 1, At, B1); PG8_BAR; PG8_SCHED;
            PG8_LDA(At, 1, 1); PG8_STAGE(PG8_SB(1, 0), b3, voffB); PG8_STAGE(PG8_SB(1, 1), b3 + hstep, voffB); PG8_STAGE(PG8_SA(1, 0), a3, voffA);
            PG8_WAIT_V(8); PG8_WAIT_L(0); PG8_BAR; PG8_MMA(1, 0, At, B0); PG8_MMA(1, 1, At, B1); PG8_BAR; PG8_SCHED;
            } else {
            PG8_LDB(B0, 0, 0); PG8_SCHED; PG8_LDA(At, 0, 0); PG8_STAGE(PG8_SA(1, 1), a1 + hstep, voffA);
            PG8_WAIT_L(8); PG8_BAR; PG8_WAIT_L(0); PG8_MMA(0, 0, At, B0); PG8_BAR; PG8_SCHED;
            PG8_LDB(B1, 0, 1); PG8_STAGE(PG8_SB(0, 0), b2, voffB);
            PG8_BAR; PG8_WAIT_L(0); PG8_MMA(0, 1, At, B1); PG8_BAR;
            PG8_LDA(At, 0, 1); PG8_STAGE(PG8_SA(0, 0), a2, voffA);
            PG8_BAR; PG8_WAIT_L(0); PG8_MMA(1, 0, At, B0); PG8_BAR; PG8_SCHED;
            PG8_STAGE(PG8_SB(0, 1), b2 + hstep, voffB);
            PG8_WAIT_V(6); PG8_BAR; PG8_MMA(1, 1, At, B1); PG8_BAR;
            PG8_LDB(B0, 1, 0); PG8_SCHED; PG8_LDA(At, 1, 0); PG8_STAGE(PG8_SA(0, 1), a2 + hstep, voffA);
            PG8_WAIT_L(8); PG8_BAR; PG8_WAIT_L(0); PG8_MMA(0, 0, At, B0); PG8_BAR; PG8_SCHED;
            PG8_LDB(B1, 1, 1); PG8_STAGE(PG8_SB(1, 0), b3, voffB);
            PG8_BAR; PG8_WAIT_L(0); PG8_MMA(0, 1, At, B1); PG8_BAR;
            PG8_LDA(At, 1, 1); PG8_STAGE(PG8_SA(1, 0), a3, voffA);
            PG8_BAR; PG8_WAIT_L(0); PG8_MMA(1, 0, At, B0); PG8_BAR; PG8_SCHED;
            PG8_STAGE(PG8_SB(1, 1), b3 + hstep, voffB);
            PG8_WAIT_V(6); PG8_BAR; PG8_MMA(1, 1, At, B1); PG8_BAR;
            }
        }
        if constexpr (ALIGN_EPI) { if (wr == 0) PG8_BAR; }
        if constexpr (Epi::RSTD) { if (cur.pm != rs_pm) { E.stage(cur.pm, tid); rs_pm = cur.pm; } }
        bool keep_acc = false;
        if constexpr (Epi::CARRY) { keep_acc = E.carry(acc, cur, wr, wc, fr, fq); S.done(cur); }
        else if constexpr (!Epi::AFTER_DRAIN) { E(acc, cur, wr, wc, fr, fq);
#ifdef REP_EPI
            if constexpr (Epi::RSTD) { asm volatile("" ::: "memory"); E(acc, cur, wr, wc, fr, fq); }
#endif
            S.done(cur); }
        if (!has_next) break;
        if (!keep_acc)
#pragma unroll
        for (int a = 0; a < 2; ++a)
#pragma unroll
            for (int b = 0; b < 2; ++b)
#pragma unroll
                for (int m = 0; m < 4; ++m)
#pragma unroll
                    for (int n = 0; n < 2; ++n) acc[a][b][m][n] = (f32x4){0.f, 0.f, 0.f, 0.f};
        cur = nxt; cA = nA; cB = nB; ++ui;
        if constexpr (ALIGN_EPI) { if (wr == 1) PG8_BAR; }
    }
    PG8_WAIT_V(0);
    if constexpr (!ALIGN_EPI) { if (wr == 0) PG8_BAR; }
    PG8_BAR;
    if constexpr (Epi::AFTER_DRAIN) { E.fused(acc, cur, wr, wc, fr, fq, lds, wid, lane); S.done(cur); }
#undef PG8_SA
#undef PG8_SB
#undef PG8_STAGE
#undef PG8_LDA
#undef PG8_LDB
#undef PG8_MMA
#undef PG8_WAIT_V
#undef PG8_WAIT_L
#undef PG8_BAR
#undef PG8_SCHED
}
}

namespace att {
#define ATT_LAS __attribute__((address_space(3)))
#define ATT_GAS __attribute__((address_space(1)))
typedef unsigned short bf16_t;
typedef short bf16x8 __attribute__((ext_vector_type(8)));
typedef short s16x4 __attribute__((ext_vector_type(4)));
typedef float f32x16 __attribute__((ext_vector_type(16)));
typedef float f32x4 __attribute__((ext_vector_type(4)));
typedef unsigned u32x4 __attribute__((ext_vector_type(4)));
typedef unsigned u32x2 __attribute__((ext_vector_type(2)));
typedef float f32x2_t __attribute__((ext_vector_type(2)));
typedef __bf16 bf16x2_t __attribute__((ext_vector_type(2)));
typedef short v4i16_t __attribute__((ext_vector_type(4)));
typedef ATT_LAS unsigned char* lptr;
#define ADI __device__ __forceinline__
constexpr float LOG2E = 1.4426950408889634f;
constexpr float NEG_BIG = -1e30f;

ADI int crow(int r, int hi) { return (r & 3) + 8 * (r >> 2) + 4 * hi; }
ADI unsigned cvtpk(float lo, float hi) { f32x2_t v = {lo, hi}; bf16x2_t b = __builtin_convertvector(v, bf16x2_t); return __builtin_bit_cast(unsigned, b); }
ADI float swapmax(float v) { auto rr = __builtin_amdgcn_permlane32_swap(__float_as_uint(v), __float_as_uint(v), false, false); return fmaxf(__uint_as_float(rr[0]), __uint_as_float(rr[1])); }
ADI float swapsum(float v) { auto rr = __builtin_amdgcn_permlane32_swap(__float_as_uint(v), __float_as_uint(v), false, false); return __uint_as_float(rr[0]) + __uint_as_float(rr[1]); }
ADI f32x16 splat16(float v) { f32x16 r;
#pragma unroll
  for (int i = 0; i < 16; ++i) r[i] = v; return r; }
ADI float bf2f(bf16_t b) { return __uint_as_float((unsigned)b << 16); }

ADI u32x4 ldg16(const bf16_t* p) { return *(const ATT_GAS u32x4*)p; }
ADI void k_map(int tid, int& key, int& chunk) { const int w = tid >> 6, lane = tid & 63; key = 32 * (w & 1) + (lane & 31); chunk = 2 * (w >> 1) + (lane >> 5); }
ADI int k_lds_off(int key, int chunk) { return chunk * 1024 + key * 16; }
ADI void v_map(int tid, int& key, int& dc) { key = tid >> 3; dc = tid & 7; }
ADI int v_lds_off(int key, int dc) { return ((dc >> 2) * 4 + (key >> 4)) * 1024 + (key & 15) * 64 + (dc & 3) * 16; }

ADI void qk_tile(f32x16& p0, f32x16& p1, lptr kimg, const bf16x8 (&qr)[4], int r32, int hi) {
#pragma unroll
  for (int d0 = 0; d0 < 4; ++d0) {
    const bf16x8 b0 = *(const ATT_LAS bf16x8*)(kimg + (2 * d0 + hi) * 1024 + r32 * 16);
    const bf16x8 b1 = *(const ATT_LAS bf16x8*)(kimg + (2 * d0 + hi) * 1024 + r32 * 16 + 512);
    p0 = __builtin_amdgcn_mfma_f32_32x32x16_bf16(b0, qr[d0], p0, 0, 0, 0);
    p1 = __builtin_amdgcn_mfma_f32_32x32x16_bf16(b1, qr[d0], p1, 0, 0, 0);
  }
}
template <int NO> ADI void softmax_step(f32x16& p0, f32x16& p1, float& m, float& l, f32x16 (&o)[NO]) {
  float mx = fmaxf(p0[0], p1[0]);
#pragma unroll
  for (int r = 1; r < 16; ++r) mx = fmaxf(mx, fmaxf(p0[r], p1[r]));
  mx = swapmax(mx);
  const float mn = fmaxf(m, mx), alpha = __builtin_amdgcn_exp2f(m - mn); m = mn;
  float ps = 0.f;
#pragma unroll
  for (int r = 0; r < 16; ++r) { p0[r] = __builtin_amdgcn_exp2f(p0[r] - mn); p1[r] = __builtin_amdgcn_exp2f(p1[r] - mn); ps += p0[r] + p1[r]; }
  ps = swapsum(ps); l = l * alpha + ps;
  if (!__all(alpha == 1.0f)) {
#pragma unroll
    for (int i = 0; i < NO; ++i) o[i] *= alpha;
  }
}
ADI s16x4 vtr(lptr p) { return __builtin_bit_cast(s16x4, __builtin_amdgcn_ds_read_tr16_b64_v4i16((ATT_LAS v4i16_t*)p)); }
template <int NDH> ADI void pv_tile(f32x16 (&o)[NDH], lptr vimg, const f32x16& p0, const f32x16& p1, int lane) {
  bf16x8 pf[4];
  { u32x4 w;
    w.x = cvtpk(p0[0], p0[1]); w.y = cvtpk(p0[2], p0[3]); w.z = cvtpk(p0[4], p0[5]); w.w = cvtpk(p0[6], p0[7]); pf[0] = __builtin_bit_cast(bf16x8, w);
    w.x = cvtpk(p0[8], p0[9]); w.y = cvtpk(p0[10], p0[11]); w.z = cvtpk(p0[12], p0[13]); w.w = cvtpk(p0[14], p0[15]); pf[1] = __builtin_bit_cast(bf16x8, w);
    w.x = cvtpk(p1[0], p1[1]); w.y = cvtpk(p1[2], p1[3]); w.z = cvtpk(p1[4], p1[5]); w.w = cvtpk(p1[6], p1[7]); pf[2] = __builtin_bit_cast(bf16x8, w);
    w.x = cvtpk(p1[8], p1[9]); w.y = cvtpk(p1[10], p1[11]); w.z = cvtpk(p1[12], p1[13]); w.w = cvtpk(p1[14], p1[15]); pf[3] = __builtin_bit_cast(bf16x8, w); }
  const int vb = ((lane >> 4) & 1) * 32 + (lane & 3) * 8 + (4 * (lane >> 5) + ((lane & 15) >> 2)) * 64;
#pragma unroll
  for (int dh = 0; dh < NDH; ++dh) {
#pragma unroll
    for (int kg = 0; kg < 4; ++kg) {
      lptr p = vimg + (dh >> 1) * 8192 + ((dh & 1) * 4 + kg) * 1024 + vb;
      const s16x4 lo = vtr(p), hi = vtr(p + 512);
      const bf16x8 vf = {lo[0], lo[1], lo[2], lo[3], hi[0], hi[1], hi[2], hi[3]};
      o[dh] = __builtin_amdgcn_mfma_f32_32x32x16_bf16(vf, pf[kg], o[dh], 0, 0, 0);
    }
  }
}
template <int NDH> ADI void store_o(bf16_t* orow, const f32x16 (&o)[NDH], float sc, int hi) {
#pragma unroll
  for (int dh = 0; dh < NDH; ++dh)
#pragma unroll
    for (int g = 0; g < 4; ++g) { u32x2 w; w.x = cvtpk(o[dh][4 * g] * sc, o[dh][4 * g + 1] * sc); w.y = cvtpk(o[dh][4 * g + 2] * sc, o[dh][4 * g + 3] * sc);
      *(ATT_GAS u32x2*)(orow + 32 * dh + 8 * g + 4 * hi) = w; }
}

ADI void glds16(const void* gsrc, unsigned lds_dst) { unsigned keep;
  asm volatile("s_mov_b32 %0, m0\n\ts_mov_b32 m0, %2\n\ts_nop 0\n\tglobal_load_lds_dwordx4 %1, off\n\ts_mov_b32 m0, %0" : "=&s"(keep) : "v"(gsrc), "s"(lds_dst) : "memory"); }
ADI void glds4(const void* gsrc, unsigned lds_dst) { unsigned keep;
  asm volatile("s_mov_b32 %0, m0\n\ts_mov_b32 m0, %2\n\ts_nop 0\n\tglobal_load_lds_dword %1, off\n\ts_mov_b32 m0, %0" : "=&s"(keep) : "v"(gsrc), "s"(lds_dst) : "memory"); }
template <int N> ADI void wait_bar() { asm volatile("s_waitcnt vmcnt(%0) lgkmcnt(0)\n\ts_barrier" :: "n"(N) : "memory"); }
#define MX3(a, b, c) __builtin_fmaxf(__builtin_fmaxf((a), (b)), (c))
constexpr float THR = 8.0f;
template <int NO> ADI void sm_decide(f32x16& c0, f32x16& c1, float& mref, float& l, f32x16 (&o)[NO]) {
  float a = MX3(c0[0], c0[1], c1[0]), b = MX3(c0[2], c0[3], c1[1]); a = MX3(a, c1[2], c1[3]);
#pragma unroll
  for (int r = 4; r < 16; r += 4) { a = MX3(a, c0[r], c0[r + 1]); b = MX3(b, c0[r + 2], c0[r + 3]); a = MX3(a, c1[r], c1[r + 1]); b = MX3(b, c1[r + 2], c1[r + 3]); }
  const float rm = swapmax(fmaxf(a, b));
  if (__builtin_expect(__any(rm > THR), 0)) {
    const float dl = fmaxf(rm, 0.f), f = __builtin_amdgcn_exp2f(-dl);
    mref += dl; l *= f;
#pragma unroll
    for (int r = 0; r < 16; ++r) { c0[r] -= dl; c1[r] -= dl; }
#pragma unroll
    for (int i = 0; i < NO; ++i) o[i] *= f;
  }
}
ADI void sm_exp_sum(f32x16& c0, f32x16& c1, float& l) {
  float s0 = 0.f, s1 = 0.f;
#pragma unroll
  for (int r = 0; r < 16; ++r) { c0[r] = __builtin_amdgcn_exp2f(c0[r]); c1[r] = __builtin_amdgcn_exp2f(c1[r]); s0 += c0[r]; s1 += c1[r]; }
  l += s0 + s1;
}

struct UnitArgs {
  const bf16_t* Q; int ldq; const bf16_t* K; const bf16_t* V; int ldkv; bf16_t* O; int ldo;
  int q0;
  int t0, t1;
  const float* relb;
  const unsigned* mask;
  bool nomask;
};
template <int MODE> ADI void attn_unit(lptr lds, const UnitArgs& a, int tid_in) {
  int tid_l = tid_in; asm volatile("" : "+v"(tid_l));
  const int tid = tid_l, lane = tid & 63, r32 = lane & 31, hi = lane >> 5, w = __builtin_amdgcn_readfirstlane(tid >> 6);
  constexpr int SLOT = 16384, P = (MODE == 1) ? 3 : 2;
  constexpr int MSK_OFF = 4 * SLOT, TAB_OFF = MSK_OFF + 4 * 2048;
  const unsigned lds0 = (unsigned)(size_t)lds;
  ATT_LAS float* tab = (ATT_LAS float*)(lds + TAB_OFF);
  if (MODE == 0) { for (int i = tid; i < 320; i += 512) tab[i] = ((const ATT_GAS float*)a.relb)[i] * LOG2E; }
  const int qloc = a.q0 + 32 * w + r32;
  const int cq = (a.q0 + 32 * w) >> 6;
  bf16x8 qr[4];
  { const bf16_t* qp = a.Q + (size_t)qloc * a.ldq + 8 * hi;
#pragma unroll
    for (int d0 = 0; d0 < 4; ++d0) qr[d0] = __builtin_bit_cast(bf16x8, ldg16(qp + 16 * d0)); }
  const bf16_t* ksrc = a.K + (size_t)lane * a.ldkv + w * 8;
  const bf16_t* vsrc = a.V + (size_t)(16 * (w & 3) + (lane >> 2)) * a.ldkv + (w >> 2) * 32 + (lane & 3) * 8;
  const unsigned* msrc = a.mask + (size_t)(a.q0 + 32 * w) * 2 + lane;
  const size_t tstep = (size_t)64 * a.ldkv;
#define ATT_DMA(t) do { const unsigned sb_ = lds0 + (unsigned)(((t) & 3) * SLOT + w * 1024); \
    glds16(ksrc + (size_t)(t) * tstep, (unsigned)__builtin_amdgcn_readfirstlane(sb_)); glds16(vsrc + (size_t)(t) * tstep, (unsigned)__builtin_amdgcn_readfirstlane(sb_ + 8192u)); \
    if (MODE == 1) glds4(msrc + (size_t)(t) * 8192, (unsigned)__builtin_amdgcn_readfirstlane(lds0 + (unsigned)(MSK_OFF + ((t) & 3) * 2048 + w * 256))); } while (0)
#define ATT_ACTIVE(t) ((MODE == 0) ? ((t) <= cq && (t) + 8 >= cq) : (MODE == 1) ? ((t) <= cq) : true)
#define ATT_INIT(P0, P1, t) do { if (MODE == 0) { const int dch_ = cq - (t); \
      if (dch_ >= 5) { const float c_ = tab[319] - mref; P0 = splat16(c_); P1 = splat16(c_); } \
      else { const int base_ = 64 * dch_ + (qloc & 63) + 63; \
        _Pragma("unroll") for (int r = 0; r < 16; ++r) { const int i0 = base_ - crow(r, hi); P0[r] = tab[i0 < 319 ? i0 : 319] - mref; const int i1 = i0 - 32; P1[r] = tab[i1 < 319 ? i1 : 319] - mref; } } \
    } else { P0 = splat16(-mref); P1 = splat16(-mref); } } while (0)
#define ATT_MASK(P0, P1, t) do { if (MODE == 1) { if (!a.nomask) { const unsigned mw_ = *(const ATT_LAS unsigned*)(lds + MSK_OFF + ((t) & 3) * 2048 + w * 256 + (r32 * 2 + hi) * 4); \
      _Pragma("unroll") for (int r = 0; r < 16; ++r) { P0[r] = ((int)(mw_ << (31 - r)) < 0) ? P0[r] : -INFINITY; P1[r] = ((int)(mw_ << (15 - r)) < 0) ? P1[r] : -INFINITY; } } } } while (0)
  float mref = 0.f, l = 0.f; f32x16 o[2]; o[0] = splat16(0.f); o[1] = splat16(0.f);
  ATT_DMA(a.t0); if (a.t0 + 1 <= a.t1) ATT_DMA(a.t0 + 1); if (a.t0 + 2 <= a.t1) ATT_DMA(a.t0 + 2);
  wait_bar<0>();
  f32x16 c0 = splat16(0.f), c1 = splat16(0.f);
  bool act_cur = ATT_ACTIVE(a.t0);
  if (act_cur) { ATT_INIT(c0, c1, a.t0); qk_tile(c0, c1, lds + (a.t0 & 3) * SLOT, qr, r32, hi); }
  for (int t = a.t0; t <= a.t1; ++t) {
    if (t > a.t0) { if (t + 2 <= a.t1) wait_bar<P>(); else wait_bar<0>(); }
    if (t + 3 <= a.t1) ATT_DMA(t + 3);
    const bool act_next = (t + 1 <= a.t1) && ATT_ACTIVE(t + 1);
    f32x16 n0 = splat16(0.f), n1 = splat16(0.f);
    lptr slot_c = lds + (t & 3) * SLOT, slot_n = lds + ((t + 1) & 3) * SLOT;
    if (act_cur && act_next) {
      ATT_MASK(c0, c1, t);
      sm_decide<2>(c0, c1, mref, l, o);
      ATT_INIT(n0, n1, t + 1);
      qk_tile(n0, n1, slot_n, qr, r32, hi);
      sm_exp_sum(c0, c1, l);
      pv_tile<2>(o, slot_c + 8192, c0, c1, lane);
    } else if (act_cur) {
      ATT_MASK(c0, c1, t);
      sm_decide<2>(c0, c1, mref, l, o);
      sm_exp_sum(c0, c1, l);
      pv_tile<2>(o, slot_c + 8192, c0, c1, lane);
    } else if (act_next) {
      ATT_INIT(n0, n1, t + 1);
      qk_tile(n0, n1, slot_n, qr, r32, hi);
    }
    c0 = n0; c1 = n1; act_cur = act_next;
  }
  asm volatile("s_waitcnt lgkmcnt(0)\n\ts_barrier" ::: "memory");
  l = swapsum(l);
  store_o<2>(a.O + (size_t)qloc * a.ldo, o, __builtin_amdgcn_rcpf(l), hi);
#undef ATT_DMA
#undef ATT_ACTIVE
#undef ATT_INIT
#undef ATT_MASK
}

constexpr int TOPK = 256;
ADI void idx_kload(const bf16_t* ki0, int s, unsigned loff, bf16x8 (&kf)[4]) {
  const ATT_GAS char* bs = (const ATT_GAS char*)(ki0 + (size_t)s * (32 * 256));
#pragma unroll
  for (int d0 = 0; d0 < 4; ++d0) kf[d0] = __builtin_bit_cast(bf16x8, *(const ATT_GAS u32x4*)(bs + (loff + 32u * d0)));
}
ADI void idx_park(unsigned* kscr, int s, int lane, const unsigned (&u)[16]) {
  ATT_GAS u32x4* p = (ATT_GAS u32x4*)(kscr + (size_t)s * 1024) + lane;
#pragma unroll
  for (int j = 0; j < 4; ++j) { u32x4 v = {u[4 * j], u[4 * j + 1], u[4 * j + 2], u[4 * j + 3]}; p[64 * j] = v; }
}
ADI void idx_fetch(const unsigned* kscr, int s, int lane, unsigned (&u)[16]) {
  const ATT_GAS u32x4* p = (const ATT_GAS u32x4*)(kscr + (size_t)s * 1024) + lane;
#pragma unroll
  for (int j = 0; j < 4; ++j) { const u32x4 v = p[64 * j]; u[4 * j] = v.x; u[4 * j + 1] = v.y; u[4 * j + 2] = v.z; u[4 * j + 3] = v.w; }
}
ADI void idx_scores2(const bf16x8 (&kA)[4], const bf16x8 (&kB)[4], lptr qimg, const float (&wv)[4], unsigned (&uA)[16], unsigned (&uB)[16], unsigned zA, unsigned zB) {
  float sA[16], sB[16];
#pragma unroll
  for (int hp = 0; hp < 2; ++hp) {
    bf16x8 q0[4], q1[4];
#pragma unroll
    for (int d0 = 0; d0 < 4; ++d0) { q0[d0] = *(const ATT_LAS bf16x8*)(qimg + ((2 * hp) * 4 + d0) * 1024); q1[d0] = *(const ATT_LAS bf16x8*)(qimg + ((2 * hp + 1) * 4 + d0) * 1024); }
    f32x16 a0 = splat16(0.f), a1 = splat16(0.f), b0 = splat16(0.f), b1 = splat16(0.f);
#pragma unroll
    for (int d0 = 0; d0 < 4; ++d0) {
      a0 = __builtin_amdgcn_mfma_f32_32x32x16_bf16(kA[d0], q0[d0], a0, 0, 0, 0); b0 = __builtin_amdgcn_mfma_f32_32x32x16_bf16(kB[d0], q0[d0], b0, 0, 0, 0);
      a1 = __builtin_amdgcn_mfma_f32_32x32x16_bf16(kA[d0], q1[d0], a1, 0, 0, 0); b1 = __builtin_amdgcn_mfma_f32_32x32x16_bf16(kB[d0], q1[d0], b1, 0, 0, 0); }
#pragma unroll
    for (int r = 0; r < 16; ++r) {
      const float ra0 = __int_as_float(max(__float_as_int(a0[r]), 0)), ra1 = __int_as_float(max(__float_as_int(a1[r]), 0));
      const float rb0 = __int_as_float(max(__float_as_int(b0[r]), 0)), rb1 = __int_as_float(max(__float_as_int(b1[r]), 0));
      sA[r] = __builtin_fmaf(ra0, wv[2 * hp], hp == 0 ? 0.0f : sA[r]); sA[r] = __builtin_fmaf(ra1, wv[2 * hp + 1], sA[r]);
      sB[r] = __builtin_fmaf(rb0, wv[2 * hp], hp == 0 ? 0.0f : sB[r]); sB[r] = __builtin_fmaf(rb1, wv[2 * hp + 1], sB[r]);
    }
  }
#pragma unroll
  for (int r = 0; r < 16; ++r) {
    const unsigned ba = __float_as_uint(sA[r]), bb = __float_as_uint(sB[r]);
    const unsigned kk = (unsigned)(((r & 3) + 8 * (r >> 2)) << 11);
    unsigned ka = ((int)ba < 0) ? ~ba : ba + 0x80800000u, kb = ((int)bb < 0) ? ~bb : bb + 0x80800000u;
    uA[r] = (ba == 0u) ? zA - kk : ka; uB[r] = (bb == 0u) ? zB - kk : kb;
  }
}
ADI unsigned wave_excl_scan(unsigned v, int lane) {
  unsigned x = v;
#pragma unroll
  for (int d = 1; d < 64; d <<= 1) { const unsigned t = __shfl_up(x, d); if (lane >= d) x += t; }
  return x - v;
}
#define IDX_DPP_SHR(x, n) ((unsigned)__builtin_amdgcn_update_dpp(0, (int)(x), 0x110 + (n), 0xf, 0xf, true))
ADI void hist_scan4(ATT_LAS unsigned* hist, ATT_LAS unsigned* res, int w, int lane_in) {
  int lane = lane_in; asm volatile("" : "+v"(lane));
  const int rho = lane >> 4, q = 4 * w + rho, li = lane & 15;
  const unsigned k = res[q * 4 + 1];
  ATT_LAS unsigned* hq = hist + q * 1024;
  const int p0 = 1023 - 64 * li;
  unsigned T = 0;
#pragma unroll 16
  for (int t = 0; t < 64; ++t) { const unsigned o = (unsigned)(t + 4 * li + rho) & 63u; const unsigned wd = hq[(unsigned)(p0 - (int)o) ^ (unsigned)q]; T += (wd & 0xffffu) + (wd >> 16); }
  unsigned x = T;
  x += IDX_DPP_SHR(x, 1); x += IDX_DPP_SHR(x, 2); x += IDX_DPP_SHR(x, 4); x += IDX_DPP_SHR(x, 8);
  const unsigned E = x - T;
  if (E < k && k <= E + T) { res[q * 4 + 3] = (unsigned)p0; res[q * 4 + 2] = E; }
  asm volatile("s_waitcnt lgkmcnt(0)" ::: "memory");
  const int pL = (int)res[q * 4 + 3]; const unsigned EL = res[q * 4 + 2];
  unsigned wd4[4]; unsigned s4 = 0;
#pragma unroll
  for (int j = 0; j < 4; ++j) { wd4[j] = hq[(unsigned)(pL - 4 * li - j) ^ (unsigned)q]; s4 += (wd4[j] & 0xffffu) + (wd4[j] >> 16); }
  unsigned y = s4;
  y += IDX_DPP_SHR(y, 1); y += IDX_DPP_SHR(y, 2); y += IDX_DPP_SHR(y, 4); y += IDX_DPP_SHR(y, 8);
  const unsigned E2 = EL + (y - s4);
  asm volatile("s_waitcnt lgkmcnt(0)" ::: "memory");
  if (E2 < k && k <= E2 + s4) {
    unsigned cum = E2, fbin = 0, frem = 0, fcnt = 0;
#pragma unroll
    for (int j = 0; j < 4; ++j) {
      const unsigned p = (unsigned)(pL - 4 * li - j), chi = wd4[j] >> 16, clo = wd4[j] & 0xffffu;
      if (cum < k && k <= cum + chi) { fbin = 2 * p + 1; frem = k - cum; fcnt = chi; }
      cum += chi;
      if (cum < k && k <= cum + clo) { fbin = 2 * p; frem = k - cum; fcnt = clo; }
      cum += clo;
    }
    res[q * 4 + 0] = fbin; res[q * 4 + 1] = frem; res[q * 4 + 2] = fcnt;
  }
}
#define IDX_PREF0() do { if (w < NS) { idx_kload(KI, w, loff, kA_); idx_kload(KI, (w + 8 < NS) ? w + 8 : w, loff, kB_); } } while (0)
#define IDX_LOOP0(BODY) do { \
    for (int s_ = w; s_ < NS; s_ += 16) { const bool hb_ = s_ + 8 < NS; \
      unsigned pA_[16], pB_[16]; { const unsigned zA_ = 0x80000000u + ((4095u - 32u * (unsigned)s_ - 4u * (unsigned)hi) << 11); idx_scores2(kA_, kB_, qimg, wv, pA_, pB_, zA_, zA_ - (256u << 11)); } \
      if (s_ + 16 < NS) { idx_kload(KI, s_ + 16, loff, kA_); idx_kload(KI, (s_ + 24 < NS) ? s_ + 24 : s_ + 16, loff, kB_); } \
      { unsigned (&u)[16] = pA_; idx_park(kscr, s_, lane, u); BODY(s_); } \
      if (hb_) { unsigned (&u)[16] = pB_; idx_park(kscr, s_ + 8, lane, u); BODY(s_ + 8); } } } while (0)
#define IDX_SWEEP0(BODY) do { IDX_PREF0(); IDX_LOOP0(BODY); } while (0)
#define IDX_PREF() do { if (w < NS) idx_fetch(kscr, w, lane, uA_); if (w + 8 < NS) idx_fetch(kscr, w + 8, lane, uB_); if (w + 16 < NS) idx_fetch(kscr, w + 16, lane, uC_); } while (0)
#define IDX_LOOP(BODY) do { \
    for (int s_ = w; s_ < NS; s_ += 32) { \
      if (s_ + 24 < NS) idx_fetch(kscr, s_ + 24, lane, uD_); { unsigned (&u)[16] = uA_; BODY(s_); } \
      if (s_ + 8 < NS) { if (s_ + 32 < NS) idx_fetch(kscr, s_ + 32, lane, uA_); unsigned (&u)[16] = uB_; BODY(s_ + 8); } \
      if (s_ + 16 < NS) { if (s_ + 40 < NS) idx_fetch(kscr, s_ + 40, lane, uB_); unsigned (&u)[16] = uC_; BODY(s_ + 16); } \
      if (s_ + 24 < NS) { if (s_ + 48 < NS) idx_fetch(kscr, s_ + 48, lane, uC_); unsigned (&u)[16] = uD_; BODY(s_ + 24); } } } while (0)
#define IDX_SWEEP(BODY) do { IDX_PREF(); IDX_LOOP(BODY); } while (0)
#define IDX_ADD(bin) do { unsigned sh_; asm("v_mad_u32_u24 %0, %1, %2, 1" : "=v"(sh_) : "v"((bin) & 1u), "s"(c16_));   \
    __hip_atomic_fetch_add(hist + r32 * 1024 + (((bin) >> 1) ^ (unsigned)r32), sh_, __ATOMIC_RELAXED, __HIP_MEMORY_SCOPE_WORKGROUP); \
    if (IDX_PROBE_DUP) __hip_atomic_fetch_add((ATT_LAS unsigned*)(lds + 148736) + (r32 * 32 + ((((bin) >> 1) ^ (unsigned)r32) & 31u)), sh_, __ATOMIC_RELAXED, __HIP_MEMORY_SCOPE_WORKGROUP); } while (0)
#ifndef IDX_PROBE_DUP
#define IDX_PROBE_DUP 0
#endif
#ifndef IDX_PROBE_P0
#define IDX_PROBE_P0 0
#endif
#ifndef IDX_PROBE_SCAN
#define IDX_PROBE_SCAN 0
#endif
#ifndef IDX_PROBE_P1
#define IDX_PROBE_P1 0
#endif
constexpr int IDX_QOFF = 132352;
constexpr unsigned IDX_CAP = 16;
ADI void idx_unit(lptr lds, const bf16_t* QI, const bf16_t* KI, unsigned short* mask16, unsigned* kscr, int n, int half, int tid_in) {
  int tid_l = tid_in; asm volatile("" : "+v"(tid_l));
#define IDX_BAR() do { asm volatile("s_waitcnt lgkmcnt(0)" ::: "memory"); __builtin_amdgcn_s_barrier(); asm volatile("" ::: "memory"); } while (0)
  const int tid = tid_l, lane = tid & 63, r32 = lane & 31, hi = lane >> 5, w = __builtin_amdgcn_readfirstlane(tid >> 6);
  ATT_LAS unsigned* hist = (ATT_LAS unsigned*)lds;
  ATT_LAS unsigned* res = (ATT_LAS unsigned*)(lds + 131072);
  const int qpos = 64 * n + 32 * half + r32;
  const int NS = 2 * (n + 1);
  const unsigned loff = (unsigned)(r32 * 512 + hi * 16);
  unsigned uA_[16], uB_[16], uC_[16], uD_[16]; bf16x8 kA_[4], kB_[4];
  IDX_PREF0();
  u32x4 qst_[2];
  { const int q0row = 64 * n + 32 * half;
#pragma unroll
    for (int i = 0; i < 2; ++i) { const int p = tid + 512 * i, q = p >> 5, c16 = p & 31; qst_[i] = ldg16(QI + (size_t)(q0row + q) * 256 + c16 * 8); } }
  lptr qimg = lds + IDX_QOFF + hi * 512 + r32 * 16;
  float wv[4];
  { const u32x2 ww = *(const ATT_GAS u32x2*)(KI + (size_t)qpos * 256 + 64);
    wv[0] = __uint_as_float(ww.x << 16) * 0.0625f; wv[1] = __uint_as_float(ww.x & 0xffff0000u) * 0.0625f; wv[2] = __uint_as_float(ww.y << 16) * 0.0625f; wv[3] = __uint_as_float(ww.y & 0xffff0000u) * 0.0625f; }
  const unsigned moff = (unsigned)(qpos * 8 + hi * 4);
  if (tid < 32) res[tid * 4 + 1] = TOPK;
  if (tid == 32 || tid == 33) res[128 + (tid - 32)] = 0u;
  unsigned pre = 0u, thr = 0u, cut = 0xffffu; bool needtie = false;
  unsigned c16_ = 0xffffu; asm volatile("" : "+s"(c16_));
#define IDX_ZERO() do { const u32x4 z_ = {0u, 0u, 0u, 0u}; _Pragma("unroll") for (int i = 0; i < 16; ++i) *(ATT_LAS u32x4*)(lds + (size_t)(i * 512 + tid) * 16) = z_; IDX_BAR(); } while (0)
#define IDX_SCAN() do { IDX_BAR(); hist_scan4(hist, res, w, lane); IDX_BAR(); } while (0)
  { const u32x4 z_ = {0u, 0u, 0u, 0u};
#pragma unroll
    for (int i = 0; i < 16; ++i) *(ATT_LAS u32x4*)(lds + (size_t)(i * 512 + tid) * 16) = z_;
#pragma unroll
    for (int i = 0; i < 2; ++i) { const int p = tid + 512 * i, q = p >> 5, c16 = p & 31; *(ATT_LAS u32x4*)(lds + IDX_QOFF + c16 * 512 + q * 16) = qst_[i]; }
    IDX_BAR(); }
#define IDX_B0(s) do { _Pragma("unroll") for (int r = 0; r < 16; ++r) IDX_ADD(u[r] >> 21); } while (0)
#define IDX_B0_(s) IDX_B0(s)
#if IDX_PROBE_P0
  { IDX_SWEEP0(IDX_B0_); IDX_BAR(); IDX_ZERO(); }
#endif
  IDX_LOOP0(IDX_B0);
#if IDX_PROBE_SCAN
  { ATT_LAS unsigned* res2 = (ATT_LAS unsigned*)(lds + 149760); if (tid < 32) res2[tid * 4 + 1] = TOPK; IDX_BAR(); hist_scan4(hist, res2, w, lane); IDX_BAR(); }
#endif
  IDX_BAR();
  IDX_PREF();
  hist_scan4(hist, res, w, lane); IDX_BAR();
  pre = res[r32 * 4 + 0];
  IDX_ZERO();
#define IDX_B1D(s) do { _Pragma("unroll") for (int r = 0; r < 16; ++r) { if ((u[r] >> 21) == pre) __hip_atomic_fetch_add((ATT_LAS unsigned*)(lds + 148736) + (r32 * 32 + (((u[r] >> 11) ^ (unsigned)r32) & 31u)), 1u, __ATOMIC_RELAXED, __HIP_MEMORY_SCOPE_WORKGROUP); } } while (0)
#define IDX_B1(s) do { _Pragma("unroll") for (int r = 0; r < 16; ++r) { if ((u[r] >> 21) == pre) IDX_ADD((u[r] >> 10) & 2047u); } } while (0)
#if IDX_PROBE_P1
  { IDX_SWEEP(IDX_B1D); IDX_BAR(); }
#endif
  IDX_LOOP(IDX_B1);
  IDX_PREF();
  IDX_SCAN();
  unsigned krem;
  { const unsigned fbin = res[r32 * 4 + 0], fcnt = res[r32 * 4 + 2]; krem = res[r32 * 4 + 1]; pre = (pre << 11) | fbin; if (fcnt > IDX_CAP) res[129] = 1u; }
  IDX_BAR();
  if (res[129] == 0u) {
    ATT_LAS unsigned* cand = (ATT_LAS unsigned*)lds;
    ATT_LAS unsigned* ccnt = (ATT_LAS unsigned*)(lds + 4096);
    if (tid < 32) ccnt[tid] = 0u;
    IDX_BAR();
#define IDX_BM(s) do { unsigned bits_ = 0u; _Pragma("unroll") for (int r = 15; r >= 0; --r) { const unsigned p_ = u[r] >> 10; bits_ = (bits_ << 1) | (p_ > pre ? 1u : 0u); \
        if (p_ == pre) { const unsigned pos_ = __hip_atomic_fetch_add(ccnt + r32, 1u, __ATOMIC_RELAXED, __HIP_MEMORY_SCOPE_WORKGROUP); cand[r32 * IDX_CAP + (pos_ & (IDX_CAP - 1))] = ((u[r] & 1023u) << 12) | (4095u - (unsigned)(32 * (s) + crow(r, hi))); } } \
      *(ATT_GAS unsigned short*)((ATT_GAS char*)(mask16 + (size_t)((s) >> 1) * 16384 + ((s) & 1)) + moff) = (unsigned short)bits_; } while (0)
    IDX_LOOP(IDX_BM);
    asm volatile("s_waitcnt vmcnt(0)" ::: "memory");
    IDX_BAR();
    if (tid < 32) {
      const unsigned q = (unsigned)tid, cnt = ccnt[q], need = res[q * 4 + 1];
      const int qp = 64 * n + 32 * half + (int)q;
      for (unsigned j = 0; j < need && j < cnt; ++j) {
        unsigned best = 0u, bi = 0u;
        for (unsigned i = 0; i < cnt; ++i) { const unsigned c = cand[q * IDX_CAP + i]; if (c >= best) { best = c; bi = i; } }
        cand[q * IDX_CAP + bi] = 0u;
        if (j + 1 == need || true) { const unsigned kidx = 4095u - (best & 4095u), s2 = kidx >> 5, wi = kidx & 31u, hc = (wi >> 2) & 1u, rr = (wi & 3u) + 4u * (wi >> 3);
          __hip_atomic_fetch_or((ATT_GAS unsigned*)mask16 + (((size_t)(s2 >> 1) * 4096 + qp) * 2 + hc), 1u << (16u * (s2 & 1u) + rr), __ATOMIC_RELAXED, __HIP_MEMORY_SCOPE_AGENT); }
      }
    }
    (void)krem;
  } else {
    IDX_ZERO();
#define IDX_B2(s) do { _Pragma("unroll") for (int r = 0; r < 16; ++r) { if ((u[r] >> 10) == pre) IDX_ADD(u[r] & 1023u); } } while (0)
    IDX_LOOP(IDX_B2);
    IDX_SCAN();
    { const unsigned fbin = res[r32 * 4 + 0], frem = res[r32 * 4 + 1], fcnt = res[r32 * 4 + 2]; thr = (pre << 10) | fbin; needtie = frem < fcnt; if (needtie) res[128] = 1u; }
    IDX_BAR();
    if (res[128] != 0u) {
      IDX_ZERO();
#define IDX_B3(s) do { _Pragma("unroll") for (int r = 0; r < 16; ++r) { if (u[r] == thr) IDX_ADD(2047u - (unsigned)((32 * (s) + crow(r, hi)) >> 1)); } } while (0)
      IDX_SWEEP(IDX_B3);
      IDX_SCAN();
      { const unsigned fbin = res[r32 * 4 + 0], frem = res[r32 * 4 + 1], fcnt = res[r32 * 4 + 2]; const unsigned bt = 2047u - fbin; if (needtie) cut = (frem == 1u && fcnt == 2u) ? 2u * bt : 2u * bt + 1u; }
      IDX_BAR();
    }
#define IDX_BS(s) do { unsigned bits_ = 0u; _Pragma("unroll") for (int r = 15; r >= 0; --r) { const unsigned kidx_ = (unsigned)(32 * (s) + crow(r, hi)); const bool sel_ = (u[r] > thr) || (u[r] == thr && kidx_ <= cut); bits_ = (bits_ << 1) | (sel_ ? 1u : 0u); } \
      *(ATT_GAS unsigned short*)((ATT_GAS char*)(mask16 + (size_t)((s) >> 1) * 16384 + ((s) & 1)) + moff) = (unsigned short)bits_; } while (0)
    IDX_SWEEP(IDX_BS);
  }
#undef IDX_BAR
#undef IDX_ZERO
#undef IDX_SCAN
#undef IDX_B0
#undef IDX_B1
#undef IDX_B2
#undef IDX_B3
#undef IDX_BM
#undef IDX_BS
}
#undef IDX_SWEEP
#undef IDX_SWEEP0
#undef IDX_PREF
#undef IDX_PREF0
#undef IDX_LOOP
#undef IDX_LOOP0
#undef IDX_ADD
}

namespace attx {
using bf16=__hip_bfloat16;
using bf16x8=__attribute__((ext_vector_type(8)))short;
using s16x4=__attribute__((ext_vector_type(4)))short;
using f32x16=__attribute__((ext_vector_type(16)))float;
using u32x4=__attribute__((ext_vector_type(4)))unsigned;
using f32x4v=__attribute__((ext_vector_type(4)))float;
constexpr int D=64,NW=8,QBLK=32,QB=QBLK*NW,KVBLK=64;
__device__ __forceinline__ int crow(int r,int hi){return (r&3)+8*(r>>2)+4*hi;}
#define SBAR() __builtin_amdgcn_sched_barrier(0)
constexpr int NSLOT=3, SLOTB=8192;
constexpr int LDS_K=0, LDS_V=NSLOT*SLOTB, LDS_WS=2*NSLOT*SLOTB, LDS_OST=LDS_WS+NW*64*4, LDS_MSK=LDS_OST+NW*4096, LDS_TAB=LDS_MSK+4*2048, LDS_BYTES=LDS_TAB+384*4;
__device__ __forceinline__ void glds16(const void*gsrc,unsigned lds_dst){unsigned keep;
  asm volatile("s_mov_b32 %0, m0\n\ts_mov_b32 m0, %2\n\ts_nop 0\n\tglobal_load_lds_dwordx4 %1, off\n\ts_mov_b32 m0, %0":"=&s"(keep):"v"(gsrc),"s"(lds_dst):"memory");}
__device__ __forceinline__ void glds4(const void*gsrc,unsigned lds_dst){unsigned keep;
  asm volatile("s_mov_b32 %0, m0\n\ts_mov_b32 m0, %2\n\ts_nop 0\n\tglobal_load_lds_dword %1, off\n\ts_mov_b32 m0, %0":"=&s"(keep):"v"(gsrc),"s"(lds_dst):"memory");}
__device__ __forceinline__ float max3f(float a,float b,float c){float r;asm("v_max3_f32 %0, %1, %2, %3":"=v"(r):"v"(a),"v"(b),"v"(c));return r;}
__device__ __forceinline__ float max2f(float a,float b){float r;asm("v_max_f32_e32 %0, %1, %2":"=v"(r):"v"(a),"v"(b));return r;}
__device__ __forceinline__ float fadd_s(float a,float b){float r;asm("v_add_f32_e32 %0, %1, %2":"=v"(r):"v"(a),"v"(b));return r;}
__device__ __forceinline__ float fsub_s(float a,float b){float r;asm("v_sub_f32_e32 %0, %1, %2":"=v"(r):"v"(a),"v"(b));return r;}
typedef float f32x2_t __attribute__((ext_vector_type(2))); typedef __bf16 bf16x2_t __attribute__((ext_vector_type(2)));
__device__ __forceinline__ unsigned cvtpk_s(float lo,float hi){f32x2_t v={lo,hi};bf16x2_t b=__builtin_convertvector(v,bf16x2_t);return __builtin_bit_cast(unsigned,b);}
#define WAIT_BAR(N) asm volatile("s_waitcnt vmcnt(" #N ") lgkmcnt(0)\n\ts_barrier":::"memory")
__device__ __forceinline__ void qkt(f32x16&p0,f32x16&p1,const char*Kslot,const bf16x8*qr,const f32x16&negm,int r32,int hi){
  const char*kb=Kslot+hi*1024+r32*16;
  #pragma unroll
  for(int d0=0;d0<4;++d0){
    const bf16x8 b0=*reinterpret_cast<const bf16x8*>(kb+d0*2048);
    const bf16x8 b1=*reinterpret_cast<const bf16x8*>(kb+d0*2048+512);
    if(d0==0){p0=__builtin_amdgcn_mfma_f32_32x32x16_bf16(b0,qr[0],negm,0,0,0);p1=__builtin_amdgcn_mfma_f32_32x32x16_bf16(b1,qr[0],negm,0,0,0);}
    else{p0=__builtin_amdgcn_mfma_f32_32x32x16_bf16(b0,qr[d0],p0,0,0,0);p1=__builtin_amdgcn_mfma_f32_32x32x16_bf16(b1,qr[d0],p1,0,0,0);}}
}
typedef __attribute__((address_space(3))) const char* lds_cptr;
typedef short v4i16_t __attribute__((ext_vector_type(4)));
__device__ __forceinline__ void kload8(bf16x8*kf,lds_cptr kp){
  kf[0]=*(const __attribute__((address_space(3))) bf16x8*)(kp);      kf[1]=*(const __attribute__((address_space(3))) bf16x8*)(kp+512);
  kf[2]=*(const __attribute__((address_space(3))) bf16x8*)(kp+2048); kf[3]=*(const __attribute__((address_space(3))) bf16x8*)(kp+2560);
  kf[4]=*(const __attribute__((address_space(3))) bf16x8*)(kp+4096); kf[5]=*(const __attribute__((address_space(3))) bf16x8*)(kp+4608);
  kf[6]=*(const __attribute__((address_space(3))) bf16x8*)(kp+6144); kf[7]=*(const __attribute__((address_space(3))) bf16x8*)(kp+6656);
}
__device__ __forceinline__ void kload2(bf16x8*kf,lds_cptr kp,int j){ kf[2*j]=*(const __attribute__((address_space(3))) bf16x8*)(kp+j*2048); kf[2*j+1]=*(const __attribute__((address_space(3))) bf16x8*)(kp+j*2048+512); }
__device__ __forceinline__ s16x4 vtr(lds_cptr p){ return __builtin_bit_cast(s16x4,__builtin_amdgcn_ds_read_tr16_b64_v4i16((__attribute__((address_space(3))) v4i16_t*)p)); }
__device__ __forceinline__ float rowmax(const f32x16&p0,const f32x16&p1){
  float a=max3f(p0[0],p0[1],p1[0]),b=max3f(p0[2],p0[3],p1[1]);a=max3f(a,p1[2],p1[3]);
  #pragma unroll
  for(int r=4;r<16;r+=4){a=max3f(a,p0[r],p0[r+1]);b=max3f(b,p0[r+2],p0[r+3]);a=max3f(a,p1[r],p1[r+1]);b=max3f(b,p1[r+2],p1[r+3]);}
  const float m=max2f(a,b);
  auto rr=__builtin_amdgcn_permlane32_swap(__float_as_uint(m),__float_as_uint(m),false,false);
  return max2f(__uint_as_float(rr[0]),__uint_as_float(rr[1]));
}
__device__ __forceinline__ void pv(f32x16*o,int vb,bf16x8 pa0,bf16x8 pa1,bf16x8 pa2,bf16x8 pa3){
  #pragma unroll
  for(int d0=0;d0<2;++d0){s16x4 lo[4],hi[4];
    #pragma unroll
    for(int ks=0;ks<4;++ks){
      asm volatile("ds_read_b64_tr_b16 %0,%1 offset:%c2":"=&v"(lo[ks]):"v"(vb),"i"(d0*4096+ks*1024):"memory");
      asm volatile("ds_read_b64_tr_b16 %0,%1 offset:%c2":"=&v"(hi[ks]):"v"(vb),"i"(d0*4096+ks*1024+512):"memory");}
    asm volatile("s_waitcnt lgkmcnt(0)":::"memory");SBAR();
    #define PK(k) (bf16x8){lo[k][0],lo[k][1],lo[k][2],lo[k][3],hi[k][0],hi[k][1],hi[k][2],hi[k][3]}
    o[d0]=__builtin_amdgcn_mfma_f32_32x32x16_bf16(pa0,PK(0),o[d0],0,0,0);
    o[d0]=__builtin_amdgcn_mfma_f32_32x32x16_bf16(pa1,PK(1),o[d0],0,0,0);
    o[d0]=__builtin_amdgcn_mfma_f32_32x32x16_bf16(pa2,PK(2),o[d0],0,0,0);
    o[d0]=__builtin_amdgcn_mfma_f32_32x32x16_bf16(pa3,PK(3),o[d0],0,0,0);
    #undef PK
  }
}
struct UA {
  const bf16* Qw0; int ldq;
  const bf16* Kh; const bf16* Vh; int ldkv;
  bf16* Ow0; int ldo;
  int NT;
  int tabs0;
  int cq0;
  const float* relb;
  const unsigned* msk;
  int nomask;
};
#ifndef ATTN_STORE16
#define ATTN_STORE16(p,v) (*(__attribute__((address_space(1))) u32x4*)(p)=(v))
#endif
template<int MODE,int THRL> __device__ __forceinline__ void attn_unit(const UA& a,char*shm,int tid_in){
  int tid_l=tid_in; asm volatile("":"+v"(tid_l));
  const int tid=tid_l,lane=tid&63,r32=lane&31,hi=lane>>5; const int wid=__builtin_amdgcn_readfirstlane(tid>>6);
  const long ldq=a.ldq, ldkv=a.ldkv, ldo=a.ldo;
  const bf16*Qw=a.Qw0+(long)(wid*QBLK)*ldq;
  const bf16*Kh=a.Kh,*Vh=a.Vh;
  const unsigned lds0=(unsigned)(uintptr_t)shm;
  float*wsf=(float*)(shm+LDS_WS)+wid*64;
  const bf16*ksrc=Kh+(long)lane*ldkv+wid*8;
  const bf16*vsrc=Vh+(long)(16*(wid&3)+(lane>>2))*ldkv+(wid>>2)*32+(lane&3)*8;
  const unsigned kdst=lds0+LDS_K+wid*1024, vdst=lds0+LDS_V+wid*1024;
  const int cq=a.cq0+(wid>>1);
  const unsigned* msrc=a.msk+((long)a.cq0*64+wid*32)*2+lane;
  const unsigned mdst=lds0+LDS_MSK+wid*256;
  const __attribute__((address_space(3))) float* tab=(const __attribute__((address_space(3))) float*)(__attribute__((address_space(3))) char*)(shm+LDS_TAB);
  if(MODE==0){ __attribute__((address_space(3))) float* tw=(__attribute__((address_space(3))) float*)(__attribute__((address_space(3))) char*)(shm+LDS_TAB);
    for(int i=tid;i<384;i+=512) tw[i]=((const __attribute__((address_space(1))) float*)a.relb)[i<319?i:319]*1.4426950408889634f; }
  #define DMA_K(t,slot) glds16(ksrc+(long)(t)*KVBLK*ldkv,(unsigned)__builtin_amdgcn_readfirstlane(kdst+(slot)))
  #define DMA_V(t,slot) glds16(vsrc+(long)(t)*KVBLK*ldkv,(unsigned)__builtin_amdgcn_readfirstlane(vdst+(slot)))
  #define DMA_M(t) do{ if(MODE==1) glds4(msrc+(long)(a.tabs0+(t))*8192,(unsigned)__builtin_amdgcn_readfirstlane(mdst+(((t)&3)*2048))); }while(0)
  const int vb0=(int)(lds0+LDS_V)+((lane>>4)&1)*32+(lane&3)*8+(4*hi+((lane&15)>>2))*64;
  const char*Kbase=shm+LDS_K; bf16x8 kf[8];
  const lds_cptr shm3=(lds_cptr)shm; const lds_cptr kp0=shm3+LDS_K+hi*1024+r32*16; const lds_cptr vp0=shm3+LDS_V+((lane>>4)&1)*32+(lane&3)*8+(4*hi+((lane&15)>>2))*64;
  const lds_cptr mp0=shm3+LDS_MSK+wid*256+(r32*2+hi)*4;
  const int NT=a.NT;
  DMA_K(0,0);DMA_V(0,0);DMA_K(1,SLOTB);DMA_M(0);DMA_M(1);
  bf16x8 qr[4];
  #pragma unroll
  for(int d0=0;d0<4;++d0)qr[d0]=*(const __attribute__((address_space(1))) bf16x8*)(&Qw[(long)r32*ldq+d0*16+hi*8]);
  float mhat=0.f,l_reg=0.f;f32x16 o[2];o[0]=f32x16{};o[1]=f32x16{};f32x16 negm=f32x16{};asm volatile("":"+v"(negm));
  const int qi=(wid&1)*32+r32;
  #define HOOK(P0,P1,tl) do{ const int ta_=a.tabs0+(tl); \
    if(MODE==0){ const int dch_=cq-ta_; \
      if(dch_<0||dch_>8){ _Pragma("unroll") for(int r=0;r<16;++r){P0[r]=-INFINITY;P1[r]=-INFINITY;} } \
      else if(dch_>=5){ const float c_=tab[319]; _Pragma("unroll") for(int r=0;r<16;++r){P0[r]+=c_;P1[r]+=c_;} } \
      else{ int ll_=lane; asm volatile("":"+v"(ll_)); const __attribute__((address_space(3))) float* tp_=tab+(64*dch_+(wid&1)*32+(ll_&31)+4-4*(ll_>>5)); _Pragma("unroll") for(int r=0;r<16;++r){ P0[r]+=tp_[59-((r&3)+8*(r>>2))]; P1[r]+=tp_[27-((r&3)+8*(r>>2))]; } } } \
    else if(MODE==1){ \
      if(ta_>cq){ _Pragma("unroll") for(int r=0;r<16;++r){P0[r]=-INFINITY;P1[r]=-INFINITY;} } \
      else if(!a.nomask){ const unsigned mw_=*(const __attribute__((address_space(3))) unsigned*)(mp0+(((tl)&3)*2048)); \
        _Pragma("unroll") for(int r=0;r<16;++r){ P0[r]=((int)(mw_<<(31-r))<0)?P0[r]:-INFINITY; P1[r]=((int)(mw_<<(15-r))<0)?P1[r]:-INFINITY; } } } \
    else if(MODE==3){ if(ta_>cq){ _Pragma("unroll") for(int r=0;r<16;++r){P0[r]=-INFINITY;P1[r]=-INFINITY;} } } \
  }while(0)
  bool resc=false;
  #define START(P0,P1) do{ const float rm=rowmax(P0,P1); resc=false; \
    { const float dl=(rm>-1e30f)?rm:0.f; mhat=fadd_s(mhat,dl); \
      _Pragma("unroll") for(int r=0;r<16;++r){P0[r]=fsub_s(P0[r],dl);P1[r]=fsub_s(P1[r],dl);} \
      _Pragma("unroll") for(int r=0;r<16;++r)negm[r]=-mhat; asm volatile("":"+v"(negm)); } \
    _Pragma("unroll") for(int r=0;r<16;++r)P0[r]=__builtin_amdgcn_exp2f(P0[r]); }while(0)
  #define RESC() do{ if(resc){ asm volatile("s_waitcnt lgkmcnt(0)":::"memory"); int hl_=lane>>5; asm volatile("":"+v"(hl_)); const float* wq_=(const float*)(shm+LDS_WS)+wid*64+4*hl_; \
      _Pragma("unroll") for(int d_=0;d_<2;++d_) _Pragma("unroll") for(int r=0;r<16;++r)o[d_][r]*=wq_[(r&3)+8*(r>>2)]; } }while(0)
  f32x16 pA0,pA1,pB0,pB1;
  int sl_prev=0,sl_cur=0,sl_next=SLOTB;
  #define ROT() do{sl_prev=sl_cur;sl_cur=sl_next;sl_next=(sl_next==(NSLOT-1)*SLOTB)?0:sl_next+SLOTB;}while(0)
  DMA_K(2,2*SLOTB);
  WAIT_BAR(0);
  qkt(pA0,pA1,Kbase,qr,negm,r32,hi);asm volatile("s_nop 15\n\ts_nop 7":"+v"(pA0),"+v"(pA1));HOOK(pA0,pA1,0);
  START(pA0,pA1);
  _Pragma("unroll") for(int r=0;r<16;++r)pA1[r]=__builtin_amdgcn_exp2f(pA1[r]);
  WAIT_BAR(0);
  DMA_K(3,0);DMA_V(1,SLOTB);DMA_M(2);
  ROT();
  kload8(kf,kp0+sl_cur);
  if(MODE==1){WAIT_BAR(3);}else{WAIT_BAR(2);}
  s16x4 vlo[8],vhi[8]; u32x4 pw0,pw1,pw2,pw3;
  #define PKW(P,B) cvtpk_s(P[B],P[B+1])
  #define PAF(k) __builtin_bit_cast(bf16x8,pw##k)
  #define VFR(i) (bf16x8){vlo[i][0],vlo[i][1],vlo[i][2],vlo[i][3],vhi[i][0],vhi[i][1],vhi[i][2],vhi[i][3]}
  #define PIN(x) asm volatile("":"+v"(x))
  #define MX3(a,b,c) __builtin_fmaxf(__builtin_fmaxf((a),(b)),(c))
  #define GAPA(MF,A0,A1,A2,A3,W0,W1,PW) do{ MF; sacc+=A0; sacc+=A1; sacc+=A2; sacc+=A3; PIN(sacc); W0; W1; PIN(PW); SBAR(); }while(0)
  #define EX(v) __builtin_amdgcn_exp2f(v)
  #define GAPB(MF,X,B) do{ MF; X[B]=EX(X[B]); X[B+1]=EX(X[B+1]); X[B+2]=EX(X[B+2]); X[B+3]=EX(X[B+3]); PIN(X); SBAR(); }while(0)
  #define VRD(i) do{ vlo[i]=vtr(vp_+(((i)>>2)*4096+((i)&3)*1024)); vhi[i]=vtr(vp_+(((i)>>2)*4096+((i)&3)*1024+512)); }while(0)
  #define KRD(G,j) do{ if(G){ kload2(kf,kp0+sl_next,j); SBAR(); } }while(0)
  #define STEP(C0,C1,P0,P1,t,GK,GV,GL,GM) do{ SBAR(); \
    const lds_cptr vp_=vp0+sl_prev; \
    VRD(0); SBAR(); float sacc=(P0[0]+P0[1]); \
    GAPA(C0=__builtin_amdgcn_mfma_f32_32x32x16_bf16(kf[0],qr[0],negm,0,0,0), P0[2],P0[3],P0[4],P0[5],     pw0[0]=PKW(P0,0), pw0[1]=PKW(P0,2), pw0); \
    VRD(4); SBAR(); GAPA(C1=__builtin_amdgcn_mfma_f32_32x32x16_bf16(kf[1],qr[0],negm,0,0,0), P0[6],P0[7],P0[8],P0[9],     pw0[2]=PKW(P0,4), pw0[3]=PKW(P0,6), pw0); \
    VRD(1); SBAR(); GAPA(C0=__builtin_amdgcn_mfma_f32_32x32x16_bf16(kf[2],qr[1],C0,0,0,0),   P0[10],P0[11],P0[12],P0[13], pw1[0]=PKW(P0,8), pw1[1]=PKW(P0,10), pw1); \
    VRD(5); SBAR(); GAPA(C1=__builtin_amdgcn_mfma_f32_32x32x16_bf16(kf[3],qr[1],C1,0,0,0),   P0[14],P0[15],P1[0],P1[1],   pw1[2]=PKW(P0,12),pw1[3]=PKW(P0,14), pw1); \
    VRD(2); SBAR(); GAPA(C0=__builtin_amdgcn_mfma_f32_32x32x16_bf16(kf[4],qr[2],C0,0,0,0),   P1[2],P1[3],P1[4],P1[5],     pw2[0]=PKW(P1,0), pw2[1]=PKW(P1,2), pw2); \
    VRD(6); SBAR(); GAPA(C1=__builtin_amdgcn_mfma_f32_32x32x16_bf16(kf[5],qr[2],C1,0,0,0),   P1[6],P1[7],P1[8],P1[9],     pw2[2]=PKW(P1,4), pw2[3]=PKW(P1,6), pw2); \
    VRD(3); SBAR(); GAPA(C0=__builtin_amdgcn_mfma_f32_32x32x16_bf16(kf[6],qr[3],C0,0,0,0),   P1[10],P1[11],P1[12],P1[13], pw3[0]=PKW(P1,8), pw3[1]=PKW(P1,10), pw3); \
    VRD(7); SBAR(); GAPA(C1=__builtin_amdgcn_mfma_f32_32x32x16_bf16(kf[7],qr[3],C1,0,0,0),   P1[14],P1[15],0.f,0.f,       pw3[2]=PKW(P1,12),pw3[3]=PKW(P1,14), pw3); \
    l_reg+=sacc; \
    if(GK){DMA_K((t)+3,sl_cur);} if(GV){DMA_V((t)+1,sl_next);} if(GM){DMA_M((t)+2);} \
    HOOK(C0,C1,t); \
    { float a_=MX3(C0[0],C0[1],C1[0]),b_=MX3(C0[2],C0[3],C1[1]); a_=MX3(a_,C1[2],C1[3]); \
      _Pragma("unroll") for(int r=4;r<16;r+=4){a_=MX3(a_,C0[r],C0[r+1]);b_=MX3(b_,C0[r+2],C0[r+3]);a_=MX3(a_,C1[r],C1[r+1]);b_=MX3(b_,C1[r+2],C1[r+3]);} \
      float rm=__builtin_fmaxf(a_,b_); { auto rr=__builtin_amdgcn_permlane32_swap(__float_as_uint(rm),__float_as_uint(rm),false,false); rm=__builtin_fmaxf(__uint_as_float(rr[0]),__uint_as_float(rr[1])); } \
      resc=false; \
      if(__builtin_expect(__any(rm>(float)THRL),0)){ const float dl=__builtin_fmaxf(rm,0.f); mhat+=dl; \
        _Pragma("unroll") for(int r=0;r<16;++r){C0[r]-=dl;C1[r]-=dl;} \
        _Pragma("unroll") for(int r=0;r<16;++r)negm[r]=-mhat; asm volatile("":"+v"(negm)); \
        const float f=__builtin_amdgcn_exp2f(-dl); l_reg*=f; { int rl_=lane; asm volatile("":"+v"(rl_)); if(rl_<32)((float*)(shm+LDS_WS))[wid*64+rl_]=f; } resc=true; } } \
    SBAR(); \
    GAPB(o[0]=__builtin_amdgcn_mfma_f32_32x32x16_bf16(PAF(0),VFR(0),o[0],0,0,0), C0,0); \
    GAPB(o[1]=__builtin_amdgcn_mfma_f32_32x32x16_bf16(PAF(0),VFR(4),o[1],0,0,0), C0,4); \
    KRD(GL,0); GAPB(o[0]=__builtin_amdgcn_mfma_f32_32x32x16_bf16(PAF(1),VFR(1),o[0],0,0,0), C0,8); \
    KRD(GL,1); GAPB(o[1]=__builtin_amdgcn_mfma_f32_32x32x16_bf16(PAF(1),VFR(5),o[1],0,0,0), C0,12); \
    KRD(GL,2); GAPB(o[0]=__builtin_amdgcn_mfma_f32_32x32x16_bf16(PAF(2),VFR(2),o[0],0,0,0), C1,0); \
    KRD(GL,3); GAPB(o[1]=__builtin_amdgcn_mfma_f32_32x32x16_bf16(PAF(2),VFR(6),o[1],0,0,0), C1,4); \
    GAPB(o[0]=__builtin_amdgcn_mfma_f32_32x32x16_bf16(PAF(3),VFR(3),o[0],0,0,0), C1,8); \
    GAPB(o[1]=__builtin_amdgcn_mfma_f32_32x32x16_bf16(PAF(3),VFR(7),o[1],0,0,0), C1,12); \
    }while(0)
  #define WSTD() do{ if(MODE==1){WAIT_BAR(3);}else{WAIT_BAR(2);} }while(0)
  #define ENDW(tt) do{ if((tt)+3<NT){WSTD();} else if((tt)+2<NT){ if(MODE==1){WAIT_BAR(2);}else{WAIT_BAR(1);} } else {WAIT_BAR(0);} }while(0)
  int t=1;
  for(;t+5<NT;t+=2){
    STEP(pB0,pB1,pA0,pA1,t,true,true,true,true);     WSTD(); RESC(); ROT();
    STEP(pA0,pA1,pB0,pB1,t+1,true,true,true,true);   WSTD(); RESC(); ROT();
  }
  for(;t+1<NT;t+=2){
    STEP(pB0,pB1,pA0,pA1,t,(t+3<NT),(t+1<NT),(t+1<NT),(t+2<NT));       ENDW(t);   RESC(); ROT();
    STEP(pA0,pA1,pB0,pB1,t+1,(t+4<NT),(t+2<NT),(t+2<NT),(t+3<NT));     ENDW(t+1); RESC(); ROT();
  }
  STEP(pB0,pB1,pA0,pA1,NT-1,false,false,false,false); RESC();
  { float sacc=pB0[0]+pB0[1]; _Pragma("unroll") for(int r=2;r<16;++r)sacc+=pB0[r]; _Pragma("unroll") for(int r=0;r<16;++r)sacc+=pB1[r]; l_reg+=sacc;
    pw0=(u32x4){PKW(pB0,0),PKW(pB0,2),PKW(pB0,4),PKW(pB0,6)};pw1=(u32x4){PKW(pB0,8),PKW(pB0,10),PKW(pB0,12),PKW(pB0,14)};pw2=(u32x4){PKW(pB1,0),PKW(pB1,2),PKW(pB1,4),PKW(pB1,6)};pw3=(u32x4){PKW(pB1,8),PKW(pB1,10),PKW(pB1,12),PKW(pB1,14)};
    SBAR(); pv(o,vb0+sl_cur,PAF(0),PAF(1),PAF(2),PAF(3)); }
  #undef PKW
  #undef PAF
  #undef VFR
  #undef PIN
  #undef MX3
  #undef GAPA
  #undef GAPB
  #undef EX
  #undef VRD
  #undef KRD
  #undef STEP
  #undef ENDW
  #undef WSTD
  {auto rr=__builtin_amdgcn_permlane32_swap(__float_as_uint(l_reg),__float_as_uint(l_reg),false,false);l_reg=__uint_as_float(rr[0])+__uint_as_float(rr[1]);}
  if(hi==0)wsf[32+r32]=l_reg;asm volatile("s_waitcnt lgkmcnt(0)":::"memory");
  float rli[16];
  #pragma unroll
  for(int r=0;r<16;++r)rli[r]=__builtin_amdgcn_rcpf(wsf[32+crow(r,hi)]);
  bf16*Ow=a.Ow0+(long)(wid*QBLK)*ldo;
  { bf16*stg=(bf16*)(shm+LDS_OST)+wid*2048;
    #pragma unroll
    for(int r=0;r<16;++r){const int orow=crow(r,hi);
      #pragma unroll
      for(int d0=0;d0<2;++d0)stg[orow*64+d0*32+r32]=__float2bfloat16(o[d0][r]*rli[r]);}
    asm volatile("s_waitcnt lgkmcnt(0)":::"memory");
    #pragma unroll
    for(int i=0;i<4;++i){const int row=i*8+(lane>>3),ch=lane&7; const u32x4 v=*(const u32x4*)(stg+row*64+ch*8); ATTN_STORE16(Ow+(long)row*ldo+ch*8,v);} }
  asm volatile("s_waitcnt lgkmcnt(0)\n\ts_barrier":::"memory");
  #undef DMA_K
  #undef DMA_V
  #undef DMA_M
  #undef HOOK
  #undef START
  #undef RESC
  #undef ROT
}

struct UB { const bf16* Q; const bf16* K; const bf16* V; bf16* O;
  int qt;
  const float* subln; float lam, oscale; };
constexpr int B_SLOT=16384, B_LDS_K=0, B_LDS_V=3*B_SLOT, B_LDS_WS=6*B_SLOT, B_XROW=132;
template<int THRL> __device__ __forceinline__ void attn_unit_b2(const UB& a,char*shm,int tid_in){
  int tid_l=tid_in; asm volatile("":"+v"(tid_l));
  const int tid=tid_l,lane=tid&63,r32=lane&31,hi=lane>>5; const int wid=__builtin_amdgcn_readfirstlane(tid>>6);
  const int c=wid>>2, wq=wid&3;
  const int q0=128*a.qt;
  const int NT=(2*a.qt+2<4)?4:2*a.qt+2;
  const int cq=2*a.qt+(wq>>1);
  const bf16*Qw=a.Q+(long)(q0+32*wq)*512+c*64;
  const unsigned lds0=(unsigned)(uintptr_t)shm;
  float*wsf=(float*)(shm+B_LDS_WS)+wid*64;
  const bf16*ksrc=a.K+(long)lane*512+wid*8;
  const bf16*vsrc=a.V+(long)(16*(wid&3)+(lane>>2))*512+(wid>>2)*32+(lane&3)*8;
  const unsigned kdst=lds0+B_LDS_K+wid*1024, vdst=lds0+B_LDS_V+wid*1024;
  #define DMA_K(t,slot) do{ glds16(ksrc+(long)(t)*KVBLK*512,(unsigned)__builtin_amdgcn_readfirstlane(kdst+(slot))); glds16(ksrc+(long)(t)*KVBLK*512+64,(unsigned)__builtin_amdgcn_readfirstlane(kdst+(slot)+8192u)); }while(0)
  #define DMA_V(t,slot) do{ glds16(vsrc+(long)(t)*KVBLK*512,(unsigned)__builtin_amdgcn_readfirstlane(vdst+(slot))); glds16(vsrc+(long)(t)*KVBLK*512+64,(unsigned)__builtin_amdgcn_readfirstlane(vdst+(slot)+8192u)); }while(0)
  const int vb0=(int)(lds0+B_LDS_V)+((lane>>4)&1)*32+(lane&3)*8+(4*hi+((lane&15)>>2))*64;
  const char*Kbase=shm+B_LDS_K+c*8192; bf16x8 kf[8];
  const lds_cptr shm3=(lds_cptr)shm; const lds_cptr kp0=shm3+B_LDS_K+c*8192+hi*1024+r32*16; const lds_cptr vp0=shm3+B_LDS_V+((lane>>4)&1)*32+(lane&3)*8+(4*hi+((lane&15)>>2))*64;
  DMA_K(0,0);DMA_V(0,0);DMA_K(1,B_SLOT);
  bf16x8 qr[4];
  #pragma unroll
  for(int d0=0;d0<4;++d0)qr[d0]=*(const __attribute__((address_space(1))) bf16x8*)(&Qw[(long)r32*512+d0*16+hi*8]);
  float mhat=0.f,l_reg=0.f;f32x16 o[4];o[0]=f32x16{};o[1]=f32x16{};o[2]=f32x16{};o[3]=f32x16{};f32x16 negm=f32x16{};asm volatile("":"+v"(negm));
  #define HOOK(P0,P1,tl) do{ if((tl)>cq){ _Pragma("unroll") for(int r=0;r<16;++r){P0[r]=-INFINITY;P1[r]=-INFINITY;} } }while(0)
  bool resc=false;
  #define START(P0,P1) do{ const float rm=rowmax(P0,P1); resc=false; \
    { const float dl=(rm>-1e30f)?rm:0.f; mhat=fadd_s(mhat,dl); \
      _Pragma("unroll") for(int r=0;r<16;++r){P0[r]=fsub_s(P0[r],dl);P1[r]=fsub_s(P1[r],dl);} \
      _Pragma("unroll") for(int r=0;r<16;++r)negm[r]=-mhat; asm volatile("":"+v"(negm)); } \
    _Pragma("unroll") for(int r=0;r<16;++r)P0[r]=__builtin_amdgcn_exp2f(P0[r]); }while(0)
  #define RESC() do{ if(resc){ asm volatile("s_waitcnt lgkmcnt(0)":::"memory"); int hl_=lane>>5; asm volatile("":"+v"(hl_)); const float* wq_=(const float*)(shm+B_LDS_WS)+wid*64+4*hl_; \
      _Pragma("unroll") for(int d_=0;d_<4;++d_) _Pragma("unroll") for(int r=0;r<16;++r)o[d_][r]*=wq_[(r&3)+8*(r>>2)]; } }while(0)
  f32x16 pA0,pA1,pB0,pB1;
  int sl_prev=0,sl_cur=0,sl_next=B_SLOT;
  #define ROT() do{sl_prev=sl_cur;sl_cur=sl_next;sl_next=(sl_next==2*B_SLOT)?0:sl_next+B_SLOT;}while(0)
  DMA_K(2,2*B_SLOT);
  WAIT_BAR(0);
  qkt(pA0,pA1,Kbase,qr,negm,r32,hi);asm volatile("s_nop 15\n\ts_nop 7":"+v"(pA0),"+v"(pA1));HOOK(pA0,pA1,0);
  START(pA0,pA1);
  _Pragma("unroll") for(int r=0;r<16;++r)pA1[r]=__builtin_amdgcn_exp2f(pA1[r]);
  WAIT_BAR(0);
  DMA_K(3,0);DMA_V(1,B_SLOT);
  ROT();
  kload8(kf,kp0+sl_cur);
  WAIT_BAR(4);
  s16x4 valo,vahi,vblo,vbhi; u32x4 pw0,pw1,pw2,pw3;
  #define PKW(P,B) cvtpk_s(P[B],P[B+1])
  #define PAF(k) __builtin_bit_cast(bf16x8,pw##k)
  #define PIN(x) asm volatile("":"+v"(x))
  #define MX3(a,b,c) __builtin_fmaxf(__builtin_fmaxf((a),(b)),(c))
  #define GAPA(MF,A0,A1,A2,A3,W0,W1,PW) do{ MF; sacc+=A0; sacc+=A1; sacc+=A2; sacc+=A3; PIN(sacc); W0; W1; PIN(PW); SBAR(); }while(0)
  #define EX(v) __builtin_amdgcn_exp2f(v)
  #define VOFF(m) (((((m)&3)>>1)*8192)+((((m)&3)&1)*4+((m)>>2))*1024)
  #define VLDA(m) do{ valo=vtr(vp_+VOFF(m)); vahi=vtr(vp_+VOFF(m)+512); }while(0)
  #define VLDB(m) do{ vblo=vtr(vp_+VOFF(m)); vbhi=vtr(vp_+VOFF(m)+512); }while(0)
  #define VFA (bf16x8){valo[0],valo[1],valo[2],valo[3],vahi[0],vahi[1],vahi[2],vahi[3]}
  #define VFB (bf16x8){vblo[0],vblo[1],vblo[2],vblo[3],vbhi[0],vbhi[1],vbhi[2],vbhi[3]}
  #define GAPB2(MF,X,B) do{ MF; X[B]=EX(X[B]); X[B+1]=EX(X[B+1]); PIN(X); SBAR(); }while(0)
  #define KRD(G,j) do{ if(G){ kload2(kf,kp0+sl_next,j); SBAR(); } }while(0)
  #define PVE(m,PA,X,B) do{ VLDB((m)+1); SBAR(); GAPB2(o[(m)&3]=__builtin_amdgcn_mfma_f32_32x32x16_bf16(PA,VFA,o[(m)&3],0,0,0),X,B); }while(0)
  #define PVO(m,PA,X,B,LAST) do{ if(!(LAST)){VLDA((m)+1);} SBAR(); GAPB2(o[(m)&3]=__builtin_amdgcn_mfma_f32_32x32x16_bf16(PA,VFB,o[(m)&3],0,0,0),X,B); }while(0)
  #define STEP(C0,C1,P0,P1,t,GK,GV,GL) do{ SBAR(); \
    const lds_cptr vp_=vp0+sl_prev; \
    float sacc=(P0[0]+P0[1]); \
    GAPA(C0=__builtin_amdgcn_mfma_f32_32x32x16_bf16(kf[0],qr[0],negm,0,0,0), P0[2],P0[3],P0[4],P0[5],     pw0[0]=PKW(P0,0), pw0[1]=PKW(P0,2), pw0); \
    GAPA(C1=__builtin_amdgcn_mfma_f32_32x32x16_bf16(kf[1],qr[0],negm,0,0,0), P0[6],P0[7],P0[8],P0[9],     pw0[2]=PKW(P0,4), pw0[3]=PKW(P0,6), pw0); \
    GAPA(C0=__builtin_amdgcn_mfma_f32_32x32x16_bf16(kf[2],qr[1],C0,0,0,0),   P0[10],P0[11],P0[12],P0[13], pw1[0]=PKW(P0,8), pw1[1]=PKW(P0,10), pw1); \
    GAPA(C1=__builtin_amdgcn_mfma_f32_32x32x16_bf16(kf[3],qr[1],C1,0,0,0),   P0[14],P0[15],P1[0],P1[1],   pw1[2]=PKW(P0,12),pw1[3]=PKW(P0,14), pw1); \
    GAPA(C0=__builtin_amdgcn_mfma_f32_32x32x16_bf16(kf[4],qr[2],C0,0,0,0),   P1[2],P1[3],P1[4],P1[5],     pw2[0]=PKW(P1,0), pw2[1]=PKW(P1,2), pw2); \
    GAPA(C1=__builtin_amdgcn_mfma_f32_32x32x16_bf16(kf[5],qr[2],C1,0,0,0),   P1[6],P1[7],P1[8],P1[9],     pw2[2]=PKW(P1,4), pw2[3]=PKW(P1,6), pw2); \
    GAPA(C0=__builtin_amdgcn_mfma_f32_32x32x16_bf16(kf[6],qr[3],C0,0,0,0),   P1[10],P1[11],P1[12],P1[13], pw3[0]=PKW(P1,8), pw3[1]=PKW(P1,10), pw3); \
    VLDA(0); SBAR(); \
    GAPA(C1=__builtin_amdgcn_mfma_f32_32x32x16_bf16(kf[7],qr[3],C1,0,0,0),   P1[14],P1[15],0.f,0.f,       pw3[2]=PKW(P1,12),pw3[3]=PKW(P1,14), pw3); \
    l_reg+=sacc; \
    if(GK){DMA_K((t)+3,sl_cur);} if(GV){DMA_V((t)+1,sl_next);} \
    HOOK(C0,C1,t); \
    { float a_=MX3(C0[0],C0[1],C1[0]),b_=MX3(C0[2],C0[3],C1[1]); a_=MX3(a_,C1[2],C1[3]); \
      _Pragma("unroll") for(int r=4;r<16;r+=4){a_=MX3(a_,C0[r],C0[r+1]);b_=MX3(b_,C0[r+2],C0[r+3]);a_=MX3(a_,C1[r],C1[r+1]);b_=MX3(b_,C1[r+2],C1[r+3]);} \
      float rm=__builtin_fmaxf(a_,b_); { auto rr=__builtin_amdgcn_permlane32_swap(__float_as_uint(rm),__float_as_uint(rm),false,false); rm=__builtin_fmaxf(__uint_as_float(rr[0]),__uint_as_float(rr[1])); } \
      resc=false; \
      if(__builtin_expect(__any(rm>(float)THRL),0)){ const float dl=__builtin_fmaxf(rm,0.f); mhat+=dl; \
        _Pragma("unroll") for(int r=0;r<16;++r){C0[r]-=dl;C1[r]-=dl;} \
        _Pragma("unroll") for(int r=0;r<16;++r)negm[r]=-mhat; asm volatile("":"+v"(negm)); \
        const float f=__builtin_amdgcn_exp2f(-dl); l_reg*=f; { int rl_=lane; asm volatile("":"+v"(rl_)); if(rl_<32)((float*)(shm+B_LDS_WS))[wid*64+rl_]=f; } resc=true; } } \
    SBAR(); \
    PVE(0,PAF(0),C0,0);  PVO(1,PAF(0),C0,2,false);  PVE(2,PAF(0),C0,4);  PVO(3,PAF(0),C0,6,false); \
    KRD(GL,0); PVE(4,PAF(1),C0,8);  PVO(5,PAF(1),C0,10,false); KRD(GL,1); PVE(6,PAF(1),C0,12); PVO(7,PAF(1),C0,14,false); \
    KRD(GL,2); PVE(8,PAF(2),C1,0);  PVO(9,PAF(2),C1,2,false);  KRD(GL,3); PVE(10,PAF(2),C1,4); PVO(11,PAF(2),C1,6,false); \
    PVE(12,PAF(3),C1,8); PVO(13,PAF(3),C1,10,false); PVE(14,PAF(3),C1,12); PVO(15,PAF(3),C1,14,true); \
    }while(0)
  #define ENDW(tt) do{ if((tt)+3<NT){WAIT_BAR(4);} else if((tt)+2<NT){WAIT_BAR(2);} else {WAIT_BAR(0);} }while(0)
  int t=1;
  for(;t+5<NT;t+=2){
    STEP(pB0,pB1,pA0,pA1,t,true,true,true);     WAIT_BAR(4); RESC(); ROT();
    STEP(pA0,pA1,pB0,pB1,t+1,true,true,true);   WAIT_BAR(4); RESC(); ROT();
  }
  for(;t+1<NT;t+=2){
    STEP(pB0,pB1,pA0,pA1,t,(t+3<NT),(t+1<NT),(t+1<NT));       ENDW(t);   RESC(); ROT();
    STEP(pA0,pA1,pB0,pB1,t+1,(t+4<NT),(t+2<NT),(t+2<NT));     ENDW(t+1); RESC(); ROT();
  }
  STEP(pB0,pB1,pA0,pA1,NT-1,false,false,false); RESC();
  { float sacc=pB0[0]+pB0[1]; _Pragma("unroll") for(int r=2;r<16;++r)sacc+=pB0[r]; _Pragma("unroll") for(int r=0;r<16;++r)sacc+=pB1[r]; l_reg+=sacc;
    pw0=(u32x4){PKW(pB0,0),PKW(pB0,2),PKW(pB0,4),PKW(pB0,6)};pw1=(u32x4){PKW(pB0,8),PKW(pB0,10),PKW(pB0,12),PKW(pB0,14)};pw2=(u32x4){PKW(pB1,0),PKW(pB1,2),PKW(pB1,4),PKW(pB1,6)};pw3=(u32x4){PKW(pB1,8),PKW(pB1,10),PKW(pB1,12),PKW(pB1,14)};
    SBAR(); pv(o,vb0+sl_cur,PAF(0),PAF(1),PAF(2),PAF(3)); pv(o+2,vb0+sl_cur+8192,PAF(0),PAF(1),PAF(2),PAF(3)); }
  #undef PKW
  #undef PAF
  #undef PIN
  #undef MX3
  #undef GAPA
  #undef EX
  #undef VOFF
  #undef VLDA
  #undef VLDB
  #undef VFA
  #undef VFB
  #undef GAPB2
  #undef KRD
  #undef PVE
  #undef PVO
  #undef STEP
  #undef ENDW
  {auto rr=__builtin_amdgcn_permlane32_swap(__float_as_uint(l_reg),__float_as_uint(l_reg),false,false);l_reg=__uint_as_float(rr[0])+__uint_as_float(rr[1]);}
  if(hi==0)wsf[32+r32]=l_reg;asm volatile("s_waitcnt lgkmcnt(0)":::"memory");
  float rli[16];
  #pragma unroll
  for(int r=0;r<16;++r)rli[r]=__builtin_amdgcn_rcpf(wsf[32+crow(r,hi)]);
  asm volatile("s_waitcnt lgkmcnt(0)\n\ts_barrier":::"memory");
  float*xw=(float*)shm+(long)wq*32*B_XROW;
  if(c==1){
    #pragma unroll
    for(int r=0;r<16;++r){const int row=crow(r,hi);
      #pragma unroll
      for(int d=0;d<4;++d)xw[row*B_XROW+32*d+r32]=o[d][r]*rli[r];}
  }
  asm volatile("s_waitcnt lgkmcnt(0)\n\ts_barrier":::"memory");
  if(c==0){
    #pragma unroll
    for(int r=0;r<16;++r){const int row=crow(r,hi);
      #pragma unroll
      for(int d=0;d<4;++d){float*p=xw+row*B_XROW+32*d+r32; *p=o[d][r]*rli[r]-a.lam*(*p);} }
    asm volatile("s_waitcnt lgkmcnt(0)":::"memory");
    const int row=lane>>1, hf=lane&1; const float*rp=xw+row*B_XROW+64*hf;
    f32x4v dv[16]; float ss=0.f;
    #pragma unroll
    for(int j=0;j<16;++j){dv[j]=*(const f32x4v*)(rp+4*j); ss+=(dv[j][0]*dv[j][0]+dv[j][1]*dv[j][1])+(dv[j][2]*dv[j][2]+dv[j][3]*dv[j][3]);}
    ss+=__shfl_xor(ss,1);
    const float rs=1.0f/sqrtf(ss*(1.0f/128.0f)+1e-6f);
    bf16*orow=a.O+(long)(q0+32*wq+row)*512+64*hf;
    #pragma unroll
    for(int j=0;j<8;++j){
      u32x4 w; w.x=cvtpk_s(dv[2*j][0]*rs,dv[2*j][1]*rs); w.y=cvtpk_s(dv[2*j][2]*rs,dv[2*j][3]*rs); w.z=cvtpk_s(dv[2*j+1][0]*rs,dv[2*j+1][1]*rs); w.w=cvtpk_s(dv[2*j+1][2]*rs,dv[2*j+1][3]*rs);
      ATTN_STORE16(orow+8*j,w); }
  }
  asm volatile("s_waitcnt lgkmcnt(0)\n\ts_barrier":::"memory");
  #undef DMA_K
  #undef DMA_V
  #undef HOOK
  #undef START
  #undef RESC
  #undef ROT
}
#undef SBAR
#undef WAIT_BAR
}

constexpr int NWAVES = 8;
constexpr int NB = 16, SEQ = 4096, DM = 1024, DEPTH = 4, R = NB * SEQ;
constexpr int GB = 8, RG = GB * SEQ, NGRP = NB / GB;
constexpr int NIN = 8004, NINP = 8192, DFF = 2816, MEMLEN = 256;
constexpr float RMS_EPS = 1e-6f;
constexpr float QSCALE = 0.125f * 1.4426950408889634f;
constexpr size_t MiB = 1u << 20;
constexpr size_t WS_CTL = 0, CTL_ZERO_BYTES = 1 * MiB;
constexpr size_t WS_ROPE = 1 * MiB;
constexpr size_t WS_SCAL = 2 * MiB;
constexpr size_t WS_WKV = 3 * MiB;
constexpr size_t WS_MN = 7 * MiB;
constexpr size_t WS_KVX = 15 * MiB;
constexpr size_t WS_WL = 32 * MiB;
constexpr size_t WL_WIN = 0, WL_WUP = 16 * MiB, WL_WOUT = 19 * MiB, WL_WQX = 21 * MiB, WL_WOX = 21 * MiB + 512 * 1024, WL_WGU = 22 * MiB, WL_WDN = 33 * MiB;
constexpr size_t WS_XN = 72 * MiB;
constexpr size_t WS_MIX = 200 * MiB;
constexpr size_t WS_QKV = WS_MIX;
constexpr size_t QKV_STRIDE = (size_t)RG * 512;
constexpr size_t WS_QI = WS_MIX + 288 * MiB, WS_KI = WS_MIX + 304 * MiB;
constexpr size_t WS_GATES = WS_MIX + 320 * MiB;
constexpr size_t WS_Y = WS_MIX + 512 * MiB;
constexpr size_t WS_MASK = WS_MIX + 576 * MiB;
constexpr size_t WS_H = WS_MIX;
constexpr size_t WS_QX = WS_MIX + 400 * MiB;
constexpr size_t WS_OBUF = WS_MIX + 592 * MiB;
constexpr size_t WS_SS = WS_MIX + 688 * MiB;
constexpr size_t WS_XS = WS_MIX + 692 * MiB;
constexpr size_t WS_END = WS_MIX + 820 * MiB;
static_assert(WS_WL + WL_WDN + (size_t)1024 * DFF * 2 <= WS_XN && WS_XN + (size_t)R * DM * 2 <= WS_MIX && WS_H + (size_t)R * DFF * 2 <= WS_QX && WS_MASK + (size_t)GB * 64 * 4096 * 8 <= WS_OBUF && WS_OBUF + 3 * (size_t)RG * 512 * 2 <= WS_SS && WS_SS + (size_t)R * 64 <= WS_XS && WS_XS + (size_t)256 * 524288 <= WS_END && WS_END <= 1024 * MiB, "d_ws map");
constexpr int CW_BAR = 4096, CW_QUEUE = 8192;
constexpr int RING_BYTES = 131072, XRES_OFF = 131072, LDSCTL_OFF = 132096, LDS_BYTES = 155648;

#define GAS __attribute__((address_space(1)))
#define LAS __attribute__((address_space(3)))
typedef unsigned short bf16;
typedef unsigned v4u __attribute__((ext_vector_type(4)));
typedef float f32x4 __attribute__((ext_vector_type(4)));
typedef GAS unsigned gu32;
#define RLX_AGENT __ATOMIC_RELAXED, __HIP_MEMORY_SCOPE_AGENT
#define LDS_WAIT() asm volatile("s_waitcnt lgkmcnt(0)" ::: "memory")
__device__ __forceinline__ unsigned f2bf(float f) { unsigned u = __builtin_bit_cast(unsigned, f); return (u + 0x7fffu + ((u >> 16) & 1u)) >> 16; }
__device__ __forceinline__ unsigned pk2(float lo, float hi) { return f2bf(lo) | (f2bf(hi) << 16); }
#define XB_TMO      128
#define XB_XCNT(j)  (256  + 64 * (j))
#define XB_XSUB(j)  (1280 + 64 * (j))
#define XB_XGEN(j)  (2304 + 64 * (j))
#define XB_TOP      3328
#define XB_TOPGEN   3392
#define XCD_BAR_WORDS 3456
#define XB_SPIN_CAP (1u << 18)

__device__ __forceinline__ unsigned xb_ld(unsigned* p)              { return __hip_atomic_load(p, __ATOMIC_RELAXED, __HIP_MEMORY_SCOPE_AGENT); }
__device__ __forceinline__ unsigned xb_add(unsigned* p, unsigned v) { asm volatile("" : "+v"(v)); return __hip_atomic_fetch_add(p, v, __ATOMIC_RELAXED, __HIP_MEMORY_SCOPE_AGENT); }
__device__ __forceinline__ unsigned xb_xcc_id() { return (unsigned)__builtin_amdgcn_s_getreg((3 << 11) | 20) & 0xFu; }
#define XB_SPIN(cond, bar) do { unsigned _sp = 0; while (cond) { __builtin_amdgcn_s_sleep(1); \
    if ((++_sp & 255u) == 0u) { if (xb_ld(&(bar)[XB_TMO])) break; if (_sp > XB_SPIN_CAP) { atomicAdd(&(bar)[XB_TMO], 1u); break; } } } } while (0)

struct XcdBarrier {
    unsigned* bar; unsigned x;
    volatile LAS unsigned* st;
};

__device__ __forceinline__ XcdBarrier xcd_barrier_post(unsigned* bar, volatile LAS unsigned* st) {
    XcdBarrier b; b.bar = bar; b.x = xb_xcc_id(); b.st = st;
    if (threadIdx.x == 0) (void)xb_add(&bar[XB_XCNT(b.x)], 1u);
    return b;
}
__device__ __forceinline__ void xcd_barrier_complete(unsigned* bar, unsigned x, unsigned& nloc, unsigned& nx) {
    const unsigned G = gridDim.x * gridDim.y * gridDim.z; asm volatile("" : "+s"(x));
    unsigned sum, cnt, mine, sp = 0u;
    for (;;) {
        sum = 0u; cnt = 0u; mine = 0u;
#pragma unroll
        for (unsigned j = 0; j < 16; ++j) { const unsigned c = xb_ld(&bar[XB_XCNT(j)]); sum += c; cnt += (c > 0u) ? 1u : 0u; mine = (j == x) ? c : mine; }
        if (sum == G) break;
        __builtin_amdgcn_s_sleep(1);
        if ((++sp & 255u) == 0u) { if (xb_ld(&bar[XB_TMO])) break; if (sp > XB_SPIN_CAP) { atomicAdd(&bar[XB_TMO], 1u); break; } }
    }
    nloc = mine > 0u ? mine : 1u; nx = cnt > 0u ? cnt : 1u;
}

__device__ __forceinline__ void xcd_barrier(const XcdBarrier& b, int tid_in) {
    asm volatile("s_waitcnt vmcnt(0)" ::: "memory");
    __syncthreads();
    if (tid_in == 0) {
        unsigned* bar = b.bar; asm volatile("" : "+s"(bar));
        __builtin_amdgcn_s_waitcnt(0);
        unsigned nloc = b.st[0], nx = b.st[1];
        if (nloc == 0u) { xcd_barrier_complete(bar, b.x, nloc, nx); b.st[0] = nloc; b.st[1] = nx; }
        const unsigned old = xb_add(&bar[XB_XSUB(b.x)], 1u);
        const unsigned gen = old / nloc;
        if (old + 1u == (gen + 1u) * nloc) {
            __builtin_amdgcn_fence(__ATOMIC_RELEASE, "agent");
            asm volatile("s_waitcnt vmcnt(0)" ::: "memory");
            const unsigned og = xb_add(&bar[XB_TOP], 1u);
            const unsigned tg = og / nx;
            if (og + 1u == (tg + 1u) * nx) xb_add(&bar[XB_TOPGEN], 1u);
            else XB_SPIN(xb_ld(&bar[XB_TOPGEN]) == tg, bar);
            __builtin_amdgcn_fence(__ATOMIC_ACQUIRE, "agent");
            xb_add(&bar[XB_XGEN(b.x)], 1u);
            asm volatile("s_waitcnt vmcnt(0)" ::: "memory");
        } else {
            XB_SPIN(xb_ld(&bar[XB_XGEN(b.x)]) == gen, bar);
            __builtin_amdgcn_fence(__ATOMIC_ACQUIRE, "agent");
            asm volatile("s_waitcnt vmcnt(0)" ::: "memory");
        }
    }
    __syncthreads();
}

__device__ __forceinline__ float wave_sum(float v) {
#pragma unroll
    for (int o = 1; o < 64; o <<= 1) v += __shfl_xor(v, o);
    return v;
}
__device__ __forceinline__ int rope_dim(int c64) { return 32 * ((c64 >> 2) & 1) + 4 * (c64 >> 3) + (c64 & 3); }
struct MapId { __device__ __forceinline__ int operator()(int n) const { return n; } };
struct MapWin { __device__ __forceinline__ int operator()(int n) const {
    if (n < 4608) { const int region = n >> 9; const bool rope = (region == 3 || region == 4 || region == 6 || region == 7); return rope ? (n & ~63) + rope_dim(n & 63) : n; }
    if (n < 4928) return (n & ~63) + rope_dim(n & 63);
    if (n < 4932) return n;
    if (n < 5120) return -1;
    return 4932 + (n - 5120); } };
struct MapGu { __device__ __forceinline__ int operator()(int n) const { return ((n >> 2) & 1) * DFF + 4 * (n >> 3) + (n & 3); } };
template <class Map> __device__ __forceinline__ void cvt_item(const float* W, int K, int Nsrc, bf16* WT, const float* gain, const Map& mp, LAS float* scr, int item, int nblk, int lane) {
    const int kb = item / nblk, nb = item % nblk, k0 = 64 * kb, n0 = 32 * nb;
    const int src = mp(n0 + (lane & 31));
#pragma unroll 8
    for (int i = 0; i < 32; ++i) { const int kk = 2 * i + (lane >> 5); float v = 0.f;
        if (src >= 0) { v = ((const GAS float*)W)[(size_t)(k0 + kk) * Nsrc + src]; if (gain) v *= ((const GAS float*)gain)[k0 + kk]; }
        scr[kk * 33 + (lane & 31)] = v; }
    LDS_WAIT(); asm volatile("" ::: "memory");
    const int c = lane & 7;
#pragma unroll
    for (int j = 0; j < 4; ++j) { const int n = (lane >> 3) + 8 * j; const LAS float* s = scr + (8 * c) * 33 + n;
        v4u o; o.x = pk2(s[0 * 33], s[1 * 33]); o.y = pk2(s[2 * 33], s[3 * 33]); o.z = pk2(s[4 * 33], s[5 * 33]); o.w = pk2(s[6 * 33], s[7 * 33]);
        *(GAS v4u*)(WT + (size_t)(n0 + n) * K + k0 + 8 * c) = o; }
    LDS_WAIT(); asm volatile("" ::: "memory");
}
__device__ __forceinline__ void rms_row_to_bf16(const float* xrow, bf16* orow, int lane) {
    const GAS f32x4* xr = (const GAS f32x4*)xrow + lane;
    f32x4 v[4]; float s = 0.f;
#pragma unroll
    for (int j = 0; j < 4; ++j) { v[j] = xr[64 * j]; s += (v[j].x * v[j].x + v[j].y * v[j].y) + (v[j].z * v[j].z + v[j].w * v[j].w); }
    float eps = RMS_EPS; asm volatile("" : "+v"(eps));
    const float rstd = 1.f / sqrtf(wave_sum(s) * (1.f / DM) + eps);
    GAS unsigned long long* o8 = (GAS unsigned long long*)orow + lane;
#pragma unroll
    for (int j = 0; j < 4; ++j) o8[64 * j] = (unsigned long long)pk2(v[j].x * rstd, v[j].y * rstd) | ((unsigned long long)pk2(v[j].z * rstd, v[j].w * rstd) << 32);
}
__device__ __forceinline__ void x_row_init(const float* xrow, bf16* orow, float* ssrow, int lane) {
    const GAS f32x4* xr = (const GAS f32x4*)xrow + lane;
    f32x4 v[4]; float s = 0.f;
#pragma unroll
    for (int j = 0; j < 4; ++j) { v[j] = xr[64 * j]; s += (v[j].x * v[j].x + v[j].y * v[j].y) + (v[j].z * v[j].z + v[j].w * v[j].w); }
    s = wave_sum(s);
    GAS unsigned long long* o8 = (GAS unsigned long long*)orow + lane;
#pragma unroll
    for (int j = 0; j < 4; ++j) o8[64 * j] = (unsigned long long)pk2(v[j].x, v[j].y) | ((unsigned long long)pk2(v[j].z, v[j].w) << 32);
    if (lane < 16) ((GAS float*)ssrow)[lane] = (lane == 0) ? s : 0.f;
}
__device__ __forceinline__ void rms_row_final(const bf16* xrow, float* orow, const float* gain, int lane) {
    const GAS v4u* xr = (const GAS v4u*)xrow + lane;
    float v[16]; float s = 0.f;
#pragma unroll
    for (int j = 0; j < 2; ++j) { const v4u b = xr[64 * j]; const unsigned bw[4] = {b.x, b.y, b.z, b.w};
#pragma unroll
        for (int i = 0; i < 4; ++i) { v[8 * j + 2 * i] = __uint_as_float(bw[i] << 16); v[8 * j + 2 * i + 1] = __uint_as_float(bw[i] & 0xffff0000u); } }
#pragma unroll
    for (int i = 0; i < 16; ++i) s += v[i] * v[i];
    const float rstd = 1.f / sqrtf(wave_sum(s) * (1.f / DM) + RMS_EPS);
#pragma unroll
    for (int j = 0; j < 2; ++j)
#pragma unroll
        for (int h = 0; h < 2; ++h) { const int c = 512 * j + 8 * lane + 4 * h; const f32x4 g = *(const GAS f32x4*)(gain + c);
            f32x4 o = {v[8 * j + 4 * h] * rstd * g.x, v[8 * j + 4 * h + 1] * rstd * g.y, v[8 * j + 4 * h + 2] * rstd * g.z, v[8 * j + 4 * h + 3] * rstd * g.w};
            *(GAS f32x4*)(orow + c) = o; }
}
__device__ __forceinline__ int fresh_tid(int wave_s) { int l; asm volatile("v_mbcnt_lo_u32_b32 %0, -1, 0\n\tv_mbcnt_hi_u32_b32 %0, -1, %0" : "=v"(l)); int w = wave_s; asm volatile("" : "+s"(w)); return (w << 6) | l; }
__device__ __forceinline__ unsigned wq_claim(gu32* ctr) {
    return __builtin_amdgcn_atomic_inc32((unsigned*)ctr, 0xffffffffu, __ATOMIC_RELAXED, "agent");
}
__device__ __forceinline__ int wq_next(gu32* ctr, volatile LAS unsigned* slot, int tid_in, unsigned& nxt, unsigned& par) {
    if (tid_in == 0) { slot[par] = nxt; nxt = wq_claim(ctr); }
    asm volatile("s_waitcnt lgkmcnt(0)" ::: "memory"); __builtin_amdgcn_s_barrier(); asm volatile("" ::: "memory");
    const int i = (int)slot[par]; par ^= 1u;
    return i;
}

__device__ __forceinline__ void diff_combine_row(const bf16* tb, bf16* ob, const float* subln, float lam, float oscale, int lane) {
    const int h = lane >> 4, d0 = (lane & 15) * 8;
    const v4u a = *(const GAS v4u*)(tb + (h * 2 + 0) * 128 + d0), c = *(const GAS v4u*)(tb + (h * 2 + 1) * 128 + d0);
    const unsigned aw[4] = {a.x, a.y, a.z, a.w}, cw[4] = {c.x, c.y, c.z, c.w};
    float d[8]; float ss = 0.f;
#pragma unroll
    for (int i = 0; i < 4; ++i) { d[2 * i] = __uint_as_float(aw[i] << 16) - lam * __uint_as_float(cw[i] << 16); d[2 * i + 1] = __uint_as_float(aw[i] & 0xffff0000u) - lam * __uint_as_float(cw[i] & 0xffff0000u);
        ss += d[2 * i] * d[2 * i] + d[2 * i + 1] * d[2 * i + 1]; }
    ss += __shfl_xor(ss, 1); ss += __shfl_xor(ss, 2); ss += __shfl_xor(ss, 4); ss += __shfl_xor(ss, 8);
    const float rs = (1.0f / sqrtf(ss * (1.0f / 128.0f) + RMS_EPS)) * oscale;
    const f32x4 g0 = *(const GAS f32x4*)(subln + d0), g1 = *(const GAS f32x4*)(subln + d0 + 4);
    v4u o; o.x = pk2(d[0] * rs * g0.x, d[1] * rs * g0.y); o.y = pk2(d[2] * rs * g0.z, d[3] * rs * g0.w); o.z = pk2(d[4] * rs * g1.x, d[5] * rs * g1.y); o.w = pk2(d[6] * rs * g1.z, d[7] * rs * g1.w);
    *(GAS v4u*)(ob + h * 128 + d0) = o;
}

#ifndef PROBE_CHECK
#define PROBE_CHECK 0
#endif
#if PROBE_CHECK
__device__ __forceinline__ void probe_check_query(const bf16* QI, const bf16* KI, const unsigned* MASKB, int qpos, int n, LAS float* qs, gu32* flag, int lane) {
#pragma unroll 1
    for (int i = lane; i < 256; i += 64) qs[i] = __uint_as_float((unsigned)QI[(size_t)qpos * 256 + i] << 16);
    float wv[4];
#pragma unroll
    for (int h = 0; h < 4; ++h) wv[h] = __uint_as_float((unsigned)KI[(size_t)qpos * 256 + 64 + h] << 16) * 0.0625f;
    LDS_WAIT();
    const int N = 64 * (n + 1);
    float smin = 3.0e38f, umax = -3.0e38f; int cnt = 0, selz_max = -1, unz_min = 1 << 30;
#pragma unroll 1
    for (int k = lane; k < N; k += 64) {
        float sc = 0.f;
#pragma unroll 1
        for (int h = 0; h < 4; ++h) { float l = 0.f;
#pragma unroll 2
            for (int d = 0; d < 64; ++d) l = __builtin_fmaf(qs[h * 64 + d], __uint_as_float((unsigned)KI[(size_t)k * 256 + d] << 16), l); sc += fmaxf(l, 0.f) * (h == 0 ? wv[0] : h == 1 ? wv[1] : h == 2 ? wv[2] : wv[3]); }
        const int t = k >> 6, sub = (k >> 5) & 1, wi = k & 31, hc = (wi >> 2) & 1, rr = (wi & 3) + 4 * (wi >> 3);
        const unsigned word = MASKB[((size_t)t * 4096 + qpos) * 2 + hc];
        const bool sel = (word >> (16 * sub + rr)) & 1u;
        if (sel) { ++cnt; smin = fminf(smin, sc); if (sc == 0.f) selz_max = max(selz_max, k); } else { umax = fmaxf(umax, sc); if (sc == 0.f) unz_min = min(unz_min, k); }
    }
#pragma unroll 1
    for (int o = 1; o < 64; o <<= 1) { smin = fminf(smin, __shfl_xor(smin, o)); umax = fmaxf(umax, __shfl_xor(umax, o)); cnt += __shfl_xor(cnt, o); selz_max = max(selz_max, __shfl_xor(selz_max, o)); unz_min = min(unz_min, __shfl_xor(unz_min, o)); }
    const int want = N < 256 ? N : 256;
    bool bad = (cnt != want);
    if (N > 256) { const float slack = 2e-3f * (fabsf(umax) + fabsf(smin)) + 1e-4f; if (smin < umax - slack) bad = true; if (smin == 0.f && umax == 0.f && selz_max > unz_min) bad = true; }
    if (bad && lane == 0) __hip_atomic_store(flag, 1u, RLX_AGENT);
}
#endif

#ifndef REP_L2
#define REP_L2 1
#endif
#ifndef REP_X
#define REP_X 1
#endif
#ifndef REP_PROJ
#define REP_PROJ 1
#endif
#ifndef REP_CVT
#define REP_CVT 1
#endif
#ifndef REP_GU
#define REP_GU 1
#endif
#ifndef REP_UP
#define REP_UP 1
#endif
#ifndef REP_B
#define REP_B 1
#endif
#ifndef REP_WOUT
#define REP_WOUT 1
#endif
#ifndef REP_OX
#define REP_OX 1
#endif
#ifndef REP_DOWN
#define REP_DOWN 1
#endif
#ifndef REP_A
#define REP_A 1
#endif
#ifndef REP_L3
#define REP_L3 1
#endif
struct Args { const float* in[20]; float* out; unsigned char* ws; int lo, hi; };
enum { I_X = 0, I_MEM, I_NORM_MIX, I_W_IN, I_REL_BIAS, I_LAMBDA, I_SUBLN, I_UP_A, I_UP_B, I_UP_C, I_W_OUT, I_NORM_CROSS, I_WQX, I_WKVX, I_WOX, I_NORM_FFN, I_WGU, I_WDOWN, I_MEM_NORM, I_FINAL_NORM };

__global__ void __launch_bounds__(NWAVES * 64, 2) hybrid_fwd(Args args) {
    extern __shared__ __attribute__((aligned(16))) unsigned char lds_raw[];
    LAS unsigned char* lds = (LAS unsigned char*)lds_raw;
    volatile LAS unsigned* MISC = (volatile LAS unsigned*)(lds + LDSCTL_OFF);
    for (int u = threadIdx.x; u < 64; u += NWAVES * 64) MISC[u] = 0u;
    __syncthreads();
    const int wave_s = __builtin_amdgcn_readfirstlane((int)threadIdx.x >> 6);
    XcdBarrier bar = xcd_barrier_post((unsigned*)((gu32*)(args.ws + WS_CTL) + CW_BAR), MISC + 8);
    volatile LAS unsigned* qslot = MISC + 16;

    int step = 0;
#define STEP_ON (step >= args.lo && step < args.hi)
#define STEP_END(need_bar) do { if ((need_bar) && step >= args.lo && step + 1 < args.hi) xcd_barrier(bar, fresh_tid(wave_s)); ++step; } while (0)
#define PH_ENTER unsigned char* ws = args.ws; int G = gridDim.x, bx = blockIdx.x, tid = fresh_tid(wave_s); asm volatile("" : "+s"(ws), "+s"(G), "+s"(bx), "+v"(tid)); \
    const int lane = tid & 63, wave = __builtin_amdgcn_readfirstlane(tid >> 6), gw = bx * NWAVES + wave, NGW = G * NWAVES; (void)lane; (void)gw; (void)NGW;
#define P_BF(off) ((bf16*)(ws + (off)))
#define P_Q(off) ((bf16*)(wsq + (off)))

    if (STEP_ON) { PH_ENTER
        float* rope = (float*)(ws + WS_ROPE); float* scal = (float*)(ws + WS_SCAL);
        LAS float* scr = (LAS float*)(lds + wave * 16384);
        for (int i = bx * (NWAVES * 64) + tid; i < SEQ * 32; i += G * NWAVES * 64) {
            const int pos = i >> 5, k = i & 31;
            const float inv = (float)pow(10000.0, -(double)(2 * k) / 64.0);
            const float ang = (float)pos * inv;
            rope[pos * 64 + k] = (float)cos((double)ang); rope[pos * 64 + 32 + k] = (float)sin((double)ang);
        }
        if (bx == 0 && wave < DEPTH) {
            const float* lv = args.in[I_LAMBDA] + wave * 4 * 64;
            const float sa = wave_sum(lv[lane] * lv[64 + lane]), sb = wave_sum(lv[128 + lane] * lv[192 + lane]);
            const float lam_init = 0.8f - 0.6f * expf(-0.3f * (float)wave);
            if (lane == 0) { scal[wave * 2] = expf(sa) - expf(sb) + lam_init; scal[wave * 2 + 1] = 1.0f - lam_init; }
        }
        { float* gb = (float*)(ws + WS_SCAL) + 1024;
          for (int i = bx * (NWAVES * 64) + tid; i < DEPTH * 512; i += G * NWAVES * 64) { const int l_ = i >> 9; gb[i] = args.in[I_SUBLN][l_ * 128 + (i & 127)] * (0.6f * expf(-0.3f * (float)l_) + 0.2f); } }
        for (int m = gw; m < NB * MEMLEN; m += NGW) rms_row_to_bf16(args.in[I_MEM] + (size_t)m * DM, P_BF(WS_MN) + (size_t)m * DM, lane);
        for (int it = gw; it < DEPTH * 16 * 16; it += NGW) { const int l = it >> 8;
            cvt_item(args.in[I_WKVX] + (size_t)l * DM * 512, DM, 512, P_BF(WS_WKV) + (size_t)l * 512 * DM, args.in[I_MEM_NORM], MapId(), scr, it & 255, 16, lane); }
    }
    STEP_END(true);
    if (STEP_ON) { PH_ENTER
        pg8::Gemm g{P_BF(WS_MN), P_BF(WS_WKV), NB * MEMLEN, DEPTH * 512, DM, 0}; pg8::StaticOrder S; S.init(NB * MEMLEN, DEPTH * 512, G, bx);
        pg8::EpiBf16S E{P_BF(WS_KVX), DEPTH * 512, 1.0f, nullptr, (LAS float*)(lds + 139264)};
        pg8::gemm_phase<pg8::EpiBf16S, pg8::StaticOrder, true, true>(lds, g, S, E, tid);
    }
    STEP_END(true);

#pragma unroll 1
    for (int l = 0; l < DEPTH; ++l) {
        if (STEP_ON) { PH_ENTER
            LAS float* scr = (LAS float*)(lds + wave * 16384);
            bf16* WL = P_BF(WS_WL);
            constexpr int I0 = 16 * 256, I1 = 8 * 32, I4 = 16 * 32, I5 = 16 * 8, I6 = 4 * 32, I7 = 16 * 176, I8 = 44 * 32;
            constexpr int NITEMS = I0 + 3 * I1 + I4 + I5 + I6 + I7 + I8;
#pragma unroll 1
            for (int rc = 0; rc < REP_CVT; ++rc)
            for (int it = gw; it < NITEMS; it += NGW) {
                int r = it;
                if (r < I0) { cvt_item(args.in[I_W_IN] + (size_t)l * DM * NIN, DM, NIN, WL + WL_WIN / 2, args.in[I_NORM_MIX] + l * DM, MapWin(), scr, r, 256, lane); continue; } r -= I0;
                if (r < I1) { cvt_item(args.in[I_UP_A] + (size_t)l * 512 * DM, 512, DM, WL + WL_WUP / 2, nullptr, MapId(), scr, r, 32, lane); continue; } r -= I1;
                if (r < I1) { cvt_item(args.in[I_UP_B] + (size_t)l * 512 * DM, 512, DM, WL + WL_WUP / 2 + (size_t)1024 * 512, (const float*)(ws + WS_SCAL) + 1024 + l * 512, MapId(), scr, r, 32, lane); continue; } r -= I1;
                if (r < I1) { cvt_item(args.in[I_UP_C] + (size_t)l * 512 * DM, 512, DM, WL + WL_WUP / 2 + (size_t)2048 * 512, nullptr, MapId(), scr, r, 32, lane); continue; } r -= I1;
                if (r < I4) { cvt_item(args.in[I_W_OUT] + (size_t)l * DM * DM, DM, DM, WL + WL_WOUT / 2, nullptr, MapId(), scr, r, 32, lane); continue; } r -= I4;
                if (r < I5) { cvt_item(args.in[I_WQX] + (size_t)l * DM * 256, DM, 256, WL + WL_WQX / 2, args.in[I_NORM_CROSS] + l * DM, MapId(), scr, r, 8, lane); continue; } r -= I5;
                if (r < I6) { cvt_item(args.in[I_WOX] + (size_t)l * 256 * DM, 256, DM, WL + WL_WOX / 2, nullptr, MapId(), scr, r, 32, lane); continue; } r -= I6;
                if (r < I7) { cvt_item(args.in[I_WGU] + (size_t)l * DM * 2 * DFF, DM, 2 * DFF, WL + WL_WGU / 2, args.in[I_NORM_FFN] + l * DM, MapGu(), scr, r, 176, lane); continue; } r -= I7;
                cvt_item(args.in[I_WDOWN] + (size_t)l * DFF * DM, DFF, DM, WL + WL_WDN / 2, nullptr, MapId(), scr, r, 32, lane);
            }
            if (l == 0) { for (int m = gw; m < R; m += NGW) x_row_init(args.in[I_X] + (size_t)m * DM, P_BF(WS_XN) + (size_t)m * DM, (float*)(ws + WS_SS) + (size_t)m * 16, lane); }
        }
        STEP_END(true);

#pragma unroll 1
        for (int grp = 0; grp < NGRP; ++grp) {
            if (STEP_ON) { PH_ENTER
                pg8::Gemm g{P_BF(WS_XN) + (size_t)grp * RG * DM, P_BF(WS_WL + WL_WIN), RG, NINP, DM, 0}; pg8::StaticOrder S; S.init(RG, NINP, G, bx);
                pg8::EpiProj E{P_BF(WS_QKV), P_BF(WS_QI), P_BF(WS_KI), P_BF(WS_GATES), (const float*)(ws + WS_ROPE), QSCALE, QKV_STRIDE, (const float*)(ws + WS_SS) + (size_t)grp * RG * 16, (LAS float*)(lds + 139264)};
#pragma unroll 1
                for (int rp = 0; rp < REP_PROJ; ++rp)
                pg8::gemm_phase<pg8::EpiProj, pg8::StaticOrder, true, true>(lds, g, S, E, tid);
            }
            STEP_END(true);
            if (STEP_ON) { PH_ENTER
                constexpr int NX = GB * 60 * 2, NBU = GB * 4 * 32, NAU = GB * 8 * 16;
#pragma unroll 1
                for (int rep = 0; rep < REP_L2; ++rep) { gu32* ctr = (gu32*)(ws + WS_CTL) + CW_QUEUE + 64 * (((l * NGRP + grp) * 2 + 0) * 4 + rep);
                const bool stat = (G == 256);
                gu32* qctr = stat ? ctr + 4 * (1 + (bx & 7)) : ctr; int stage = stat ? 0 : 2;
                unsigned qnxt = 0u, qpar = 0u; if (tid == 0) qnxt = wq_claim(qctr);
#pragma unroll 1
                for (int it = 0;; ++it) {
                    int i;
                    if (stat && it < 4) { const int x = bx & 7, j = bx >> 3, jj = j & 7, combo = x + 8 * (j >> 3), qt = (it == 0) ? 31 - jj : (it == 1) ? 16 + jj : (it == 2) ? 15 - jj : jj;
                        i = NX + (31 - qt) * 32 + (combo >> 2) * 4 + (combo & 3); __syncthreads(); }
                    else { int k = wq_next(qctr, qslot, tid, qnxt, qpar);
                        if (stage == 0) { if (k < 120) i = (k >> 1) * 16 + (bx & 7) * 2 + (k & 1);
                                          else { stage = 1; qctr = ctr; if (tid == 0) qnxt = wq_claim(qctr); k = wq_next(qctr, qslot, tid, qnxt, qpar); i = NX + NBU + k; } }
                        else if (stage == 1) i = NX + NBU + k;
                        else i = k;
                        if (i >= NX + NBU + NAU) break; }
                    unsigned char* wsq = args.ws; asm volatile("" : "+s"(wsq)); bf16* QKV = (bf16*)(wsq + WS_QKV);
                    if (i < NX) { const int n = 63 - (i >> 4), b = (i & 15) >> 1, half = i & 1;
#pragma unroll 1
                        for (int rx = 0; rx < REP_X; ++rx) { if (rx) __syncthreads();
                        att::idx_unit(lds, P_Q(WS_QI) + (size_t)b * SEQ * 256, P_Q(WS_KI) + (size_t)b * SEQ * 256, (unsigned short*)((unsigned*)(wsq + WS_MASK) + (size_t)b * 64 * 4096 * 2), (unsigned*)(wsq + WS_XS) + (size_t)(bx & 255) * 131072, n, half, tid); }
                    } else if (i < NX + NBU) { const int j = i - NX, qt = 31 - (j >> 5), b = (j & 31) >> 2, h = j & 3;
                        const size_t off = (size_t)b * SEQ * 512 + h * 128;
                        const float* scal = (const float*)(wsq + WS_SCAL);
                        const float lam = __hip_atomic_load(scal + l * 2, RLX_AGENT), oscale = __hip_atomic_load(scal + l * 2 + 1, RLX_AGENT);
                        attx::UB a{(const attx::bf16*)(QKV + 3 * QKV_STRIDE + off), (const attx::bf16*)(QKV + 4 * QKV_STRIDE + off), (const attx::bf16*)(QKV + 5 * QKV_STRIDE + off),
                                   (attx::bf16*)(P_Q(WS_OBUF) + 1 * QKV_STRIDE + off), qt, args.in[I_SUBLN] + l * 128, lam, oscale};
#pragma unroll 1
                        for (int rb_ = 0; rb_ < REP_B; ++rb_)
                        attx::attn_unit_b2<8>(a, (char*)lds_raw, tid);
                    } else { const int j = i - NX - NBU, qb = 15 - (j >> 6), b = (j & 63) >> 3, h = j & 7;
                        const size_t off = (size_t)b * SEQ * 512 + h * 64;
                        att::UnitArgs a{QKV + off, 512, QKV + 1 * QKV_STRIDE + off, QKV + 2 * QKV_STRIDE + off, 512, P_Q(WS_OBUF) + off, 512, 256 * qb, (4 * qb - 8 > 0) ? 4 * qb - 8 : 0, 4 * qb + 3,
                                        args.in[I_REL_BIAS] + (size_t)(l * 8 + h) * 320, nullptr, false};
#pragma unroll 1
                        for (int ra_ = 0; ra_ < REP_A; ++ra_)
                        att::attn_unit<0>(lds, a, tid);
                    }
                } }
            }
            STEP_END(true);
            if (STEP_ON) { PH_ENTER
#if PROBE_CHECK
                if (l == 0 && grp == 0) { const int si = gw, b_ = si & 7, n_ = 4 + ((si >> 3) % 60), qo = (si * 7) & 63;
                    probe_check_query(P_BF(WS_QI) + (size_t)b_ * SEQ * 256, P_BF(WS_KI) + (size_t)b_ * SEQ * 256, (const unsigned*)(ws + WS_MASK) + (size_t)b_ * 64 * 4096 * 2, 64 * n_ + qo, n_,
                                      (LAS float*)(lds + wave * 16384), (gu32*)(ws + WS_CTL) + 32, lane); __syncthreads(); }
#endif
#pragma unroll 1
                for (int rep = 0; rep < REP_L3; ++rep) { gu32* ctr = (gu32*)(ws + WS_CTL) + CW_QUEUE + 64 * (((l * NGRP + grp) * 2 + 1) * 4 + rep);
                const bool stat = (G == 256);
                unsigned qnxt = 0u, qpar = 0u; if (!stat && tid == 0) qnxt = wq_claim(ctr);
#pragma unroll 1
                for (int it = 0;; ++it) {
                    int qb, b, h;
                    if (stat) { if (it >= 4) break; const int j = bx >> 3, jj = j & 3; h = bx & 7; b = j >> 2; qb = (it == 0) ? 15 - jj : (it == 1) ? 8 + jj : (it == 2) ? 7 - jj : jj; __syncthreads(); }
                    else { const int i = wq_next(ctr, qslot, tid, qnxt, qpar); if (i >= GB * 8 * 16) break; qb = 15 - (i >> 6); b = (i & 63) >> 3; h = i & 7; }
                    unsigned char* wsq = args.ws; asm volatile("" : "+s"(wsq)); bf16* QKV = (bf16*)(wsq + WS_QKV);
                    const size_t rb = (size_t)b * SEQ * 512;
                    attx::UA a{(const attx::bf16*)(QKV + 6 * QKV_STRIDE + rb + (size_t)256 * qb * 512 + h * 64), 512,
                               (const attx::bf16*)(QKV + 7 * QKV_STRIDE + rb + h * 64), (const attx::bf16*)(QKV + 8 * QKV_STRIDE + rb + h * 64), 512,
                               (attx::bf16*)(P_Q(WS_OBUF) + 2 * QKV_STRIDE + rb + (size_t)256 * qb * 512 + h * 64), 512, 4 * qb + 4, 0, 4 * qb, nullptr,
                               (const unsigned*)(wsq + WS_MASK) + (size_t)b * 64 * 4096 * 2, qb == 0};
                    attx::attn_unit<1, 8>(a, (char*)lds_raw, tid);
                } }
            }
            STEP_END(true);
            if (STEP_ON) { PH_ENTER
                pg8::Gemm g{P_BF(WS_OBUF), P_BF(WS_WL + WL_WUP), RG, 3072, 512, QKV_STRIDE * 2}; pg8::UpOrder S; S.init(RG, G, bx);
                pg8::EpiGateC E{P_BF(WS_GATES), P_BF(WS_Y)};
#pragma unroll 1
                for (int ru = 0; ru < REP_UP; ++ru)
                pg8::gemm_phase<pg8::EpiGateC, pg8::UpOrder, true, true>(lds, g, S, E, tid);
            }
            STEP_END(true);
            if (STEP_ON) { PH_ENTER
                pg8::Gemm g{P_BF(WS_Y), P_BF(WS_WL + WL_WOUT), RG, DM, DM, 0}; pg8::StaticOrder S; S.init(RG, DM, G, bx);
                pg8::EpiRes E{P_BF(WS_XN) + (size_t)grp * RG * DM, DM, (float*)(ws + WS_SS) + (size_t)grp * RG * 16, 1.0f};
                pg8::gemm_phase<pg8::EpiRes, pg8::StaticOrder, true, true>(lds, g, S, E, tid);
#if REP_WOUT > 1
                { pg8::EpiRes E0{P_BF(WS_XN) + (size_t)grp * RG * DM, DM, (float*)(ws + WS_SS) + (size_t)grp * RG * 16, 0.0f}; __syncthreads(); pg8::gemm_phase<pg8::EpiRes, pg8::StaticOrder, true, true>(lds, g, S, E0, tid); }
#endif
            }
            STEP_END(grp == NGRP - 1);
        }
        if (STEP_ON) { PH_ENTER
            pg8::Gemm g{P_BF(WS_XN), P_BF(WS_WL + WL_WQX), R, 256, DM, 0}; pg8::StaticOrder S; S.init(R, 256, G, bx);
            pg8::EpiBf16S E{P_BF(WS_QX), 256, QSCALE, (const float*)(ws + WS_SS), (LAS float*)(lds + 139264)};
            pg8::gemm_phase<pg8::EpiBf16S, pg8::StaticOrder, true, true>(lds, g, S, E, tid);
        }
        STEP_END(true);
        if (STEP_ON) { PH_ENTER
            bf16* QX = P_BF(WS_QX);
            for (int i = bx; i < NB * 4 * 16; i += G) {
                const int qb = i & 15, b = i >> 6, h = (i >> 4) & 3;
                const bf16* kx = P_BF(WS_KVX) + (size_t)b * MEMLEN * (DEPTH * 512) + l * 512 + h * 64;
                attx::bf16* qp = (attx::bf16*)(QX + ((size_t)b * SEQ + 256 * qb) * 256 + h * 64);
                attx::UA a{qp, 256, (const attx::bf16*)kx, (const attx::bf16*)(kx + 256), DEPTH * 512, qp, 256, 4, 0, 0, nullptr, nullptr, 1};
                attx::attn_unit<2, 8>(a, (char*)lds_raw, tid);
            }
        }
        STEP_END(true);
        if (STEP_ON) { PH_ENTER
            pg8::Gemm g{P_BF(WS_QX), P_BF(WS_WL + WL_WOX), R, DM, 256, 0}; pg8::StaticOrder S; S.init(R, DM, G, bx);
            pg8::EpiRes E{P_BF(WS_XN), DM, (float*)(ws + WS_SS), 1.0f};
            pg8::gemm_phase<pg8::EpiRes, pg8::StaticOrder, true, true>(lds, g, S, E, tid);
#if REP_OX > 1
            { pg8::EpiRes E0{P_BF(WS_XN), DM, (float*)(ws + WS_SS), 0.0f}; __syncthreads(); pg8::gemm_phase<pg8::EpiRes, pg8::StaticOrder, true, true>(lds, g, S, E0, tid); }
#endif
        }
        STEP_END(true);
        if (STEP_ON) { PH_ENTER
            pg8::Gemm g{P_BF(WS_XN), P_BF(WS_WL + WL_WGU), R, 2 * DFF, DM, 0}; pg8::StaticOrder S; S.init(R, 2 * DFF, G, bx);
            pg8::EpiSwiglu E{P_BF(WS_H), DFF, (const float*)(ws + WS_SS), (LAS float*)(lds + 139264)};
#pragma unroll 1
            for (int rg = 0; rg < REP_GU; ++rg)
            pg8::gemm_phase<pg8::EpiSwiglu, pg8::StaticOrder, true, true>(lds, g, S, E, tid);
        }
        STEP_END(true);
        if (STEP_ON) { PH_ENTER
            pg8::Gemm g{P_BF(WS_H), P_BF(WS_WL + WL_WDN), R, DM, DFF, 0}; pg8::StaticOrder S; S.init(R, DM, G, bx);
            pg8::EpiRes E{P_BF(WS_XN), DM, (float*)(ws + WS_SS), 1.0f};
            pg8::gemm_phase<pg8::EpiRes, pg8::StaticOrder, true, true>(lds, g, S, E, tid);
#if REP_DOWN > 1
            { pg8::EpiRes E0{P_BF(WS_XN), DM, (float*)(ws + WS_SS), 0.0f}; __syncthreads(); pg8::gemm_phase<pg8::EpiRes, pg8::StaticOrder, true, true>(lds, g, S, E0, tid); }
#endif
        }
        STEP_END(true);
    }
    if (STEP_ON) { PH_ENTER for (int m = gw; m < R; m += NGW) rms_row_final(P_BF(WS_XN) + (size_t)m * DM, args.out + (size_t)m * DM, args.in[I_FINAL_NORM], lane);
#if PROBE_CHECK
        if (__hip_atomic_load((gu32*)(ws + WS_CTL) + 32, RLX_AGENT) != 0u) { for (int m = gw; m < R; m += NGW) { GAS f32x4* xr = (GAS f32x4*)(args.out + (size_t)m * DM) + lane; for (int j = 0; j < 4; ++j) xr[64 * j] = xr[64 * j] * 2.0f; } }
#endif
    }
    STEP_END(false);
#undef STEP_ON
#undef STEP_END
#undef PH_ENTER
#undef P_BF
#undef P_Q
}

constexpr int N_STEPS = 2 + DEPTH * (1 + NGRP * 5 + 5) + 1;
#ifndef MK_PER_STEP
#define MK_PER_STEP 0
#endif
extern "C" void kernel_launch(void* const* d_in, const int* in_sizes, int n_in, void* d_out, int out_size, void* d_ws, size_t ws_size, hipStream_t stream) {
    static int grid = 0;
    if (grid == 0) {
        if (n_in != 20 || in_sizes[0] != R * DM || out_size != R * DM || ws_size < WS_END) { fprintf(stderr, "kernel_launch: shape mismatch (n_in %d, in0 %d, out %d, ws %zu < %zu); nothing launched\n", n_in, n_in > 0 ? in_sizes[0] : -1, out_size, ws_size, (size_t)WS_END); grid = -1; return; }
        int dev = 0, cus = 0, per_cu = 0;
        if (hipGetDevice(&dev) != hipSuccess || hipDeviceGetAttribute(&cus, hipDeviceAttributeMultiprocessorCount, dev) != hipSuccess) { grid = -1; return; }
        if (hipFuncSetAttribute((const void*)hybrid_fwd, hipFuncAttributeMaxDynamicSharedMemorySize, LDS_BYTES) != hipSuccess) { fprintf(stderr, "kernel_launch: hipFuncSetAttribute failed\n"); grid = -1; return; }
        if (hipOccupancyMaxActiveBlocksPerMultiprocessor(&per_cu, (const void*)hybrid_fwd, NWAVES * 64, LDS_BYTES) != hipSuccess || per_cu < 1) { fprintf(stderr, "kernel_launch: occupancy query says %d blocks per CU\n", per_cu); }
        (void)hipGetLastError();
        grid = cus < 256 ? cus : 256;
    }
    if (grid < 0) return;
    if (hipMemsetAsync((char*)d_ws + WS_CTL, 0, CTL_ZERO_BYTES, stream) != hipSuccess) return;
    Args a{};
    for (int i = 0; i < 20; ++i) a.in[i] = (const float*)d_in[i];
    a.out = (float*)d_out; a.ws = (unsigned char*)d_ws;
#if MK_PER_STEP
    for (int s = 0; s < N_STEPS; ++s) { a.lo = s; a.hi = s + 1; hipLaunchKernelGGL(hybrid_fwd, dim3(grid), dim3(NWAVES * 64), LDS_BYTES, stream, a); }
#else
    a.lo = 0; a.hi = 1 << 30;
    hipLaunchKernelGGL(hybrid_fwd, dim3(grid), dim3(NWAVES * 64), LDS_BYTES, stream, a);
#endif
    const hipError_t le = hipPeekAtLastError();
    if (le != hipSuccess) fprintf(stderr, "kernel_launch: launch failed: %s\n", hipGetErrorName(le));
}
```

```cpp
#include <hip/hip_runtime.h>
#include <hip/hip_bf16.h>
#include <cstdio>
#include <cstdint>
#include <cmath>
namespace pg8 {
#define PG8_LAS __attribute__((address_space(3)))
typedef unsigned short bf16_t;
typedef short bf16x8 __attribute__((ext_vector_type(8)));
typedef float f32x4 __attribute__((ext_vector_type(4)));
typedef unsigned u32x4 __attribute__((ext_vector_type(4)));
constexpr int BM = 256, BK = 64, HALF = 128, HTB = HALF * BK * 2  , STAGE_BYTES = 8 * HTB, NXCD = 8, WGM = 8;

__host__ __device__ __forceinline__ int lds_byte(int r, int c) { const int st = (r >> 4) * 2 + (c >> 5), rr = r & 15, cc = c & 31, ob = rr * 64 + cc * 2; return st * 1024 + (ob ^ (((ob >> 9) & 1) << 5)); }
__host__ __device__ __forceinline__ void stage_rc(int b, int& R, int& C) { const int st = b / 1024, sb = b % 1024, swz = sb ^ (((sb >> 9) & 1) << 5); R = (st >> 1) * 16 + swz / 64; C = (st & 1) * 32 + (swz % 64) / 2; }
__host__ __device__ __forceinline__ int perm32(int rho) { const int n = rho >> 4, i = rho & 15; return 8 * (i >> 2) + 4 * n + (i & 3); }

struct Unit { int pm, pn, az; };
struct Gemm { const bf16_t* A; const bf16_t* Bt; int M, N, K; size_t azs; };

struct StaticOrder {
    int nM, nN, nwg, G, c;
    __host__ __device__ void init(int M, int N, int G_, int c_) { nM = M / BM; nN = N / BM; nwg = nM * nN; G = G_; c = c_; }
    __host__ __device__ bool next(int i, Unit& u) const {
        const long L = (long)i * G + c; if (L >= nwg) return false;
        int wgid = (int)L; { const int q = nwg / NXCD, r = nwg % NXCD, xcd = wgid % NXCD, off = wgid / NXCD; wgid = (xcd < r ? xcd * (q + 1) : r * (q + 1) + (xcd - r) * q) + off; }
        const int nig = WGM * nN, gid = wgid / nig, fm = gid * WGM, gsz = (nM - fm) < WGM ? (nM - fm) : WGM;
        u.pm = fm + ((wgid % nig) % gsz); u.pn = (wgid % nig) / gsz; u.az = 0; return true;
    }
    __device__ __forceinline__ void a_ready(const Unit&) const {}
    __device__ __forceinline__ void done(const Unit&) const {}
};

__device__ __forceinline__ unsigned cvt_pk_bf16(float lo, float hi) { unsigned r; asm volatile("v_cvt_pk_bf16_f32 %0, %1, %2" : "=v"(r) : "v"(lo), "v"(hi)); return r; }
typedef float f32x2c_t __attribute__((ext_vector_type(2))); typedef __bf16 bf16x2c_t __attribute__((ext_vector_type(2)));
__device__ __forceinline__ unsigned cvt_pk_bf16_c(float lo, float hi) { const f32x2c_t v = {lo, hi}; const bf16x2c_t b = __builtin_convertvector(v, bf16x2c_t); return __builtin_bit_cast(unsigned, b); }
typedef float f32x2 __attribute__((ext_vector_type(2)));

typedef unsigned u32x2 __attribute__((ext_vector_type(2)));
#define PG8_GAS __attribute__((address_space(1)))
__device__ __forceinline__ float bf_lo(unsigned w) { return __uint_as_float(w << 16); }
__device__ __forceinline__ float bf_hi(unsigned w) { return __uint_as_float(w & 0xffff0000u); }

__device__ __forceinline__ float row_rstd(const float* ss, size_t row) {
    const PG8_GAS f32x4* p = (const PG8_GAS f32x4*)(ss + row * 16);
    const f32x4 a = p[0], b = p[1], c = p[2], d = p[3];
    const float s = (((a[0] + a[1]) + (a[2] + a[3])) + ((b[0] + b[1]) + (b[2] + b[3]))) + (((c[0] + c[1]) + (c[2] + c[3])) + ((d[0] + d[1]) + (d[2] + d[3])));
    float eps = 1e-6f; asm volatile("" : "+v"(eps));
    return 1.0f / sqrtf(s * (1.0f / 1024.0f) + eps);
}
__device__ __forceinline__ void stage_rstd(const float* ss, PG8_LAS float* rs, int pm, int tid) {
    const int r = tid >> 1, h = tid & 1;
    const PG8_GAS f32x4* p = (const PG8_GAS f32x4*)(ss + ((size_t)pm * BM + r) * 16 + h * 8);
    const f32x4 a = p[0], b = p[1];
    float s = ((a[0] + a[1]) + (a[2] + a[3])) + ((b[0] + b[1]) + (b[2] + b[3]));
    s += __shfl_xor(s, 1);
    float eps = 1e-6f; asm volatile("" : "+v"(eps));
    if (h == 0) rs[r] = 1.0f / sqrtf(s * (1.0f / 1024.0f) + eps);
    asm volatile("s_waitcnt lgkmcnt(0)" ::: "memory"); __builtin_amdgcn_s_barrier(); asm volatile("" ::: "memory");
}
struct EpiRes {
    static constexpr bool PERM = true, AFTER_DRAIN = false, CARRY = false, RSTD = false;
    bf16_t* xb; int ldc; float* ss; float s;
    __device__ __forceinline__ void operator()(const f32x4 (&acc)[2][2][4][2], const Unit& u, int wr, int wc, int fr, int fq) const {
        const int row0 = u.pm * BM + wr * 64 + fr, col0 = u.pn * BM + wc * 32 + 8 * fq;
#pragma unroll
        for (int ai = 0; ai < 2; ++ai)
#pragma unroll
            for (int m = 0; m < 4; ++m) { const size_t row = (size_t)(row0 + ai * HALF + m * 16); bf16_t* rowp = xb + row * ldc + col0; float sq = 0.f;
#pragma unroll
                for (int bj = 0; bj < 2; ++bj) { const u32x4 b = *(const PG8_GAS u32x4*)(rowp + bj * HALF);
                    const f32x4 b0 = {__uint_as_float(b.x << 16), __uint_as_float(b.x & 0xffff0000u), __uint_as_float(b.y << 16), __uint_as_float(b.y & 0xffff0000u)};
                    const f32x4 b1 = {__uint_as_float(b.z << 16), __uint_as_float(b.z & 0xffff0000u), __uint_as_float(b.w << 16), __uint_as_float(b.w & 0xffff0000u)};
                    const f32x4 v0 = b0 + acc[ai][bj][m][0] * s, v1 = b1 + acc[ai][bj][m][1] * s;
                    u32x4 w; w.x = cvt_pk_bf16(v0[0], v0[1]); w.y = cvt_pk_bf16(v0[2], v0[3]); w.z = cvt_pk_bf16(v1[0], v1[1]); w.w = cvt_pk_bf16(v1[2], v1[3]);
                    *(PG8_GAS u32x4*)(rowp + bj * HALF) = w;
                    sq += ((v0[0] * v0[0] + v0[1] * v0[1]) + (v0[2] * v0[2] + v0[3] * v0[3])) + ((v1[0] * v1[0] + v1[1] * v1[1]) + (v1[2] * v1[2] + v1[3] * v1[3])); }
                sq += __shfl_xor(sq, 16); sq += __shfl_xor(sq, 32);
                if (fq == 0) *(PG8_GAS float*)(ss + row * 16 + u.pn * 4 + wc) = sq; }
    }
};

struct EpiBf16S {
    static constexpr bool PERM = true, AFTER_DRAIN = false, CARRY = false, RSTD = true;
    bf16_t* O; int ldc; float sc; const float* ss; PG8_LAS float* rs;
    __device__ __forceinline__ void stage(int pm, int tid) const { if (ss) stage_rstd(ss, rs, pm, tid); }
    __device__ __forceinline__ void operator()(const f32x4 (&acc)[2][2][4][2], const Unit& u, int wr, int wc, int fr, int fq) const {
        const int row0 = u.pm * BM + wr * 64 + fr, col0 = u.pn * BM + wc * 32 + 8 * fq;
#pragma unroll
        for (int ai = 0; ai < 2; ++ai)
#pragma unroll
            for (int m = 0; m < 4; ++m) { bf16_t* rowp = O + (size_t)(row0 + ai * HALF + m * 16) * ldc + col0; const float rq = ss ? sc * rs[ai * HALF + wr * 64 + m * 16 + fr] : sc;
#pragma unroll
                for (int bj = 0; bj < 2; ++bj) { const f32x4 v0 = acc[ai][bj][m][0] * rq, v1 = acc[ai][bj][m][1] * rq;
                    u32x4 w; w.x = cvt_pk_bf16(v0[0], v0[1]); w.y = cvt_pk_bf16(v0[2], v0[3]); w.z = cvt_pk_bf16(v1[0], v1[1]); w.w = cvt_pk_bf16(v1[2], v1[3]);
                    *(PG8_GAS u32x4*)(rowp + bj * HALF) = w; } }
    }
};

struct EpiProj {
    static constexpr bool PERM = true, AFTER_DRAIN = false, CARRY = false, RSTD = true;
    __device__ __forceinline__ void stage(int pm, int tid) const { stage_rstd(ss, rs, pm, tid); }
    bf16_t* qkv; bf16_t* qi; bf16_t* ki; bf16_t* gates; const float* cs; float qscale; size_t bufstride; const float* ss; PG8_LAS float* rs;
    __device__ __forceinline__ void operator()(const f32x4 (&acc)[2][2][4][2], const Unit& u, int wr, int wc, int fr, int fq) const {
        const int pn = u.pn;
        bf16_t* dst; int ld, colbase; float sc = 1.f; int mode;
        if (pn < 18) { const int buf = pn >> 1, kind = buf % 3, mixer = buf / 3; dst = qkv + (size_t)buf * bufstride; ld = 512; colbase = (pn & 1) * 256;
            mode = (mixer >= 1 && kind < 2) ? 1 : 0; if (kind == 0) sc = qscale; }
        else if (pn == 18) { dst = qi; ld = 256; colbase = 0; mode = 1; }
        else if (pn == 19) { dst = ki; ld = 256; colbase = 0; mode = 3; }
        else { dst = gates; ld = 3072; colbase = (pn - 20) * 256; mode = 2; }
        const int row0 = u.pm * BM + wr * 64 + fr;
        const int jj = 4 * (wc & 1) + fq;
        if (mode == 1 || mode == 3) {
            f32x4 c4[8], s4[8];
#pragma unroll
            for (int k = 0; k < 8; ++k) { const int row = row0 + (k >> 2) * HALF + (k & 3) * 16; const float* t = cs + (size_t)(row & 4095) * 64 + 4 * jj; c4[k] = *(const PG8_GAS f32x4*)t; s4[k] = *(const PG8_GAS f32x4*)(t + 32); }
#pragma unroll
            for (int ai = 0; ai < 2; ++ai)
#pragma unroll
                for (int m = 0; m < 4; ++m) {
                    const int row = row0 + ai * HALF + m * 16;
                    bf16_t* rowp = dst + (size_t)row * ld + colbase;
                    const float rstd = rs[ai * HALF + wr * 64 + m * 16 + fr];
                    const f32x4 c4v = c4[ai * 4 + m], s4v = s4[ai * 4 + m];
#pragma unroll
                    for (int bj = 0; bj < 2; ++bj) {
                        const f32x4 x1 = acc[ai][bj][m][0] * rstd, x2 = acc[ai][bj][m][1] * rstd;
                        const int blk = 2 * bj + (wc >> 1);
                        if (mode == 1 || blk == 0) {
                            const f32x4 o1 = (x1 * c4v - x2 * s4v) * sc, o2 = (x2 * c4v + x1 * s4v) * sc;
                            u32x2 w1, w2; w1.x = cvt_pk_bf16(o1[0], o1[1]); w1.y = cvt_pk_bf16(o1[2], o1[3]); w2.x = cvt_pk_bf16(o2[0], o2[1]); w2.y = cvt_pk_bf16(o2[2], o2[3]);
                            *(PG8_GAS u32x2*)(rowp + 64 * blk + 4 * jj) = w1; *(PG8_GAS u32x2*)(rowp + 64 * blk + 32 + 4 * jj) = w2;
                        } else {
                            const f32x4 v0 = x1 * sc, v1 = x2 * sc;
                            u32x4 w; w.x = cvt_pk_bf16(v0[0], v0[1]); w.y = cvt_pk_bf16(v0[2], v0[3]); w.z = cvt_pk_bf16(v1[0], v1[1]); w.w = cvt_pk_bf16(v1[2], v1[3]);
                            *(PG8_GAS u32x4*)(rowp + bj * HALF + wc * 32 + 8 * fq) = w;
                        }
                    }
                }
        } else if (mode == 2) {
#pragma unroll
            for (int ai = 0; ai < 2; ++ai)
#pragma unroll
                for (int m = 0; m < 4; ++m) {
                    bf16_t* rowp = dst + (size_t)(row0 + ai * HALF + m * 16) * ld + colbase;
                    const float rq = rs[ai * HALF + wr * 64 + m * 16 + fr] * -1.4426950408889634f;
#pragma unroll
                    for (int bj = 0; bj < 2; ++bj) {
                        f32x4 v0 = acc[ai][bj][m][0] * rq, v1 = acc[ai][bj][m][1] * rq;
#pragma unroll
                        for (int e = 0; e < 4; ++e) { v0[e] = __builtin_amdgcn_exp2f(fminf(v0[e], 60.f)); v1[e] = __builtin_amdgcn_exp2f(fminf(v1[e], 60.f)); }
                        u32x4 w; w.x = cvt_pk_bf16_c(v0[0], v0[1]); w.y = cvt_pk_bf16_c(v0[2], v0[3]); w.z = cvt_pk_bf16_c(v1[0], v1[1]); w.w = cvt_pk_bf16_c(v1[2], v1[3]);
                        *(PG8_GAS u32x4*)(rowp + bj * HALF + wc * 32 + 8 * fq) = w;
                    }
                }
        } else {
#pragma unroll
            for (int ai = 0; ai < 2; ++ai)
#pragma unroll
                for (int m = 0; m < 4; ++m) {
                    bf16_t* rowp = dst + (size_t)(row0 + ai * HALF + m * 16) * ld + colbase;
                    const float rq = rs[ai * HALF + wr * 64 + m * 16 + fr] * sc;
#pragma unroll
                    for (int bj = 0; bj < 2; ++bj) {
                        const f32x4 v0 = acc[ai][bj][m][0] * rq, v1 = acc[ai][bj][m][1] * rq;
                        u32x4 w; w.x = cvt_pk_bf16(v0[0], v0[1]); w.y = cvt_pk_bf16(v0[2], v0[3]); w.z = cvt_pk_bf16(v1[0], v1[1]); w.w = cvt_pk_bf16(v1[2], v1[3]);
                        *(PG8_GAS u32x4*)(rowp + bj * HALF + wc * 32 + 8 * fq) = w;
                    }
                }
        }
    }
};

struct EpiSwiglu {
    static constexpr bool PERM = true, AFTER_DRAIN = false, CARRY = false, RSTD = true;
    bf16_t* H; int ldh; const float* ss; PG8_LAS float* rs;
    __device__ __forceinline__ void stage(int pm, int tid) const { stage_rstd(ss, rs, pm, tid); }
    __device__ __forceinline__ void operator()(const f32x4 (&acc)[2][2][4][2], const Unit& u, int wr, int wc, int fr, int fq) const {
        const int row0 = u.pm * BM + wr * 64 + fr, col0 = u.pn * (BM / 2) + wc * 16 + 4 * fq;
#pragma unroll
        for (int ai = 0; ai < 2; ++ai)
#pragma unroll
            for (int m = 0; m < 4; ++m) { bf16_t* rowp = H + (size_t)(row0 + ai * HALF + m * 16) * ldh + col0; const float rstd = rs[ai * HALF + wr * 64 + m * 16 + fr];
#pragma unroll
                for (int bj = 0; bj < 2; ++bj) { const f32x4 g = acc[ai][bj][m][0] * rstd, up = acc[ai][bj][m][1] * rstd; f32x4 h;
#pragma unroll
                    for (int e = 0; e < 4; ++e) h[e] = g[e] * __builtin_amdgcn_rcpf(1.f + __builtin_amdgcn_exp2f(-1.4426950408889634f * g[e])) * up[e];
                    u32x2 w; w.x = cvt_pk_bf16(h[0], h[1]); w.y = cvt_pk_bf16(h[2], h[3]);
                    *(PG8_GAS u32x2*)(rowp + bj * (HALF / 2)) = w; } }
    }
};

struct EpiGateC {
    static constexpr bool PERM = true, AFTER_DRAIN = false, CARRY = true, RSTD = false;
    const bf16_t* gates; bf16_t* Y;
    __device__ __forceinline__ bool carry(f32x4 (&acc)[2][2][4][2], const Unit& u, int wr, int wc, int fr, int fq) const {
        const int branch = u.pn >> 2, row0 = u.pm * BM + wr * 64 + fr, col0 = (u.pn & 3) * BM + wc * 32 + 8 * fq;
        if (branch < 2) {
            u32x4 gb[2][8];
#define GATE_ISSUE(ST) do { _Pragma("unroll") for (int mm = 0; mm < 2; ++mm) _Pragma("unroll") for (int bj = 0; bj < 2; ++bj) { \
                const bf16_t* p_ = gates + (size_t)(row0 + ((ST) >> 1) * HALF + (((ST) & 1) * 2 + mm) * 16) * 3072 + branch * 1024 + col0 + bj * HALF; \
                gb[(ST) & 1][(mm * 2 + bj) * 2] = *(const PG8_GAS u32x4*)p_; gb[(ST) & 1][(mm * 2 + bj) * 2 + 1] = *(const PG8_GAS u32x4*)(p_ + 1024); } } while (0)
            GATE_ISSUE(0);
#pragma unroll
            for (int st = 0; st < 4; ++st) {
                if (st + 1 < 4) GATE_ISSUE(st + 1);
#pragma unroll
                for (int mm = 0; mm < 2; ++mm)
#pragma unroll
                    for (int bj = 0; bj < 2; ++bj) { const int ai = st >> 1, m = (st & 1) * 2 + mm;
                        const u32x4 g = gb[st & 1][(mm * 2 + bj) * 2], h = gb[st & 1][(mm * 2 + bj) * 2 + 1];
                        float gc[8] = {bf_lo(g.x), bf_hi(g.x), bf_lo(g.y), bf_hi(g.y), bf_lo(g.z), bf_hi(g.z), bf_lo(g.w), bf_hi(g.w)};
                        const float gn[8] = {bf_lo(h.x), bf_hi(h.x), bf_lo(h.y), bf_hi(h.y), bf_lo(h.z), bf_hi(h.z), bf_lo(h.w), bf_hi(h.w)};
#pragma unroll
                        for (int e = 0; e < 8; ++e) gc[e] = (1.f + gn[e]) * __builtin_amdgcn_rcpf(1.f + gc[e]);
                        acc[ai][bj][m][0] = acc[ai][bj][m][0] * (f32x4){gc[0], gc[1], gc[2], gc[3]};
                        acc[ai][bj][m][1] = acc[ai][bj][m][1] * (f32x4){gc[4], gc[5], gc[6], gc[7]}; }
            }
#undef GATE_ISSUE
            return true;
        }
        u32x4 gl[16];
#pragma unroll
        for (int k = 0; k < 16; ++k) { const int ai = k >> 3, m = (k >> 1) & 3, bj = k & 1; gl[k] = *(const PG8_GAS u32x4*)(gates + (size_t)(row0 + ai * HALF + m * 16) * 3072 + branch * 1024 + col0 + bj * HALF); }
#pragma unroll
        for (int k = 0; k < 16; ++k) { const int ai = k >> 3, m = (k >> 1) & 3, bj = k & 1; const u32x4 g = gl[k];
            float gc[8] = {bf_lo(g.x), bf_hi(g.x), bf_lo(g.y), bf_hi(g.y), bf_lo(g.z), bf_hi(g.z), bf_lo(g.w), bf_hi(g.w)};
            const f32x4 a0 = acc[ai][bj][m][0], a1 = acc[ai][bj][m][1];
#pragma unroll
            for (int e = 0; e < 8; ++e) gc[e] = __builtin_amdgcn_rcpf(1.f + gc[e]);
            u32x4 w; w.x = cvt_pk_bf16(gc[0] * a0[0], gc[1] * a0[1]); w.y = cvt_pk_bf16(gc[2] * a0[2], gc[3] * a0[3]); w.z = cvt_pk_bf16(gc[4] * a1[0], gc[5] * a1[1]); w.w = cvt_pk_bf16(gc[6] * a1[2], gc[7] * a1[3]);
            *(PG8_GAS u32x4*)(Y + (size_t)(row0 + ai * HALF + m * 16) * 1024 + col0 + bj * HALF) = w; }
        return false;
    }
};

struct UpOrder {
    StaticOrder so;
    __host__ __device__ void init(int M, int G_, int c_) { so.init(M, 1024, G_, c_); }
    __host__ __device__ bool next(int i, Unit& u) const { const int br = i % 3; if (!so.next(i / 3, u)) return false; u.pn += 4 * br; u.az = br; return true; }
    __device__ __forceinline__ void a_ready(const Unit&) const {}
    __device__ __forceinline__ void done(const Unit&) const {}
};
template <class Epi, class Sched, bool ALIGN_EPI = false, bool SP2 = false>
__device__ __forceinline__ void gemm_phase(PG8_LAS unsigned char* lds, const Gemm g, const Sched& S, const Epi& E, int tid_in) {
    int tid_l = tid_in; asm volatile("" : "+v"(tid_l));
    const int tid = tid_l, wid = __builtin_amdgcn_readfirstlane(tid >> 6), lane = tid & 63, wr = wid >> 2, wc = wid & 3, fr = lane & 15, fq = lane >> 4;
    const int K = g.K, nt = K / BK;
    unsigned voffA[2], voffB[2];
#pragma unroll
    for (int i = 0; i < 2; ++i) { int R, C; stage_rc(tid * 16 + i * 8192, R, C); const int Rb = Epi::PERM ? ((R & ~31) + perm32(R & 31)) : R;
        voffA[i] = (unsigned)(R * K + C) * 2u; voffB[i] = (unsigned)(Rb * K + C) * 2u; }
    const size_t kstep = (size_t)(BK * 2);
    const size_t hstep = (size_t)HALF * K * 2;
    const size_t tstep = 2 * hstep;
    const unsigned ldsw = (unsigned)wid * 1024u;
    const int aoff = lds_byte(wr * 64 + fr, fq * 8), boff = lds_byte(wc * 32 + fr, fq * 8);
#define PG8_SA(b, h) (((b) * 2 + (h)) * HTB)
#define PG8_SB(b, h) ((4 + (b) * 2 + (h)) * HTB)
#define PG8_STAGE(bufoff, gbase, voff) do { _Pragma("unroll") for (int _i = 0; _i < 2; ++_i) \
        __builtin_amdgcn_global_load_lds((const unsigned*)((const char*)(gbase) + (voff)[_i]), (PG8_LAS unsigned*)(lds + (bufoff) + ldsw + _i * 8192), 16, 0, 0); } while (0)
#define PG8_LDA(dst, b, h) do { _Pragma("unroll") for (int m = 0; m < 4; ++m) _Pragma("unroll") for (int k = 0; k < 2; ++k) dst[m][k] = *(const PG8_LAS bf16x8*)(lds + PG8_SA(b, h) + aoff + m * 2048 + k * 1024); } while (0)
#define PG8_LDB(dst, b, h) do { _Pragma("unroll") for (int n = 0; n < 2; ++n) _Pragma("unroll") for (int k = 0; k < 2; ++k) dst[n][k] = *(const PG8_LAS bf16x8*)(lds + PG8_SB(b, h) + boff + n * 2048 + k * 1024); } while (0)
#define PG8_MMA(ai, bj, At, Bt) do { __builtin_amdgcn_s_setprio(1); _Pragma("unroll") for (int m = 0; m < 4; ++m) _Pragma("unroll") for (int n = 0; n < 2; ++n) _Pragma("unroll") for (int k = 0; k < 2; ++k) \
        acc[ai][bj][m][n] = __builtin_amdgcn_mfma_f32_16x16x32_bf16(Bt[n][k], At[m][k], acc[ai][bj][m][n], 0, 0, 0); __builtin_amdgcn_s_setprio(0); } while (0)
#define PG8_WAIT_V(n) asm volatile("s_waitcnt vmcnt(" #n ")" ::: "memory")
#define PG8_WAIT_L(n) asm volatile("s_waitcnt lgkmcnt(" #n ")" ::: "memory")
#define PG8_BAR __builtin_amdgcn_s_barrier()
#define PG8_SCHED __builtin_amdgcn_sched_barrier(0)
    Unit cur, nxt; int ui = 0; int rs_pm = -1;
    if (!S.next(0, cur)) return;
    f32x4 acc[2][2][4][2];
#pragma unroll
    for (int a = 0; a < 2; ++a)
#pragma unroll
        for (int b = 0; b < 2; ++b)
#pragma unroll
            for (int m = 0; m < 4; ++m)
#pragma unroll
                for (int n = 0; n < 2; ++n) acc[a][b][m][n] = (f32x4){0.f, 0.f, 0.f, 0.f};
    bf16x8 At[4][2], B0[2][2], B1[2][2];
    const char* cA = (const char*)g.A + (size_t)cur.pm * tstep + (size_t)cur.az * g.azs; const char* cB = (const char*)g.Bt + (size_t)cur.pn * tstep;
    S.a_ready(cur);
    if constexpr (SP2) {
        PG8_STAGE(PG8_SB(0, 0), cB, voffB); PG8_STAGE(PG8_SB(0, 1), cB + hstep, voffB); PG8_STAGE(PG8_SA(0, 0), cA, voffA); PG8_STAGE(PG8_SA(0, 1), cA + hstep, voffA);
        if (wr == 1) PG8_BAR;
        PG8_WAIT_V(2); PG8_BAR;
        PG8_STAGE(PG8_SB(1, 0), cB + kstep, voffB); PG8_STAGE(PG8_SA(1, 0), cA + kstep, voffA); PG8_STAGE(PG8_SB(1, 1), cB + hstep + kstep, voffB);
        PG8_WAIT_V(6); PG8_BAR;
    } else {
        PG8_STAGE(PG8_SB(0, 0), cB, voffB); PG8_STAGE(PG8_SA(0, 0), cA, voffA); PG8_STAGE(PG8_SB(0, 1), cB + hstep, voffB); PG8_STAGE(PG8_SA(0, 1), cA + hstep, voffA);
        if (wr == 1) PG8_BAR;
        PG8_WAIT_V(4); PG8_BAR;
        PG8_STAGE(PG8_SB(1, 0), cB + kstep, voffB); PG8_STAGE(PG8_SA(1, 0), cA + kstep, voffA); PG8_STAGE(PG8_SB(1, 1), cB + hstep + kstep, voffB);
        PG8_WAIT_V(6); PG8_BAR;
    }
    for (;;) {
        const bool has_next = S.next(ui + 1, nxt);
        const char* nA = has_next ? (const char*)g.A + (size_t)nxt.pm * tstep + (size_t)nxt.az * g.azs : cA; const char* nB = has_next ? (const char*)g.Bt + (size_t)nxt.pn * tstep : cB;
        for (int t = 0; t < nt; t += 2) {
            const bool last = (t == nt - 2);
            const char* a1 = cA + (size_t)(t + 1) * kstep;
            const char* a2 = last ? nA : cA + (size_t)(t + 2) * kstep; const char* b2 = last ? nB : cB + (size_t)(t + 2) * kstep;
            const char* a3 = a2 + kstep; const char* b3 = b2 + kstep;
            if (last && has_next) S.a_ready(nxt);
            if constexpr (SP2) {
            PG8_LDB(B0, 0, 0); PG8_LDB(B1, 0, 1); PG8_SCHED; PG8_LDA(At, 0, 0); PG8_STAGE(PG8_SA(1, 1), a1 + hstep, voffA);
            PG8_WAIT_V(8); PG8_WAIT_L(0); PG8_BAR; PG8_MMA(0, 0, At, B0); PG8_MMA(0, 1, At, B1); PG8_BAR; PG8_SCHED;
            PG8_LDA(At, 0, 1); PG8_STAGE(PG8_SB(0, 0), b2, voffB); PG8_STAGE(PG8_SB(0, 1), b2 + hstep, voffB); PG8_STAGE(PG8_SA(0, 0), a2, voffA);
            PG8_WAIT_V(8); PG8_WAIT_L(0); PG8_BAR; PG8_MMA(1, 0, At, B0); PG8_MMA(1, 1, At, B1); PG8_BAR; PG8_SCHED;
            PG8_LDB(B0, 1, 0); PG8_LDB(B1, 1, 1); PG8_SCHED; PG8_LDA(At, 1, 0); PG8_STAGE(PG8_SA(0, 1), a2 + hstep, voffA);
            PG8_WAIT_V(8); PG8_WAIT_L(0); PG8_BAR; PG8_MMA(0, 0, At, B0); PG8_MMA(0, 1, At, B1); PG8_BAR; PG8_SCHED;
            PG8_LDA(At, 1, 1); PG8_STAGE(PG8_SB(1, 0), b3, voffB); PG8_STAGE(PG8_SB(1, 1), b3 + hstep, voffB); PG8_STAGE(PG8_SA(1, 0), a3, voffA);
            PG8_WAIT_V(8); PG8_WAIT_L(0); PG8_BAR; PG8_MMA(1, 0, At, B0); PG8_MMA(1, 1, At, B1); PG8_BAR; PG8_SCHED;
            } else {
            PG8_LDB(B0, 0, 0); PG8_SCHED; PG8_LDA(At, 0, 0); PG8_STAGE(PG8_SA(1, 1), a1 + hstep, voffA);
            PG8_WAIT_L(8); PG8_BAR; PG8_WAIT_L(0); PG8_MMA(0, 0, At, B0); PG8_BAR; PG8_SCHED;
            PG8_LDB(B1, 0, 1); PG8_STAGE(PG8_SB(0, 0), b2, voffB);
            PG8_BAR; PG8_WAIT_L(0); PG8_MMA(0, 1, At, B1); PG8_BAR;
            PG8_LDA(At, 0, 1); PG8_STAGE(PG8_SA(0, 0), a2, voffA);
            PG8_BAR; PG8_WAIT_L(0); PG8_MMA(1, 0, At, B0); PG8_BAR; PG8_SCHED;
            PG8_STAGE(PG8_SB(0, 1), b2 + hstep, voffB);
            PG8_WAIT_V(6); PG8_BAR; PG8_MMA(1, 1, At, B1); PG8_BAR;
            PG8_LDB(B0, 1, 0); PG8_SCHED; PG8_LDA(At, 1, 0); PG8_STAGE(PG8_SA(0, 1), a2 + hstep, voffA);
            PG8_WAIT_L(8); PG8_BAR; PG8_WAIT_L(0); PG8_MMA(0, 0, At, B0); PG8_BAR; PG8_SCHED;
            PG8_LDB(B1, 1, 1); PG8_STAGE(PG8_SB(1, 0), b3, voffB);
            PG8_BAR; PG8_WAIT_L(0); PG8_MMA(0, 1, At, B1); PG8_BAR;
            PG8_LDA(At, 1, 1); PG8_STAGE(PG8_SA(1, 0), a3, voffA);
            PG8_BAR; PG8_WAIT_L(0); PG8_MMA(1, 0, At, B0); PG8_BAR; PG8_SCHED;
            PG8_STAGE(PG8_SB(1, 1), b3 + hstep, voffB);
            PG8_WAIT_V(6); PG8_BAR; PG8_MMA(1, 1, At, B1); PG8_BAR;
            }
        }
        if constexpr (ALIGN_EPI) { if (wr == 0) PG8_BAR; }
        if constexpr (Epi::RSTD) { if (cur.pm != rs_pm) { E.stage(cur.pm, tid); rs_pm = cur.pm; } }
        bool keep_acc = false;
        if constexpr (Epi::CARRY) { keep_acc = E.carry(acc, cur, wr, wc, fr, fq); S.done(cur); }
        else if constexpr (!Epi::AFTER_DRAIN) { E(acc, cur, wr, wc, fr, fq);
#ifdef REP_EPI
            if constexpr (Epi::RSTD) { asm volatile("" ::: "memory"); E(acc, cur, wr, wc, fr, fq); }
#endif
            S.done(cur); }
        if (!has_next) break;
        if (!keep_acc)
#pragma unroll
        for (int a = 0; a < 2; ++a)
#pragma unroll
            for (int b = 0; b < 2; ++b)
#pragma unroll
                for (int m = 0; m < 4; ++m)
#pragma unroll
                    for (int n = 0; n < 2; ++n) acc[a][b][m][n] = (f32x4){0.f, 0.f, 0.f, 0.f};
        cur = nxt; cA = nA; cB = nB; ++ui;
        if constexpr (ALIGN_EPI) { if (wr == 1) PG8_BAR; }
    }
    PG8_WAIT_V(0);
    if constexpr (!ALIGN_EPI) { if (wr == 0) PG8_BAR; }
    PG8_BAR;
    if constexpr (Epi::AFTER_DRAIN) { E.fused(acc, cur, wr, wc, fr, fq, lds, wid, lane); S.done(cur); }
#undef PG8_SA
#undef PG8_SB
#undef PG8_STAGE
#undef PG8_LDA
#undef PG8_LDB
#undef PG8_MMA
#undef PG8_WAIT_V
#undef PG8_WAIT_L
#undef PG8_BAR
#undef PG8_SCHED
}
}

namespace att {
#define ATT_LAS __attribute__((address_space(3)))
#define ATT_GAS __attribute__((address_space(1)))
typedef unsigned short bf16_t;
typedef short bf16x8 __attribute__((ext_vector_type(8)));
typedef short s16x4 __attribute__((ext_vector_type(4)));
typedef float f32x16 __attribute__((ext_vector_type(16)));
typedef float f32x4 __attribute__((ext_vector_type(4)));
typedef unsigned u32x4 __attribute__((ext_vector_type(4)));
typedef unsigned u32x2 __attribute__((ext_vector_type(2)));
typedef float f32x2_t __attribute__((ext_vector_type(2)));
typedef __bf16 bf16x2_t __attribute__((ext_vector_type(2)));
typedef short v4i16_t __attribute__((ext_vector_type(4)));
typedef ATT_LAS unsigned char* lptr;
#define ADI __device__ __forceinline__
constexpr float LOG2E = 1.4426950408889634f;
constexpr float NEG_BIG = -1e30f;

ADI int crow(int r, int hi) { return (r & 3) + 8 * (r >> 2) + 4 * hi; }
ADI unsigned cvtpk(float lo, float hi) { f32x2_t v = {lo, hi}; bf16x2_t b = __builtin_convertvector(v, bf16x2_t); return __builtin_bit_cast(unsigned, b); }
ADI float swapmax(float v) { auto rr = __builtin_amdgcn_permlane32_swap(__float_as_uint(v), __float_as_uint(v), false, false); return fmaxf(__uint_as_float(rr[0]), __uint_as_float(rr[1])); }
ADI float swapsum(float v) { auto rr = __builtin_amdgcn_permlane32_swap(__float_as_uint(v), __float_as_uint(v), false, false); return __uint_as_float(rr[0]) + __uint_as_float(rr[1]); }
ADI f32x16 splat16(float v) { f32x16 r;
#pragma unroll
  for (int i = 0; i < 16; ++i) r[i] = v; return r; }
ADI float bf2f(bf16_t b) { return __uint_as_float((unsigned)b << 16); }

ADI u32x4 ldg16(const bf16_t* p) { return *(const ATT_GAS u32x4*)p; }
ADI void k_map(int tid, int& key, int& chunk) { const int w = tid >> 6, lane = tid & 63; key = 32 * (w & 1) + (lane & 31); chunk = 2 * (w >> 1) + (lane >> 5); }
ADI int k_lds_off(int key, int chunk) { return chunk * 1024 + key * 16; }
ADI void v_map(int tid, int& key, int& dc) { key = tid >> 3; dc = tid & 7; }
ADI int v_lds_off(int key, int dc) { return ((dc >> 2) * 4 + (key >> 4)) * 1024 + (key & 15) * 64 + (dc & 3) * 16; }

ADI void qk_tile(f32x16& p0, f32x16& p1, lptr kimg, const bf16x8 (&qr)[4], int r32, int hi) {
#pragma unroll
  for (int d0 = 0; d0 < 4; ++d0) {
    const bf16x8 b0 = *(const ATT_LAS bf16x8*)(kimg + (2 * d0 + hi) * 1024 + r32 * 16);
    const bf16x8 b1 = *(const ATT_LAS bf16x8*)(kimg + (2 * d0 + hi) * 1024 + r32 * 16 + 512);
    p0 = __builtin_amdgcn_mfma_f32_32x32x16_bf16(b0, qr[d0], p0, 0, 0, 0);
    p1 = __builtin_amdgcn_mfma_f32_32x32x16_bf16(b1, qr[d0], p1, 0, 0, 0);
  }
}
template <int NO> ADI void softmax_step(f32x16& p0, f32x16& p1, float& m, float& l, f32x16 (&o)[NO]) {
  float mx = fmaxf(p0[0], p1[0]);
#pragma unroll
  for (int r = 1; r < 16; ++r) mx = fmaxf(mx, fmaxf(p0[r], p1[r]));
  mx = swapmax(mx);
  const float mn = fmaxf(m, mx), alpha = __builtin_amdgcn_exp2f(m - mn); m = mn;
  float ps = 0.f;
#pragma unroll
  for (int r = 0; r < 16; ++r) { p0[r] = __builtin_amdgcn_exp2f(p0[r] - mn); p1[r] = __builtin_amdgcn_exp2f(p1[r] - mn); ps += p0[r] + p1[r]; }
  ps = swapsum(ps); l = l * alpha + ps;
  if (!__all(alpha == 1.0f)) {
#pragma unroll
    for (int i = 0; i < NO; ++i) o[i] *= alpha;
  }
}
ADI s16x4 vtr(lptr p) { return __builtin_bit_cast(s16x4, __builtin_amdgcn_ds_read_tr16_b64_v4i16((ATT_LAS v4i16_t*)p)); }
template <int NDH> ADI void pv_tile(f32x16 (&o)[NDH], lptr vimg, const f32x16& p0, const f32x16& p1, int lane) {
  bf16x8 pf[4];
  { u32x4 w;
    w.x = cvtpk(p0[0], p0[1]); w.y = cvtpk(p0[2], p0[3]); w.z = cvtpk(p0[4], p0[5]); w.w = cvtpk(p0[6], p0[7]); pf[0] = __builtin_bit_cast(bf16x8, w);
    w.x = cvtpk(p0[8], p0[9]); w.y = cvtpk(p0[10], p0[11]); w.z = cvtpk(p0[12], p0[13]); w.w = cvtpk(p0[14], p0[15]); pf[1] = __builtin_bit_cast(bf16x8, w);
    w.x = cvtpk(p1[0], p1[1]); w.y = cvtpk(p1[2], p1[3]); w.z = cvtpk(p1[4], p1[5]); w.w = cvtpk(p1[6], p1[7]); pf[2] = __builtin_bit_cast(bf16x8, w);
    w.x = cvtpk(p1[8], p1[9]); w.y = cvtpk(p1[10], p1[11]); w.z = cvtpk(p1[12], p1[13]); w.w = cvtpk(p1[14], p1[15]); pf[3] = __builtin_bit_cast(bf16x8, w); }
  const int vb = ((lane >> 4) & 1) * 32 + (lane & 3) * 8 + (4 * (lane >> 5) + ((lane & 15) >> 2)) * 64;
#pragma unroll
  for (int dh = 0; dh < NDH; ++dh) {
#pragma unroll
    for (int kg = 0; kg < 4; ++kg) {
      lptr p = vimg + (dh >> 1) * 8192 + ((dh & 1) * 4 + kg) * 1024 + vb;
      const s16x4 lo = vtr(p), hi = vtr(p + 512);
      const bf16x8 vf = {lo[0], lo[1], lo[2], lo[3], hi[0], hi[1], hi[2], hi[3]};
      o[dh] = __builtin_amdgcn_mfma_f32_32x32x16_bf16(vf, pf[kg], o[dh], 0, 0, 0);
    }
  }
}
template <int NDH> ADI void store_o(bf16_t* orow, const f32x16 (&o)[NDH], float sc, int hi) {
#pragma unroll
  for (int dh = 0; dh < NDH; ++dh)
#pragma unroll
    for (int g = 0; g < 4; ++g) { u32x2 w; w.x = cvtpk(o[dh][4 * g] * sc, o[dh][4 * g + 1] * sc); w.y = cvtpk(o[dh][4 * g + 2] * sc, o[dh][4 * g + 3] * sc);
      *(ATT_GAS u32x2*)(orow + 32 * dh + 8 * g + 4 * hi) = w; }
}

ADI void glds16(const void* gsrc, unsigned lds_dst) { unsigned keep;
  asm volatile("s_mov_b32 %0, m0\n\ts_mov_b32 m0, %2\n\ts_nop 0\n\tglobal_load_lds_dwordx4 %1, off\n\ts_mov_b32 m0, %0" : "=&s"(keep) : "v"(gsrc), "s"(lds_dst) : "memory"); }
ADI void glds4(const void* gsrc, unsigned lds_dst) { unsigned keep;
  asm volatile("s_mov_b32 %0, m0\n\ts_mov_b32 m0, %2\n\ts_nop 0\n\tglobal_load_lds_dword %1, off\n\ts_mov_b32 m0, %0" : "=&s"(keep) : "v"(gsrc), "s"(lds_dst) : "memory"); }
template <int N> ADI void wait_bar() { asm volatile("s_waitcnt vmcnt(%0) lgkmcnt(0)\n\ts_barrier" :: "n"(N) : "memory"); }
#define MX3(a, b, c) __builtin_fmaxf(__builtin_fmaxf((a), (b)), (c))
constexpr float THR = 8.0f;
template <int NO> ADI void sm_decide(f32x16& c0, f32x16& c1, float& mref, float& l, f32x16 (&o)[NO]) {
  float a = MX3(c0[0], c0[1], c1[0]), b = MX3(c0[2], c0[3], c1[1]); a = MX3(a, c1[2], c1[3]);
#pragma unroll
  for (int r = 4; r < 16; r += 4) { a = MX3(a, c0[r], c0[r + 1]); b = MX3(b, c0[r + 2], c0[r + 3]); a = MX3(a, c1[r], c1[r + 1]); b = MX3(b, c1[r + 2], c1[r + 3]); }
  const float rm = swapmax(fmaxf(a, b));
  if (__builtin_expect(__any(rm > THR), 0)) {
    const float dl = fmaxf(rm, 0.f), f = __builtin_amdgcn_exp2f(-dl);
    mref += dl; l *= f;
#pragma unroll
    for (int r = 0; r < 16; ++r) { c0[r] -= dl; c1[r] -= dl; }
#pragma unroll
    for (int i = 0; i < NO; ++i) o[i] *= f;
  }
}
ADI void sm_exp_sum(f32x16& c0, f32x16& c1, float& l) {
  float s0 = 0.f, s1 = 0.f;
#pragma unroll
  for (int r = 0; r < 16; ++r) { c0[r] = __builtin_amdgcn_exp2f(c0[r]); c1[r] = __builtin_amdgcn_exp2f(c1[r]); s0 += c0[r]; s1 += c1[r]; }
  l += s0 + s1;
}

struct UnitArgs {
  const bf16_t* Q; int ldq; const bf16_t* K; const bf16_t* V; int ldkv; bf16_t* O; int ldo;
  int q0;
  int t0, t1;
  const float* relb;
  const unsigned* mask;
  bool nomask;
};
template <int MODE> ADI void attn_unit(lptr lds, const UnitArgs& a, int tid_in) {
  int tid_l = tid_in; asm volatile("" : "+v"(tid_l));
  const int tid = tid_l, lane = tid & 63, r32 = lane & 31, hi = lane >> 5, w = __builtin_amdgcn_readfirstlane(tid >> 6);
  constexpr int SLOT = 16384, P = (MODE == 1) ? 3 : 2;
  constexpr int MSK_OFF = 4 * SLOT, TAB_OFF = MSK_OFF + 4 * 2048;
  const unsigned lds0 = (unsigned)(size_t)lds;
  ATT_LAS float* tab = (ATT_LAS float*)(lds + TAB_OFF);
  if (MODE == 0) { for (int i = tid; i < 320; i += 512) tab[i] = ((const ATT_GAS float*)a.relb)[i] * LOG2E; }
  const int qloc = a.q0 + 32 * w + r32;
  const int cq = (a.q0 + 32 * w) >> 6;
  bf16x8 qr[4];
  { const bf16_t* qp = a.Q + (size_t)qloc * a.ldq + 8 * hi;
#pragma unroll
    for (int d0 = 0; d0 < 4; ++d0) qr[d0] = __builtin_bit_cast(bf16x8, ldg16(qp + 16 * d0)); }
  const bf16_t* ksrc = a.K + (size_t)lane * a.ldkv + w * 8;
  const bf16_t* vsrc = a.V + (size_t)(16 * (w & 3) + (lane >> 2)) * a.ldkv + (w >> 2) * 32 + (lane & 3) * 8;
  const unsigned* msrc = a.mask + (size_t)(a.q0 + 32 * w) * 2 + lane;
  const size_t tstep = (size_t)64 * a.ldkv;
#define ATT_DMA(t) do { const unsigned sb_ = lds0 + (unsigned)(((t) & 3) * SLOT + w * 1024); \
    glds16(ksrc + (size_t)(t) * tstep, (unsigned)__builtin_amdgcn_readfirstlane(sb_)); glds16(vsrc + (size_t)(t) * tstep, (unsigned)__builtin_amdgcn_readfirstlane(sb_ + 8192u)); \
    if (MODE == 1) glds4(msrc + (size_t)(t) * 8192, (unsigned)__builtin_amdgcn_readfirstlane(lds0 + (unsigned)(MSK_OFF + ((t) & 3) * 2048 + w * 256))); } while (0)
#define ATT_ACTIVE(t) ((MODE == 0) ? ((t) <= cq && (t) + 8 >= cq) : (MODE == 1) ? ((t) <= cq) : true)
#define ATT_INIT(P0, P1, t) do { if (MODE == 0) { const int dch_ = cq - (t); \
      if (dch_ >= 5) { const float c_ = tab[319] - mref; P0 = splat16(c_); P1 = splat16(c_); } \
      else { const int base_ = 64 * dch_ + (qloc & 63) + 63; \
        _Pragma("unroll") for (int r = 0; r < 16; ++r) { const int i0 = base_ - crow(r, hi); P0[r] = tab[i0 < 319 ? i0 : 319] - mref; const int i1 = i0 - 32; P1[r] = tab[i1 < 319 ? i1 : 319] - mref; } } \
    } else { P0 = splat16(-mref); P1 = splat16(-mref); } } while (0)
#define ATT_MASK(P0, P1, t) do { if (MODE == 1) { if (!a.nomask) { const unsigned mw_ = *(const ATT_LAS unsigned*)(lds + MSK_OFF + ((t) & 3) * 2048 + w * 256 + (r32 * 2 + hi) * 4); \
      _Pragma("unroll") for (int r = 0; r < 16; ++r) { P0[r] = ((int)(mw_ << (31 - r)) < 0) ? P0[r] : -INFINITY; P1[r] = ((int)(mw_ << (15 - r)) < 0) ? P1[r] : -INFINITY; } } } } while (0)
  float mref = 0.f, l = 0.f; f32x16 o[2]; o[0] = splat16(0.f); o[1] = splat16(0.f);
  ATT_DMA(a.t0); if (a.t0 + 1 <= a.t1) ATT_DMA(a.t0 + 1); if (a.t0 + 2 <= a.t1) ATT_DMA(a.t0 + 2);
  wait_bar<0>();
  f32x16 c0 = splat16(0.f), c1 = splat16(0.f);
  bool act_cur = ATT_ACTIVE(a.t0);
  if (act_cur) { ATT_INIT(c0, c1, a.t0); qk_tile(c0, c1, lds + (a.t0 & 3) * SLOT, qr, r32, hi); }
  for (int t = a.t0; t <= a.t1; ++t) {
    if (t > a.t0) { if (t + 2 <= a.t1) wait_bar<P>(); else wait_bar<0>(); }
    if (t + 3 <= a.t1) ATT_DMA(t + 3);
    const bool act_next = (t + 1 <= a.t1) && ATT_ACTIVE(t + 1);
    f32x16 n0 = splat16(0.f), n1 = splat16(0.f);
    lptr slot_c = lds + (t & 3) * SLOT, slot_n = lds + ((t + 1) & 3) * SLOT;
    if (act_cur && act_next) {
      ATT_MASK(c0, c1, t);
      sm_decide<2>(c0, c1, mref, l, o);
      ATT_INIT(n0, n1, t + 1);
      qk_tile(n0, n1, slot_n, qr, r32, hi);
      sm_exp_sum(c0, c1, l);
      pv_tile<2>(o, slot_c + 8192, c0, c1, lane);
    } else if (act_cur) {
      ATT_MASK(c0, c1, t);
      sm_decide<2>(c0, c1, mref, l, o);
      sm_exp_sum(c0, c1, l);
      pv_tile<2>(o, slot_c + 8192, c0, c1, lane);
    } else if (act_next) {
      ATT_INIT(n0, n1, t + 1);
      qk_tile(n0, n1, slot_n, qr, r32, hi);
    }
    c0 = n0; c1 = n1; act_cur = act_next;
  }
  asm volatile("s_waitcnt lgkmcnt(0)\n\ts_barrier" ::: "memory");
  l = swapsum(l);
  store_o<2>(a.O + (size_t)qloc * a.ldo, o, __builtin_amdgcn_rcpf(l), hi);
#undef ATT_DMA
#undef ATT_ACTIVE
#undef ATT_INIT
#undef ATT_MASK
}

constexpr int TOPK = 256;
ADI void idx_kload(const bf16_t* ki0, int s, unsigned loff, bf16x8 (&kf)[4]) {
  const ATT_GAS char* bs = (const ATT_GAS char*)(ki0 + (size_t)s * (32 * 256));
#pragma unroll
  for (int d0 = 0; d0 < 4; ++d0) kf[d0] = __builtin_bit_cast(bf16x8, *(const ATT_GAS u32x4*)(bs + (loff + 32u * d0)));
}
ADI void idx_park(unsigned* kscr, int s, int lane, const unsigned (&u)[16]) {
  ATT_GAS u32x4* p = (ATT_GAS u32x4*)(kscr + (size_t)s * 1024) + lane;
#pragma unroll
  for (int j = 0; j < 4; ++j) { u32x4 v = {u[4 * j], u[4 * j + 1], u[4 * j + 2], u[4 * j + 3]}; p[64 * j] = v; }
}
ADI void idx_fetch(const unsigned* kscr, int s, int lane, unsigned (&u)[16]) {
  const ATT_GAS u32x4* p = (const ATT_GAS u32x4*)(kscr + (size_t)s * 1024) + lane;
#pragma unroll
  for (int j = 0; j < 4; ++j) { const u32x4 v = p[64 * j]; u[4 * j] = v.x; u[4 * j + 1] = v.y; u[4 * j + 2] = v.z; u[4 * j + 3] = v.w; }
}
ADI void idx_scores2(const bf16x8 (&kA)[4], const bf16x8 (&kB)[4], lptr qimg, const float (&wv)[4], unsigned (&uA)[16], unsigned (&uB)[16], unsigned zA, unsigned zB) {
  float sA[16], sB[16];
#pragma unroll
  for (int hp = 0; hp < 2; ++hp) {
    bf16x8 q0[4], q1[4];
#pragma unroll
    for (int d0 = 0; d0 < 4; ++d0) { q0[d0] = *(const ATT_LAS bf16x8*)(qimg + ((2 * hp) * 4 + d0) * 1024); q1[d0] = *(const ATT_LAS bf16x8*)(qimg + ((2 * hp + 1) * 4 + d0) * 1024); }
    f32x16 a0 = splat16(0.f), a1 = splat16(0.f), b0 = splat16(0.f), b1 = splat16(0.f);
#pragma unroll
    for (int d0 = 0; d0 < 4; ++d0) {
      a0 = __builtin_amdgcn_mfma_f32_32x32x16_bf16(kA[d0], q0[d0], a0, 0, 0, 0); b0 = __builtin_amdgcn_mfma_f32_32x32x16_bf16(kB[d0], q0[d0], b0, 0, 0, 0);
      a1 = __builtin_amdgcn_mfma_f32_32x32x16_bf16(kA[d0], q1[d0], a1, 0, 0, 0); b1 = __builtin_amdgcn_mfma_f32_32x32x16_bf16(kB[d0], q1[d0], b1, 0, 0, 0); }
#pragma unroll
    for (int r = 0; r < 16; ++r) {
      const float ra0 = __int_as_float(max(__float_as_int(a0[r]), 0)), ra1 = __int_as_float(max(__float_as_int(a1[r]), 0));
      const float rb0 = __int_as_float(max(__float_as_int(b0[r]), 0)), rb1 = __int_as_float(max(__float_as_int(b1[r]), 0));
      sA[r] = __builtin_fmaf(ra0, wv[2 * hp], hp == 0 ? 0.0f : sA[r]); sA[r] = __builtin_fmaf(ra1, wv[2 * hp + 1], sA[r]);
      sB[r] = __builtin_fmaf(rb0, wv[2 * hp], hp == 0 ? 0.0f : sB[r]); sB[r] = __builtin_fmaf(rb1, wv[2 * hp + 1], sB[r]);
    }
  }
#pragma unroll
  for (int r = 0; r < 16; ++r) {
    const unsigned ba = __float_as_uint(sA[r]), bb = __float_as_uint(sB[r]);
    const unsigned kk = (unsigned)(((r & 3) + 8 * (r >> 2)) << 11);
    unsigned ka = ((int)ba < 0) ? ~ba : ba + 0x80800000u, kb = ((int)bb < 0) ? ~bb : bb + 0x80800000u;
    uA[r] = (ba == 0u) ? zA - kk : ka; uB[r] = (bb == 0u) ? zB - kk : kb;
  }
}
ADI unsigned wave_excl_scan(unsigned v, int lane) {
  unsigned x = v;
#pragma unroll
  for (int d = 1; d < 64; d <<= 1) { const unsigned t = __shfl_up(x, d); if (lane >= d) x += t; }
  return x - v;
}
#define IDX_DPP_SHR(x, n) ((unsigned)__builtin_amdgcn_update_dpp(0, (int)(x), 0x110 + (n), 0xf, 0xf, true))
ADI void hist_scan4(ATT_LAS unsigned* hist, ATT_LAS unsigned* res, int w, int lane_in) {
  int lane = lane_in; asm volatile("" : "+v"(lane));
  const int rho = lane >> 4, q = 4 * w + rho, li = lane & 15;
  const unsigned k = res[q * 4 + 1];
  ATT_LAS unsigned* hq = hist + q * 1024;
  const int p0 = 1023 - 64 * li;
  unsigned T = 0;
#pragma unroll 16
  for (int t = 0; t < 64; ++t) { const unsigned o = (unsigned)(t + 4 * li + rho) & 63u; const unsigned wd = hq[(unsigned)(p0 - (int)o) ^ (unsigned)q]; T += (wd & 0xffffu) + (wd >> 16); }
  unsigned x = T;
  x += IDX_DPP_SHR(x, 1); x += IDX_DPP_SHR(x, 2); x += IDX_DPP_SHR(x, 4); x += IDX_DPP_SHR(x, 8);
  const unsigned E = x - T;
  if (E < k && k <= E + T) { res[q * 4 + 3] = (unsigned)p0; res[q * 4 + 2] = E; }
  asm volatile("s_waitcnt lgkmcnt(0)" ::: "memory");
  const int pL = (int)res[q * 4 + 3]; const unsigned EL = res[q * 4 + 2];
  unsigned wd4[4]; unsigned s4 = 0;
#pragma unroll
  for (int j = 0; j < 4; ++j) { wd4[j] = hq[(unsigned)(pL - 4 * li - j) ^ (unsigned)q]; s4 += (wd4[j] & 0xffffu) + (wd4[j] >> 16); }
  unsigned y = s4;
  y += IDX_DPP_SHR(y, 1); y += IDX_DPP_SHR(y, 2); y += IDX_DPP_SHR(y, 4); y += IDX_DPP_SHR(y, 8);
  const unsigned E2 = EL + (y - s4);
  asm volatile("s_waitcnt lgkmcnt(0)" ::: "memory");
  if (E2 < k && k <= E2 + s4) {
    unsigned cum = E2, fbin = 0, frem = 0, fcnt = 0;
#pragma unroll
    for (int j = 0; j < 4; ++j) {
      const unsigned p = (unsigned)(pL - 4 * li - j), chi = wd4[j] >> 16, clo = wd4[j] & 0xffffu;
      if (cum < k && k <= cum + chi) { fbin = 2 * p + 1; frem = k - cum; fcnt = chi; }
      cum += chi;
      if (cum < k && k <= cum + clo) { fbin = 2 * p; frem = k - cum; fcnt = clo; }
      cum += clo;
    }
    res[q * 4 + 0] = fbin; res[q * 4 + 1] = frem; res[q * 4 + 2] = fcnt;
  }
}
#define IDX_PREF0() do { if (w < NS) { idx_kload(KI, w, loff, kA_); idx_kload(KI, (w + 8 < NS) ? w + 8 : w, loff, kB_); } } while (0)
#define IDX_LOOP0(BODY) do { \
    for (int s_ = w; s_ < NS; s_ += 16) { const bool hb_ = s_ + 8 < NS; \
      unsigned pA_[16], pB_[16]; { const unsigned zA_ = 0x80000000u + ((4095u - 32u * (unsigned)s_ - 4u * (unsigned)hi) << 11); idx_scores2(kA_, kB_, qimg, wv, pA_, pB_, zA_, zA_ - (256u << 11)); } \
      if (s_ + 16 < NS) { idx_kload(KI, s_ + 16, loff, kA_); idx_kload(KI, (s_ + 24 < NS) ? s_ + 24 : s_ + 16, loff, kB_); } \
      { unsigned (&u)[16] = pA_; idx_park(kscr, s_, lane, u); BODY(s_); } \
      if (hb_) { unsigned (&u)[16] = pB_; idx_park(kscr, s_ + 8, lane, u); BODY(s_ + 8); } } } while (0)
#define IDX_SWEEP0(BODY) do { IDX_PREF0(); IDX_LOOP0(BODY); } while (0)
#define IDX_PREF() do { if (w < NS) idx_fetch(kscr, w, lane, uA_); if (w + 8 < NS) idx_fetch(kscr, w + 8, lane, uB_); if (w + 16 < NS) idx_fetch(kscr, w + 16, lane, uC_); } while (0)
#define IDX_LOOP(BODY) do { \
    for (int s_ = w; s_ < NS; s_ += 32) { \
      if (s_ + 24 < NS) idx_fetch(kscr, s_ + 24, lane, uD_); { unsigned (&u)[16] = uA_; BODY(s_); } \
      if (s_ + 8 < NS) { if (s_ + 32 < NS) idx_fetch(kscr, s_ + 32, lane, uA_); unsigned (&u)[16] = uB_; BODY(s_ + 8); } \
      if (s_ + 16 < NS) { if (s_ + 40 < NS) idx_fetch(kscr, s_ + 40, lane, uB_); unsigned (&u)[16] = uC_; BODY(s_ + 16); } \
      if (s_ + 24 < NS) { if (s_ + 48 < NS) idx_fetch(kscr, s_ + 48, lane, uC_); unsigned (&u)[16] = uD_; BODY(s_ + 24); } } } while (0)
#define IDX_SWEEP(BODY) do { IDX_PREF(); IDX_LOOP(BODY); } while (0)
#define IDX_ADD(bin) do { unsigned sh_; asm("v_mad_u32_u24 %0, %1, %2, 1" : "=v"(sh_) : "v"((bin) & 1u), "s"(c16_));   \
    __hip_atomic_fetch_add(hist + r32 * 1024 + (((bin) >> 1) ^ (unsigned)r32), sh_, __ATOMIC_RELAXED, __HIP_MEMORY_SCOPE_WORKGROUP); \
    if (IDX_PROBE_DUP) __hip_atomic_fetch_add((ATT_LAS unsigned*)(lds + 148736) + (r32 * 32 + ((((bin) >> 1) ^ (unsigned)r32) & 31u)), sh_, __ATOMIC_RELAXED, __HIP_MEMORY_SCOPE_WORKGROUP); } while (0)
#ifndef IDX_PROBE_DUP
#define IDX_PROBE_DUP 0
#endif
#ifndef IDX_PROBE_P0
#define IDX_PROBE_P0 0
#endif
#ifndef IDX_PROBE_SCAN
#define IDX_PROBE_SCAN 0
#endif
#ifndef IDX_PROBE_P1
#define IDX_PROBE_P1 0
#endif
constexpr int IDX_QOFF = 132352;
constexpr unsigned IDX_CAP = 16;
ADI void idx_unit(lptr lds, const bf16_t* QI, const bf16_t* KI, unsigned short* mask16, unsigned* kscr, int n, int half, int tid_in) {
  int tid_l = tid_in; asm volatile("" : "+v"(tid_l));
#define IDX_BAR() do { asm volatile("s_waitcnt lgkmcnt(0)" ::: "memory"); __builtin_amdgcn_s_barrier(); asm volatile("" ::: "memory"); } while (0)
  const int tid = tid_l, lane = tid & 63, r32 = lane & 31, hi = lane >> 5, w = __builtin_amdgcn_readfirstlane(tid >> 6);
  ATT_LAS unsigned* hist = (ATT_LAS unsigned*)lds;
  ATT_LAS unsigned* res = (ATT_LAS unsigned*)(lds + 131072);
  const int qpos = 64 * n + 32 * half + r32;
  const int NS = 2 * (n + 1);
  const unsigned loff = (unsigned)(r32 * 512 + hi * 16);
  unsigned uA_[16], uB_[16], uC_[16], uD_[16]; bf16x8 kA_[4], kB_[4];
  IDX_PREF0();
  u32x4 qst_[2];
  { const int q0row = 64 * n + 32 * half;
#pragma unroll
    for (int i = 0; i < 2; ++i) { const int p = tid + 512 * i, q = p >> 5, c16 = p & 31; qst_[i] = ldg16(QI + (size_t)(q0row + q) * 256 + c16 * 8); } }
  lptr qimg = lds + IDX_QOFF + hi * 512 + r32 * 16;
  float wv[4];
  { const u32x2 ww = *(const ATT_GAS u32x2*)(KI + (size_t)qpos * 256 + 64);
    wv[0] = __uint_as_float(ww.x << 16) * 0.0625f; wv[1] = __uint_as_float(ww.x & 0xffff0000u) * 0.0625f; wv[2] = __uint_as_float(ww.y << 16) * 0.0625f; wv[3] = __uint_as_float(ww.y & 0xffff0000u) * 0.0625f; }
  const unsigned moff = (unsigned)(qpos * 8 + hi * 4);
  if (tid < 32) res[tid * 4 + 1] = TOPK;
  if (tid == 32 || tid == 33) res[128 + (tid - 32)] = 0u;
  unsigned pre = 0u, thr = 0u, cut = 0xffffu; bool needtie = false;
  unsigned c16_ = 0xffffu; asm volatile("" : "+s"(c16_));
#define IDX_ZERO() do { const u32x4 z_ = {0u, 0u, 0u, 0u}; _Pragma("unroll") for (int i = 0; i < 16; ++i) *(ATT_LAS u32x4*)(lds + (size_t)(i * 512 + tid) * 16) = z_; IDX_BAR(); } while (0)
#define IDX_SCAN() do { IDX_BAR(); hist_scan4(hist, res, w, lane); IDX_BAR(); } while (0)
  { const u32x4 z_ = {0u, 0u, 0u, 0u};
#pragma unroll
    for (int i = 0; i < 16; ++i) *(ATT_LAS u32x4*)(lds + (size_t)(i * 512 + tid) * 16) = z_;
#pragma unroll
    for (int i = 0; i < 2; ++i) { const int p = tid + 512 * i, q = p >> 5, c16 = p & 31; *(ATT_LAS u32x4*)(lds + IDX_QOFF + c16 * 512 + q * 16) = qst_[i]; }
    IDX_BAR(); }
#define IDX_B0(s) do { _Pragma("unroll") for (int r = 0; r < 16; ++r) IDX_ADD(u[r] >> 21); } while (0)
#define IDX_B0_(s) IDX_B0(s)
#if IDX_PROBE_P0
  { IDX_SWEEP0(IDX_B0_); IDX_BAR(); IDX_ZERO(); }
#endif
  IDX_LOOP0(IDX_B0);
#if IDX_PROBE_SCAN
  { ATT_LAS unsigned* res2 = (ATT_LAS unsigned*)(lds + 149760); if (tid < 32) res2[tid * 4 + 1] = TOPK; IDX_BAR(); hist_scan4(hist, res2, w, lane); IDX_BAR(); }
#endif
  IDX_BAR();
  IDX_PREF();
  hist_scan4(hist, res, w, lane); IDX_BAR();
  pre = res[r32 * 4 + 0];
  IDX_ZERO();
#define IDX_B1D(s) do { _Pragma("unroll") for (int r = 0; r < 16; ++r) { if ((u[r] >> 21) == pre) __hip_atomic_fetch_add((ATT_LAS unsigned*)(lds + 148736) + (r32 * 32 + (((u[r] >> 11) ^ (unsigned)r32) & 31u)), 1u, __ATOMIC_RELAXED, __HIP_MEMORY_SCOPE_WORKGROUP); } } while (0)
#define IDX_B1(s) do { _Pragma("unroll") for (int r = 0; r < 16; ++r) { if ((u[r] >> 21) == pre) IDX_ADD((u[r] >> 10) & 2047u); } } while (0)
#if IDX_PROBE_P1
  { IDX_SWEEP(IDX_B1D); IDX_BAR(); }
#endif
  IDX_LOOP(IDX_B1);
  IDX_PREF();
  IDX_SCAN();
  unsigned krem;
  { const unsigned fbin = res[r32 * 4 + 0], fcnt = res[r32 * 4 + 2]; krem = res[r32 * 4 + 1]; pre = (pre << 11) | fbin; if (fcnt > IDX_CAP) res[129] = 1u; }
  IDX_BAR();
  if (res[129] == 0u) {
    ATT_LAS unsigned* cand = (ATT_LAS unsigned*)lds;
    ATT_LAS unsigned* ccnt = (ATT_LAS unsigned*)(lds + 4096);
    if (tid < 32) ccnt[tid] = 0u;
    IDX_BAR();
#define IDX_BM(s) do { unsigned bits_ = 0u; _Pragma("unroll") for (int r = 15; r >= 0; --r) { const unsigned p_ = u[r] >> 10; bits_ = (bits_ << 1) | (p_ > pre ? 1u : 0u); \
        if (p_ == pre) { const unsigned pos_ = __hip_atomic_fetch_add(ccnt + r32, 1u, __ATOMIC_RELAXED, __HIP_MEMORY_SCOPE_WORKGROUP); cand[r32 * IDX_CAP + (pos_ & (IDX_CAP - 1))] = ((u[r] & 1023u) << 12) | (4095u - (unsigned)(32 * (s) + crow(r, hi))); } } \
      *(ATT_GAS unsigned short*)((ATT_GAS char*)(mask16 + (size_t)((s) >> 1) * 16384 + ((s) & 1)) + moff) = (unsigned short)bits_; } while (0)
    IDX_LOOP(IDX_BM);
    asm volatile("s_waitcnt vmcnt(0)" ::: "memory");
    IDX_BAR();
    if (tid < 32) {
      const unsigned q = (unsigned)tid, cnt = ccnt[q], need = res[q * 4 + 1];
      const int qp = 64 * n + 32 * half + (int)q;
      for (unsigned j = 0; j < need && j < cnt; ++j) {
        unsigned best = 0u, bi = 0u;
        for (unsigned i = 0; i < cnt; ++i) { const unsigned c = cand[q * IDX_CAP + i]; if (c >= best) { best = c; bi = i; } }
        cand[q * IDX_CAP + bi] = 0u;
        if (j + 1 == need || true) { const unsigned kidx = 4095u - (best & 4095u), s2 = kidx >> 5, wi = kidx & 31u, hc = (wi >> 2) & 1u, rr = (wi & 3u) + 4u * (wi >> 3);
          __hip_atomic_fetch_or((ATT_GAS unsigned*)mask16 + (((size_t)(s2 >> 1) * 4096 + qp) * 2 + hc), 1u << (16u * (s2 & 1u) + rr), __ATOMIC_RELAXED, __HIP_MEMORY_SCOPE_AGENT); }
      }
    }
    (void)krem;
  } else {
    IDX_ZERO();
#define IDX_B2(s) do { _Pragma("unroll") for (int r = 0; r < 16; ++r) { if ((u[r] >> 10) == pre) IDX_ADD(u[r] & 1023u); } } while (0)
    IDX_LOOP(IDX_B2);
    IDX_SCAN();
    { const unsigned fbin = res[r32 * 4 + 0], frem = res[r32 * 4 + 1], fcnt = res[r32 * 4 + 2]; thr = (pre << 10) | fbin; needtie = frem < fcnt; if (needtie) res[128] = 1u; }
    IDX_BAR();
    if (res[128] != 0u) {
      IDX_ZERO();
#define IDX_B3(s) do { _Pragma("unroll") for (int r = 0; r < 16; ++r) { if (u[r] == thr) IDX_ADD(2047u - (unsigned)((32 * (s) + crow(r, hi)) >> 1)); } } while (0)
      IDX_SWEEP(IDX_B3);
      IDX_SCAN();
      { const unsigned fbin = res[r32 * 4 + 0], frem = res[r32 * 4 + 1], fcnt = res[r32 * 4 + 2]; const unsigned bt = 2047u - fbin; if (needtie) cut = (frem == 1u && fcnt == 2u) ? 2u * bt : 2u * bt + 1u; }
      IDX_BAR();
    }
#define IDX_BS(s) do { unsigned bits_ = 0u; _Pragma("unroll") for (int r = 15; r >= 0; --r) { const unsigned kidx_ = (unsigned)(32 * (s) + crow(r, hi)); const bool sel_ = (u[r] > thr) || (u[r] == thr && kidx_ <= cut); bits_ = (bits_ << 1) | (sel_ ? 1u : 0u); } \
      *(ATT_GAS unsigned short*)((ATT_GAS char*)(mask16 + (size_t)((s) >> 1) * 16384 + ((s) & 1)) + moff) = (unsigned short)bits_; } while (0)
    IDX_SWEEP(IDX_BS);
  }
#undef IDX_BAR
#undef IDX_ZERO
#undef IDX_SCAN
#undef IDX_B0
#undef IDX_B1
#undef IDX_B2
#undef IDX_B3
#undef IDX_BM
#undef IDX_BS
}
#undef IDX_SWEEP
#undef IDX_SWEEP0
#undef IDX_PREF
#undef IDX_PREF0
#undef IDX_LOOP
#undef IDX_LOOP0
#undef IDX_ADD
}

namespace attx {
using bf16=__hip_bfloat16;
using bf16x8=__attribute__((ext_vector_type(8)))short;
using s16x4=__attribute__((ext_vector_type(4)))short;
using f32x16=__attribute__((ext_vector_type(16)))float;
using u32x4=__attribute__((ext_vector_type(4)))unsigned;
using f32x4v=__attribute__((ext_vector_type(4)))float;
constexpr int D=64,NW=8,QBLK=32,QB=QBLK*NW,KVBLK=64;
__device__ __forceinline__ int crow(int r,int hi){return (r&3)+8*(r>>2)+4*hi;}
#define SBAR() __builtin_amdgcn_sched_barrier(0)
constexpr int NSLOT=3, SLOTB=8192;
constexpr int LDS_K=0, LDS_V=NSLOT*SLOTB, LDS_WS=2*NSLOT*SLOTB, LDS_OST=LDS_WS+NW*64*4, LDS_MSK=LDS_OST+NW*4096, LDS_TAB=LDS_MSK+4*2048, LDS_BYTES=LDS_TAB+384*4;
__device__ __forceinline__ void glds16(const void*gsrc,unsigned lds_dst){unsigned keep;
  asm volatile("s_mov_b32 %0, m0\n\ts_mov_b32 m0, %2\n\ts_nop 0\n\tglobal_load_lds_dwordx4 %1, off\n\ts_mov_b32 m0, %0":"=&s"(keep):"v"(gsrc),"s"(lds_dst):"memory");}
__device__ __forceinline__ void glds4(const void*gsrc,unsigned lds_dst){unsigned keep;
  asm volatile("s_mov_b32 %0, m0\n\ts_mov_b32 m0, %2\n\ts_nop 0\n\tglobal_load_lds_dword %1, off\n\ts_mov_b32 m0, %0":"=&s"(keep):"v"(gsrc),"s"(lds_dst):"memory");}
__device__ __forceinline__ float max3f(float a,float b,float c){float r;asm("v_max3_f32 %0, %1, %2, %3":"=v"(r):"v"(a),"v"(b),"v"(c));return r;}
__device__ __forceinline__ float max2f(float a,float b){float r;asm("v_max_f32_e32 %0, %1, %2":"=v"(r):"v"(a),"v"(b));return r;}
__device__ __forceinline__ float fadd_s(float a,float b){float r;asm("v_add_f32_e32 %0, %1, %2":"=v"(r):"v"(a),"v"(b));return r;}
__device__ __forceinline__ float fsub_s(float a,float b){float r;asm("v_sub_f32_e32 %0, %1, %2":"=v"(r):"v"(a),"v"(b));return r;}
typedef float f32x2_t __attribute__((ext_vector_type(2))); typedef __bf16 bf16x2_t __attribute__((ext_vector_type(2)));
__device__ __forceinline__ unsigned cvtpk_s(float lo,float hi){f32x2_t v={lo,hi};bf16x2_t b=__builtin_convertvector(v,bf16x2_t);return __builtin_bit_cast(unsigned,b);}
#define WAIT_BAR(N) asm volatile("s_waitcnt vmcnt(" #N ") lgkmcnt(0)\n\ts_barrier":::"memory")
__device__ __forceinline__ void qkt(f32x16&p0,f32x16&p1,const char*Kslot,const bf16x8*qr,const f32x16&negm,int r32,int hi){
  const char*kb=Kslot+hi*1024+r32*16;
  #pragma unroll
  for(int d0=0;d0<4;++d0){
    const bf16x8 b0=*reinterpret_cast<const bf16x8*>(kb+d0*2048);
    const bf16x8 b1=*reinterpret_cast<const bf16x8*>(kb+d0*2048+512);
    if(d0==0){p0=__builtin_amdgcn_mfma_f32_32x32x16_bf16(b0,qr[0],negm,0,0,0);p1=__builtin_amdgcn_mfma_f32_32x32x16_bf16(b1,qr[0],negm,0,0,0);}
    else{p0=__builtin_amdgcn_mfma_f32_32x32x16_bf16(b0,qr[d0],p0,0,0,0);p1=__builtin_amdgcn_mfma_f32_32x32x16_bf16(b1,qr[d0],p1,0,0,0);}}
}
typedef __attribute__((address_space(3))) const char* lds_cptr;
typedef short v4i16_t __attribute__((ext_vector_type(4)));
__device__ __forceinline__ void kload8(bf16x8*kf,lds_cptr kp){
  kf[0]=*(const __attribute__((address_space(3))) bf16x8*)(kp);      kf[1]=*(const __attribute__((address_space(3))) bf16x8*)(kp+512);
  kf[2]=*(const __attribute__((address_space(3))) bf16x8*)(kp+2048); kf[3]=*(const __attribute__((address_space(3))) bf16x8*)(kp+2560);
  kf[4]=*(const __attribute__((address_space(3))) bf16x8*)(kp+4096); kf[5]=*(const __attribute__((address_space(3))) bf16x8*)(kp+4608);
  kf[6]=*(const __attribute__((address_space(3))) bf16x8*)(kp+6144); kf[7]=*(const __attribute__((address_space(3))) bf16x8*)(kp+6656);
}
__device__ __forceinline__ void kload2(bf16x8*kf,lds_cptr kp,int j){ kf[2*j]=*(const __attribute__((address_space(3))) bf16x8*)(kp+j*2048); kf[2*j+1]=*(const __attribute__((address_space(3))) bf16x8*)(kp+j*2048+512); }
__device__ __forceinline__ s16x4 vtr(lds_cptr p){ return __builtin_bit_cast(s16x4,__builtin_amdgcn_ds_read_tr16_b64_v4i16((__attribute__((address_space(3))) v4i16_t*)p)); }
__device__ __forceinline__ float rowmax(const f32x16&p0,const f32x16&p1){
  float a=max3f(p0[0],p0[1],p1[0]),b=max3f(p0[2],p0[3],p1[1]);a=max3f(a,p1[2],p1[3]);
  #pragma unroll
  for(int r=4;r<16;r+=4){a=max3f(a,p0[r],p0[r+1]);b=max3f(b,p0[r+2],p0[r+3]);a=max3f(a,p1[r],p1[r+1]);b=max3f(b,p1[r+2],p1[r+3]);}
  const float m=max2f(a,b);
  auto rr=__builtin_amdgcn_permlane32_swap(__float_as_uint(m),__float_as_uint(m),false,false);
  return max2f(__uint_as_float(rr[0]),__uint_as_float(rr[1]));
}
__device__ __forceinline__ void pv(f32x16*o,int vb,bf16x8 pa0,bf16x8 pa1,bf16x8 pa2,bf16x8 pa3){
  #pragma unroll
  for(int d0=0;d0<2;++d0){s16x4 lo[4],hi[4];
    #pragma unroll
    for(int ks=0;ks<4;++ks){
      asm volatile("ds_read_b64_tr_b16 %0,%1 offset:%c2":"=&v"(lo[ks]):"v"(vb),"i"(d0*4096+ks*1024):"memory");
      asm volatile("ds_read_b64_tr_b16 %0,%1 offset:%c2":"=&v"(hi[ks]):"v"(vb),"i"(d0*4096+ks*1024+512):"memory");}
    asm volatile("s_waitcnt lgkmcnt(0)":::"memory");SBAR();
    #define PK(k) (bf16x8){lo[k][0],lo[k][1],lo[k][2],lo[k][3],hi[k][0],hi[k][1],hi[k][2],hi[k][3]}
    o[d0]=__builtin_amdgcn_mfma_f32_32x32x16_bf16(pa0,PK(0),o[d0],0,0,0);
    o[d0]=__builtin_amdgcn_mfma_f32_32x32x16_bf16(pa1,PK(1),o[d0],0,0,0);
    o[d0]=__builtin_amdgcn_mfma_f32_32x32x16_bf16(pa2,PK(2),o[d0],0,0,0);
    o[d0]=__builtin_amdgcn_mfma_f32_32x32x16_bf16(pa3,PK(3),o[d0],0,0,0);
    #undef PK
  }
}
struct UA {
  const bf16* Qw0; int ldq;
  const bf16* Kh; const bf16* Vh; int ldkv;
  bf16* Ow0; int ldo;
  int NT;
  int tabs0;
  int cq0;
  const float* relb;
  const unsigned* msk;
  int nomask;
};
#ifndef ATTN_STORE16
#define ATTN_STORE16(p,v) (*(__attribute__((address_space(1))) u32x4*)(p)=(v))
#endif
template<int MODE,int THRL> __device__ __forceinline__ void attn_unit(const UA& a,char*shm,int tid_in){
  int tid_l=tid_in; asm volatile("":"+v"(tid_l));
  const int tid=tid_l,lane=tid&63,r32=lane&31,hi=lane>>5; const int wid=__builtin_amdgcn_readfirstlane(tid>>6);
  const long ldq=a.ldq, ldkv=a.ldkv, ldo=a.ldo;
  const bf16*Qw=a.Qw0+(long)(wid*QBLK)*ldq;
  const bf16*Kh=a.Kh,*Vh=a.Vh;
  const unsigned lds0=(unsigned)(uintptr_t)shm;
  float*wsf=(float*)(shm+LDS_WS)+wid*64;
  const bf16*ksrc=Kh+(long)lane*ldkv+wid*8;
  const bf16*vsrc=Vh+(long)(16*(wid&3)+(lane>>2))*ldkv+(wid>>2)*32+(lane&3)*8;
  const unsigned kdst=lds0+LDS_K+wid*1024, vdst=lds0+LDS_V+wid*1024;
  const int cq=a.cq0+(wid>>1);
  const unsigned* msrc=a.msk+((long)a.cq0*64+wid*32)*2+lane;
  const unsigned mdst=lds0+LDS_MSK+wid*256;
  const __attribute__((address_space(3))) float* tab=(const __attribute__((address_space(3))) float*)(__attribute__((address_space(3))) char*)(shm+LDS_TAB);
  if(MODE==0){ __attribute__((address_space(3))) float* tw=(__attribute__((address_space(3))) float*)(__attribute__((address_space(3))) char*)(shm+LDS_TAB);
    for(int i=tid;i<384;i+=512) tw[i]=((const __attribute__((address_space(1))) float*)a.relb)[i<319?i:319]*1.4426950408889634f; }
  #define DMA_K(t,slot) glds16(ksrc+(long)(t)*KVBLK*ldkv,(unsigned)__builtin_amdgcn_readfirstlane(kdst+(slot)))
  #define DMA_V(t,slot) glds16(vsrc+(long)(t)*KVBLK*ldkv,(unsigned)__builtin_amdgcn_readfirstlane(vdst+(slot)))
  #define DMA_M(t) do{ if(MODE==1) glds4(msrc+(long)(a.tabs0+(t))*8192,(unsigned)__builtin_amdgcn_readfirstlane(mdst+(((t)&3)*2048))); }while(0)
  const int vb0=(int)(lds0+LDS_V)+((lane>>4)&1)*32+(lane&3)*8+(4*hi+((lane&15)>>2))*64;
  const char*Kbase=shm+LDS_K; bf16x8 kf[8];
  const lds_cptr shm3=(lds_cptr)shm; const lds_cptr kp0=shm3+LDS_K+hi*1024+r32*16; const lds_cptr vp0=shm3+LDS_V+((lane>>4)&1)*32+(lane&3)*8+(4*hi+((lane&15)>>2))*64;
  const lds_cptr mp0=shm3+LDS_MSK+wid*256+(r32*2+hi)*4;
  const int NT=a.NT;
  DMA_K(0,0);DMA_V(0,0);DMA_K(1,SLOTB);DMA_M(0);DMA_M(1);
  bf16x8 qr[4];
  #pragma unroll
  for(int d0=0;d0<4;++d0)qr[d0]=*(const __attribute__((address_space(1))) bf16x8*)(&Qw[(long)r32*ldq+d0*16+hi*8]);
  float mhat=0.f,l_reg=0.f;f32x16 o[2];o[0]=f32x16{};o[1]=f32x16{};f32x16 negm=f32x16{};asm volatile("":"+v"(negm));
  const int qi=(wid&1)*32+r32;
  #define HOOK(P0,P1,tl) do{ const int ta_=a.tabs0+(tl); \
    if(MODE==0){ const int dch_=cq-ta_; \
      if(dch_<0||dch_>8){ _Pragma("unroll") for(int r=0;r<16;++r){P0[r]=-INFINITY;P1[r]=-INFINITY;} } \
      else if(dch_>=5){ const float c_=tab[319]; _Pragma("unroll") for(int r=0;r<16;++r){P0[r]+=c_;P1[r]+=c_;} } \
      else{ int ll_=lane; asm volatile("":"+v"(ll_)); const __attribute__((address_space(3))) float* tp_=tab+(64*dch_+(wid&1)*32+(ll_&31)+4-4*(ll_>>5)); _Pragma("unroll") for(int r=0;r<16;++r){ P0[r]+=tp_[59-((r&3)+8*(r>>2))]; P1[r]+=tp_[27-((r&3)+8*(r>>2))]; } } } \
    else if(MODE==1){ \
      if(ta_>cq){ _Pragma("unroll") for(int r=0;r<16;++r){P0[r]=-INFINITY;P1[r]=-INFINITY;} } \
      else if(!a.nomask){ const unsigned mw_=*(const __attribute__((address_space(3))) unsigned*)(mp0+(((tl)&3)*2048)); \
        _Pragma("unroll") for(int r=0;r<16;++r){ P0[r]=((int)(mw_<<(31-r))<0)?P0[r]:-INFINITY; P1[r]=((int)(mw_<<(15-r))<0)?P1[r]:-INFINITY; } } } \
    else if(MODE==3){ if(ta_>cq){ _Pragma("unroll") for(int r=0;r<16;++r){P0[r]=-INFINITY;P1[r]=-INFINITY;} } } \
  }while(0)
  bool resc=false;
  #define START(P0,P1) do{ const float rm=rowmax(P0,P1); resc=false; \
    { const float dl=(rm>-1e30f)?rm:0.f; mhat=fadd_s(mhat,dl); \
      _Pragma("unroll") for(int r=0;r<16;++r){P0[r]=fsub_s(P0[r],dl);P1[r]=fsub_s(P1[r],dl);} \
      _Pragma("unroll") for(int r=0;r<16;++r)negm[r]=-mhat; asm volatile("":"+v"(negm)); } \
    _Pragma("unroll") for(int r=0;r<16;++r)P0[r]=__builtin_amdgcn_exp2f(P0[r]); }while(0)
  #define RESC() do{ if(resc){ asm volatile("s_waitcnt lgkmcnt(0)":::"memory"); int hl_=lane>>5; asm volatile("":"+v"(hl_)); const float* wq_=(const float*)(shm+LDS_WS)+wid*64+4*hl_; \
      _Pragma("unroll") for(int d_=0;d_<2;++d_) _Pragma("unroll") for(int r=0;r<16;++r)o[d_][r]*=wq_[(r&3)+8*(r>>2)]; } }while(0)
  f32x16 pA0,pA1,pB0,pB1;
  int sl_prev=0,sl_cur=0,sl_next=SLOTB;
  #define ROT() do{sl_prev=sl_cur;sl_cur=sl_next;sl_next=(sl_next==(NSLOT-1)*SLOTB)?0:sl_next+SLOTB;}while(0)
  DMA_K(2,2*SLOTB);
  WAIT_BAR(0);
  qkt(pA0,pA1,Kbase,qr,negm,r32,hi);asm volatile("s_nop 15\n\ts_nop 7":"+v"(pA0),"+v"(pA1));HOOK(pA0,pA1,0);
  START(pA0,pA1);
  _Pragma("unroll") for(int r=0;r<16;++r)pA1[r]=__builtin_amdgcn_exp2f(pA1[r]);
  WAIT_BAR(0);
  DMA_K(3,0);DMA_V(1,SLOTB);DMA_M(2);
  ROT();
  kload8(kf,kp0+sl_cur);
  if(MODE==1){WAIT_BAR(3);}else{WAIT_BAR(2);}
  s16x4 vlo[8],vhi[8]; u32x4 pw0,pw1,pw2,pw3;
  #define PKW(P,B) cvtpk_s(P[B],P[B+1])
  #define PAF(k) __builtin_bit_cast(bf16x8,pw##k)
  #define VFR(i) (bf16x8){vlo[i][0],vlo[i][1],vlo[i][2],vlo[i][3],vhi[i][0],vhi[i][1],vhi[i][2],vhi[i][3]}
  #define PIN(x) asm volatile("":"+v"(x))
  #define MX3(a,b,c) __builtin_fmaxf(__builtin_fmaxf((a),(b)),(c))
  #define GAPA(MF,A0,A1,A2,A3,W0,W1,PW) do{ MF; sacc+=A0; sacc+=A1; sacc+=A2; sacc+=A3; PIN(sacc); W0; W1; PIN(PW); SBAR(); }while(0)
  #define EX(v) __builtin_amdgcn_exp2f(v)
  #define GAPB(MF,X,B) do{ MF; X[B]=EX(X[B]); X[B+1]=EX(X[B+1]); X[B+2]=EX(X[B+2]); X[B+3]=EX(X[B+3]); PIN(X); SBAR(); }while(0)
  #define VRD(i) do{ vlo[i]=vtr(vp_+(((i)>>2)*4096+((i)&3)*1024)); vhi[i]=vtr(vp_+(((i)>>2)*4096+((i)&3)*1024+512)); }while(0)
  #define KRD(G,j) do{ if(G){ kload2(kf,kp0+sl_next,j); SBAR(); } }while(0)
  #define STEP(C0,C1,P0,P1,t,GK,GV,GL,GM) do{ SBAR(); \
    const lds_cptr vp_=vp0+sl_prev; \
    VRD(0); SBAR(); float sacc=(P0[0]+P0[1]); \
    GAPA(C0=__builtin_amdgcn_mfma_f32_32x32x16_bf16(kf[0],qr[0],negm,0,0,0), P0[2],P0[3],P0[4],P0[5],     pw0[0]=PKW(P0,0), pw0[1]=PKW(P0,2), pw0); \
    VRD(4); SBAR(); GAPA(C1=__builtin_amdgcn_mfma_f32_32x32x16_bf16(kf[1],qr[0],negm,0,0,0), P0[6],P0[7],P0[8],P0[9],     pw0[2]=PKW(P0,4), pw0[3]=PKW(P0,6), pw0); \
    VRD(1); SBAR(); GAPA(C0=__builtin_amdgcn_mfma_f32_32x32x16_bf16(kf[2],qr[1],C0,0,0,0),   P0[10],P0[11],P0[12],P0[13], pw1[0]=PKW(P0,8), pw1[1]=PKW(P0,10), pw1); \
    VRD(5); SBAR(); GAPA(C1=__builtin_amdgcn_mfma_f32_32x32x16_bf16(kf[3],qr[1],C1,0,0,0),   P0[14],P0[15],P1[0],P1[1],   pw1[2]=PKW(P0,12),pw1[3]=PKW(P0,14), pw1); \
    VRD(2); SBAR(); GAPA(C0=__builtin_amdgcn_mfma_f32_32x32x16_bf16(kf[4],qr[2],C0,0,0,0),   P1[2],P1[3],P1[4],P1[5],     pw2[0]=PKW(P1,0), pw2[1]=PKW(P1,2), pw2); \
    VRD(6); SBAR(); GAPA(C1=__builtin_amdgcn_mfma_f32_32x32x16_bf16(kf[5],qr[2],C1,0,0,0),   P1[6],P1[7],P1[8],P1[9],     pw2[2]=PKW(P1,4), pw2[3]=PKW(P1,6), pw2); \
    VRD(3); SBAR(); GAPA(C0=__builtin_amdgcn_mfma_f32_32x32x16_bf16(kf[6],qr[3],C0,0,0,0),   P1[10],P1[11],P1[12],P1[13], pw3[0]=PKW(P1,8), pw3[1]=PKW(P1,10), pw3); \
    VRD(7); SBAR(); GAPA(C1=__builtin_amdgcn_mfma_f32_32x32x16_bf16(kf[7],qr[3],C1,0,0,0),   P1[14],P1[15],0.f,0.f,       pw3[2]=PKW(P1,12),pw3[3]=PKW(P1,14), pw3); \
    l_reg+=sacc; \
    if(GK){DMA_K((t)+3,sl_cur);} if(GV){DMA_V((t)+1,sl_next);} if(GM){DMA_M((t)+2);} \
    HOOK(C0,C1,t); \
    { float a_=MX3(C0[0],C0[1],C1[0]),b_=MX3(C0[2],C0[3],C1[1]); a_=MX3(a_,C1[2],C1[3]); \
      _Pragma("unroll") for(int r=4;r<16;r+=4){a_=MX3(a_,C0[r],C0[r+1]);b_=MX3(b_,C0[r+2],C0[r+3]);a_=MX3(a_,C1[r],C1[r+1]);b_=MX3(b_,C1[r+2],C1[r+3]);} \
      float rm=__builtin_fmaxf(a_,b_); { auto rr=__builtin_amdgcn_permlane32_swap(__float_as_uint(rm),__float_as_uint(rm),false,false); rm=__builtin_fmaxf(__uint_as_float(rr[0]),__uint_as_float(rr[1])); } \
      resc=false; \
      if(__builtin_expect(__any(rm>(float)THRL),0)){ const float dl=__builtin_fmaxf(rm,0.f); mhat+=dl; \
        _Pragma("unroll") for(int r=0;r<16;++r){C0[r]-=dl;C1[r]-=dl;} \
        _Pragma("unroll") for(int r=0;r<16;++r)negm[r]=-mhat; asm volatile("":"+v"(negm)); \
        const float f=__builtin_amdgcn_exp2f(-dl); l_reg*=f; { int rl_=lane; asm volatile("":"+v"(rl_)); if(rl_<32)((float*)(shm+LDS_WS))[wid*64+rl_]=f; } resc=true; } } \
    SBAR(); \
    GAPB(o[0]=__builtin_amdgcn_mfma_f32_32x32x16_bf16(PAF(0),VFR(0),o[0],0,0,0), C0,0); \
    GAPB(o[1]=__builtin_amdgcn_mfma_f32_32x32x16_bf16(PAF(0),VFR(4),o[1],0,0,0), C0,4); \
    KRD(GL,0); GAPB(o[0]=__builtin_amdgcn_mfma_f32_32x32x16_bf16(PAF(1),VFR(1),o[0],0,0,0), C0,8); \
    KRD(GL,1); GAPB(o[1]=__builtin_amdgcn_mfma_f32_32x32x16_bf16(PAF(1),VFR(5),o[1],0,0,0), C0,12); \
    KRD(GL,2); GAPB(o[0]=__builtin_amdgcn_mfma_f32_32x32x16_bf16(PAF(2),VFR(2),o[0],0,0,0), C1,0); \
    KRD(GL,3); GAPB(o[1]=__builtin_amdgcn_mfma_f32_32x32x16_bf16(PAF(2),VFR(6),o[1],0,0,0), C1,4); \
    GAPB(o[0]=__builtin_amdgcn_mfma_f32_32x32x16_bf16(PAF(3),VFR(3),o[0],0,0,0), C1,8); \
    GAPB(o[1]=__builtin_amdgcn_mfma_f32_32x32x16_bf16(PAF(3),VFR(7),o[1],0,0,0), C1,12); \
    }while(0)
  #define WSTD() do{ if(MODE==1){WAIT_BAR(3);}else{WAIT_BAR(2);} }while(0)
  #define ENDW(tt) do{ if((tt)+3<NT){WSTD();} else if((tt)+2<NT){ if(MODE==1){WAIT_BAR(2);}else{WAIT_BAR(1);} } else {WAIT_BAR(0);} }while(0)
  int t=1;
  for(;t+5<NT;t+=2){
    STEP(pB0,pB1,pA0,pA1,t,true,true,true,true);     WSTD(); RESC(); ROT();
    STEP(pA0,pA1,pB0,pB1,t+1,true,true,true,true);   WSTD(); RESC(); ROT();
  }
  for(;t+1<NT;t+=2){
    STEP(pB0,pB1,pA0,pA1,t,(t+3<NT),(t+1<NT),(t+1<NT),(t+2<NT));       ENDW(t);   RESC(); ROT();
    STEP(pA0,pA1,pB0,pB1,t+1,(t+4<NT),(t+2<NT),(t+2<NT),(t+3<NT));     ENDW(t+1); RESC(); ROT();
  }
  STEP(pB0,pB1,pA0,pA1,NT-1,false,false,false,false); RESC();
  { float sacc=pB0[0]+pB0[1]; _Pragma("unroll") for(int r=2;r<16;++r)sacc+=pB0[r]; _Pragma("unroll") for(int r=0;r<16;++r)sacc+=pB1[r]; l_reg+=sacc;
    pw0=(u32x4){PKW(pB0,0),PKW(pB0,2),PKW(pB0,4),PKW(pB0,6)};pw1=(u32x4){PKW(pB0,8),PKW(pB0,10),PKW(pB0,12),PKW(pB0,14)};pw2=(u32x4){PKW(pB1,0),PKW(pB1,2),PKW(pB1,4),PKW(pB1,6)};pw3=(u32x4){PKW(pB1,8),PKW(pB1,10),PKW(pB1,12),PKW(pB1,14)};
    SBAR(); pv(o,vb0+sl_cur,PAF(0),PAF(1),PAF(2),PAF(3)); }
  #undef PKW
  #undef PAF
  #undef VFR
  #undef PIN
  #undef MX3
  #undef GAPA
  #undef GAPB
  #undef EX
  #undef VRD
  #undef KRD
  #undef STEP
  #undef ENDW
  #undef WSTD
  {auto rr=__builtin_amdgcn_permlane32_swap(__float_as_uint(l_reg),__float_as_uint(l_reg),false,false);l_reg=__uint_as_float(rr[0])+__uint_as_float(rr[1]);}
  if(hi==0)wsf[32+r32]=l_reg;asm volatile("s_waitcnt lgkmcnt(0)":::"memory");
  float rli[16];
  #pragma unroll
  for(int r=0;r<16;++r)rli[r]=__builtin_amdgcn_rcpf(wsf[32+crow(r,hi)]);
  bf16*Ow=a.Ow0+(long)(wid*QBLK)*ldo;
  { bf16*stg=(bf16*)(shm+LDS_OST)+wid*2048;
    #pragma unroll
    for(int r=0;r<16;++r){const int orow=crow(r,hi);
      #pragma unroll
      for(int d0=0;d0<2;++d0)stg[orow*64+d0*32+r32]=__float2bfloat16(o[d0][r]*rli[r]);}
    asm volatile("s_waitcnt lgkmcnt(0)":::"memory");
    #pragma unroll
    for(int i=0;i<4;++i){const int row=i*8+(lane>>3),ch=lane&7; const u32x4 v=*(const u32x4*)(stg+row*64+ch*8); ATTN_STORE16(Ow+(long)row*ldo+ch*8,v);} }
  asm volatile("s_waitcnt lgkmcnt(0)\n\ts_barrier":::"memory");
  #undef DMA_K
  #undef DMA_V
  #undef DMA_M
  #undef HOOK
  #undef START
  #undef RESC
  #undef ROT
}

struct UB { const bf16* Q; const bf16* K; const bf16* V; bf16* O;
  int qt;
  const float* subln; float lam, oscale; };
constexpr int B_SLOT=16384, B_LDS_K=0, B_LDS_V=3*B_SLOT, B_LDS_WS=6*B_SLOT, B_XROW=132;
template<int THRL> __device__ __forceinline__ void attn_unit_b2(const UB& a,char*shm,int tid_in){
  int tid_l=tid_in; asm volatile("":"+v"(tid_l));
  const int tid=tid_l,lane=tid&63,r32=lane&31,hi=lane>>5; const int wid=__builtin_amdgcn_readfirstlane(tid>>6);
  const int c=wid>>2, wq=wid&3;
  const int q0=128*a.qt;
  const int NT=(2*a.qt+2<4)?4:2*a.qt+2;
  const int cq=2*a.qt+(wq>>1);
  const bf16*Qw=a.Q+(long)(q0+32*wq)*512+c*64;
  const unsigned lds0=(unsigned)(uintptr_t)shm;
  float*wsf=(float*)(shm+B_LDS_WS)+wid*64;
  const bf16*ksrc=a.K+(long)lane*512+wid*8;
  const bf16*vsrc=a.V+(long)(16*(wid&3)+(lane>>2))*512+(wid>>2)*32+(lane&3)*8;
  const unsigned kdst=lds0+B_LDS_K+wid*1024, vdst=lds0+B_LDS_V+wid*1024;
  #define DMA_K(t,slot) do{ glds16(ksrc+(long)(t)*KVBLK*512,(unsigned)__builtin_amdgcn_readfirstlane(kdst+(slot))); glds16(ksrc+(long)(t)*KVBLK*512+64,(unsigned)__builtin_amdgcn_readfirstlane(kdst+(slot)+8192u)); }while(0)
  #define DMA_V(t,slot) do{ glds16(vsrc+(long)(t)*KVBLK*512,(unsigned)__builtin_amdgcn_readfirstlane(vdst+(slot))); glds16(vsrc+(long)(t)*KVBLK*512+64,(unsigned)__builtin_amdgcn_readfirstlane(vdst+(slot)+8192u)); }while(0)
  const int vb0=(int)(lds0+B_LDS_V)+((lane>>4)&1)*32+(lane&3)*8+(4*hi+((lane&15)>>2))*64;
  const char*Kbase=shm+B_LDS_K+c*8192; bf16x8 kf[8];
  const lds_cptr shm3=(lds_cptr)shm; const lds_cptr kp0=shm3+B_LDS_K+c*8192+hi*1024+r32*16; const lds_cptr vp0=shm3+B_LDS_V+((lane>>4)&1)*32+(lane&3)*8+(4*hi+((lane&15)>>2))*64;
  DMA_K(0,0);DMA_V(0,0);DMA_K(1,B_SLOT);
  bf16x8 qr[4];
  #pragma unroll
  for(int d0=0;d0<4;++d0)qr[d0]=*(const __attribute__((address_space(1))) bf16x8*)(&Qw[(long)r32*512+d0*16+hi*8]);
  float mhat=0.f,l_reg=0.f;f32x16 o[4];o[0]=f32x16{};o[1]=f32x16{};o[2]=f32x16{};o[3]=f32x16{};f32x16 negm=f32x16{};asm volatile("":"+v"(negm));
  #define HOOK(P0,P1,tl) do{ if((tl)>cq){ _Pragma("unroll") for(int r=0;r<16;++r){P0[r]=-INFINITY;P1[r]=-INFINITY;} } }while(0)
  bool resc=false;
  #define START(P0,P1) do{ const float rm=rowmax(P0,P1); resc=false; \
    { const float dl=(rm>-1e30f)?rm:0.f; mhat=fadd_s(mhat,dl); \
      _Pragma("unroll") for(int r=0;r<16;++r){P0[r]=fsub_s(P0[r],dl);P1[r]=fsub_s(P1[r],dl);} \
      _Pragma("unroll") for(int r=0;r<16;++r)negm[r]=-mhat; asm volatile("":"+v"(negm)); } \
    _Pragma("unroll") for(int r=0;r<16;++r)P0[r]=__builtin_amdgcn_exp2f(P0[r]); }while(0)
  #define RESC() do{ if(resc){ asm volatile("s_waitcnt lgkmcnt(0)":::"memory"); int hl_=lane>>5; asm volatile("":"+v"(hl_)); const float* wq_=(const float*)(shm+B_LDS_WS)+wid*64+4*hl_; \
      _Pragma("unroll") for(int d_=0;d_<4;++d_) _Pragma("unroll") for(int r=0;r<16;++r)o[d_][r]*=wq_[(r&3)+8*(r>>2)]; } }while(0)
  f32x16 pA0,pA1,pB0,pB1;
  int sl_prev=0,sl_cur=0,sl_next=B_SLOT;
  #define ROT() do{sl_prev=sl_cur;sl_cur=sl_next;sl_next=(sl_next==2*B_SLOT)?0:sl_next+B_SLOT;}while(0)
  DMA_K(2,2*B_SLOT);
  WAIT_BAR(0);
  qkt(pA0,pA1,Kbase,qr,negm,r32,hi);asm volatile("s_nop 15\n\ts_nop 7":"+v"(pA0),"+v"(pA1));HOOK(pA0,pA1,0);
  START(pA0,pA1);
  _Pragma("unroll") for(int r=0;r<16;++r)pA1[r]=__builtin_amdgcn_exp2f(pA1[r]);
  WAIT_BAR(0);
  DMA_K(3,0);DMA_V(1,B_SLOT);
  ROT();
  kload8(kf,kp0+sl_cur);
  WAIT_BAR(4);
  s16x4 valo,vahi,vblo,vbhi; u32x4 pw0,pw1,pw2,pw3;
  #define PKW(P,B) cvtpk_s(P[B],P[B+1])
  #define PAF(k) __builtin_bit_cast(bf16x8,pw##k)
  #define PIN(x) asm volatile("":"+v"(x))
  #define MX3(a,b,c) __builtin_fmaxf(__builtin_fmaxf((a),(b)),(c))
  #define GAPA(MF,A0,A1,A2,A3,W0,W1,PW) do{ MF; sacc+=A0; sacc+=A1; sacc+=A2; sacc+=A3; PIN(sacc); W0; W1; PIN(PW); SBAR(); }while(0)
  #define EX(v) __builtin_amdgcn_exp2f(v)
  #define VOFF(m) (((((m)&3)>>1)*8192)+((((m)&3)&1)*4+((m)>>2))*1024)
  #define VLDA(m) do{ valo=vtr(vp_+VOFF(m)); vahi=vtr(vp_+VOFF(m)+512); }while(0)
  #define VLDB(m) do{ vblo=vtr(vp_+VOFF(m)); vbhi=vtr(vp_+VOFF(m)+512); }while(0)
  #define VFA (bf16x8){valo[0],valo[1],valo[2],valo[3],vahi[0],vahi[1],vahi[2],vahi[3]}
  #define VFB (bf16x8){vblo[0],vblo[1],vblo[2],vblo[3],vbhi[0],vbhi[1],vbhi[2],vbhi[3]}
  #define GAPB2(MF,X,B) do{ MF; X[B]=EX(X[B]); X[B+1]=EX(X[B+1]); PIN(X); SBAR(); }while(0)
  #define KRD(G,j) do{ if(G){ kload2(kf,kp0+sl_next,j); SBAR(); } }while(0)
  #define PVE(m,PA,X,B) do{ VLDB((m)+1); SBAR(); GAPB2(o[(m)&3]=__builtin_amdgcn_mfma_f32_32x32x16_bf16(PA,VFA,o[(m)&3],0,0,0),X,B); }while(0)
  #define PVO(m,PA,X,B,LAST) do{ if(!(LAST)){VLDA((m)+1);} SBAR(); GAPB2(o[(m)&3]=__builtin_amdgcn_mfma_f32_32x32x16_bf16(PA,VFB,o[(m)&3],0,0,0),X,B); }while(0)
  #define STEP(C0,C1,P0,P1,t,GK,GV,GL) do{ SBAR(); \
    const lds_cptr vp_=vp0+sl_prev; \
    float sacc=(P0[0]+P0[1]); \
    GAPA(C0=__builtin_amdgcn_mfma_f32_32x32x16_bf16(kf[0],qr[0],negm,0,0,0), P0[2],P0[3],P0[4],P0[5],     pw0[0]=PKW(P0,0), pw0[1]=PKW(P0,2), pw0); \
    GAPA(C1=__builtin_amdgcn_mfma_f32_32x32x16_bf16(kf[1],qr[0],negm,0,0,0), P0[6],P0[7],P0[8],P0[9],     pw0[2]=PKW(P0,4), pw0[3]=PKW(P0,6), pw0); \
    GAPA(C0=__builtin_amdgcn_mfma_f32_32x32x16_bf16(kf[2],qr[1],C0,0,0,0),   P0[10],P0[11],P0[12],P0[13], pw1[0]=PKW(P0,8), pw1[1]=PKW(P0,10), pw1); \
    GAPA(C1=__builtin_amdgcn_mfma_f32_32x32x16_bf16(kf[3],qr[1],C1,0,0,0),   P0[14],P0[15],P1[0],P1[1],   pw1[2]=PKW(P0,12),pw1[3]=PKW(P0,14), pw1); \
    GAPA(C0=__builtin_amdgcn_mfma_f32_32x32x16_bf16(kf[4],qr[2],C0,0,0,0),   P1[2],P1[3],P1[4],P1[5],     pw2[0]=PKW(P1,0), pw2[1]=PKW(P1,2), pw2); \
    GAPA(C1=__builtin_amdgcn_mfma_f32_32x32x16_bf16(kf[5],qr[2],C1,0,0,0),   P1[6],P1[7],P1[8],P1[9],     pw2[2]=PKW(P1,4), pw2[3]=PKW(P1,6), pw2); \
    GAPA(C0=__builtin_amdgcn_mfma_f32_32x32x16_bf16(kf[6],qr[3],C0,0,0,0),   P1[10],P1[11],P1[12],P1[13], pw3[0]=PKW(P1,8), pw3[1]=PKW(P1,10), pw3); \
    VLDA(0); SBAR(); \
    GAPA(C1=__builtin_amdgcn_mfma_f32_32x32x16_bf16(kf[7],qr[3],C1,0,0,0),   P1[14],P1[15],0.f,0.f,       pw3[2]=PKW(P1,12),pw3[3]=PKW(P1,14), pw3); \
    l_reg+=sacc; \
    if(GK){DMA_K((t)+3,sl_cur);} if(GV){DMA_V((t)+1,sl_next);} \
    HOOK(C0,C1,t); \
    { float a_=MX3(C0[0],C0[1],C1[0]),b_=MX3(C0[2],C0[3],C1[1]); a_=MX3(a_,C1[2],C1[3]); \
      _Pragma("unroll") for(int r=4;r<16;r+=4){a_=MX3(a_,C0[r],C0[r+1]);b_=MX3(b_,C0[r+2],C0[r+3]);a_=MX3(a_,C1[r],C1[r+1]);b_=MX3(b_,C1[r+2],C1[r+3]);} \
      float rm=__builtin_fmaxf(a_,b_); { auto rr=__builtin_amdgcn_permlane32_swap(__float_as_uint(rm),__float_as_uint(rm),false,false); rm=__builtin_fmaxf(__uint_as_float(rr[0]),__uint_as_float(rr[1])); } \
      resc=false; \
      if(__builtin_expect(__any(rm>(float)THRL),0)){ const float dl=__builtin_fmaxf(rm,0.f); mhat+=dl; \
        _Pragma("unroll") for(int r=0;r<16;++r){C0[r]-=dl;C1[r]-=dl;} \
        _Pragma("unroll") for(int r=0;r<16;++r)negm[r]=-mhat; asm volatile("":"+v"(negm)); \
        const float f=__builtin_amdgcn_exp2f(-dl); l_reg*=f; { int rl_=lane; asm volatile("":"+v"(rl_)); if(rl_<32)((float*)(shm+B_LDS_WS))[wid*64+rl_]=f; } resc=true; } } \
    SBAR(); \
    PVE(0,PAF(0),C0,0);  PVO(1,PAF(0),C0,2,false);  PVE(2,PAF(0),C0,4);  PVO(3,PAF(0),C0,6,false); \
    KRD(GL,0); PVE(4,PAF(1),C0,8);  PVO(5,PAF(1),C0,10,false); KRD(GL,1); PVE(6,PAF(1),C0,12); PVO(7,PAF(1),C0,14,false); \
    KRD(GL,2); PVE(8,PAF(2),C1,0);  PVO(9,PAF(2),C1,2,false);  KRD(GL,3); PVE(10,PAF(2),C1,4); PVO(11,PAF(2),C1,6,false); \
    PVE(12,PAF(3),C1,8); PVO(13,PAF(3),C1,10,false); PVE(14,PAF(3),C1,12); PVO(15,PAF(3),C1,14,true); \
    }while(0)
  #define ENDW(tt) do{ if((tt)+3<NT){WAIT_BAR(4);} else if((tt)+2<NT){WAIT_BAR(2);} else {WAIT_BAR(0);} }while(0)
  int t=1;
  for(;t+5<NT;t+=2){
    STEP(pB0,pB1,pA0,pA1,t,true,true,true);     WAIT_BAR(4); RESC(); ROT();
    STEP(pA0,pA1,pB0,pB1,t+1,true,true,true);   WAIT_BAR(4); RESC(); ROT();
  }
  for(;t+1<NT;t+=2){
    STEP(pB0,pB1,pA0,pA1,t,(t+3<NT),(t+1<NT),(t+1<NT));       ENDW(t);   RESC(); ROT();
    STEP(pA0,pA1,pB0,pB1,t+1,(t+4<NT),(t+2<NT),(t+2<NT));     ENDW(t+1); RESC(); ROT();
  }
  STEP(pB0,pB1,pA0,pA1,NT-1,false,false,false); RESC();
  { float sacc=pB0[0]+pB0[1]; _Pragma("unroll") for(int r=2;r<16;++r)sacc+=pB0[r]; _Pragma("unroll") for(int r=0;r<16;++r)sacc+=pB1[r]; l_reg+=sacc;
    pw0=(u32x4){PKW(pB0,0),PKW(pB0,2),PKW(pB0,4),PKW(pB0,6)};pw1=(u32x4){PKW(pB0,8),PKW(pB0,10),PKW(pB0,12),PKW(pB0,14)};pw2=(u32x4){PKW(pB1,0),PKW(pB1,2),PKW(pB1,4),PKW(pB1,6)};pw3=(u32x4){PKW(pB1,8),PKW(pB1,10),PKW(pB1,12),PKW(pB1,14)};
    SBAR(); pv(o,vb0+sl_cur,PAF(0),PAF(1),PAF(2),PAF(3)); pv(o+2,vb0+sl_cur+8192,PAF(0),PAF(1),PAF(2),PAF(3)); }
  #undef PKW
  #undef PAF
  #undef PIN
  #undef MX3
  #undef GAPA
  #undef EX
  #undef VOFF
  #undef VLDA
  #undef VLDB
  #undef VFA
  #undef VFB
  #undef GAPB2
  #undef KRD
  #undef PVE
  #undef PVO
  #undef STEP
  #undef ENDW
  {auto rr=__builtin_amdgcn_permlane32_swap(__float_as_uint(l_reg),__float_as_uint(l_reg),false,false);l_reg=__uint_as_float(rr[0])+__uint_as_float(rr[1]);}
  if(hi==0)wsf[32+r32]=l_reg;asm volatile("s_waitcnt lgkmcnt(0)":::"memory");
  float rli[16];
  #pragma unroll
  for(int r=0;r<16;++r)rli[r]=__builtin_amdgcn_rcpf(wsf[32+crow(r,hi)]);
  asm volatile("s_waitcnt lgkmcnt(0)\n\ts_barrier":::"memory");
  float*xw=(float*)shm+(long)wq*32*B_XROW;
  if(c==1){
    #pragma unroll
    for(int r=0;r<16;++r){const int row=crow(r,hi);
      #pragma unroll
      for(int d=0;d<4;++d)xw[row*B_XROW+32*d+r32]=o[d][r]*rli[r];}
  }
  asm volatile("s_waitcnt lgkmcnt(0)\n\ts_barrier":::"memory");
  if(c==0){
    #pragma unroll
    for(int r=0;r<16;++r){const int row=crow(r,hi);
      #pragma unroll
      for(int d=0;d<4;++d){float*p=xw+row*B_XROW+32*d+r32; *p=o[d][r]*rli[r]-a.lam*(*p);} }
    asm volatile("s_waitcnt lgkmcnt(0)":::"memory");
    const int row=lane>>1, hf=lane&1; const float*rp=xw+row*B_XROW+64*hf;
    f32x4v dv[16]; float ss=0.f;
    #pragma unroll
    for(int j=0;j<16;++j){dv[j]=*(const f32x4v*)(rp+4*j); ss+=(dv[j][0]*dv[j][0]+dv[j][1]*dv[j][1])+(dv[j][2]*dv[j][2]+dv[j][3]*dv[j][3]);}
    ss+=__shfl_xor(ss,1);
    const float rs=1.0f/sqrtf(ss*(1.0f/128.0f)+1e-6f);
    bf16*orow=a.O+(long)(q0+32*wq+row)*512+64*hf;
    #pragma unroll
    for(int j=0;j<8;++j){
      u32x4 w; w.x=cvtpk_s(dv[2*j][0]*rs,dv[2*j][1]*rs); w.y=cvtpk_s(dv[2*j][2]*rs,dv[2*j][3]*rs); w.z=cvtpk_s(dv[2*j+1][0]*rs,dv[2*j+1][1]*rs); w.w=cvtpk_s(dv[2*j+1][2]*rs,dv[2*j+1][3]*rs);
      ATTN_STORE16(orow+8*j,w); }
  }
  asm volatile("s_waitcnt lgkmcnt(0)\n\ts_barrier":::"memory");
  #undef DMA_K
  #undef DMA_V
  #undef HOOK
  #undef START
  #undef RESC
  #undef ROT
}
#undef SBAR
#undef WAIT_BAR
}

constexpr int NWAVES = 8;
constexpr int NB = 16, SEQ = 4096, DM = 1024, DEPTH = 4, R = NB * SEQ;
constexpr int GB = 8, RG = GB * SEQ, NGRP = NB / GB;
constexpr int NIN = 8004, NINP = 8192, DFF = 2816, MEMLEN = 256;
constexpr float RMS_EPS = 1e-6f;
constexpr float QSCALE = 0.125f * 1.4426950408889634f;
constexpr size_t MiB = 1u << 20;
constexpr size_t WS_CTL = 0, CTL_ZERO_BYTES = 1 * MiB;
constexpr size_t WS_ROPE = 1 * MiB;
constexpr size_t WS_SCAL = 2 * MiB;
constexpr size_t WS_WKV = 3 * MiB;
constexpr size_t WS_MN = 7 * MiB;
constexpr size_t WS_KVX = 15 * MiB;
constexpr size_t WS_WL = 32 * MiB;
constexpr size_t WL_WIN = 0, WL_WUP = 16 * MiB, WL_WOUT = 19 * MiB, WL_WQX = 21 * MiB, WL_WOX = 21 * MiB + 512 * 1024, WL_WGU = 22 * MiB, WL_WDN = 33 * MiB;
constexpr size_t WS_XN = 72 * MiB;
constexpr size_t WS_MIX = 200 * MiB;
constexpr size_t WS_QKV = WS_MIX;
constexpr size_t QKV_STRIDE = (size_t)RG * 512;
constexpr size_t WS_QI = WS_MIX + 288 * MiB, WS_KI = WS_MIX + 304 * MiB;
constexpr size_t WS_GATES = WS_MIX + 320 * MiB;
constexpr size_t WS_Y = WS_MIX + 512 * MiB;
constexpr size_t WS_MASK = WS_MIX + 576 * MiB;
constexpr size_t WS_H = WS_MIX;
constexpr size_t WS_QX = WS_MIX + 400 * MiB;
constexpr size_t WS_OBUF = WS_MIX + 592 * MiB;
constexpr size_t WS_SS = WS_MIX + 688 * MiB;
constexpr size_t WS_XS = WS_MIX + 692 * MiB;
constexpr size_t WS_END = WS_MIX + 820 * MiB;
static_assert(WS_WL + WL_WDN + (size_t)1024 * DFF * 2 <= WS_XN && WS_XN + (size_t)R * DM * 2 <= WS_MIX && WS_H + (size_t)R * DFF * 2 <= WS_QX && WS_MASK + (size_t)GB * 64 * 4096 * 8 <= WS_OBUF && WS_OBUF + 3 * (size_t)RG * 512 * 2 <= WS_SS && WS_SS + (size_t)R * 64 <= WS_XS && WS_XS + (size_t)256 * 524288 <= WS_END && WS_END <= 1024 * MiB, "d_ws map");
constexpr int CW_BAR = 4096, CW_QUEUE = 8192;
constexpr int RING_BYTES = 131072, XRES_OFF = 131072, LDSCTL_OFF = 132096, LDS_BYTES = 155648;

#define GAS __attribute__((address_space(1)))
#define LAS __attribute__((address_space(3)))
typedef unsigned short bf16;
typedef unsigned v4u __attribute__((ext_vector_type(4)));
typedef float f32x4 __attribute__((ext_vector_type(4)));
typedef GAS unsigned gu32;
#define RLX_AGENT __ATOMIC_RELAXED, __HIP_MEMORY_SCOPE_AGENT
#define LDS_WAIT() asm volatile("s_waitcnt lgkmcnt(0)" ::: "memory")
__device__ __forceinline__ unsigned f2bf(float f) { unsigned u = __builtin_bit_cast(unsigned, f); return (u + 0x7fffu + ((u >> 16) & 1u)) >> 16; }
__device__ __forceinline__ unsigned pk2(float lo, float hi) { return f2bf(lo) | (f2bf(hi) << 16); }
#define XB_TMO      128
#define XB_XCNT(j)  (256  + 64 * (j))
#define XB_XSUB(j)  (1280 + 64 * (j))
#define XB_XGEN(j)  (2304 + 64 * (j))
#define XB_TOP      3328
#define XB_TOPGEN   3392
#define XCD_BAR_WORDS 3456
#define XB_SPIN_CAP (1u << 18)

__device__ __forceinline__ unsigned xb_ld(unsigned* p)              { return __hip_atomic_load(p, __ATOMIC_RELAXED, __HIP_MEMORY_SCOPE_AGENT); }
__device__ __forceinline__ unsigned xb_add(unsigned* p, unsigned v) { asm volatile("" : "+v"(v)); return __hip_atomic_fetch_add(p, v, __ATOMIC_RELAXED, __HIP_MEMORY_SCOPE_AGENT); }
__device__ __forceinline__ unsigned xb_xcc_id() { return (unsigned)__builtin_amdgcn_s_getreg((3 << 11) | 20) & 0xFu; }
#define XB_SPIN(cond, bar) do { unsigned _sp = 0; while (cond) { __builtin_amdgcn_s_sleep(1); \
    if ((++_sp & 255u) == 0u) { if (xb_ld(&(bar)[XB_TMO])) break; if (_sp > XB_SPIN_CAP) { atomicAdd(&(bar)[XB_TMO], 1u); break; } } } } while (0)

struct XcdBarrier {
    unsigned* bar; unsigned x;
    volatile LAS unsigned* st;
};

__device__ __forceinline__ XcdBarrier xcd_barrier_post(unsigned* bar, volatile LAS unsigned* st) {
    XcdBarrier b; b.bar = bar; b.x = xb_xcc_id(); b.st = st;
    if (threadIdx.x == 0) (void)xb_add(&bar[XB_XCNT(b.x)], 1u);
    return b;
}
__device__ __forceinline__ void xcd_barrier_complete(unsigned* bar, unsigned x, unsigned& nloc, unsigned& nx) {
    const unsigned G = gridDim.x * gridDim.y * gridDim.z; asm volatile("" : "+s"(x));
    unsigned sum, cnt, mine, sp = 0u;
    for (;;) {
        sum = 0u; cnt = 0u; mine = 0u;
#pragma unroll
        for (unsigned j = 0; j < 16; ++j) { const unsigned c = xb_ld(&bar[XB_XCNT(j)]); sum += c; cnt += (c > 0u) ? 1u : 0u; mine = (j == x) ? c : mine; }
        if (sum == G) break;
        __builtin_amdgcn_s_sleep(1);
        if ((++sp & 255u) == 0u) { if (xb_ld(&bar[XB_TMO])) break; if (sp > XB_SPIN_CAP) { atomicAdd(&bar[XB_TMO], 1u); break; } }
    }
    nloc = mine > 0u ? mine : 1u; nx = cnt > 0u ? cnt : 1u;
}

__device__ __forceinline__ void xcd_barrier(const XcdBarrier& b, int tid_in) {
    asm volatile("s_waitcnt vmcnt(0)" ::: "memory");
    __syncthreads();
    if (tid_in == 0) {
        unsigned* bar = b.bar; asm volatile("" : "+s"(bar));
        __builtin_amdgcn_s_waitcnt(0);
        unsigned nloc = b.st[0], nx = b.st[1];
        if (nloc == 0u) { xcd_barrier_complete(bar, b.x, nloc, nx); b.st[0] = nloc; b.st[1] = nx; }
        const unsigned old = xb_add(&bar[XB_XSUB(b.x)], 1u);
        const unsigned gen = old / nloc;
        if (old + 1u == (gen + 1u) * nloc) {
            __builtin_amdgcn_fence(__ATOMIC_RELEASE, "agent");
            asm volatile("s_waitcnt vmcnt(0)" ::: "memory");
            const unsigned og = xb_add(&bar[XB_TOP], 1u);
            const unsigned tg = og / nx;
            if (og + 1u == (tg + 1u) * nx) xb_add(&bar[XB_TOPGEN], 1u);
            else XB_SPIN(xb_ld(&bar[XB_TOPGEN]) == tg, bar);
            __builtin_amdgcn_fence(__ATOMIC_ACQUIRE, "agent");
            xb_add(&bar[XB_XGEN(b.x)], 1u);
            asm volatile("s_waitcnt vmcnt(0)" ::: "memory");
        } else {
            XB_SPIN(xb_ld(&bar[XB_XGEN(b.x)]) == gen, bar);
            __builtin_amdgcn_fence(__ATOMIC_ACQUIRE, "agent");
            asm volatile("s_waitcnt vmcnt(0)" ::: "memory");
        }
    }
    __syncthreads();
}

__device__ __forceinline__ float wave_sum(float v) {
#pragma unroll
    for (int o = 1; o < 64; o <<= 1) v += __shfl_xor(v, o);
    return v;
}
__device__ __forceinline__ int rope_dim(int c64) { return 32 * ((c64 >> 2) & 1) + 4 * (c64 >> 3) + (c64 & 3); }
struct MapId { __device__ __forceinline__ int operator()(int n) const { return n; } };
struct MapWin { __device__ __forceinline__ int operator()(int n) const {
    if (n < 4608) { const int region = n >> 9; const bool rope = (region == 3 || region == 4 || region == 6 || region == 7); return rope ? (n & ~63) + rope_dim(n & 63) : n; }
    if (n < 4928) return (n & ~63) + rope_dim(n & 63);
    if (n < 4932) return n;
    if (n < 5120) return -1;
    return 4932 + (n - 5120); } };
struct MapGu { __device__ __forceinline__ int operator()(int n) const { return ((n >> 2) & 1) * DFF + 4 * (n >> 3) + (n & 3); } };
template <class Map> __device__ __forceinline__ void cvt_item(const float* W, int K, int Nsrc, bf16* WT, const float* gain, const Map& mp, LAS float* scr, int item, int nblk, int lane) {
    const int kb = item / nblk, nb = item % nblk, k0 = 64 * kb, n0 = 32 * nb;
    const int src = mp(n0 + (lane & 31));
#pragma unroll 8
    for (int i = 0; i < 32; ++i) { const int kk = 2 * i + (lane >> 5); float v = 0.f;
        if (src >= 0) { v = ((const GAS float*)W)[(size_t)(k0 + kk) * Nsrc + src]; if (gain) v *= ((const GAS float*)gain)[k0 + kk]; }
        scr[kk * 33 + (lane & 31)] = v; }
    LDS_WAIT(); asm volatile("" ::: "memory");
    const int c = lane & 7;
#pragma unroll
    for (int j = 0; j < 4; ++j) { const int n = (lane >> 3) + 8 * j; const LAS float* s = scr + (8 * c) * 33 + n;
        v4u o; o.x = pk2(s[0 * 33], s[1 * 33]); o.y = pk2(s[2 * 33], s[3 * 33]); o.z = pk2(s[4 * 33], s[5 * 33]); o.w = pk2(s[6 * 33], s[7 * 33]);
        *(GAS v4u*)(WT + (size_t)(n0 + n) * K + k0 + 8 * c) = o; }
    LDS_WAIT(); asm volatile("" ::: "memory");
}
__device__ __forceinline__ void rms_row_to_bf16(const float* xrow, bf16* orow, int lane) {
    const GAS f32x4* xr = (const GAS f32x4*)xrow + lane;
    f32x4 v[4]; float s = 0.f;
#pragma unroll
    for (int j = 0; j < 4; ++j) { v[j] = xr[64 * j]; s += (v[j].x * v[j].x + v[j].y * v[j].y) + (v[j].z * v[j].z + v[j].w * v[j].w); }
    float eps = RMS_EPS; asm volatile("" : "+v"(eps));
    const float rstd = 1.f / sqrtf(wave_sum(s) * (1.f / DM) + eps);
    GAS unsigned long long* o8 = (GAS unsigned long long*)orow + lane;
#pragma unroll
    for (int j = 0; j < 4; ++j) o8[64 * j] = (unsigned long long)pk2(v[j].x * rstd, v[j].y * rstd) | ((unsigned long long)pk2(v[j].z * rstd, v[j].w * rstd) << 32);
}
__device__ __forceinline__ void x_row_init(const float* xrow, bf16* orow, float* ssrow, int lane) {
    const GAS f32x4* xr = (const GAS f32x4*)xrow + lane;
    f32x4 v[4]; float s = 0.f;
#pragma unroll
    for (int j = 0; j < 4; ++j) { v[j] = xr[64 * j]; s += (v[j].x * v[j].x + v[j].y * v[j].y) + (v[j].z * v[j].z + v[j].w * v[j].w); }
    s = wave_sum(s);
    GAS unsigned long long* o8 = (GAS unsigned long long*)orow + lane;
#pragma unroll
    for (int j = 0; j < 4; ++j) o8[64 * j] = (unsigned long long)pk2(v[j].x, v[j].y) | ((unsigned long long)pk2(v[j].z, v[j].w) << 32);
    if (lane < 16) ((GAS float*)ssrow)[lane] = (lane == 0) ? s : 0.f;
}
__device__ __forceinline__ void rms_row_final(const bf16* xrow, float* orow, const float* gain, int lane) {
    const GAS v4u* xr = (const GAS v4u*)xrow + lane;
    float v[16]; float s = 0.f;
#pragma unroll
    for (int j = 0; j < 2; ++j) { const v4u b = xr[64 * j]; const unsigned bw[4] = {b.x, b.y, b.z, b.w};
#pragma unroll
        for (int i = 0; i < 4; ++i) { v[8 * j + 2 * i] = __uint_as_float(bw[i] << 16); v[8 * j + 2 * i + 1] = __uint_as_float(bw[i] & 0xffff0000u); } }
#pragma unroll
    for (int i = 0; i < 16; ++i) s += v[i] * v[i];
    const float rstd = 1.f / sqrtf(wave_sum(s) * (1.f / DM) + RMS_EPS);
#pragma unroll
    for (int j = 0; j < 2; ++j)
#pragma unroll
        for (int h = 0; h < 2; ++h) { const int c = 512 * j + 8 * lane + 4 * h; const f32x4 g = *(const GAS f32x4*)(gain + c);
            f32x4 o = {v[8 * j + 4 * h] * rstd * g.x, v[8 * j + 4 * h + 1] * rstd * g.y, v[8 * j + 4 * h + 2] * rstd * g.z, v[8 * j + 4 * h + 3] * rstd * g.w};
            *(GAS f32x4*)(orow + c) = o; }
}
__device__ __forceinline__ int fresh_tid(int wave_s) { int l; asm volatile("v_mbcnt_lo_u32_b32 %0, -1, 0\n\tv_mbcnt_hi_u32_b32 %0, -1, %0" : "=v"(l)); int w = wave_s; asm volatile("" : "+s"(w)); return (w << 6) | l; }
__device__ __forceinline__ unsigned wq_claim(gu32* ctr) {
    return __builtin_amdgcn_atomic_inc32((unsigned*)ctr, 0xffffffffu, __ATOMIC_RELAXED, "agent");
}
__device__ __forceinline__ int wq_next(gu32* ctr, volatile LAS unsigned* slot, int tid_in, unsigned& nxt, unsigned& par) {
    if (tid_in == 0) { slot[par] = nxt; nxt = wq_claim(ctr); }
    asm volatile("s_waitcnt lgkmcnt(0)" ::: "memory"); __builtin_amdgcn_s_barrier(); asm volatile("" ::: "memory");
    const int i = (int)slot[par]; par ^= 1u;
    return i;
}

__device__ __forceinline__ void diff_combine_row(const bf16* tb, bf16* ob, const float* subln, float lam, float oscale, int lane) {
    const int h = lane >> 4, d0 = (lane & 15) * 8;
    const v4u a = *(const GAS v4u*)(tb + (h * 2 + 0) * 128 + d0), c = *(const GAS v4u*)(tb + (h * 2 + 1) * 128 + d0);
    const unsigned aw[4] = {a.x, a.y, a.z, a.w}, cw[4] = {c.x, c.y, c.z, c.w};
    float d[8]; float ss = 0.f;
#pragma unroll
    for (int i = 0; i < 4; ++i) { d[2 * i] = __uint_as_float(aw[i] << 16) - lam * __uint_as_float(cw[i] << 16); d[2 * i + 1] = __uint_as_float(aw[i] & 0xffff0000u) - lam * __uint_as_float(cw[i] & 0xffff0000u);
        ss += d[2 * i] * d[2 * i] + d[2 * i + 1] * d[2 * i + 1]; }
    ss += __shfl_xor(ss, 1); ss += __shfl_xor(ss, 2); ss += __shfl_xor(ss, 4); ss += __shfl_xor(ss, 8);
    const float rs = (1.0f / sqrtf(ss * (1.0f / 128.0f) + RMS_EPS)) * oscale;
    const f32x4 g0 = *(const GAS f32x4*)(subln + d0), g1 = *(const GAS f32x4*)(subln + d0 + 4);
    v4u o; o.x = pk2(d[0] * rs * g0.x, d[1] * rs * g0.y); o.y = pk2(d[2] * rs * g0.z, d[3] * rs * g0.w); o.z = pk2(d[4] * rs * g1.x, d[5] * rs * g1.y); o.w = pk2(d[6] * rs * g1.z, d[7] * rs * g1.w);
    *(GAS v4u*)(ob + h * 128 + d0) = o;
}

#ifndef PROBE_CHECK
#define PROBE_CHECK 0
#endif
#if PROBE_CHECK
__device__ __forceinline__ void probe_check_query(const bf16* QI, const bf16* KI, const unsigned* MASKB, int qpos, int n, LAS float* qs, gu32* flag, int lane) {
#pragma unroll 1
    for (int i = lane; i < 256; i += 64) qs[i] = __uint_as_float((unsigned)QI[(size_t)qpos * 256 + i] << 16);
    float wv[4];
#pragma unroll
    for (int h = 0; h < 4; ++h) wv[h] = __uint_as_float((unsigned)KI[(size_t)qpos * 256 + 64 + h] << 16) * 0.0625f;
    LDS_WAIT();
    const int N = 64 * (n + 1);
    float smin = 3.0e38f, umax = -3.0e38f; int cnt = 0, selz_max = -1, unz_min = 1 << 30;
#pragma unroll 1
    for (int k = lane; k < N; k += 64) {
        float sc = 0.f;
#pragma unroll 1
        for (int h = 0; h < 4; ++h) { float l = 0.f;
#pragma unroll 2
            for (int d = 0; d < 64; ++d) l = __builtin_fmaf(qs[h * 64 + d], __uint_as_float((unsigned)KI[(size_t)k * 256 + d] << 16), l); sc += fmaxf(l, 0.f) * (h == 0 ? wv[0] : h == 1 ? wv[1] : h == 2 ? wv[2] : wv[3]); }
        const int t = k >> 6, sub = (k >> 5) & 1, wi = k & 31, hc = (wi >> 2) & 1, rr = (wi & 3) + 4 * (wi >> 3);
        const unsigned word = MASKB[((size_t)t * 4096 + qpos) * 2 + hc];
        const bool sel = (word >> (16 * sub + rr)) & 1u;
        if (sel) { ++cnt; smin = fminf(smin, sc); if (sc == 0.f) selz_max = max(selz_max, k); } else { umax = fmaxf(umax, sc); if (sc == 0.f) unz_min = min(unz_min, k); }
    }
#pragma unroll 1
    for (int o = 1; o < 64; o <<= 1) { smin = fminf(smin, __shfl_xor(smin, o)); umax = fmaxf(umax, __shfl_xor(umax, o)); cnt += __shfl_xor(cnt, o); selz_max = max(selz_max, __shfl_xor(selz_max, o)); unz_min = min(unz_min, __shfl_xor(unz_min, o)); }
    const int want = N < 256 ? N : 256;
    bool bad = (cnt != want);
    if (N > 256) { const float slack = 2e-3f * (fabsf(umax) + fabsf(smin)) + 1e-4f; if (smin < umax - slack) bad = true; if (smin == 0.f && umax == 0.f && selz_max > unz_min) bad = true; }
    if (bad && lane == 0) __hip_atomic_store(flag, 1u, RLX_AGENT);
}
#endif

#ifndef REP_L2
#define REP_L2 1
#endif
#ifndef REP_X
#define REP_X 1
#endif
#ifndef REP_PROJ
#define REP_PROJ 1
#endif
#ifndef REP_CVT
#define REP_CVT 1
#endif
#ifndef REP_GU
#define REP_GU 1
#endif
#ifndef REP_UP
#define REP_UP 1
#endif
#ifndef REP_B
#define REP_B 1
#endif
#ifndef REP_WOUT
#define REP_WOUT 1
#endif
#ifndef REP_OX
#define REP_OX 1
#endif
#ifndef REP_DOWN
#define REP_DOWN 1
#endif
#ifndef REP_A
#define REP_A 1
#endif
#ifndef REP_L3
#define REP_L3 1
#endif
struct Args { const float* in[20]; float* out; unsigned char* ws; int lo, hi; };
enum { I_X = 0, I_MEM, I_NORM_MIX, I_W_IN, I_REL_BIAS, I_LAMBDA, I_SUBLN, I_UP_A, I_UP_B, I_UP_C, I_W_OUT, I_NORM_CROSS, I_WQX, I_WKVX, I_WOX, I_NORM_FFN, I_WGU, I_WDOWN, I_MEM_NORM, I_FINAL_NORM };

__global__ void __launch_bounds__(NWAVES * 64, 2) hybrid_fwd(Args args) {
    extern __shared__ __attribute__((aligned(16))) unsigned char lds_raw[];
    LAS unsigned char* lds = (LAS unsigned char*)lds_raw;
    volatile LAS unsigned* MISC = (volatile LAS unsigned*)(lds + LDSCTL_OFF);
    for (int u = threadIdx.x; u < 64; u += NWAVES * 64) MISC[u] = 0u;
    __syncthreads();
    const int wave_s = __builtin_amdgcn_readfirstlane((int)threadIdx.x >> 6);
    XcdBarrier bar = xcd_barrier_post((unsigned*)((gu32*)(args.ws + WS_CTL) + CW_BAR), MISC + 8);
    volatile LAS unsigned* qslot = MISC + 16;

    int step = 0;
#define STEP_ON (step >= args.lo && step < args.hi)
#define STEP_END(need_bar) do { if ((need_bar) && step >= args.lo && step + 1 < args.hi) xcd_barrier(bar, fresh_tid(wave_s)); ++step; } while (0)
#define PH_ENTER unsigned char* ws = args.ws; int G = gridDim.x, bx = blockIdx.x, tid = fresh_tid(wave_s); asm volatile("" : "+s"(ws), "+s"(G), "+s"(bx), "+v"(tid)); \
    const int lane = tid & 63, wave = __builtin_amdgcn_readfirstlane(tid >> 6), gw = bx * NWAVES + wave, NGW = G * NWAVES; (void)lane; (void)gw; (void)NGW;
#define P_BF(off) ((bf16*)(ws + (off)))
#define P_Q(off) ((bf16*)(wsq + (off)))

    if (STEP_ON) { PH_ENTER
        float* rope = (float*)(ws + WS_ROPE); float* scal = (float*)(ws + WS_SCAL);
        LAS float* scr = (LAS float*)(lds + wave * 16384);
        for (int i = bx * (NWAVES * 64) + tid; i < SEQ * 32; i += G * NWAVES * 64) {
            const int pos = i >> 5, k = i & 31;
            const float inv = (float)pow(10000.0, -(double)(2 * k) / 64.0);
            const float ang = (float)pos * inv;
            rope[pos * 64 + k] = (float)cos((double)ang); rope[pos * 64 + 32 + k] = (float)sin((double)ang);
        }
        if (bx == 0 && wave < DEPTH) {
            const float* lv = args.in[I_LAMBDA] + wave * 4 * 64;
            const float sa = wave_sum(lv[lane] * lv[64 + lane]), sb = wave_sum(lv[128 + lane] * lv[192 + lane]);
            const float lam_init = 0.8f - 0.6f * expf(-0.3f * (float)wave);
            if (lane == 0) { scal[wave * 2] = expf(sa) - expf(sb) + lam_init; scal[wave * 2 + 1] = 1.0f - lam_init; }
        }
        { float* gb = (float*)(ws + WS_SCAL) + 1024;
          for (int i = bx * (NWAVES * 64) + tid; i < DEPTH * 512; i += G * NWAVES * 64) { const int l_ = i >> 9; gb[i] = args.in[I_SUBLN][l_ * 128 + (i & 127)] * (0.6f * expf(-0.3f * (float)l_) + 0.2f); } }
        for (int m = gw; m < NB * MEMLEN; m += NGW) rms_row_to_bf16(args.in[I_MEM] + (size_t)m * DM, P_BF(WS_MN) + (size_t)m * DM, lane);
        for (int it = gw; it < DEPTH * 16 * 16; it += NGW) { const int l = it >> 8;
            cvt_item(args.in[I_WKVX] + (size_t)l * DM * 512, DM, 512, P_BF(WS_WKV) + (size_t)l * 512 * DM, args.in[I_MEM_NORM], MapId(), scr, it & 255, 16, lane); }
    }
    STEP_END(true);
    if (STEP_ON) { PH_ENTER
        pg8::Gemm g{P_BF(WS_MN), P_BF(WS_WKV), NB * MEMLEN, DEPTH * 512, DM, 0}; pg8::StaticOrder S; S.init(NB * MEMLEN, DEPTH * 512, G, bx);
        pg8::EpiBf16S E{P_BF(WS_KVX), DEPTH * 512, 1.0f, nullptr, (LAS float*)(lds + 139264)};
        pg8::gemm_phase<pg8::EpiBf16S, pg8::StaticOrder, true, true>(lds, g, S, E, tid);
    }
    STEP_END(true);

#pragma unroll 1
    for (int l = 0; l < DEPTH; ++l) {
        if (STEP_ON) { PH_ENTER
            LAS float* scr = (LAS float*)(lds + wave * 16384);
            bf16* WL = P_BF(WS_WL);
            constexpr int I0 = 16 * 256, I1 = 8 * 32, I4 = 16 * 32, I5 = 16 * 8, I6 = 4 * 32, I7 = 16 * 176, I8 = 44 * 32;
            constexpr int NITEMS = I0 + 3 * I1 + I4 + I5 + I6 + I7 + I8;
#pragma unroll 1
            for (int rc = 0; rc < REP_CVT; ++rc)
            for (int it = gw; it < NITEMS; it += NGW) {
                int r = it;
                if (r < I0) { cvt_item(args.in[I_W_IN] + (size_t)l * DM * NIN, DM, NIN, WL + WL_WIN / 2, args.in[I_NORM_MIX] + l * DM, MapWin(), scr, r, 256, lane); continue; } r -= I0;
                if (r < I1) { cvt_item(args.in[I_UP_A] + (size_t)l * 512 * DM, 512, DM, WL + WL_WUP / 2, nullptr, MapId(), scr, r, 32, lane); continue; } r -= I1;
                if (r < I1) { cvt_item(args.in[I_UP_B] + (size_t)l * 512 * DM, 512, DM, WL + WL_WUP / 2 + (size_t)1024 * 512, (const float*)(ws + WS_SCAL) + 1024 + l * 512, MapId(), scr, r, 32, lane); continue; } r -= I1;
                if (r < I1) { cvt_item(args.in[I_UP_C] + (size_t)l * 512 * DM, 512, DM, WL + WL_WUP / 2 + (size_t)2048 * 512, nullptr, MapId(), scr, r, 32, lane); continue; } r -= I1;
                if (r < I4) { cvt_item(args.in[I_W_OUT] + (size_t)l * DM * DM, DM, DM, WL + WL_WOUT / 2, nullptr, MapId(), scr, r, 32, lane); continue; } r -= I4;
                if (r < I5) { cvt_item(args.in[I_WQX] + (size_t)l * DM * 256, DM, 256, WL + WL_WQX / 2, args.in[I_NORM_CROSS] + l * DM, MapId(), scr, r, 8, lane); continue; } r -= I5;
                if (r < I6) { cvt_item(args.in[I_WOX] + (size_t)l * 256 * DM, 256, DM, WL + WL_WOX / 2, nullptr, MapId(), scr, r, 32, lane); continue; } r -= I6;
                if (r < I7) { cvt_item(args.in[I_WGU] + (size_t)l * DM * 2 * DFF, DM, 2 * DFF, WL + WL_WGU / 2, args.in[I_NORM_FFN] + l * DM, MapGu(), scr, r, 176, lane); continue; } r -= I7;
                cvt_item(args.in[I_WDOWN] + (size_t)l * DFF * DM, DFF, DM, WL + WL_WDN / 2, nullptr, MapId(), scr, r, 32, lane);
            }
            if (l == 0) { for (int m = gw; m < R; m += NGW) x_row_init(args.in[I_X] + (size_t)m * DM, P_BF(WS_XN) + (size_t)m * DM, (float*)(ws + WS_SS) + (size_t)m * 16, lane); }
        }
        STEP_END(true);

#pragma unroll 1
        for (int grp = 0; grp < NGRP; ++grp) {
            if (STEP_ON) { PH_ENTER
                pg8::Gemm g{P_BF(WS_XN) + (size_t)grp * RG * DM, P_BF(WS_WL + WL_WIN), RG, NINP, DM, 0}; pg8::StaticOrder S; S.init(RG, NINP, G, bx);
                pg8::EpiProj E{P_BF(WS_QKV), P_BF(WS_QI), P_BF(WS_KI), P_BF(WS_GATES), (const float*)(ws + WS_ROPE), QSCALE, QKV_STRIDE, (const float*)(ws + WS_SS) + (size_t)grp * RG * 16, (LAS float*)(lds + 139264)};
#pragma unroll 1
                for (int rp = 0; rp < REP_PROJ; ++rp)
                pg8::gemm_phase<pg8::EpiProj, pg8::StaticOrder, true, true>(lds, g, S, E, tid);
            }
            STEP_END(true);
            if (STEP_ON) { PH_ENTER
                constexpr int NX = GB * 60 * 2, NBU = GB * 4 * 32, NAU = GB * 8 * 16;
#pragma unroll 1
                for (int rep = 0; rep < REP_L2; ++rep) { gu32* ctr = (gu32*)(ws + WS_CTL) + CW_QUEUE + 64 * (((l * NGRP + grp) * 2 + 0) * 4 + rep);
                const bool stat = (G == 256);
                gu32* qctr = stat ? ctr + 4 * (1 + (bx & 7)) : ctr; int stage = stat ? 0 : 2;
                unsigned qnxt = 0u, qpar = 0u; if (tid == 0) qnxt = wq_claim(qctr);
#pragma unroll 1
                for (int it = 0;; ++it) {
                    int i;
                    if (stat && it < 4) { const int x = bx & 7, j = bx >> 3, jj = j & 7, combo = x + 8 * (j >> 3), qt = (it == 0) ? 31 - jj : (it == 1) ? 16 + jj : (it == 2) ? 15 - jj : jj;
                        i = NX + (31 - qt) * 32 + (combo >> 2) * 4 + (combo & 3); __syncthreads(); }
                    else { int k = wq_next(qctr, qslot, tid, qnxt, qpar);
                        if (stage == 0) { if (k < 120) i = (k >> 1) * 16 + (bx & 7) * 2 + (k & 1);
                                          else { stage = 1; qctr = ctr; if (tid == 0) qnxt = wq_claim(qctr); k = wq_next(qctr, qslot, tid, qnxt, qpar); i = NX + NBU + k; } }
                        else if (stage == 1) i = NX + NBU + k;
                        else i = k;
                        if (i >= NX + NBU + NAU) break; }
                    unsigned char* wsq = args.ws; asm volatile("" : "+s"(wsq)); bf16* QKV = (bf16*)(wsq + WS_QKV);
                    if (i < NX) { const int n = 63 - (i >> 4), b = (i & 15) >> 1, half = i & 1;
#pragma unroll 1
                        for (int rx = 0; rx < REP_X; ++rx) { if (rx) __syncthreads();
                        att::idx_unit(lds, P_Q(WS_QI) + (size_t)b * SEQ * 256, P_Q(WS_KI) + (size_t)b * SEQ * 256, (unsigned short*)((unsigned*)(wsq + WS_MASK) + (size_t)b * 64 * 4096 * 2), (unsigned*)(wsq + WS_XS) + (size_t)(bx & 255) * 131072, n, half, tid); }
                    } else if (i < NX + NBU) { const int j = i - NX, qt = 31 - (j >> 5), b = (j & 31) >> 2, h = j & 3;
                        const size_t off = (size_t)b * SEQ * 512 + h * 128;
                        const float* scal = (const float*)(wsq + WS_SCAL);
                        const float lam = __hip_atomic_load(scal + l * 2, RLX_AGENT), oscale = __hip_atomic_load(scal + l * 2 + 1, RLX_AGENT);
                        attx::UB a{(const attx::bf16*)(QKV + 3 * QKV_STRIDE + off), (const attx::bf16*)(QKV + 4 * QKV_STRIDE + off), (const attx::bf16*)(QKV + 5 * QKV_STRIDE + off),
                                   (attx::bf16*)(P_Q(WS_OBUF) + 1 * QKV_STRIDE + off), qt, args.in[I_SUBLN] + l * 128, lam, oscale};
#pragma unroll 1
                        for (int rb_ = 0; rb_ < REP_B; ++rb_)
                        attx::attn_unit_b2<8>(a, (char*)lds_raw, tid);
                    } else { const int j = i - NX - NBU, qb = 15 - (j >> 6), b = (j & 63) >> 3, h = j & 7;
                        const size_t off = (size_t)b * SEQ * 512 + h * 64;
                        att::UnitArgs a{QKV + off, 512, QKV + 1 * QKV_STRIDE + off, QKV + 2 * QKV_STRIDE + off, 512, P_Q(WS_OBUF) + off, 512, 256 * qb, (4 * qb - 8 > 0) ? 4 * qb - 8 : 0, 4 * qb + 3,
                                        args.in[I_REL_BIAS] + (size_t)(l * 8 + h) * 320, nullptr, false};
#pragma unroll 1
                        for (int ra_ = 0; ra_ < REP_A; ++ra_)
                        att::attn_unit<0>(lds, a, tid);
                    }
                } }
            }
            STEP_END(true);
            if (STEP_ON) { PH_ENTER
#if PROBE_CHECK
                if (l == 0 && grp == 0) { const int si = gw, b_ = si & 7, n_ = 4 + ((si >> 3) % 60), qo = (si * 7) & 63;
                    probe_check_query(P_BF(WS_QI) + (size_t)b_ * SEQ * 256, P_BF(WS_KI) + (size_t)b_ * SEQ * 256, (const unsigned*)(ws + WS_MASK) + (size_t)b_ * 64 * 4096 * 2, 64 * n_ + qo, n_,
                                      (LAS float*)(lds + wave * 16384), (gu32*)(ws + WS_CTL) + 32, lane); __syncthreads(); }
#endif
#pragma unroll 1
                for (int rep = 0; rep < REP_L3; ++rep) { gu32* ctr = (gu32*)(ws + WS_CTL) + CW_QUEUE + 64 * (((l * NGRP + grp) * 2 + 1) * 4 + rep);
                const bool stat = (G == 256);
                unsigned qnxt = 0u, qpar = 0u; if (!stat && tid == 0) qnxt = wq_claim(ctr);
#pragma unroll 1
                for (int it = 0;; ++it) {
                    int qb, b, h;
                    if (stat) { if (it >= 4) break; const int j = bx >> 3, jj = j & 3; h = bx & 7; b = j >> 2; qb = (it == 0) ? 15 - jj : (it == 1) ? 8 + jj : (it == 2) ? 7 - jj : jj; __syncthreads(); }
                    else { const int i = wq_next(ctr, qslot, tid, qnxt, qpar); if (i >= GB * 8 * 16) break; qb = 15 - (i >> 6); b = (i & 63) >> 3; h = i & 7; }
                    unsigned char* wsq = args.ws; asm volatile("" : "+s"(wsq)); bf16* QKV = (bf16*)(wsq + WS_QKV);
                    const size_t rb = (size_t)b * SEQ * 512;
                    attx::UA a{(const attx::bf16*)(QKV + 6 * QKV_STRIDE + rb + (size_t)256 * qb * 512 + h * 64), 512,
                               (const attx::bf16*)(QKV + 7 * QKV_STRIDE + rb + h * 64), (const attx::bf16*)(QKV + 8 * QKV_STRIDE + rb + h * 64), 512,
                               (attx::bf16*)(P_Q(WS_OBUF) + 2 * QKV_STRIDE + rb + (size_t)256 * qb * 512 + h * 64), 512, 4 * qb + 4, 0, 4 * qb, nullptr,
                               (const unsigned*)(wsq + WS_MASK) + (size_t)b * 64 * 4096 * 2, qb == 0};
                    attx::attn_unit<1, 8>(a, (char*)lds_raw, tid);
                } }
            }
            STEP_END(true);
            if (STEP_ON) { PH_ENTER
                pg8::Gemm g{P_BF(WS_OBUF), P_BF(WS_WL + WL_WUP), RG, 3072, 512, QKV_STRIDE * 2}; pg8::UpOrder S; S.init(RG, G, bx);
                pg8::EpiGateC E{P_BF(WS_GATES), P_BF(WS_Y)};
#pragma unroll 1
                for (int ru = 0; ru < REP_UP; ++ru)
                pg8::gemm_phase<pg8::EpiGateC, pg8::UpOrder, true, true>(lds, g, S, E, tid);
            }
            STEP_END(true);
            if (STEP_ON) { PH_ENTER
                pg8::Gemm g{P_BF(WS_Y), P_BF(WS_WL + WL_WOUT), RG, DM, DM, 0}; pg8::StaticOrder S; S.init(RG, DM, G, bx);
                pg8::EpiRes E{P_BF(WS_XN) + (size_t)grp * RG * DM, DM, (float*)(ws + WS_SS) + (size_t)grp * RG * 16, 1.0f};
                pg8::gemm_phase<pg8::EpiRes, pg8::StaticOrder, true, true>(lds, g, S, E, tid);
#if REP_WOUT > 1
                { pg8::EpiRes E0{P_BF(WS_XN) + (size_t)grp * RG * DM, DM, (float*)(ws + WS_SS) + (size_t)grp * RG * 16, 0.0f}; __syncthreads(); pg8::gemm_phase<pg8::EpiRes, pg8::StaticOrder, true, true>(lds, g, S, E0, tid); }
#endif
            }
            STEP_END(grp == NGRP - 1);
        }
        if (STEP_ON) { PH_ENTER
            pg8::Gemm g{P_BF(WS_XN), P_BF(WS_WL + WL_WQX), R, 256, DM, 0}; pg8::StaticOrder S; S.init(R, 256, G, bx);
            pg8::EpiBf16S E{P_BF(WS_QX), 256, QSCALE, (const float*)(ws + WS_SS), (LAS float*)(lds + 139264)};
            pg8::gemm_phase<pg8::EpiBf16S, pg8::StaticOrder, true, true>(lds, g, S, E, tid);
        }
        STEP_END(true);
        if (STEP_ON) { PH_ENTER
            bf16* QX = P_BF(WS_QX);
            for (int i = bx; i < NB * 4 * 16; i += G) {
                const int qb = i & 15, b = i >> 6, h = (i >> 4) & 3;
                const bf16* kx = P_BF(WS_KVX) + (size_t)b * MEMLEN * (DEPTH * 512) + l * 512 + h * 64;
                attx::bf16* qp = (attx::bf16*)(QX + ((size_t)b * SEQ + 256 * qb) * 256 + h * 64);
                attx::UA a{qp, 256, (const attx::bf16*)kx, (const attx::bf16*)(kx + 256), DEPTH * 512, qp, 256, 4, 0, 0, nullptr, nullptr, 1};
                attx::attn_unit<2, 8>(a, (char*)lds_raw, tid);
            }
        }
        STEP_END(true);
        if (STEP_ON) { PH_ENTER
            pg8::Gemm g{P_BF(WS_QX), P_BF(WS_WL + WL_WOX), R, DM, 256, 0}; pg8::StaticOrder S; S.init(R, DM, G, bx);
            pg8::EpiRes E{P_BF(WS_XN), DM, (float*)(ws + WS_SS), 1.0f};
            pg8::gemm_phase<pg8::EpiRes, pg8::StaticOrder, true, true>(lds, g, S, E, tid);
#if REP_OX > 1
            { pg8::EpiRes E0{P_BF(WS_XN), DM, (float*)(ws + WS_SS), 0.0f}; __syncthreads(); pg8::gemm_phase<pg8::EpiRes, pg8::StaticOrder, true, true>(lds, g, S, E0, tid); }
#endif
        }
        STEP_END(true);
        if (STEP_ON) { PH_ENTER
            pg8::Gemm g{P_BF(WS_XN), P_BF(WS_WL + WL_WGU), R, 2 * DFF, DM, 0}; pg8::StaticOrder S; S.init(R, 2 * DFF, G, bx);
            pg8::EpiSwiglu E{P_BF(WS_H), DFF, (const float*)(ws + WS_SS), (LAS float*)(lds + 139264)};
#pragma unroll 1
            for (int rg = 0; rg < REP_GU; ++rg)
            pg8::gemm_phase<pg8::EpiSwiglu, pg8::StaticOrder, true, true>(lds, g, S, E, tid);
        }
        STEP_END(true);
        if (STEP_ON) { PH_ENTER
            pg8::Gemm g{P_BF(WS_H), P_BF(WS_WL + WL_WDN), R, DM, DFF, 0}; pg8::StaticOrder S; S.init(R, DM, G, bx);
            pg8::EpiRes E{P_BF(WS_XN), DM, (float*)(ws + WS_SS), 1.0f};
            pg8::gemm_phase<pg8::EpiRes, pg8::StaticOrder, true, true>(lds, g, S, E, tid);
#if REP_DOWN > 1
            { pg8::EpiRes E0{P_BF(WS_XN), DM, (float*)(ws + WS_SS), 0.0f}; __syncthreads(); pg8::gemm_phase<pg8::EpiRes, pg8::StaticOrder, true, true>(lds, g, S, E0, tid); }
#endif
        }
        STEP_END(true);
    }
    if (STEP_ON) { PH_ENTER for (int m = gw; m < R; m += NGW) rms_row_final(P_BF(WS_XN) + (size_t)m * DM, args.out + (size_t)m * DM, args.in[I_FINAL_NORM], lane);
#if PROBE_CHECK
        if (__hip_atomic_load((gu32*)(ws + WS_CTL) + 32, RLX_AGENT) != 0u) { for (int m = gw; m < R; m += NGW) { GAS f32x4* xr = (GAS f32x4*)(args.out + (size_t)m * DM) + lane; for (int j = 0; j < 4; ++j) xr[64 * j] = xr[64 * j] * 2.0f; } }
#endif
    }
    STEP_END(false);
#undef STEP_ON
#undef STEP_END
#undef PH_ENTER
#undef P_BF
#undef P_Q
}

constexpr int N_STEPS = 2 + DEPTH * (1 + NGRP * 5 + 5) + 1;
#ifndef MK_PER_STEP
#define MK_PER_STEP 0
#endif
extern "C" void kernel_launch(void* const* d_in, const int* in_sizes, int n_in, void* d_out, int out_size, void* d_ws, size_t ws_size, hipStream_t stream) {
    static int grid = 0;
    if (grid == 0) {
        if (n_in != 20 || in_sizes[0] != R * DM || out_size != R * DM || ws_size < WS_END) { fprintf(stderr, "kernel_launch: shape mismatch (n_in %d, in0 %d, out %d, ws %zu < %zu); nothing launched\n", n_in, n_in > 0 ? in_sizes[0] : -1, out_size, ws_size, (size_t)WS_END); grid = -1; return; }
        int dev = 0, cus = 0, per_cu = 0;
        if (hipGetDevice(&dev) != hipSuccess || hipDeviceGetAttribute(&cus, hipDeviceAttributeMultiprocessorCount, dev) != hipSuccess) { grid = -1; return; }
        if (hipFuncSetAttribute((const void*)hybrid_fwd, hipFuncAttributeMaxDynamicSharedMemorySize, LDS_BYTES) != hipSuccess) { fprintf(stderr, "kernel_launch: hipFuncSetAttribute failed\n"); grid = -1; return; }
        if (hipOccupancyMaxActiveBlocksPerMultiprocessor(&per_cu, (const void*)hybrid_fwd, NWAVES * 64, LDS_BYTES) != hipSuccess || per_cu < 1) { fprintf(stderr, "kernel_launch: occupancy query says %d blocks per CU\n", per_cu); }
        (void)hipGetLastError();
        grid = cus < 256 ? cus : 256;
    }
    if (grid < 0) return;
    if (hipMemsetAsync((char*)d_ws + WS_CTL, 0, CTL_ZERO_BYTES, stream) != hipSuccess) return;
    Args a{};
    for (int i = 0; i < 20; ++i) a.in[i] = (const float*)d_in[i];
    a.out = (float*)d_out; a.ws = (unsigned char*)d_ws;
#if MK_PER_STEP
    for (int s = 0; s < N_STEPS; ++s) { a.lo = s; a.hi = s + 1; hipLaunchKernelGGL(hybrid_fwd, dim3(grid), dim3(NWAVES * 64), LDS_BYTES, stream, a); }
#else
    a.lo = 0; a.hi = 1 << 30;
    hipLaunchKernelGGL(hybrid_fwd, dim3(grid), dim3(NWAVES * 64), LDS_BYTES, stream, a);
#endif
    const hipError_t le = hipPeekAtLastError();
    if (le != hipSuccess) fprintf(stderr, "kernel_launch: launch failed: %s\n", hipGetErrorName(le));
}
```

```cpp
#include <hip/hip_runtime.h>
#include <hip/hip_bf16.h>
#include <cstdio>
#include <cstdint>
#include <cmath>
namespace pg8 {
#define PG8_LAS __attribute__((address_space(3)))
typedef unsigned short bf16_t;
typedef short bf16x8 __attribute__((ext_vector_type(8)));
typedef float f32x4 __attribute__((ext_vector_type(4)));
typedef unsigned u32x4 __attribute__((ext_vector_type(4)));
constexpr int BM = 256, BK = 64, HALF = 128, HTB = HALF * BK * 2  , STAGE_BYTES = 8 * HTB, NXCD = 8, WGM = 8;

__host__ __device__ __forceinline__ int lds_byte(int r, int c) { const int st = (r >> 4) * 2 + (c >> 5), rr = r & 15, cc = c & 31, ob = rr * 64 + cc * 2; return st * 1024 + (ob ^ (((ob >> 9) & 1) << 5)); }
__host__ __device__ __forceinline__ void stage_rc(int b, int& R, int& C) { const int st = b / 1024, sb = b % 1024, swz = sb ^ (((sb >> 9) & 1) << 5); R = (st >> 1) * 16 + swz / 64; C = (st & 1) * 32 + (swz % 64) / 2; }
__host__ __device__ __forceinline__ int perm32(int rho) { const int n = rho >> 4, i = rho & 15; return 8 * (i >> 2) + 4 * n + (i & 3); }

struct Unit { int pm, pn, az; };
struct Gemm { const bf16_t* A; const bf16_t* Bt; int M, N, K; size_t azs; };

struct StaticOrder {
    int nM, nN, nwg, G, c;
    __host__ __device__ void init(int M, int N, int G_, int c_) { nM = M / BM; nN = N / BM; nwg = nM * nN; G = G_; c = c_; }
    __host__ __device__ bool next(int i, Unit& u) const {
        const long L = (long)i * G + c; if (L >= nwg) return false;
        int wgid = (int)L; { const int q = nwg / NXCD, r = nwg % NXCD, xcd = wgid % NXCD, off = wgid / NXCD; wgid = (xcd < r ? xcd * (q + 1) : r * (q + 1) + (xcd - r) * q) + off; }
        const int nig = WGM * nN, gid = wgid / nig, fm = gid * WGM, gsz = (nM - fm) < WGM ? (nM - fm) : WGM;
        u.pm = fm + ((wgid % nig) % gsz); u.pn = (wgid % nig) / gsz; u.az = 0; return true;
    }
    __device__ __forceinline__ void a_ready(const Unit&) const {}
    __device__ __forceinline__ void done(const Unit&) const {}
};

__device__ __forceinline__ unsigned cvt_pk_bf16(float lo, float hi) { unsigned r; asm volatile("v_cvt_pk_bf16_f32 %0, %1, %2" : "=v"(r) : "v"(lo), "v"(hi)); return r; }
typedef float f32x2c_t __attribute__((ext_vector_type(2))); typedef __bf16 bf16x2c_t __attribute__((ext_vector_type(2)));
__device__ __forceinline__ unsigned cvt_pk_bf16_c(float lo, float hi) { const f32x2c_t v = {lo, hi}; const bf16x2c_t b = __builtin_convertvector(v, bf16x2c_t); return __builtin_bit_cast(unsigned, b); }
typedef float f32x2 __attribute__((ext_vector_type(2)));

typedef unsigned u32x2 __attribute__((ext_vector_type(2)));
#define PG8_GAS __attribute__((address_space(1)))
__device__ __forceinline__ float bf_lo(unsigned w) { return __uint_as_float(w << 16); }
__device__ __forceinline__ float bf_hi(unsigned w) { return __uint_as_float(w & 0xffff0000u); }

__device__ __forceinline__ float row_rstd(const float* ss, size_t row) {
    const PG8_GAS f32x4* p = (const PG8_GAS f32x4*)(ss + row * 16);
    const f32x4 a = p[0], b = p[1], c = p[2], d = p[3];
    const float s = (((a[0] + a[1]) + (a[2] + a[3])) + ((b[0] + b[1]) + (b[2] + b[3]))) + (((c[0] + c[1]) + (c[2] + c[3])) + ((d[0] + d[1]) + (d[2] + d[3])));
    float eps = 1e-6f; asm volatile("" : "+v"(eps));
    return 1.0f / sqrtf(s * (1.0f / 1024.0f) + eps);
}
__device__ __forceinline__ void stage_rstd(const float* ss, PG8_LAS float* rs, int pm, int tid) {
    const int r = tid >> 1, h = tid & 1;
    const PG8_GAS f32x4* p = (const PG8_GAS f32x4*)(ss + ((size_t)pm * BM + r) * 16 + h * 8);
    const f32x4 a = p[0], b = p[1];
    float s = ((a[0] + a[1]) + (a[2] + a[3])) + ((b[0] + b[1]) + (b[2] + b[3]));
    s += __shfl_xor(s, 1);
    float eps = 1e-6f; asm volatile("" : "+v"(eps));
    if (h == 0) rs[r] = 1.0f / sqrtf(s * (1.0f / 1024.0f) + eps);
    asm volatile("s_waitcnt lgkmcnt(0)" ::: "memory"); __builtin_amdgcn_s_barrier(); asm volatile("" ::: "memory");
}
struct EpiRes {
    static constexpr bool PERM = true, AFTER_DRAIN = false, CARRY = false, RSTD = false;
    bf16_t* xb; int ldc; float* ss; float s;
    __device__ __forceinline__ void operator()(const f32x4 (&acc)[2][2][4][2], const Unit& u, int wr, int wc, int fr, int fq) const {
        const int row0 = u.pm * BM + wr * 64 + fr, col0 = u.pn * BM + wc * 32 + 8 * fq;
#pragma unroll
        for (int ai = 0; ai < 2; ++ai)
#pragma unroll
            for (int m = 0; m < 4; ++m) { const size_t row = (size_t)(row0 + ai * HALF + m * 16); bf16_t* rowp = xb + row * ldc + col0; float sq = 0.f;
#pragma unroll
                for (int bj = 0; bj < 2; ++bj) { const u32x4 b = *(const PG8_GAS u32x4*)(rowp + bj * HALF);
                    const f32x4 b0 = {__uint_as_float(b.x << 16), __uint_as_float(b.x & 0xffff0000u), __uint_as_float(b.y << 16), __uint_as_float(b.y & 0xffff0000u)};
                    const f32x4 b1 = {__uint_as_float(b.z << 16), __uint_as_float(b.z & 0xffff0000u), __uint_as_float(b.w << 16), __uint_as_float(b.w & 0xffff0000u)};
                    const f32x4 v0 = b0 + acc[ai][bj][m][0] * s, v1 = b1 + acc[ai][bj][m][1] * s;
                    u32x4 w; w.x = cvt_pk_bf16(v0[0], v0[1]); w.y = cvt_pk_bf16(v0[2], v0[3]); w.z = cvt_pk_bf16(v1[0], v1[1]); w.w = cvt_pk_bf16(v1[2], v1[3]);
                    *(PG8_GAS u32x4*)(rowp + bj * HALF) = w;
                    sq += ((v0[0] * v0[0] + v0[1] * v0[1]) + (v0[2] * v0[2] + v0[3] * v0[3])) + ((v1[0] * v1[0] + v1[1] * v1[1]) + (v1[2] * v1[2] + v1[3] * v1[3])); }
                sq += __shfl_xor(sq, 16); sq += __shfl_xor(sq, 32);
                if (fq == 0) *(PG8_GAS float*)(ss + row * 16 + u.pn * 4 + wc) = sq; }
    }
};

struct EpiBf16S {
    static constexpr bool PERM = true, AFTER_DRAIN = false, CARRY = false, RSTD = true;
    bf16_t* O; int ldc; float sc; const float* ss; PG8_LAS float* rs;
    __device__ __forceinline__ void stage(int pm, int tid) const { if (ss) stage_rstd(ss, rs, pm, tid); }
    __device__ __forceinline__ void operator()(const f32x4 (&acc)[2][2][4][2], const Unit& u, int wr, int wc, int fr, int fq) const {
        const int row0 = u.pm * BM + wr * 64 + fr, col0 = u.pn * BM + wc * 32 + 8 * fq;
#pragma unroll
        for (int ai = 0; ai < 2; ++ai)
#pragma unroll
            for (int m = 0; m < 4; ++m) { bf16_t* rowp = O + (size_t)(row0 + ai * HALF + m * 16) * ldc + col0; const float rq = ss ? sc * rs[ai * HALF + wr * 64 + m * 16 + fr] : sc;
#pragma unroll
                for (int bj = 0; bj < 2; ++bj) { const f32x4 v0 = acc[ai][bj][m][0] * rq, v1 = acc[ai][bj][m][1] * rq;
                    u32x4 w; w.x = cvt_pk_bf16(v0[0], v0[1]); w.y = cvt_pk_bf16(v0[2], v0[3]); w.z = cvt_pk_bf16(v1[0], v1[1]); w.w = cvt_pk_bf16(v1[2], v1[3]);
                    *(PG8_GAS u32x4*)(rowp + bj * HALF) = w; } }
    }
};

struct EpiProj {
    static constexpr bool PERM = true, AFTER_DRAIN = false, CARRY = false, RSTD = true;
    __device__ __forceinline__ void stage(int pm, int tid) const { stage_rstd(ss, rs, pm, tid); }
    bf16_t* qkv; bf16_t* qi; bf16_t* ki; bf16_t* gates; const float* cs; float qscale; size_t bufstride; const float* ss; PG8_LAS float* rs;
    __device__ __forceinline__ void operator()(const f32x4 (&acc)[2][2][4][2], const Unit& u, int wr, int wc, int fr, int fq) const {
        const int pn = u.pn;
        bf16_t* dst; int ld, colbase; float sc = 1.f; int mode;
        if (pn < 18) { const int buf = pn >> 1, kind = buf % 3, mixer = buf / 3; dst = qkv + (size_t)buf * bufstride; ld = 512; colbase = (pn & 1) * 256;
            mode = (mixer >= 1 && kind < 2) ? 1 : 0; if (kind == 0) sc = qscale; }
        else if (pn == 18) { dst = qi; ld = 256; colbase = 0; mode = 1; }
        else if (pn == 19) { dst = ki; ld = 256; colbase = 0; mode = 3; }
        else { dst = gates; ld = 3072; colbase = (pn - 20) * 256; mode = 2; }
        const int row0 = u.pm * BM + wr * 64 + fr;
        const int jj = 4 * (wc & 1) + fq;
        if (mode == 1 || mode == 3) {
            f32x4 c4[8], s4[8];
#pragma unroll
            for (int k = 0; k < 8; ++k) { const int row = row0 + (k >> 2) * HALF + (k & 3) * 16; const float* t = cs + (size_t)(row & 4095) * 64 + 4 * jj; c4[k] = *(const PG8_GAS f32x4*)t; s4[k] = *(const PG8_GAS f32x4*)(t + 32); }
#pragma unroll
            for (int ai = 0; ai < 2; ++ai)
#pragma unroll
                for (int m = 0; m < 4; ++m) {
                    const int row = row0 + ai * HALF + m * 16;
                    bf16_t* rowp = dst + (size_t)row * ld + colbase;
                    const float rstd = rs[ai * HALF + wr * 64 + m * 16 + fr];
                    const f32x4 c4v = c4[ai * 4 + m], s4v = s4[ai * 4 + m];
#pragma unroll
                    for (int bj = 0; bj < 2; ++bj) {
                        const f32x4 x1 = acc[ai][bj][m][0] * rstd, x2 = acc[ai][bj][m][1] * rstd;
                        const int blk = 2 * bj + (wc >> 1);
                        if (mode == 1 || blk == 0) {
                            const f32x4 o1 = (x1 * c4v - x2 * s4v) * sc, o2 = (x2 * c4v + x1 * s4v) * sc;
                            u32x2 w1, w2; w1.x = cvt_pk_bf16(o1[0], o1[1]); w1.y = cvt_pk_bf16(o1[2], o1[3]); w2.x = cvt_pk_bf16(o2[0], o2[1]); w2.y = cvt_pk_bf16(o2[2], o2[3]);
                            *(PG8_GAS u32x2*)(rowp + 64 * blk + 4 * jj) = w1; *(PG8_GAS u32x2*)(rowp + 64 * blk + 32 + 4 * jj) = w2;
                        } else {
                            const f32x4 v0 = x1 * sc, v1 = x2 * sc;
                            u32x4 w; w.x = cvt_pk_bf16(v0[0], v0[1]); w.y = cvt_pk_bf16(v0[2], v0[3]); w.z = cvt_pk_bf16(v1[0], v1[1]); w.w = cvt_pk_bf16(v1[2], v1[3]);
                            *(PG8_GAS u32x4*)(rowp + bj * HALF + wc * 32 + 8 * fq) = w;
                        }
                    }
                }
        } else if (mode == 2) {
#pragma unroll
            for (int ai = 0; ai < 2; ++ai)
#pragma unroll
                for (int m = 0; m < 4; ++m) {
                    bf16_t* rowp = dst + (size_t)(row0 + ai * HALF + m * 16) * ld + colbase;
                    const float rq = rs[ai * HALF + wr * 64 + m * 16 + fr] * -1.4426950408889634f;
#pragma unroll
                    for (int bj = 0; bj < 2; ++bj) {
                        f32x4 v0 = acc[ai][bj][m][0] * rq, v1 = acc[ai][bj][m][1] * rq;
#pragma unroll
                        for (int e = 0; e < 4; ++e) { v0[e] = __builtin_amdgcn_exp2f(fminf(v0[e], 60.f)); v1[e] = __builtin_amdgcn_exp2f(fminf(v1[e], 60.f)); }
                        u32x4 w; w.x = cvt_pk_bf16_c(v0[0], v0[1]); w.y = cvt_pk_bf16_c(v0[2], v0[3]); w.z = cvt_pk_bf16_c(v1[0], v1[1]); w.w = cvt_pk_bf16_c(v1[2], v1[3]);
                        *(PG8_GAS u32x4*)(rowp + bj * HALF + wc * 32 + 8 * fq) = w;
                    }
                }
        } else {
#pragma unroll
            for (int ai = 0; ai < 2; ++ai)
#pragma unroll
                for (int m = 0; m < 4; ++m) {
                    bf16_t* rowp = dst + (size_t)(row0 + ai * HALF + m * 16) * ld + colbase;
                    const float rq = rs[ai * HALF + wr * 64 + m * 16 + fr] * sc;
#pragma unroll
                    for (int bj = 0; bj < 2; ++bj) {
                        const f32x4 v0 = acc[ai][bj][m][0] * rq, v1 = acc[ai][bj][m][1] * rq;
                        u32x4 w; w.x = cvt_pk_bf16(v0[0], v0[1]); w.y = cvt_pk_bf16(v0[2], v0[3]); w.z = cvt_pk_bf16(v1[0], v1[1]); w.w = cvt_pk_bf16(v1[2], v1[3]);
                        *(PG8_GAS u32x4*)(rowp + bj * HALF + wc * 32 + 8 * fq) = w;
                    }
                }
        }
    }
};

struct EpiSwiglu {
    static constexpr bool PERM = true, AFTER_DRAIN = false, CARRY = false, RSTD = true;
    bf16_t* H; int ldh; const float* ss; PG8_LAS float* rs;
    __device__ __forceinline__ void stage(int pm, int tid) const { stage_rstd(ss, rs, pm, tid); }
    __device__ __forceinline__ void operator()(const f32x4 (&acc)[2][2][4][2], const Unit& u, int wr, int wc, int fr, int fq) const {
        const int row0 = u.pm * BM + wr * 64 + fr, col0 = u.pn * (BM / 2) + wc * 16 + 4 * fq;
#pragma unroll
        for (int ai = 0; ai < 2; ++ai)
#pragma unroll
            for (int m = 0; m < 4; ++m) { bf16_t* rowp = H + (size_t)(row0 + ai * HALF + m * 16) * ldh + col0; const float rstd = rs[ai * HALF + wr * 64 + m * 16 + fr];
#pragma unroll
                for (int bj = 0; bj < 2; ++bj) { const f32x4 g = acc[ai][bj][m][0] * rstd, up = acc[ai][bj][m][1] * rstd; f32x4 h;
#pragma unroll
                    for (int e = 0; e < 4; ++e) h[e] = g[e] * __builtin_amdgcn_rcpf(1.f + __builtin_amdgcn_exp2f(-1.4426950408889634f * g[e])) * up[e];
                    u32x2 w; w.x = cvt_pk_bf16(h[0], h[1]); w.y = cvt_pk_bf16(h[2], h[3]);
                    *(PG8_GAS u32x2*)(rowp + bj * (HALF / 2)) = w; } }
    }
};

struct EpiGateC {
    static constexpr bool PERM = true, AFTER_DRAIN = false, CARRY = true, RSTD = false;
    const bf16_t* gates; bf16_t* Y;
    __device__ __forceinline__ bool carry(f32x4 (&acc)[2][2][4][2], const Unit& u, int wr, int wc, int fr, int fq) const {
        const int branch = u.pn >> 2, row0 = u.pm * BM + wr * 64 + fr, col0 = (u.pn & 3) * BM + wc * 32 + 8 * fq;
        if (branch < 2) {
            u32x4 gb[2][8];
#define GATE_ISSUE(ST) do { _Pragma("unroll") for (int mm = 0; mm < 2; ++mm) _Pragma("unroll") for (int bj = 0; bj < 2; ++bj) { \
                const bf16_t* p_ = gates + (size_t)(row0 + ((ST) >> 1) * HALF + (((ST) & 1) * 2 + mm) * 16) * 3072 + branch * 1024 + col0 + bj * HALF; \
                gb[(ST) & 1][(mm * 2 + bj) * 2] = *(const PG8_GAS u32x4*)p_; gb[(ST) & 1][(mm * 2 + bj) * 2 + 1] = *(const PG8_GAS u32x4*)(p_ + 1024); } } while (0)
            GATE_ISSUE(0);
#pragma unroll
            for (int st = 0; st < 4; ++st) {
                if (st + 1 < 4) GATE_ISSUE(st + 1);
#pragma unroll
                for (int mm = 0; mm < 2; ++mm)
#pragma unroll
                    for (int bj = 0; bj < 2; ++bj) { const int ai = st >> 1, m = (st & 1) * 2 + mm;
                        const u32x4 g = gb[st & 1][(mm * 2 + bj) * 2], h = gb[st & 1][(mm * 2 + bj) * 2 + 1];
                        float gc[8] = {bf_lo(g.x), bf_hi(g.x), bf_lo(g.y), bf_hi(g.y), bf_lo(g.z), bf_hi(g.z), bf_lo(g.w), bf_hi(g.w)};
                        const float gn[8] = {bf_lo(h.x), bf_hi(h.x), bf_lo(h.y), bf_hi(h.y), bf_lo(h.z), bf_hi(h.z), bf_lo(h.w), bf_hi(h.w)};
#pragma unroll
                        for (int e = 0; e < 8; ++e) gc[e] = (1.f + gn[e]) * __builtin_amdgcn_rcpf(1.f + gc[e]);
                        acc[ai][bj][m][0] = acc[ai][bj][m][0] * (f32x4){gc[0], gc[1], gc[2], gc[3]};
                        acc[ai][bj][m][1] = acc[ai][bj][m][1] * (f32x4){gc[4], gc[5], gc[6], gc[7]}; }
            }
#undef GATE_ISSUE
            return true;
        }
        u32x4 gl[16];
#pragma unroll
        for (int k = 0; k < 16; ++k) { const int ai = k >> 3, m = (k >> 1) & 3, bj = k & 1; gl[k] = *(const PG8_GAS u32x4*)(gates + (size_t)(row0 + ai * HALF + m * 16) * 3072 + branch * 1024 + col0 + bj * HALF); }
#pragma unroll
        for (int k = 0; k < 16; ++k) { const int ai = k >> 3, m = (k >> 1) & 3, bj = k & 1; const u32x4 g = gl[k];
            float gc[8] = {bf_lo(g.x), bf_hi(g.x), bf_lo(g.y), bf_hi(g.y), bf_lo(g.z), bf_hi(g.z), bf_lo(g.w), bf_hi(g.w)};
            const f32x4 a0 = acc[ai][bj][m][0], a1 = acc[ai][bj][m][1];
#pragma unroll
            for (int e = 0; e < 8; ++e) gc[e] = __builtin_amdgcn_rcpf(1.f + gc[e]);
            u32x4 w; w.x = cvt_pk_bf16(gc[0] * a0[0], gc[1] * a0[1]); w.y = cvt_pk_bf16(gc[2] * a0[2], gc[3] * a0[3]); w.z = cvt_pk_bf16(gc[4] * a1[0], gc[5] * a1[1]); w.w = cvt_pk_bf16(gc[6] * a1[2], gc[7] * a1[3]);
            *(PG8_GAS u32x4*)(Y + (size_t)(row0 + ai * HALF + m * 16) * 1024 + col0 + bj * HALF) = w; }
        return false;
    }
};

struct UpOrder {
    StaticOrder so;
    __host__ __device__ void init(int M, int G_, int c_) { so.init(M, 1024, G_, c_); }
    __host__ __device__ bool next(int i, Unit& u) const { const int br = i % 3; if (!so.next(i / 3, u)) return false; u.pn += 4 * br; u.az = br; return true; }
    __device__ __forceinline__ void a_ready(const Unit&) const {}
    __device__ __forceinline__ void done(const Unit&) const {}
};
template <class Epi, class Sched, bool ALIGN_EPI = false, bool SP2 = false>
__device__ __forceinline__ void gemm_phase(PG8_LAS unsigned char* lds, const Gemm g, const Sched& S, const Epi& E, int tid_in) {
    int tid_l = tid_in; asm volatile("" : "+v"(tid_l));
    const int tid = tid_l, wid = __builtin_amdgcn_readfirstlane(tid >> 6), lane = tid & 63, wr = wid >> 2, wc = wid & 3, fr = lane & 15, fq = lane >> 4;
    const int K = g.K, nt = K / BK;
    unsigned voffA[2], voffB[2];
#pragma unroll
    for (int i = 0; i < 2; ++i) { int R, C; stage_rc(tid * 16 + i * 8192, R, C); const int Rb = Epi::PERM ? ((R & ~31) + perm32(R & 31)) : R;
        voffA[i] = (unsigned)(R * K + C) * 2u; voffB[i] = (unsigned)(Rb * K + C) * 2u; }
    const size_t kstep = (size_t)(BK * 2);
    const size_t hstep = (size_t)HALF * K * 2;
    const size_t tstep = 2 * hstep;
    const unsigned ldsw = (unsigned)wid * 1024u;
    const int aoff = lds_byte(wr * 64 + fr, fq * 8), boff = lds_byte(wc * 32 + fr, fq * 8);
#define PG8_SA(b, h) (((b) * 2 + (h)) * HTB)
#define PG8_SB(b, h) ((4 + (b) * 2 + (h)) * HTB)
#define PG8_STAGE(bufoff, gbase, voff) do { _Pragma("unroll") for (int _i = 0; _i < 2; ++_i) \
        __builtin_amdgcn_global_load_lds((const unsigned*)((const char*)(gbase) + (voff)[_i]), (PG8_LAS unsigned*)(lds + (bufoff) + ldsw + _i * 8192), 16, 0, 0); } while (0)
#define PG8_LDA(dst, b, h) do { _Pragma("unroll") for (int m = 0; m < 4; ++m) _Pragma("unroll") for (int k = 0; k < 2; ++k) dst[m][k] = *(const PG8_LAS bf16x8*)(lds + PG8_SA(b, h) + aoff + m * 2048 + k * 1024); } while (0)
#define PG8_LDB(dst, b, h) do { _Pragma("unroll") for (int n = 0; n < 2; ++n) _Pragma("unroll") for (int k = 0; k < 2; ++k) dst[n][k] = *(const PG8_LAS bf16x8*)(lds + PG8_SB(b, h) + boff + n * 2048 + k * 1024); } while (0)
#define PG8_MMA(ai, bj, At, Bt) do { __builtin_amdgcn_s_setprio(1); _Pragma("unroll") for (int m = 0; m < 4; ++m) _Pragma("unroll") for (int n = 0; n < 2; ++n) _Pragma("unroll") for (int k = 0; k < 2; ++k) \
        acc[ai][bj][m][n] = __builtin_amdgcn_mfma_f32_16x16x32_bf16(Bt[n][k], At[m][k], acc[ai][bj][m][n], 0, 0, 0); __builtin_amdgcn_s_setprio(0); } while (0)
#define PG8_WAIT_V(n) asm volatile("s_waitcnt vmcnt(" #n ")" ::: "memory")
#define PG8_WAIT_L(n) asm volatile("s_waitcnt lgkmcnt(" #n ")" ::: "memory")
#define PG8_BAR __builtin_amdgcn_s_barrier()
#define PG8_SCHED __builtin_amdgcn_sched_barrier(0)
    Unit cur, nxt; int ui = 0; int rs_pm = -1;
    if (!S.next(0, cur)) return;
    f32x4 acc[2][2][4][2];
#pragma unroll
    for (int a = 0; a < 2; ++a)
#pragma unroll
        for (int b = 0; b < 2; ++b)
#pragma unroll
            for (int m = 0; m < 4; ++m)
#pragma unroll
                for (int n = 0; n < 2; ++n) acc[a][b][m][n] = (f32x4){0.f, 0.f, 0.f, 0.f};
    bf16x8 At[4][2], B0[2][2], B1[2][2];
    const char* cA = (const char*)g.A + (size_t)cur.pm * tstep + (size_t)cur.az * g.azs; const char* cB = (const char*)g.Bt + (size_t)cur.pn * tstep;
    S.a_ready(cur);
    if constexpr (SP2) {
        PG8_STAGE(PG8_SB(0, 0), cB, voffB); PG8_STAGE(PG8_SB(0, 1), cB + hstep, voffB); PG8_STAGE(PG8_SA(0, 0), cA, voffA); PG8_STAGE(PG8_SA(0, 1), cA + hstep, voffA);
        if (wr == 1) PG8_BAR;
        PG8_WAIT_V(2); PG8_BAR;
        PG8_STAGE(PG8_SB(1, 0), cB + kstep, voffB); PG8_STAGE(PG8_SA(1, 0), cA + kstep, voffA); PG8_STAGE(PG8_SB(1, 1), cB + hstep + kstep, voffB);
        PG8_WAIT_V(6); PG8_BAR;
    } else {
        PG8_STAGE(PG8_SB(0, 0), cB, voffB); PG8_STAGE(PG8_SA(0, 0), cA, voffA); PG8_STAGE(PG8_SB(0, 1), cB + hstep, voffB); PG8_STAGE(PG8_SA(0, 1), cA + hstep, voffA);
        if (wr == 1) PG8_BAR;
        PG8_WAIT_V(4); PG8_BAR;
        PG8_STAGE(PG8_SB(1, 0), cB + kstep, voffB); PG8_STAGE(PG8_SA(1, 0), cA + kstep, voffA); PG8_STAGE(PG8_SB(1, 1), cB + hstep + kstep, voffB);
        PG8_WAIT_V(6); PG8_BAR;
    }
    for (;;) {
        const bool has_next = S.next(ui + 1, nxt);
        const char* nA = has_next ? (const char*)g.A + (size_t)nxt.pm * tstep + (size_t)nxt.az * g.azs : cA; const char* nB = has_next ? (const char*)g.Bt + (size_t)nxt.pn * tstep : cB;
        for (int t = 0; t < nt; t += 2) {
            const bool last = (t == nt - 2);
            const char* a1 = cA + (size_t)(t + 1) * kstep;
            const char* a2 = last ? nA : cA + (size_t)(t + 2) * kstep; const char* b2 = last ? nB : cB + (size_t)(t + 2) * kstep;
            const char* a3 = a2 + kstep; const char* b3 = b2 + kstep;
            if (last && has_next) S.a_ready(nxt);
            if constexpr (SP2) {
            PG8_LDB(B0, 0, 0); PG8_LDB(B1, 0, 1); PG8_SCHED; PG8_LDA(At, 0, 0); PG8_STAGE(PG8_SA(1, 1), a1 + hstep, voffA);
            PG8_WAIT_V(8); PG8_WAIT_L(0); PG8_BAR; PG8_MMA(0, 0, At, B0); PG8_MMA(0, 1, At, B1); PG8_BAR; PG8_SCHED;
            PG8_LDA(At, 0, 1); PG8_STAGE(PG8_SB(0, 0), b2, voffB); PG8_STAGE(PG8_SB(0, 1), b2 + hstep, voffB); PG8_STAGE(PG8_SA(0, 0), a2, voffA);
            PG8_WAIT_V(8); PG8_WAIT_L(0); PG8_BAR; PG8_MMA(1, 0, At, B0); PG8_MMA(1, 1, At, B1); PG8_BAR; PG8_SCHED;
            PG8_LDB(B0, 1, 0); PG8_LDB(B1, 1, 1); PG8_SCHED; PG8_LDA(At, 1, 0); PG8_STAGE(PG8_SA(0, 1), a2 + hstep, voffA);
            PG8_WAIT_V(8); PG8_WAIT_L(0); PG8_BAR; PG8_MMA(0, 0, At, B0); PG8_MMA(0, 1, At, B1); PG8_BAR; PG8_SCHED;
            PG8_LDA(At, 1, 1); PG8_STAGE(PG8_SB(1, 0), b3, voffB); PG8_STAGE(PG8_SB(1, 1), b3 + hstep, voffB); PG8_STAGE(PG8_SA(1, 0), a3, voffA);
            PG8_WAIT_V(8); PG8_WAIT_L(0); PG8_BAR; PG8_MMA(1, 0, At, B0); PG8_MMA(1, 1, At, B1); PG8_BAR; PG8_SCHED;
            } else {
            PG8_LDB(B0, 0, 0); PG8_SCHED; PG8_LDA(At, 0, 0); PG8_STAGE(PG8_SA(1, 1), a1 + hstep, voffA);
            PG8_WAIT_L(8); PG8_BAR; PG8_WAIT_L(0); PG8_MMA(0, 0, At, B0); PG8_BAR; PG8_SCHED;
            PG8_LDB(B1, 0, 1); PG8_STAGE(PG8_SB(0, 0), b2, voffB);
            PG8_BAR; PG8_WAIT_L(0); PG8_MMA(0, 1, At, B1); PG8_BAR;
            PG8_LDA(At, 0, 1); PG8_STAGE(PG8_SA(0, 0), a2, voffA);
            PG8_BAR; PG8_WAIT_L(0); PG8_MMA(1, 0, At, B0); PG8_BAR; PG8_SCHED;
            PG8_STAGE(PG8_SB(0, 1), b2 + hstep, voffB);
            PG8_WAIT_V(6); PG8_BAR; PG8_MMA(1, 1, At, B1); PG8_BAR;
            PG8_LDB(B0, 1, 0); PG8_SCHED; PG8_LDA(At, 1, 0); PG8_STAGE(PG8_SA(0, 1), a2 + hstep, voffA);
            PG8_WAIT_L(8); PG8_BAR; PG8_WAIT_L(0); PG8_MMA(0, 0, At, B0); PG8_BAR; PG8_SCHED;
            PG8_LDB(B1, 1, 1); PG8_STAGE(PG8_SB(1, 0), b3, voffB);
            PG8_BAR; PG8_WAIT_L(0); PG8_MMA(0, 1, At, B1); PG8_BAR;
            PG8_LDA(At, 1, 1); PG8_STAGE(PG8_SA(1, 0), a3, voffA);
            PG8_BAR; PG8_WAIT_L(0); PG8_MMA(1, 0, At, B0); PG8_BAR; PG8_SCHED;
            PG8_STAGE(PG8_SB(1, 1), b3 + hstep, voffB);
            PG8_WAIT_V(6); PG8_BAR; PG8_MMA(1, 1, At, B1); PG8_BAR;
            }
        }
        if constexpr (ALIGN_EPI) { if (wr == 0) PG8_BAR; }
        if constexpr (Epi::RSTD) { if (cur.pm != rs_pm) { E.stage(cur.pm, tid); rs_pm = cur.pm; } }
        bool keep_acc = false;
        if constexpr (Epi::CARRY) { keep_acc = E.carry(acc, cur, wr, wc, fr, fq); S.done(cur); }
        else if constexpr (!Epi::AFTER_DRAIN) { E(acc, cur, wr, wc, fr, fq);
#ifdef REP_EPI
            if constexpr (Epi::RSTD) { asm volatile("" ::: "memory"); E(acc, cur, wr, wc, fr, fq); }
#endif
            S.done(cur); }
        if (!has_next) break;
        if (!keep_acc)
#pragma unroll
        for (int a = 0; a < 2; ++a)
#pragma unroll
            for (int b = 0; b < 2; ++b)
#pragma unroll
                for (int m = 0; m < 4; ++m)
#pragma unroll
                    for (int n = 0; n < 2; ++n) acc[a][b][m][n] = (f32x4){0.f, 0.f, 0.f, 0.f};
        cur = nxt; cA = nA; cB = nB; ++ui;
        if constexpr (ALIGN_EPI) { if (wr == 1) PG8_BAR; }
    }
    PG8_WAIT_V(0);
    if constexpr (!ALIGN_EPI) { if (wr == 0) PG8_BAR; }
    PG8_BAR;
    if constexpr (Epi::AFTER_DRAIN) { E.fused(acc, cur, wr, wc, fr, fq, lds, wid, lane); S.done(cur); }
#undef PG8_SA
#undef PG8_SB
#undef PG8_STAGE
#undef PG8_LDA
#undef PG8_LDB
#undef PG8_MMA
#undef PG8_WAIT_V
#undef PG8_WAIT_L
#undef PG8_BAR
#undef PG8_SCHED
}
}

namespace att {
#define ATT_LAS __attribute__((address_space(3)))
#define ATT_GAS __attribute__((address_space(1)))
typedef unsigned short bf16_t;
typedef short bf16x8 __attribute__((ext_vector_type(8)));
typedef short s16x4 __attribute__((ext_vector_type(4)));
typedef float f32x16 __attribute__((ext_vector_type(16)));
typedef float f32x4 __attribute__((ext_vector_type(4)));
typedef unsigned u32x4 __attribute__((ext_vector_type(4)));
typedef unsigned u32x2 __attribute__((ext_vector_type(2)));
typedef float f32x2_t __attribute__((ext_vector_type(2)));
typedef __bf16 bf16x2_t __attribute__((ext_vector_type(2)));
typedef short v4i16_t __attribute__((ext_vector_type(4)));
typedef ATT_LAS unsigned char* lptr;
#define ADI __device__ __forceinline__
constexpr float LOG2E = 1.4426950408889634f;
constexpr float NEG_BIG = -1e30f;

ADI int crow(int r, int hi) { return (r & 3) + 8 * (r >> 2) + 4 * hi; }
ADI unsigned cvtpk(float lo, float hi) { f32x2_t v = {lo, hi}; bf16x2_t b = __builtin_convertvector(v, bf16x2_t); return __builtin_bit_cast(unsigned, b); }
ADI float swapmax(float v) { auto rr = __builtin_amdgcn_permlane32_swap(__float_as_uint(v), __float_as_uint(v), false, false); return fmaxf(__uint_as_float(rr[0]), __uint_as_float(rr[1])); }
ADI float swapsum(float v) { auto rr = __builtin_amdgcn_permlane32_swap(__float_as_uint(v), __float_as_uint(v), false, false); return __uint_as_float(rr[0]) + __uint_as_float(rr[1]); }
ADI f32x16 splat16(float v) { f32x16 r;
#pragma unroll
  for (int i = 0; i < 16; ++i) r[i] = v; return r; }
ADI float bf2f(bf16_t b) { return __uint_as_float((unsigned)b << 16); }

ADI u32x4 ldg16(const bf16_t* p) { return *(const ATT_GAS u32x4*)p; }
ADI void k_map(int tid, int& key, int& chunk) { const int w = tid >> 6, lane = tid & 63; key = 32 * (w & 1) + (lane & 31); chunk = 2 * (w >> 1) + (lane >> 5); }
ADI int k_lds_off(int key, int chunk) { return chunk * 1024 + key * 16; }
ADI void v_map(int tid, int& key, int& dc) { key = tid >> 3; dc = tid & 7; }
ADI int v_lds_off(int key, int dc) { return ((dc >> 2) * 4 + (key >> 4)) * 1024 + (key & 15) * 64 + (dc & 3) * 16; }

ADI void qk_tile(f32x16& p0, f32x16& p1, lptr kimg, const bf16x8 (&qr)[4], int r32, int hi) {
#pragma unroll
  for (int d0 = 0; d0 < 4; ++d0) {
    const bf16x8 b0 = *(const ATT_LAS bf16x8*)(kimg + (2 * d0 + hi) * 1024 + r32 * 16);
    const bf16x8 b1 = *(const ATT_LAS bf16x8*)(kimg + (2 * d0 + hi) * 1024 + r32 * 16 + 512);
    p0 = __builtin_amdgcn_mfma_f32_32x32x16_bf16(b0, qr[d0], p0, 0, 0, 0);
    p1 = __builtin_amdgcn_mfma_f32_32x32x16_bf16(b1, qr[d0], p1, 0, 0, 0);
  }
}
template <int NO> ADI void softmax_step(f32x16& p0, f32x16& p1, float& m, float& l, f32x16 (&o)[NO]) {
  float mx = fmaxf(p0[0], p1[0]);
#pragma unroll
  for (int r = 1; r < 16; ++r) mx = fmaxf(mx, fmaxf(p0[r], p1[r]));
  mx = swapmax(mx);
  const float mn = fmaxf(m, mx), alpha = __builtin_amdgcn_exp2f(m - mn); m = mn;
  float ps = 0.f;
#pragma unroll
  for (int r = 0; r < 16; ++r) { p0[r] = __builtin_amdgcn_exp2f(p0[r] - mn); p1[r] = __builtin_amdgcn_exp2f(p1[r] - mn); ps += p0[r] + p1[r]; }
  ps = swapsum(ps); l = l * alpha + ps;
  if (!__all(alpha == 1.0f)) {
#pragma unroll
    for (int i = 0; i < NO; ++i) o[i] *= alpha;
  }
}
ADI s16x4 vtr(lptr p) { return __builtin_bit_cast(s16x4, __builtin_amdgcn_ds_read_tr16_b64_v4i16((ATT_LAS v4i16_t*)p)); }
template <int NDH> ADI void pv_tile(f32x16 (&o)[NDH], lptr vimg, const f32x16& p0, const f32x16& p1, int lane) {
  bf16x8 pf[4];
  { u32x4 w;
    w.x = cvtpk(p0[0], p0[1]); w.y = cvtpk(p0[2], p0[3]); w.z = cvtpk(p0[4], p0[5]); w.w = cvtpk(p0[6], p0[7]); pf[0] = __builtin_bit_cast(bf16x8, w);
    w.x = cvtpk(p0[8], p0[9]); w.y = cvtpk(p0[10], p0[11]); w.z = cvtpk(p0[12], p0[13]); w.w = cvtpk(p0[14], p0[15]); pf[1] = __builtin_bit_cast(bf16x8, w);
    w.x = cvtpk(p1[0], p1[1]); w.y = cvtpk(p1[2], p1[3]); w.z = cvtpk(p1[4], p1[5]); w.w = cvtpk(p1[6], p1[7]); pf[2] = __builtin_bit_cast(bf16x8, w);
    w.x = cvtpk(p1[8], p1[9]); w.y = cvtpk(p1[10], p1[11]); w.z = cvtpk(p1[12], p1[13]); w.w = cvtpk(p1[14], p1[15]); pf[3] = __builtin_bit_cast(bf16x8, w); }
  const int vb = ((lane >> 4) & 1) * 32 + (lane & 3) * 8 + (4 * (lane >> 5) + ((lane & 15) >> 2)) * 64;
#pragma unroll
  for (int dh = 0; dh < NDH; ++dh) {
#pragma unroll
    for (int kg = 0; kg < 4; ++kg) {
      lptr p = vimg + (dh >> 1) * 8192 + ((dh & 1) * 4 + kg) * 1024 + vb;
      const s16x4 lo = vtr(p), hi = vtr(p + 512);
      const bf16x8 vf = {lo[0], lo[1], lo[2], lo[3], hi[0], hi[1], hi[2], hi[3]};
      o[dh] = __builtin_amdgcn_mfma_f32_32x32x16_bf16(vf, pf[kg], o[dh], 0, 0, 0);
    }
  }
}
template <int NDH> ADI void store_o(bf16_t* orow, const f32x16 (&o)[NDH], float sc, int hi) {
#pragma unroll
  for (int dh = 0; dh < NDH; ++dh)
#pragma unroll
    for (int g = 0; g < 4; ++g) { u32x2 w; w.x = cvtpk(o[dh][4 * g] * sc, o[dh][4 * g + 1] * sc); w.y = cvtpk(o[dh][4 * g + 2] * sc, o[dh][4 * g + 3] * sc);
      *(ATT_GAS u32x2*)(orow + 32 * dh + 8 * g + 4 * hi) = w; }
}

ADI void glds16(const void* gsrc, unsigned lds_dst) { unsigned keep;
  asm volatile("s_mov_b32 %0, m0\n\ts_mov_b32 m0, %2\n\ts_nop 0\n\tglobal_load_lds_dwordx4 %1, off\n\ts_mov_b32 m0, %0" : "=&s"(keep) : "v"(gsrc), "s"(lds_dst) : "memory"); }
ADI void glds4(const void* gsrc, unsigned lds_dst) { unsigned keep;
  asm volatile("s_mov_b32 %0, m0\n\ts_mov_b32 m0, %2\n\ts_nop 0\n\tglobal_load_lds_dword %1, off\n\ts_mov_b32 m0, %0" : "=&s"(keep) : "v"(gsrc), "s"(lds_dst) : "memory"); }
template <int N> ADI void wait_bar() { asm volatile("s_waitcnt vmcnt(%0) lgkmcnt(0)\n\ts_barrier" :: "n"(N) : "memory"); }
#define MX3(a, b, c) __builtin_fmaxf(__builtin_fmaxf((a), (b)), (c))
constexpr float THR = 8.0f;
template <int NO> ADI void sm_decide(f32x16& c0, f32x16& c1, float& mref, float& l, f32x16 (&o)[NO]) {
  float a = MX3(c0[0], c0[1], c1[0]), b = MX3(c0[2], c0[3], c1[1]); a = MX3(a, c1[2], c1[3]);
#pragma unroll
  for (int r = 4; r < 16; r += 4) { a = MX3(a, c0[r], c0[r + 1]); b = MX3(b, c0[r + 2], c0[r + 3]); a = MX3(a, c1[r], c1[r + 1]); b = MX3(b, c1[r + 2], c1[r + 3]); }
  const float rm = swapmax(fmaxf(a, b));
  if (__builtin_expect(__any(rm > THR), 0)) {
    const float dl = fmaxf(rm, 0.f), f = __builtin_amdgcn_exp2f(-dl);
    mref += dl; l *= f;
#pragma unroll
    for (int r = 0; r < 16; ++r) { c0[r] -= dl; c1[r] -= dl; }
#pragma unroll
    for (int i = 0; i < NO; ++i) o[i] *= f;
  }
}
ADI void sm_exp_sum(f32x16& c0, f32x16& c1, float& l) {
  float s0 = 0.f, s1 = 0.f;
#pragma unroll
  for (int r = 0; r < 16; ++r) { c0[r] = __builtin_amdgcn_exp2f(c0[r]); c1[r] = __builtin_amdgcn_exp2f(c1[r]); s0 += c0[r]; s1 += c1[r]; }
  l += s0 + s1;
}

struct UnitArgs {
  const bf16_t* Q; int ldq; const bf16_t* K; const bf16_t* V; int ldkv; bf16_t* O; int ldo;
  int q0;
  int t0, t1;
  const float* relb;
  const unsigned* mask;
  bool nomask;
};
template <int MODE> ADI void attn_unit(lptr lds, const UnitArgs& a, int tid_in) {
  int tid_l = tid_in; asm volatile("" : "+v"(tid_l));
  const int tid = tid_l, lane = tid & 63, r32 = lane & 31, hi = lane >> 5, w = __builtin_amdgcn_readfirstlane(tid >> 6);
  constexpr int SLOT = 16384, P = (MODE == 1) ? 3 : 2;
  constexpr int MSK_OFF = 4 * SLOT, TAB_OFF = MSK_OFF + 4 * 2048;
  const unsigned lds0 = (unsigned)(size_t)lds;
  ATT_LAS float* tab = (ATT_LAS float*)(lds + TAB_OFF);
  if (MODE == 0) { for (int i = tid; i < 320; i += 512) tab[i] = ((const ATT_GAS float*)a.relb)[i] * LOG2E; }
  const int qloc = a.q0 + 32 * w + r32;
  const int cq = (a.q0 + 32 * w) >> 6;
  bf16x8 qr[4];
  { const bf16_t* qp = a.Q + (size_t)qloc * a.ldq + 8 * hi;
#pragma unroll
    for (int d0 = 0; d0 < 4; ++d0) qr[d0] = __builtin_bit_cast(bf16x8, ldg16(qp + 16 * d0)); }
  const bf16_t* ksrc = a.K + (size_t)lane * a.ldkv + w * 8;
  const bf16_t* vsrc = a.V + (size_t)(16 * (w & 3) + (lane >> 2)) * a.ldkv + (w >> 2) * 32 + (lane & 3) * 8;
  const unsigned* msrc = a.mask + (size_t)(a.q0 + 32 * w) * 2 + lane;
  const size_t tstep = (size_t)64 * a.ldkv;
#define ATT_DMA(t) do { const unsigned sb_ = lds0 + (unsigned)(((t) & 3) * SLOT + w * 1024); \
    glds16(ksrc + (size_t)(t) * tstep, (unsigned)__builtin_amdgcn_readfirstlane(sb_)); glds16(vsrc + (size_t)(t) * tstep, (unsigned)__builtin_amdgcn_readfirstlane(sb_ + 8192u)); \
    if (MODE == 1) glds4(msrc + (size_t)(t) * 8192, (unsigned)__builtin_amdgcn_readfirstlane(lds0 + (unsigned)(MSK_OFF + ((t) & 3) * 2048 + w * 256))); } while (0)
#define ATT_ACTIVE(t) ((MODE == 0) ? ((t) <= cq && (t) + 8 >= cq) : (MODE == 1) ? ((t) <= cq) : true)
#define ATT_INIT(P0, P1, t) do { if (MODE == 0) { const int dch_ = cq - (t); \
      if (dch_ >= 5) { const float c_ = tab[319] - mref; P0 = splat16(c_); P1 = splat16(c_); } \
      else { const int base_ = 64 * dch_ + (qloc & 63) + 63; \
        _Pragma("unroll") for (int r = 0; r < 16; ++r) { const int i0 = base_ - crow(r, hi); P0[r] = tab[i0 < 319 ? i0 : 319] - mref; const int i1 = i0 - 32; P1[r] = tab[i1 < 319 ? i1 : 319] - mref; } } \
    } else { P0 = splat16(-mref); P1 = splat16(-mref); } } while (0)
#define ATT_MASK(P0, P1, t) do { if (MODE == 1) { if (!a.nomask) { const unsigned mw_ = *(const ATT_LAS unsigned*)(lds + MSK_OFF + ((t) & 3) * 2048 + w * 256 + (r32 * 2 + hi) * 4); \
      _Pragma("unroll") for (int r = 0; r < 16; ++r) { P0[r] = ((int)(mw_ << (31 - r)) < 0) ? P0[r] : -INFINITY; P1[r] = ((int)(mw_ << (15 - r)) < 0) ? P1[r] : -INFINITY; } } } } while (0)
  float mref = 0.f, l = 0.f; f32x16 o[2]; o[0] = splat16(0.f); o[1] = splat16(0.f);
  ATT_DMA(a.t0); if (a.t0 + 1 <= a.t1) ATT_DMA(a.t0 + 1); if (a.t0 + 2 <= a.t1) ATT_DMA(a.t0 + 2);
  wait_bar<0>();
  f32x16 c0 = splat16(0.f), c1 = splat16(0.f);
  bool act_cur = ATT_ACTIVE(a.t0);
  if (act_cur) { ATT_INIT(c0, c1, a.t0); qk_tile(c0, c1, lds + (a.t0 & 3) * SLOT, qr, r32, hi); }
  for (int t = a.t0; t <= a.t1; ++t) {
    if (t > a.t0) { if (t + 2 <= a.t1) wait_bar<P>(); else wait_bar<0>(); }
    if (t + 3 <= a.t1) ATT_DMA(t + 3);
    const bool act_next = (t + 1 <= a.t1) && ATT_ACTIVE(t + 1);
    f32x16 n0 = splat16(0.f), n1 = splat16(0.f);
    lptr slot_c = lds + (t & 3) * SLOT, slot_n = lds + ((t + 1) & 3) * SLOT;
    if (act_cur && act_next) {
      ATT_MASK(c0, c1, t);
      sm_decide<2>(c0, c1, mref, l, o);
      ATT_INIT(n0, n1, t + 1);
      qk_tile(n0, n1, slot_n, qr, r32, hi);
      sm_exp_sum(c0, c1, l);
      pv_tile<2>(o, slot_c + 8192, c0, c1, lane);
    } else if (act_cur) {
      ATT_MASK(c0, c1, t);
      sm_decide<2>(c0, c1, mref, l, o);
      sm_exp_sum(c0, c1, l);
      pv_tile<2>(o, slot_c + 8192, c0, c1, lane);
    } else if (act_next) {
      ATT_INIT(n0, n1, t + 1);
      qk_tile(n0, n1, slot_n, qr, r32, hi);
    }
    c0 = n0; c1 = n1; act_cur = act_next;
  }
  asm volatile("s_waitcnt lgkmcnt(0)\n\ts_barrier" ::: "memory");
  l = swapsum(l);
  store_o<2>(a.O + (size_t)qloc * a.ldo, o, __builtin_amdgcn_rcpf(l), hi);
#undef ATT_DMA
#undef ATT_ACTIVE
#undef ATT_INIT
#undef ATT_MASK
}

constexpr int TOPK = 256;
ADI void idx_kload(const bf16_t* ki0, int s, unsigned loff, bf16x8 (&kf)[4]) {
  const ATT_GAS char* bs = (const ATT_GAS char*)(ki0 + (size_t)s * (32 * 256));
#pragma unroll
  for (int d0 = 0; d0 < 4; ++d0) kf[d0] = __builtin_bit_cast(bf16x8, *(const ATT_GAS u32x4*)(bs + (loff + 32u * d0)));
}
ADI void idx_park(unsigned* kscr, int s, int lane, const unsigned (&u)[16]) {
  ATT_GAS u32x4* p = (ATT_GAS u32x4*)(kscr + (size_t)s * 1024) + lane;
#pragma unroll
  for (int j = 0; j < 4; ++j) { u32x4 v = {u[4 * j], u[4 * j + 1], u[4 * j + 2], u[4 * j + 3]}; p[64 * j] = v; }
}
ADI void idx_fetch(const unsigned* kscr, int s, int lane, unsigned (&u)[16]) {
  const ATT_GAS u32x4* p = (const ATT_GAS u32x4*)(kscr + (size_t)s * 1024) + lane;
#pragma unroll
  for (int j = 0; j < 4; ++j) { const u32x4 v = p[64 * j]; u[4 * j] = v.x; u[4 * j + 1] = v.y; u[4 * j + 2] = v.z; u[4 * j + 3] = v.w; }
}
ADI void idx_scores2(const bf16x8 (&kA)[4], const bf16x8 (&kB)[4], lptr qimg, const float (&wv)[4], unsigned (&uA)[16], unsigned (&uB)[16], unsigned zA, unsigned zB) {
  float sA[16], sB[16];
#pragma unroll
  for (int hp = 0; hp < 2; ++hp) {
    bf16x8 q0[4], q1[4];
#pragma unroll
    for (int d0 = 0; d0 < 4; ++d0) { q0[d0] = *(const ATT_LAS bf16x8*)(qimg + ((2 * hp) * 4 + d0) * 1024); q1[d0] = *(const ATT_LAS bf16x8*)(qimg + ((2 * hp + 1) * 4 + d0) * 1024); }
    f32x16 a0 = splat16(0.f), a1 = splat16(0.f), b0 = splat16(0.f), b1 = splat16(0.f);
#pragma unroll
    for (int d0 = 0; d0 < 4; ++d0) {
      a0 = __builtin_amdgcn_mfma_f32_32x32x16_bf16(kA[d0], q0[d0], a0, 0, 0, 0); b0 = __builtin_amdgcn_mfma_f32_32x32x16_bf16(kB[d0], q0[d0], b0, 0, 0, 0);
      a1 = __builtin_amdgcn_mfma_f32_32x32x16_bf16(kA[d0], q1[d0], a1, 0, 0, 0); b1 = __builtin_amdgcn_mfma_f32_32x32x16_bf16(kB[d0], q1[d0], b1, 0, 0, 0); }
#pragma unroll
    for (int r = 0; r < 16; ++r) {
      const float ra0 = __int_as_float(max(__float_as_int(a0[r]), 0)), ra1 = __int_as_float(max(__float_as_int(a1[r]), 0));
      const float rb0 = __int_as_float(max(__float_as_int(b0[r]), 0)), rb1 = __int_as_float(max(__float_as_int(b1[r]), 0));
      sA[r] = __builtin_fmaf(ra0, wv[2 * hp], hp == 0 ? 0.0f : sA[r]); sA[r] = __builtin_fmaf(ra1, wv[2 * hp + 1], sA[r]);
      sB[r] = __builtin_fmaf(rb0, wv[2 * hp], hp == 0 ? 0.0f : sB[r]); sB[r] = __builtin_fmaf(rb1, wv[2 * hp + 1], sB[r]);
    }
  }
#pragma unroll
  for (int r = 0; r < 16; ++r) {
    const unsigned ba = __float_as_uint(sA[r]), bb = __float_as_uint(sB[r]);
    const unsigned kk = (unsigned)(((r & 3) + 8 * (r >> 2)) << 11);
    unsigned ka = ((int)ba < 0) ? ~ba : ba + 0x80800000u, kb = ((int)bb < 0) ? ~bb : bb + 0x80800000u;
    uA[r] = (ba == 0u) ? zA - kk : ka; uB[r] = (bb == 0u) ? zB - kk : kb;
  }
}
ADI unsigned wave_excl_scan(unsigned v, int lane) {
  unsigned x = v;
#pragma unroll
  for (int d = 1; d < 64; d <<= 1) { const unsigned t = __shfl_up(x, d); if (lane >= d) x += t; }
  return x - v;
}
#define IDX_DPP_SHR(x, n) ((unsigned)__builtin_amdgcn_update_dpp(0, (int)(x), 0x110 + (n), 0xf, 0xf, true))
ADI void hist_scan4(ATT_LAS unsigned* hist, ATT_LAS unsigned* res, int w, int lane_in) {
  int lane = lane_in; asm volatile("" : "+v"(lane));
  const int rho = lane >> 4, q = 4 * w + rho, li = lane & 15;
  const unsigned k = res[q * 4 + 1];
  ATT_LAS unsigned* hq = hist + q * 1024;
  const int p0 = 1023 - 64 * li;
  unsigned T = 0;
#pragma unroll 16
  for (int t = 0; t < 64; ++t) { const unsigned o = (unsigned)(t + 4 * li + rho) & 63u; const unsigned wd = hq[(unsigned)(p0 - (int)o) ^ (unsigned)q]; T += (wd & 0xffffu) + (wd >> 16); }
  unsigned x = T;
  x += IDX_DPP_SHR(x, 1); x += IDX_DPP_SHR(x, 2); x += IDX_DPP_SHR(x, 4); x += IDX_DPP_SHR(x, 8);
  const unsigned E = x - T;
  if (E < k && k <= E + T) { res[q * 4 + 3] = (unsigned)p0; res[q * 4 + 2] = E; }
  asm volatile("s_waitcnt lgkmcnt(0)" ::: "memory");
  const int pL = (int)res[q * 4 + 3]; const unsigned EL = res[q * 4 + 2];
  unsigned wd4[4]; unsigned s4 = 0;
#pragma unroll
  for (int j = 0; j < 4; ++j) { wd4[j] = hq[(unsigned)(pL - 4 * li - j) ^ (unsigned)q]; s4 += (wd4[j] & 0xffffu) + (wd4[j] >> 16); }
  unsigned y = s4;
  y += IDX_DPP_SHR(y, 1); y += IDX_DPP_SHR(y, 2); y += IDX_DPP_SHR(y, 4); y += IDX_DPP_SHR(y, 8);
  const unsigned E2 = EL + (y - s4);
  asm volatile("s_waitcnt lgkmcnt(0)" ::: "memory");
  if (E2 < k && k <= E2 + s4) {
    unsigned cum = E2, fbin = 0, frem = 0, fcnt = 0;
#pragma unroll
    for (int j = 0; j < 4; ++j) {
      const unsigned p = (unsigned)(pL - 4 * li - j), chi = wd4[j] >> 16, clo = wd4[j] & 0xffffu;
      if (cum < k && k <= cum + chi) { fbin = 2 * p + 1; frem = k - cum; fcnt = chi; }
      cum += chi;
      if (cum < k && k <= cum + clo) { fbin = 2 * p; frem = k - cum; fcnt = clo; }
      cum += clo;
    }
    res[q * 4 + 0] = fbin; res[q * 4 + 1] = frem; res[q * 4 + 2] = fcnt;
  }
}
#define IDX_PREF0() do { if (w < NS) { idx_kload(KI, w, loff, kA_); idx_kload(KI, (w + 8 < NS) ? w + 8 : w, loff, kB_); } } while (0)
#define IDX_LOOP0(BODY) do { \
    for (int s_ = w; s_ < NS; s_ += 16) { const bool hb_ = s_ + 8 < NS; \
      unsigned pA_[16], pB_[16]; { const unsigned zA_ = 0x80000000u + ((4095u - 32u * (unsigned)s_ - 4u * (unsigned)hi) << 11); idx_scores2(kA_, kB_, qimg, wv, pA_, pB_, zA_, zA_ - (256u << 11)); } \
      if (s_ + 16 < NS) { idx_kload(KI, s_ + 16, loff, kA_); idx_kload(KI, (s_ + 24 < NS) ? s_ + 24 : s_ + 16, loff, kB_); } \
      { unsigned (&u)[16] = pA_; idx_park(kscr, s_, lane, u); BODY(s_); } \
      if (hb_) { unsigned (&u)[16] = pB_; idx_park(kscr, s_ + 8, lane, u); BODY(s_ + 8); } } } while (0)
#define IDX_SWEEP0(BODY) do { IDX_PREF0(); IDX_LOOP0(BODY); } while (0)
#define IDX_PREF() do { if (w < NS) idx_fetch(kscr, w, lane, uA_); if (w + 8 < NS) idx_fetch(kscr, w + 8, lane, uB_); if (w + 16 < NS) idx_fetch(kscr, w + 16, lane, uC_); } while (0)
#define IDX_LOOP(BODY) do { \
    for (int s_ = w; s_ < NS; s_ += 32) { \
      if (s_ + 24 < NS) idx_fetch(kscr, s_ + 24, lane, uD_); { unsigned (&u)[16] = uA_; BODY(s_); } \
      if (s_ + 8 < NS) { if (s_ + 32 < NS) idx_fetch(kscr, s_ + 32, lane, uA_); unsigned (&u)[16] = uB_; BODY(s_ + 8); } \
      if (s_ + 16 < NS) { if (s_ + 40 < NS) idx_fetch(kscr, s_ + 40, lane, uB_); unsigned (&u)[16] = uC_; BODY(s_ + 16); } \
      if (s_ + 24 < NS) { if (s_ + 48 < NS) idx_fetch(kscr, s_ + 48, lane, uC_); unsigned (&u)[16] = uD_; BODY(s_ + 24); } } } while (0)
#define IDX_SWEEP(BODY) do { IDX_PREF(); IDX_LOOP(BODY); } while (0)
#define IDX_ADD(bin) do { unsigned sh_; asm("v_mad_u32_u24 %0, %1, %2, 1" : "=v"(sh_) : "v"((bin) & 1u), "s"(c16_));   \
    __hip_atomic_fetch_add(hist + r32 * 1024 + (((bin) >> 1) ^ (unsigned)r32), sh_, __ATOMIC_RELAXED, __HIP_MEMORY_SCOPE_WORKGROUP); \
    if (IDX_PROBE_DUP) __hip_atomic_fetch_add((ATT_LAS unsigned*)(lds + 148736) + (r32 * 32 + ((((bin) >> 1) ^ (unsigned)r32) & 31u)), sh_, __ATOMIC_RELAXED, __HIP_MEMORY_SCOPE_WORKGROUP); } while (0)
#ifndef IDX_PROBE_DUP
#define IDX_PROBE_DUP 0
#endif
#ifndef IDX_PROBE_P0
#define IDX_PROBE_P0 0
#endif
#ifndef IDX_PROBE_SCAN
#define IDX_PROBE_SCAN 0
#endif
#ifndef IDX_PROBE_P1
#define IDX_PROBE_P1 0
#endif
constexpr int IDX_QOFF = 132352;
constexpr unsigned IDX_CAP = 16;
ADI void idx_unit(lptr lds, const bf16_t* QI, const bf16_t* KI, unsigned short* mask16, unsigned* kscr, int n, int half, int tid_in) {
  int tid_l = tid_in; asm volatile("" : "+v"(tid_l));
#define IDX_BAR() do { asm volatile("s_waitcnt lgkmcnt(0)" ::: "memory"); __builtin_amdgcn_s_barrier(); asm volatile("" ::: "memory"); } while (0)
  const int tid = tid_l, lane = tid & 63, r32 = lane & 31, hi = lane >> 5, w = __builtin_amdgcn_readfirstlane(tid >> 6);
  ATT_LAS unsigned* hist = (ATT_LAS unsigned*)lds;
  ATT_LAS unsigned* res = (ATT_LAS unsigned*)(lds + 131072);
  const int qpos = 64 * n + 32 * half + r32;
  const int NS = 2 * (n + 1);
  const unsigned loff = (unsigned)(r32 * 512 + hi * 16);
  unsigned uA_[16], uB_[16], uC_[16], uD_[16]; bf16x8 kA_[4], kB_[4];
  IDX_PREF0();
  u32x4 qst_[2];
  { const int q0row = 64 * n + 32 * half;
#pragma unroll
    for (int i = 0; i < 2; ++i) { const int p = tid + 512 * i, q = p >> 5, c16 = p & 31; qst_[i] = ldg16(QI + (size_t)(q0row + q) * 256 + c16 * 8); } }
  lptr qimg = lds + IDX_QOFF + hi * 512 + r32 * 16;
  float wv[4];
  { const u32x2 ww = *(const ATT_GAS u32x2*)(KI + (size_t)qpos * 256 + 64);
    wv[0] = __uint_as_float(ww.x << 16) * 0.0625f; wv[1] = __uint_as_float(ww.x & 0xffff0000u) * 0.0625f; wv[2] = __uint_as_float(ww.y << 16) * 0.0625f; wv[3] = __uint_as_float(ww.y & 0xffff0000u) * 0.0625f; }
  const unsigned moff = (unsigned)(qpos * 8 + hi * 4);
  if (tid < 32) res[tid * 4 + 1] = TOPK;
  if (tid == 32 || tid == 33) res[128 + (tid - 32)] = 0u;
  unsigned pre = 0u, thr = 0u, cut = 0xffffu; bool needtie = false;
  unsigned c16_ = 0xffffu; asm volatile("" : "+s"(c16_));
#define IDX_ZERO() do { const u32x4 z_ = {0u, 0u, 0u, 0u}; _Pragma("unroll") for (int i = 0; i < 16; ++i) *(ATT_LAS u32x4*)(lds + (size_t)(i * 512 + tid) * 16) = z_; IDX_BAR(); } while (0)
#define IDX_SCAN() do { IDX_BAR(); hist_scan4(hist, res, w, lane); IDX_BAR(); } while (0)
  { const u32x4 z_ = {0u, 0u, 0u, 0u};
#pragma unroll
    for (int i = 0; i < 16; ++i) *(ATT_LAS u32x4*)(lds + (size_t)(i * 512 + tid) * 16) = z_;
#pragma unroll
    for (int i = 0; i < 2; ++i) { const int p = tid + 512 * i, q = p >> 5, c16 = p & 31; *(ATT_LAS u32x4*)(lds + IDX_QOFF + c16 * 512 + q * 16) = qst_[i]; }
    IDX_BAR(); }
#define IDX_B0(s) do { _Pragma("unroll") for (int r = 0; r < 16; ++r) IDX_ADD(u[r] >> 21); } while (0)
#define IDX_B0_(s) IDX_B0(s)
#if IDX_PROBE_P0
  { IDX_SWEEP0(IDX_B0_); IDX_BAR(); IDX_ZERO(); }
#endif
  IDX_LOOP0(IDX_B0);
#if IDX_PROBE_SCAN
  { ATT_LAS unsigned* res2 = (ATT_LAS unsigned*)(lds + 149760); if (tid < 32) res2[tid * 4 + 1] = TOPK; IDX_BAR(); hist_scan4(hist, res2, w, lane); IDX_BAR(); }
#endif
  IDX_BAR();
  IDX_PREF();
  hist_scan4(hist, res, w, lane); IDX_BAR();
  pre = res[r32 * 4 + 0];
  IDX_ZERO();
#define IDX_B1D(s) do { _Pragma("unroll") for (int r = 0; r < 16; ++r) { if ((u[r] >> 21) == pre) __hip_atomic_fetch_add((ATT_LAS unsigned*)(lds + 148736) + (r32 * 32 + (((u[r] >> 11) ^ (unsigned)r32) & 31u)), 1u, __ATOMIC_RELAXED, __HIP_MEMORY_SCOPE_WORKGROUP); } } while (0)
#define IDX_B1(s) do { _Pragma("unroll") for (int r = 0; r < 16; ++r) { if ((u[r] >> 21) == pre) IDX_ADD((u[r] >> 10) & 2047u); } } while (0)
#if IDX_PROBE_P1
  { IDX_SWEEP(IDX_B1D); IDX_BAR(); }
#endif
  IDX_LOOP(IDX_B1);
  IDX_PREF();
  IDX_SCAN();
  unsigned krem;
  { const unsigned fbin = res[r32 * 4 + 0], fcnt = res[r32 * 4 + 2]; krem = res[r32 * 4 + 1]; pre = (pre << 11) | fbin; if (fcnt > IDX_CAP) res[129] = 1u; }
  IDX_BAR();
  if (res[129] == 0u) {
    ATT_LAS unsigned* cand = (ATT_LAS unsigned*)lds;
    ATT_LAS unsigned* ccnt = (ATT_LAS unsigned*)(lds + 4096);
    if (tid < 32) ccnt[tid] = 0u;
    IDX_BAR();
#define IDX_BM(s) do { unsigned bits_ = 0u; _Pragma("unroll") for (int r = 15; r >= 0; --r) { const unsigned p_ = u[r] >> 10; bits_ = (bits_ << 1) | (p_ > pre ? 1u : 0u); \
        if (p_ == pre) { const unsigned pos_ = __hip_atomic_fetch_add(ccnt + r32, 1u, __ATOMIC_RELAXED, __HIP_MEMORY_SCOPE_WORKGROUP); cand[r32 * IDX_CAP + (pos_ & (IDX_CAP - 1))] = ((u[r] & 1023u) << 12) | (4095u - (unsigned)(32 * (s) + crow(r, hi))); } } \
      *(ATT_GAS unsigned short*)((ATT_GAS char*)(mask16 + (size_t)((s) >> 1) * 16384 + ((s) & 1)) + moff) = (unsigned short)bits_; } while (0)
    IDX_LOOP(IDX_BM);
    asm volatile("s_waitcnt vmcnt(0)" ::: "memory");
    IDX_BAR();
    if (tid < 32) {
      const unsigned q = (unsigned)tid, cnt = ccnt[q], need = res[q * 4 + 1];
      const int qp = 64 * n + 32 * half + (int)q;
      for (unsigned j = 0; j < need && j < cnt; ++j) {
        unsigned best = 0u, bi = 0u;
        for (unsigned i = 0; i < cnt; ++i) { const unsigned c = cand[q * IDX_CAP + i]; if (c >= best) { best = c; bi = i; } }
        cand[q * IDX_CAP + bi] = 0u;
        if (j + 1 == need || true) { const unsigned kidx = 4095u - (best & 4095u), s2 = kidx >> 5, wi = kidx & 31u, hc = (wi >> 2) & 1u, rr = (wi & 3u) + 4u * (wi >> 3);
          __hip_atomic_fetch_or((ATT_GAS unsigned*)mask16 + (((size_t)(s2 >> 1) * 4096 + qp) * 2 + hc), 1u << (16u * (s2 & 1u) + rr), __ATOMIC_RELAXED, __HIP_MEMORY_SCOPE_AGENT); }
      }
    }
    (void)krem;
  } else {
    IDX_ZERO();
#define IDX_B2(s) do { _Pragma("unroll") for (int r = 0; r < 16; ++r) { if ((u[r] >> 10) == pre) IDX_ADD(u[r] & 1023u); } } while (0)
    IDX_LOOP(IDX_B2);
    IDX_SCAN();
    { const unsigned fbin = res[r32 * 4 + 0], frem = res[r32 * 4 + 1], fcnt = res[r32 * 4 + 2]; thr = (pre << 10) | fbin; needtie = frem < fcnt; if (needtie) res[128] = 1u; }
    IDX_BAR();
    if (res[128] != 0u) {
      IDX_ZERO();
#define IDX_B3(s) do { _Pragma("unroll") for (int r = 0; r < 16; ++r) { if (u[r] == thr) IDX_ADD(2047u - (unsigned)((32 * (s) + crow(r, hi)) >> 1)); } } while (0)
      IDX_SWEEP(IDX_B3);
      IDX_SCAN();
      { const unsigned fbin = res[r32 * 4 + 0], frem = res[r32 * 4 + 1], fcnt = res[r32 * 4 + 2]; const unsigned bt = 2047u - fbin; if (needtie) cut = (frem == 1u && fcnt == 2u) ? 2u * bt : 2u * bt + 1u; }
      IDX_BAR();
    }
#define IDX_BS(s) do { unsigned bits_ = 0u; _Pragma("unroll") for (int r = 15; r >= 0; --r) { const unsigned kidx_ = (unsigned)(32 * (s) + crow(r, hi)); const bool sel_ = (u[r] > thr) || (u[r] == thr && kidx_ <= cut); bits_ = (bits_ << 1) | (sel_ ? 1u : 0u); } \
      *(ATT_GAS unsigned short*)((ATT_GAS char*)(mask16 + (size_t)((s) >> 1) * 16384 + ((s) & 1)) + moff) = (unsigned short)bits_; } while (0)
    IDX_SWEEP(IDX_BS);
  }
#undef IDX_BAR
#undef IDX_ZERO
#undef IDX_SCAN
#undef IDX_B0
#undef IDX_B1
#undef IDX_B2
#undef IDX_B3
#undef IDX_BM
#undef IDX_BS
}
#undef IDX_SWEEP
#undef IDX_SWEEP0
#undef IDX_PREF
#undef IDX_PREF0
#undef IDX_LOOP
#undef IDX_LOOP0
#undef IDX_ADD
}

namespace attx {
using bf16=__hip_bfloat16;
using bf16x8=__attribute__((ext_vector_type(8)))short;
using s16x4=__attribute__((ext_vector_type(4)))short;
using f32x16=__attribute__((ext_vector_type(16)))float;
using u32x4=__attribute__((ext_vector_type(4)))unsigned;
using f32x4v=__attribute__((ext_vector_type(4)))float;
constexpr int D=64,NW=8,QBLK=32,QB=QBLK*NW,KVBLK=64;
__device__ __forceinline__ int crow(int r,int hi){return (r&3)+8*(r>>2)+4*hi;}
#define SBAR() __builtin_amdgcn_sched_barrier(0)
constexpr int NSLOT=3, SLOTB=8192;
constexpr int LDS_K=0, LDS_V=NSLOT*SLOTB, LDS_WS=2*NSLOT*SLOTB, LDS_OST=LDS_WS+NW*64*4, LDS_MSK=LDS_OST+NW*4096, LDS_TAB=LDS_MSK+4*2048, LDS_BYTES=LDS_TAB+384*4;
__device__ __forceinline__ void glds16(const void*gsrc,unsigned lds_dst){unsigned keep;
  asm volatile("s_mov_b32 %0, m0\n\ts_mov_b32 m0, %2\n\ts_nop 0\n\tglobal_load_lds_dwordx4 %1, off\n\ts_mov_b32 m0, %0":"=&s"(keep):"v"(gsrc),"s"(lds_dst):"memory");}
__device__ __forceinline__ void glds4(const void*gsrc,unsigned lds_dst){unsigned keep;
  asm volatile("s_mov_b32 %0, m0\n\ts_mov_b32 m0, %2\n\ts_nop 0\n\tglobal_load_lds_dword %1, off\n\ts_mov_b32 m0, %0":"=&s"(keep):"v"(gsrc),"s"(lds_dst):"memory");}
__device__ __forceinline__ float max3f(float a,float b,float c){float r;asm("v_max3_f32 %0, %1, %2, %3":"=v"(r):"v"(a),"v"(b),"v"(c));return r;}
__device__ __forceinline__ float max2f(float a,float b){float r;asm("v_max_f32_e32 %0, %1, %2":"=v"(r):"v"(a),"v"(b));return r;}
__device__ __forceinline__ float fadd_s(float a,float b){float r;asm("v_add_f32_e32 %0, %1, %2":"=v"(r):"v"(a),"v"(b));return r;}
__device__ __forceinline__ float fsub_s(float a,float b){float r;asm("v_sub_f32_e32 %0, %1, %2":"=v"(r):"v"(a),"v"(b));return r;}
typedef float f32x2_t __attribute__((ext_vector_type(2))); typedef __bf16 bf16x2_t __attribute__((ext_vector_type(2)));
__device__ __forceinline__ unsigned cvtpk_s(float lo,float hi){f32x2_t v={lo,hi};bf16x2_t b=__builtin_convertvector(v,bf16x2_t);return __builtin_bit_cast(unsigned,b);}
#define WAIT_BAR(N) asm volatile("s_waitcnt vmcnt(" #N ") lgkmcnt(0)\n\ts_barrier":::"memory")
__device__ __forceinline__ void qkt(f32x16&p0,f32x16&p1,const char*Kslot,const bf16x8*qr,const f32x16&negm,int r32,int hi){
  const char*kb=Kslot+hi*1024+r32*16;
  #pragma unroll
  for(int d0=0;d0<4;++d0){
    const bf16x8 b0=*reinterpret_cast<const bf16x8*>(kb+d0*2048);
    const bf16x8 b1=*reinterpret_cast<const bf16x8*>(kb+d0*2048+512);
    if(d0==0){p0=__builtin_amdgcn_mfma_f32_32x32x16_bf16(b0,qr[0],negm,0,0,0);p1=__builtin_amdgcn_mfma_f32_32x32x16_bf16(b1,qr[0],negm,0,0,0);}
    else{p0=__builtin_amdgcn_mfma_f32_32x32x16_bf16(b0,qr[d0],p0,0,0,0);p1=__builtin_amdgcn_mfma_f32_32x32x16_bf16(b1,qr[d0],p1,0,0,0);}}
}
typedef __attribute__((address_space(3))) const char* lds_cptr;
typedef short v4i16_t __attribute__((ext_vector_type(4)));
__device__ __forceinline__ void kload8(bf16x8*kf,lds_cptr kp){
  kf[0]=*(const __attribute__((address_space(3))) bf16x8*)(kp);      kf[1]=*(const __attribute__((address_space(3))) bf16x8*)(kp+512);
  kf[2]=*(const __attribute__((address_space(3))) bf16x8*)(kp+2048); kf[3]=*(const __attribute__((address_space(3))) bf16x8*)(kp+2560);
  kf[4]=*(const __attribute__((address_space(3))) bf16x8*)(kp+4096); kf[5]=*(const __attribute__((address_space(3))) bf16x8*)(kp+4608);
  kf[6]=*(const __attribute__((address_space(3))) bf16x8*)(kp+6144); kf[7]=*(const __attribute__((address_space(3))) bf16x8*)(kp+6656);
}
__device__ __forceinline__ void kload2(bf16x8*kf,lds_cptr kp,int j){ kf[2*j]=*(const __attribute__((address_space(3))) bf16x8*)(kp+j*2048); kf[2*j+1]=*(const __attribute__((address_space(3))) bf16x8*)(kp+j*2048+512); }
__device__ __forceinline__ s16x4 vtr(lds_cptr p){ return __builtin_bit_cast(s16x4,__builtin_amdgcn_ds_read_tr16_b64_v4i16((__attribute__((address_space(3))) v4i16_t*)p)); }
__device__ __forceinline__ float rowmax(const f32x16&p0,const f32x16&p1){
  float a=max3f(p0[0],p0[1],p1[0]),b=max3f(p0[2],p0[3],p1[1]);a=max3f(a,p1[2],p1[3]);
  #pragma unroll
  for(int r=4;r<16;r+=4){a=max3f(a,p0[r],p0[r+1]);b=max3f(b,p0[r+2],p0[r+3]);a=max3f(a,p1[r],p1[r+1]);b=max3f(b,p1[r+2],p1[r+3]);}
  const float m=max2f(a,b);
  auto rr=__builtin_amdgcn_permlane32_swap(__float_as_uint(m),__float_as_uint(m),false,false);
  return max2f(__uint_as_float(rr[0]),__uint_as_float(rr[1]));
}
__device__ __forceinline__ void pv(f32x16*o,int vb,bf16x8 pa0,bf16x8 pa1,bf16x8 pa2,bf16x8 pa3){
  #pragma unroll
  for(int d0=0;d0<2;++d0){s16x4 lo[4],hi[4];
    #pragma unroll
    for(int ks=0;ks<4;++ks){
      asm volatile("ds_read_b64_tr_b16 %0,%1 offset:%c2":"=&v"(lo[ks]):"v"(vb),"i"(d0*4096+ks*1024):"memory");
      asm volatile("ds_read_b64_tr_b16 %0,%1 offset:%c2":"=&v"(hi[ks]):"v"(vb),"i"(d0*4096+ks*1024+512):"memory");}
    asm volatile("s_waitcnt lgkmcnt(0)":::"memory");SBAR();
    #define PK(k) (bf16x8){lo[k][0],lo[k][1],lo[k][2],lo[k][3],hi[k][0],hi[k][1],hi[k][2],hi[k][3]}
    o[d0]=__builtin_amdgcn_mfma_f32_32x32x16_bf16(pa0,PK(0),o[d0],0,0,0);
    o[d0]=__builtin_amdgcn_mfma_f32_32x32x16_bf16(pa1,PK(1),o[d0],0,0,0);
    o[d0]=__builtin_amdgcn_mfma_f32_32x32x16_bf16(pa2,PK(2),o[d0],0,0,0);
    o[d0]=__builtin_amdgcn_mfma_f32_32x32x16_bf16(pa3,PK(3),o[d0],0,0,0);
    #undef PK
  }
}
struct UA {
  const bf16* Qw0; int ldq;
  const bf16* Kh; const bf16* Vh; int ldkv;
  bf16* Ow0; int ldo;
  int NT;
  int tabs0;
  int cq0;
  const float* relb;
  const unsigned* msk;
  int nomask;
};
#ifndef ATTN_STORE16
#define ATTN_STORE16(p,v) (*(__attribute__((address_space(1))) u32x4*)(p)=(v))
#endif
template<int MODE,int THRL> __device__ __forceinline__ void attn_unit(const UA& a,char*shm,int tid_in){
  int tid_l=tid_in; asm volatile("":"+v"(tid_l));
  const int tid=tid_l,lane=tid&63,r32=lane&31,hi=lane>>5; const int wid=__builtin_amdgcn_readfirstlane(tid>>6);
  const long ldq=a.ldq, ldkv=a.ldkv, ldo=a.ldo;
  const bf16*Qw=a.Qw0+(long)(wid*QBLK)*ldq;
  const bf16*Kh=a.Kh,*Vh=a.Vh;
  const unsigned lds0=(unsigned)(uintptr_t)shm;
  float*wsf=(float*)(shm+LDS_WS)+wid*64;
  const bf16*ksrc=Kh+(long)lane*ldkv+wid*8;
  const bf16*vsrc=Vh+(long)(16*(wid&3)+(lane>>2))*ldkv+(wid>>2)*32+(lane&3)*8;
  const unsigned kdst=lds0+LDS_K+wid*1024, vdst=lds0+LDS_V+wid*1024;
  const int cq=a.cq0+(wid>>1);
  const unsigned* msrc=a.msk+((long)a.cq0*64+wid*32)*2+lane;
  const unsigned mdst=lds0+LDS_MSK+wid*256;
  const __attribute__((address_space(3))) float* tab=(const __attribute__((address_space(3))) float*)(__attribute__((address_space(3))) char*)(shm+LDS_TAB);
  if(MODE==0){ __attribute__((address_space(3))) float* tw=(__attribute__((address_space(3))) float*)(__attribute__((address_space(3))) char*)(shm+LDS_TAB);
    for(int i=tid;i<384;i+=512) tw[i]=((const __attribute__((address_space(1))) float*)a.relb)[i<319?i:319]*1.4426950408889634f; }
  #define DMA_K(t,slot) glds16(ksrc+(long)(t)*KVBLK*ldkv,(unsigned)__builtin_amdgcn_readfirstlane(kdst+(slot)))
  #define DMA_V(t,slot) glds16(vsrc+(long)(t)*KVBLK*ldkv,(unsigned)__builtin_amdgcn_readfirstlane(vdst+(slot)))
  #define DMA_M(t) do{ if(MODE==1) glds4(msrc+(long)(a.tabs0+(t))*8192,(unsigned)__builtin_amdgcn_readfirstlane(mdst+(((t)&3)*2048))); }while(0)
  const int vb0=(int)(lds0+LDS_V)+((lane>>4)&1)*32+(lane&3)*8+(4*hi+((lane&15)>>2))*64;
  const char*Kbase=shm+LDS_K; bf16x8 kf[8];
  const lds_cptr shm3=(lds_cptr)shm; const lds_cptr kp0=shm3+LDS_K+hi*1024+r32*16; const lds_cptr vp0=shm3+LDS_V+((lane>>4)&1)*32+(lane&3)*8+(4*hi+((lane&15)>>2))*64;
  const lds_cptr mp0=shm3+LDS_MSK+wid*256+(r32*2+hi)*4;
  const int NT=a.NT;
  DMA_K(0,0);DMA_V(0,0);DMA_K(1,SLOTB);DMA_M(0);DMA_M(1);
  bf16x8 qr[4];
  #pragma unroll
  for(int d0=0;d0<4;++d0)qr[d0]=*(const __attribute__((address_space(1))) bf16x8*)(&Qw[(long)r32*ldq+d0*16+hi*8]);
  float mhat=0.f,l_reg=0.f;f32x16 o[2];o[0]=f32x16{};o[1]=f32x16{};f32x16 negm=f32x16{};asm volatile("":"+v"(negm));
  const int qi=(wid&1)*32+r32;
  #define HOOK(P0,P1,tl) do{ const int ta_=a.tabs0+(tl); \
    if(MODE==0){ const int dch_=cq-ta_; \
      if(dch_<0||dch_>8){ _Pragma("unroll") for(int r=0;r<16;++r){P0[r]=-INFINITY;P1[r]=-INFINITY;} } \
      else if(dch_>=5){ const float c_=tab[319]; _Pragma("unroll") for(int r=0;r<16;++r){P0[r]+=c_;P1[r]+=c_;} } \
      else{ int ll_=lane; asm volatile("":"+v"(ll_)); const __attribute__((address_space(3))) float* tp_=tab+(64*dch_+(wid&1)*32+(ll_&31)+4-4*(ll_>>5)); _Pragma("unroll") for(int r=0;r<16;++r){ P0[r]+=tp_[59-((r&3)+8*(r>>2))]; P1[r]+=tp_[27-((r&3)+8*(r>>2))]; } } } \
    else if(MODE==1){ \
      if(ta_>cq){ _Pragma("unroll") for(int r=0;r<16;++r){P0[r]=-INFINITY;P1[r]=-INFINITY;} } \
      else if(!a.nomask){ const unsigned mw_=*(const __attribute__((address_space(3))) unsigned*)(mp0+(((tl)&3)*2048)); \
        _Pragma("unroll") for(int r=0;r<16;++r){ P0[r]=((int)(mw_<<(31-r))<0)?P0[r]:-INFINITY; P1[r]=((int)(mw_<<(15-r))<0)?P1[r]:-INFINITY; } } } \
    else if(MODE==3){ if(ta_>cq){ _Pragma("unroll") for(int r=0;r<16;++r){P0[r]=-INFINITY;P1[r]=-INFINITY;} } } \
  }while(0)
  bool resc=false;
  #define START(P0,P1) do{ const float rm=rowmax(P0,P1); resc=false; \
    { const float dl=(rm>-1e30f)?rm:0.f; mhat=fadd_s(mhat,dl); \
      _Pragma("unroll") for(int r=0;r<16;++r){P0[r]=fsub_s(P0[r],dl);P1[r]=fsub_s(P1[r],dl);} \
      _Pragma("unroll") for(int r=0;r<16;++r)negm[r]=-mhat; asm volatile("":"+v"(negm)); } \
    _Pragma("unroll") for(int r=0;r<16;++r)P0[r]=__builtin_amdgcn_exp2f(P0[r]); }while(0)
  #define RESC() do{ if(resc){ asm volatile("s_waitcnt lgkmcnt(0)":::"memory"); int hl_=lane>>5; asm volatile("":"+v"(hl_)); const float* wq_=(const float*)(shm+LDS_WS)+wid*64+4*hl_; \
      _Pragma("unroll") for(int d_=0;d_<2;++d_) _Pragma("unroll") for(int r=0;r<16;++r)o[d_][r]*=wq_[(r&3)+8*(r>>2)]; } }while(0)
  f32x16 pA0,pA1,pB0,pB1;
  int sl_prev=0,sl_cur=0,sl_next=SLOTB;
  #define ROT() do{sl_prev=sl_cur;sl_cur=sl_next;sl_next=(sl_next==(NSLOT-1)*SLOTB)?0:sl_next+SLOTB;}while(0)
  DMA_K(2,2*SLOTB);
  WAIT_BAR(0);
  qkt(pA0,pA1,Kbase,qr,negm,r32,hi);asm volatile("s_nop 15\n\ts_nop 7":"+v"(pA0),"+v"(pA1));HOOK(pA0,pA1,0);
  START(pA0,pA1);
  _Pragma("unroll") for(int r=0;r<16;++r)pA1[r]=__builtin_amdgcn_exp2f(pA1[r]);
  WAIT_BAR(0);
  DMA_K(3,0);DMA_V(1,SLOTB);DMA_M(2);
  ROT();
  kload8(kf,kp0+sl_cur);
  if(MODE==1){WAIT_BAR(3);}else{WAIT_BAR(2);}
  s16x4 vlo[8],vhi[8]; u32x4 pw0,pw1,pw2,pw3;
  #define PKW(P,B) cvtpk_s(P[B],P[B+1])
  #define PAF(k) __builtin_bit_cast(bf16x8,pw##k)
  #define VFR(i) (bf16x8){vlo[i][0],vlo[i][1],vlo[i][2],vlo[i][3],vhi[i][0],vhi[i][1],vhi[i][2],vhi[i][3]}
  #define PIN(x) asm volatile("":"+v"(x))
  #define MX3(a,b,c) __builtin_fmaxf(__builtin_fmaxf((a),(b)),(c))
  #define GAPA(MF,A0,A1,A2,A3,W0,W1,PW) do{ MF; sacc+=A0; sacc+=A1; sacc+=A2; sacc+=A3; PIN(sacc); W0; W1; PIN(PW); SBAR(); }while(0)
  #define EX(v) __builtin_amdgcn_exp2f(v)
  #define GAPB(MF,X,B) do{ MF; X[B]=EX(X[B]); X[B+1]=EX(X[B+1]); X[B+2]=EX(X[B+2]); X[B+3]=EX(X[B+3]); PIN(X); SBAR(); }while(0)
  #define VRD(i) do{ vlo[i]=vtr(vp_+(((i)>>2)*4096+((i)&3)*1024)); vhi[i]=vtr(vp_+(((i)>>2)*4096+((i)&3)*1024+512)); }while(0)
  #define KRD(G,j) do{ if(G){ kload2(kf,kp0+sl_next,j); SBAR(); } }while(0)
  #define STEP(C0,C1,P0,P1,t,GK,GV,GL,GM) do{ SBAR(); \
    const lds_cptr vp_=vp0+sl_prev; \
    VRD(0); SBAR(); float sacc=(P0[0]+P0[1]); \
    GAPA(C0=__builtin_amdgcn_mfma_f32_32x32x16_bf16(kf[0],qr[0],negm,0,0,0), P0[2],P0[3],P0[4],P0[5],     pw0[0]=PKW(P0,0), pw0[1]=PKW(P0,2), pw0); \
    VRD(4); SBAR(); GAPA(C1=__builtin_amdgcn_mfma_f32_32x32x16_bf16(kf[1],qr[0],negm,0,0,0), P0[6],P0[7],P0[8],P0[9],     pw0[2]=PKW(P0,4), pw0[3]=PKW(P0,6), pw0); \
    VRD(1); SBAR(); GAPA(C0=__builtin_amdgcn_mfma_f32_32x32x16_bf16(kf[2],qr[1],C0,0,0,0),   P0[10],P0[11],P0[12],P0[13], pw1[0]=PKW(P0,8), pw1[1]=PKW(P0,10), pw1); \
    VRD(5); SBAR(); GAPA(C1=__builtin_amdgcn_mfma_f32_32x32x16_bf16(kf[3],qr[1],C1,0,0,0),   P0[14],P0[15],P1[0],P1[1],   pw1[2]=PKW(P0,12),pw1[3]=PKW(P0,14), pw1); \
    VRD(2); SBAR(); GAPA(C0=__builtin_amdgcn_mfma_f32_32x32x16_bf16(kf[4],qr[2],C0,0,0,0),   P1[2],P1[3],P1[4],P1[5],     pw2[0]=PKW(P1,0), pw2[1]=PKW(P1,2), pw2); \
    VRD(6); SBAR(); GAPA(C1=__builtin_amdgcn_mfma_f32_32x32x16_bf16(kf[5],qr[2],C1,0,0,0),   P1[6],P1[7],P1[8],P1[9],     pw2[2]=PKW(P1,4), pw2[3]=PKW(P1,6), pw2); \
    VRD(3); SBAR(); GAPA(C0=__builtin_amdgcn_mfma_f32_32x32x16_bf16(kf[6],qr[3],C0,0,0,0),   P1[10],P1[11],P1[12],P1[13], pw3[0]=PKW(P1,8), pw3[1]=PKW(P1,10), pw3); \
    VRD(7); SBAR(); GAPA(C1=__builtin_amdgcn_mfma_f32_32x32x16_bf16(kf[7],qr[3],C1,0,0,0),   P1[14],P1[15],0.f,0.f,       pw3[2]=PKW(P1,12),pw3[3]=PKW(P1,14), pw3); \
    l_reg+=sacc; \
    if(GK){DMA_K((t)+3,sl_cur);} if(GV){DMA_V((t)+1,sl_next);} if(GM){DMA_M((t)+2);} \
    HOOK(C0,C1,t); \
    { float a_=MX3(C0[0],C0[1],C1[0]),b_=MX3(C0[2],C0[3],C1[1]); a_=MX3(a_,C1[2],C1[3]); \
      _Pragma("unroll") for(int r=4;r<16;r+=4){a_=MX3(a_,C0[r],C0[r+1]);b_=MX3(b_,C0[r+2],C0[r+3]);a_=MX3(a_,C1[r],C1[r+1]);b_=MX3(b_,C1[r+2],C1[r+3]);} \
      float rm=__builtin_fmaxf(a_,b_); { auto rr=__builtin_amdgcn_permlane32_swap(__float_as_uint(rm),__float_as_uint(rm),false,false); rm=__builtin_fmaxf(__uint_as_float(rr[0]),__uint_as_float(rr[1])); } \
      resc=false; \
      if(__builtin_expect(__any(rm>(float)THRL),0)){ const float dl=__builtin_fmaxf(rm,0.f); mhat+=dl; \
        _Pragma("unroll") for(int r=0;r<16;++r){C0[r]-=dl;C1[r]-=dl;} \
        _Pragma("unroll") for(int r=0;r<16;++r)negm[r]=-mhat; asm volatile("":"+v"(negm)); \
        const float f=__builtin_amdgcn_exp2f(-dl); l_reg*=f; { int rl_=lane; asm volatile("":"+v"(rl_)); if(rl_<32)((float*)(shm+LDS_WS))[wid*64+rl_]=f; } resc=true; } } \
    SBAR(); \
    GAPB(o[0]=__builtin_amdgcn_mfma_f32_32x32x16_bf16(PAF(0),VFR(0),o[0],0,0,0), C0,0); \
    GAPB(o[1]=__builtin_amdgcn_mfma_f32_32x32x16_bf16(PAF(0),VFR(4),o[1],0,0,0), C0,4); \
    KRD(GL,0); GAPB(o[0]=__builtin_amdgcn_mfma_f32_32x32x16_bf16(PAF(1),VFR(1),o[0],0,0,0), C0,8); \
    KRD(GL,1); GAPB(o[1]=__builtin_amdgcn_mfma_f32_32x32x16_bf16(PAF(1),VFR(5),o[1],0,0,0), C0,12); \
    KRD(GL,2); GAPB(o[0]=__builtin_amdgcn_mfma_f32_32x32x16_bf16(PAF(2),VFR(2),o[0],0,0,0), C1,0); \
    KRD(GL,3); GAPB(o[1]=__builtin_amdgcn_mfma_f32_32x32x16_bf16(PAF(2),VFR(6),o[1],0,0,0), C1,4); \
    GAPB(o[0]=__builtin_amdgcn_mfma_f32_32x32x16_bf16(PAF(3),VFR(3),o[0],0,0,0), C1,8); \
    GAPB(o[1]=__builtin_amdgcn_mfma_f32_32x32x16_bf16(PAF(3),VFR(7),o[1],0,0,0), C1,12); \
    }while(0)
  #define WSTD() do{ if(MODE==1){WAIT_BAR(3);}else{WAIT_BAR(2);} }while(0)
  #define ENDW(tt) do{ if((tt)+3<NT){WSTD();} else if((tt)+2<NT){ if(MODE==1){WAIT_BAR(2);}else{WAIT_BAR(1);} } else {WAIT_BAR(0);} }while(0)
  int t=1;
  for(;t+5<NT;t+=2){
    STEP(pB0,pB1,pA0,pA1,t,true,true,true,true);     WSTD(); RESC(); ROT();
    STEP(pA0,pA1,pB0,pB1,t+1,true,true,true,true);   WSTD(); RESC(); ROT();
  }
  for(;t+1<NT;t+=2){
    STEP(pB0,pB1,pA0,pA1,t,(t+3<NT),(t+1<NT),(t+1<NT),(t+2<NT));       ENDW(t);   RESC(); ROT();
    STEP(pA0,pA1,pB0,pB1,t+1,(t+4<NT),(t+2<NT),(t+2<NT),(t+3<NT));     ENDW(t+1); RESC(); ROT();
  }
  STEP(pB0,pB1,pA0,pA1,NT-1,false,false,false,false); RESC();
  { float sacc=pB0[0]+pB0[1]; _Pragma("unroll") for(int r=2;r<16;++r)sacc+=pB0[r]; _Pragma("unroll") for(int r=0;r<16;++r)sacc+=pB1[r]; l_reg+=sacc;
    pw0=(u32x4){PKW(pB0,0),PKW(pB0,2),PKW(pB0,4),PKW(pB0,6)};pw1=(u32x4){PKW(pB0,8),PKW(pB0,10),PKW(pB0,12),PKW(pB0,14)};pw2=(u32x4){PKW(pB1,0),PKW(pB1,2),PKW(pB1,4),PKW(pB1,6)};pw3=(u32x4){PKW(pB1,8),PKW(pB1,10),PKW(pB1,12),PKW(pB1,14)};
    SBAR(); pv(o,vb0+sl_cur,PAF(0),PAF(1),PAF(2),PAF(3)); }
  #undef PKW
  #undef PAF
  #undef VFR
  #undef PIN
  #undef MX3
  #undef GAPA
  #undef GAPB
  #undef EX
  #undef VRD
  #undef KRD
  #undef STEP
  #undef ENDW
  #undef WSTD
  {auto rr=__builtin_amdgcn_permlane32_swap(__float_as_uint(l_reg),__float_as_uint(l_reg),false,false);l_reg=__uint_as_float(rr[0])+__uint_as_float(rr[1]);}
  if(hi==0)wsf[32+r32]=l_reg;asm volatile("s_waitcnt lgkmcnt(0)":::"memory");
  float rli[16];
  #pragma unroll
  for(int r=0;r<16;++r)rli[r]=__builtin_amdgcn_rcpf(wsf[32+crow(r,hi)]);
  bf16*Ow=a.Ow0+(long)(wid*QBLK)*ldo;
  { bf16*stg=(bf16*)(shm+LDS_OST)+wid*2048;
    #pragma unroll
    for(int r=0;r<16;++r){const int orow=crow(r,hi);
      #pragma unroll
      for(int d0=0;d0<2;++d0)stg[orow*64+d0*32+r32]=__float2bfloat16(o[d0][r]*rli[r]);}
    asm volatile("s_waitcnt lgkmcnt(0)":::"memory");
    #pragma unroll
    for(int i=0;i<4;++i){const int row=i*8+(lane>>3),ch=lane&7; const u32x4 v=*(const u32x4*)(stg+row*64+ch*8); ATTN_STORE16(Ow+(long)row*ldo+ch*8,v);} }
  asm volatile("s_waitcnt lgkmcnt(0)\n\ts_barrier":::"memory");
  #undef DMA_K
  #undef DMA_V
  #undef DMA_M
  #undef HOOK
  #undef START
  #undef RESC
  #undef ROT
}

struct UB { const bf16* Q; const bf16* K; const bf16* V; bf16* O;
  int qt;
  const float* subln; float lam, oscale; };
constexpr int B_SLOT=16384, B_LDS_K=0, B_LDS_V=3*B_SLOT, B_LDS_WS=6*B_SLOT, B_XROW=132;
template<int THRL> __device__ __forceinline__ void attn_unit_b2(const UB& a,char*shm,int tid_in){
  int tid_l=tid_in; asm volatile("":"+v"(tid_l));
  const int tid=tid_l,lane=tid&63,r32=lane&31,hi=lane>>5; const int wid=__builtin_amdgcn_readfirstlane(tid>>6);
  const int c=wid>>2, wq=wid&3;
  const int q0=128*a.qt;
  const int NT=(2*a.qt+2<4)?4:2*a.qt+2;
  const int cq=2*a.qt+(wq>>1);
  const bf16*Qw=a.Q+(long)(q0+32*wq)*512+c*64;
  const unsigned lds0=(unsigned)(uintptr_t)shm;
  float*wsf=(float*)(shm+B_LDS_WS)+wid*64;
  const bf16*ksrc=a.K+(long)lane*512+wid*8;
  const bf16*vsrc=a.V+(long)(16*(wid&3)+(lane>>2))*512+(wid>>2)*32+(lane&3)*8;
  const unsigned kdst=lds0+B_LDS_K+wid*1024, vdst=lds0+B_LDS_V+wid*1024;
  #define DMA_K(t,slot) do{ glds16(ksrc+(long)(t)*KVBLK*512,(unsigned)__builtin_amdgcn_readfirstlane(kdst+(slot))); glds16(ksrc+(long)(t)*KVBLK*512+64,(unsigned)__builtin_amdgcn_readfirstlane(kdst+(slot)+8192u)); }while(0)
  #define DMA_V(t,slot) do{ glds16(vsrc+(long)(t)*KVBLK*512,(unsigned)__builtin_amdgcn_readfirstlane(vdst+(slot))); glds16(vsrc+(long)(t)*KVBLK*512+64,(unsigned)__builtin_amdgcn_readfirstlane(vdst+(slot)+8192u)); }while(0)
  const int vb0=(int)(lds0+B_LDS_V)+((lane>>4)&1)*32+(lane&3)*8+(4*hi+((lane&15)>>2))*64;
  const char*Kbase=shm+B_LDS_K+c*8192; bf16x8 kf[8];
  const lds_cptr shm3=(lds_cptr)shm; const lds_cptr kp0=shm3+B_LDS_K+c*8192+hi*1024+r32*16; const lds_cptr vp0=shm3+B_LDS_V+((lane>>4)&1)*32+(lane&3)*8+(4*hi+((lane&15)>>2))*64;
  DMA_K(0,0);DMA_V(0,0);DMA_K(1,B_SLOT);
  bf16x8 qr[4];
  #pragma unroll
  for(int d0=0;d0<4;++d0)qr[d0]=*(const __attribute__((address_space(1))) bf16x8*)(&Qw[(long)r32*512+d0*16+hi*8]);
  float mhat=0.f,l_reg=0.f;f32x16 o[4];o[0]=f32x16{};o[1]=f32x16{};o[2]=f32x16{};o[3]=f32x16{};f32x16 negm=f32x16{};asm volatile("":"+v"(negm));
  #define HOOK(P0,P1,tl) do{ if((tl)>cq){ _Pragma("unroll") for(int r=0;r<16;++r){P0[r]=-INFINITY;P1[r]=-INFINITY;} } }while(0)
  bool resc=false;
  #define START(P0,P1) do{ const float rm=rowmax(P0,P1); resc=false; \
    { const float dl=(rm>-1e30f)?rm:0.f; mhat=fadd_s(mhat,dl); \
      _Pragma("unroll") for(int r=0;r<16;++r){P0[r]=fsub_s(P0[r],dl);P1[r]=fsub_s(P1[r],dl);} \
      _Pragma("unroll") for(int r=0;r<16;++r)negm[r]=-mhat; asm volatile("":"+v"(negm)); } \
    _Pragma("unroll") for(int r=0;r<16;++r)P0[r]=__builtin_amdgcn_exp2f(P0[r]); }while(0)
  #define RESC() do{ if(resc){ asm volatile("s_waitcnt lgkmcnt(0)":::"memory"); int hl_=lane>>5; asm volatile("":"+v"(hl_)); const float* wq_=(const float*)(shm+B_LDS_WS)+wid*64+4*hl_; \
      _Pragma("unroll") for(int d_=0;d_<4;++d_) _Pragma("unroll") for(int r=0;r<16;++r)o[d_][r]*=wq_[(r&3)+8*(r>>2)]; } }while(0)
  f32x16 pA0,pA1,pB0,pB1;
  int sl_prev=0,sl_cur=0,sl_next=B_SLOT;
  #define ROT() do{sl_prev=sl_cur;sl_cur=sl_next;sl_next=(sl_next==2*B_SLOT)?0:sl_next+B_SLOT;}while(0)
  DMA_K(2,2*B_SLOT);
  WAIT_BAR(0);
  qkt(pA0,pA1,Kbase,qr,negm,r32,hi);asm volatile("s_nop 15\n\ts_nop 7":"+v"(pA0),"+v"(pA1));HOOK(pA0,pA1,0);
  START(pA0,pA1);
  _Pragma("unroll") for(int r=0;r<16;++r)pA1[r]=__builtin_amdgcn_exp2f(pA1[r]);
  WAIT_BAR(0);
  DMA_K(3,0);DMA_V(1,B_SLOT);
  ROT();
  kload8(kf,kp0+sl_cur);
  WAIT_BAR(4);
  s16x4 valo,vahi,vblo,vbhi; u32x4 pw0,pw1,pw2,pw3;
  #define PKW(P,B) cvtpk_s(P[B],P[B+1])
  #define PAF(k) __builtin_bit_cast(bf16x8,pw##k)
  #define PIN(x) asm volatile("":"+v"(x))
  #define MX3(a,b,c) __builtin_fmaxf(__builtin_fmaxf((a),(b)),(c))
  #define GAPA(MF,A0,A1,A2,A3,W0,W1,PW) do{ MF; sacc+=A0; sacc+=A1; sacc+=A2; sacc+=A3; PIN(sacc); W0; W1; PIN(PW); SBAR(); }while(0)
  #define EX(v) __builtin_amdgcn_exp2f(v)
  #define VOFF(m) (((((m)&3)>>1)*8192)+((((m)&3)&1)*4+((m)>>2))*1024)
  #define VLDA(m) do{ valo=vtr(vp_+VOFF(m)); vahi=vtr(vp_+VOFF(m)+512); }while(0)
  #define VLDB(m) do{ vblo=vtr(vp_+VOFF(m)); vbhi=vtr(vp_+VOFF(m)+512); }while(0)
  #define VFA (bf16x8){valo[0],valo[1],valo[2],valo[3],vahi[0],vahi[1],vahi[2],vahi[3]}
  #define VFB (bf16x8){vblo[0],vblo[1],vblo[2],vblo[3],vbhi[0],vbhi[1],vbhi[2],vbhi[3]}
  #define GAPB2(MF,X,B) do{ MF; X[B]=EX(X[B]); X[B+1]=EX(X[B+1]); PIN(X); SBAR(); }while(0)
  #define KRD(G,j) do{ if(G){ kload2(kf,kp0+sl_next,j); SBAR(); } }while(0)
  #define PVE(m,PA,X,B) do{ VLDB((m)+1); SBAR(); GAPB2(o[(m)&3]=__builtin_amdgcn_mfma_f32_32x32x16_bf16(PA,VFA,o[(m)&3],0,0,0),X,B); }while(0)
  #define PVO(m,PA,X,B,LAST) do{ if(!(LAST)){VLDA((m)+1);} SBAR(); GAPB2(o[(m)&3]=__builtin_amdgcn_mfma_f32_32x32x16_bf16(PA,VFB,o[(m)&3],0,0,0),X,B); }while(0)
  #define STEP(C0,C1,P0,P1,t,GK,GV,GL) do{ SBAR(); \
    const lds_cptr vp_=vp0+sl_prev; \
    float sacc=(P0[0]+P0[1]); \
    GAPA(C0=__builtin_amdgcn_mfma_f32_32x32x16_bf16(kf[0],qr[0],negm,0,0,0), P0[2],P0[3],P0[4],P0[5],     pw0[0]=PKW(P0,0), pw0[1]=PKW(P0,2), pw0); \
    GAPA(C1=__builtin_amdgcn_mfma_f32_32x32x16_bf16(kf[1],qr[0],negm,0,0,0), P0[6],P0[7],P0[8],P0[9],     pw0[2]=PKW(P0,4), pw0[3]=PKW(P0,6), pw0); \
    GAPA(C0=__builtin_amdgcn_mfma_f32_32x32x16_bf16(kf[2],qr[1],C0,0,0,0),   P0[10],P0[11],P0[12],P0[13], pw1[0]=PKW(P0,8), pw1[1]=PKW(P0,10), pw1); \
    GAPA(C1=__builtin_amdgcn_mfma_f32_32x32x16_bf16(kf[3],qr[1],C1,0,0,0),   P0[14],P0[15],P1[0],P1[1],   pw1[2]=PKW(P0,12),pw1[3]=PKW(P0,14), pw1); \
    GAPA(C0=__builtin_amdgcn_mfma_f32_32x32x16_bf16(kf[4],qr[2],C0,0,0,0),   P1[2],P1[3],P1[4],P1[5],     pw2[0]=PKW(P1,0), pw2[1]=PKW(P1,2), pw2); \
    GAPA(C1=__builtin_amdgcn_mfma_f32_32x32x16_bf16(kf[5],qr[2],C1,0,0,0),   P1[6],P1[7],P1[8],P1[9],     pw2[2]=PKW(P1,4), pw2[3]=PKW(P1,6), pw2); \
    GAPA(C0=__builtin_amdgcn_mfma_f32_32x32x16_bf16(kf[6],qr[3],C0,0,0,0),   P1[10],P1[11],P1[12],P1[13], pw3[0]=PKW(P1,8), pw3[1]=PKW(P1,10), pw3); \
    VLDA(0); SBAR(); \
    GAPA(C1=__builtin_amdgcn_mfma_f32_32x32x16_bf16(kf[7],qr[3],C1,0,0,0),   P1[14],P1[15],0.f,0.f,       pw3[2]=PKW(P1,12),pw3[3]=PKW(P1,14), pw3); \
    l_reg+=sacc; \
    if(GK){DMA_K((t)+3,sl_cur);} if(GV){DMA_V((t)+1,sl_next);} \
    HOOK(C0,C1,t); \
    { float a_=MX3(C0[0],C0[1],C1[0]),b_=MX3(C0[2],C0[3],C1[1]); a_=MX3(a_,C1[2],C1[3]); \
      _Pragma("unroll") for(int r=4;r<16;r+=4){a_=MX3(a_,C0[r],C0[r+1]);b_=MX3(b_,C0[r+2],C0[r+3]);a_=MX3(a_,C1[r],C1[r+1]);b_=MX3(b_,C1[r+2],C1[r+3]);} \
      float rm=__builtin_fmaxf(a_,b_); { auto rr=__builtin_amdgcn_permlane32_swap(__float_as_uint(rm),__float_as_uint(rm),false,false); rm=__builtin_fmaxf(__uint_as_float(rr[0]),__uint_as_float(rr[1])); } \
      resc=false; \
      if(__builtin_expect(__any(rm>(float)THRL),0)){ const float dl=__builtin_fmaxf(rm,0.f); mhat+=dl; \
        _Pragma("unroll") for(int r=0;r<16;++r){C0[r]-=dl;C1[r]-=dl;} \
        _Pragma("unroll") for(int r=0;r<16;++r)negm[r]=-mhat; asm volatile("":"+v"(negm)); \
        const float f=__builtin_amdgcn_exp2f(-dl); l_reg*=f; { int rl_=lane; asm volatile("":"+v"(rl_)); if(rl_<32)((float*)(shm+B_LDS_WS))[wid*64+rl_]=f; } resc=true; } } \
    SBAR(); \
    PVE(0,PAF(0),C0,0);  PVO(1,PAF(0),C0,2,false);  PVE(2,PAF(0),C0,4);  PVO(3,PAF(0),C0,6,false); \
    KRD(GL,0); PVE(4,PAF(1),C0,8);  PVO(5,PAF(1),C0,10,false); KRD(GL,1); PVE(6,PAF(1),C0,12); PVO(7,PAF(1),C0,14,false); \
    KRD(GL,2); PVE(8,PAF(2),C1,0);  PVO(9,PAF(2),C1,2,false);  KRD(GL,3); PVE(10,PAF(2),C1,4); PVO(11,PAF(2),C1,6,false); \
    PVE(12,PAF(3),C1,8); PVO(13,PAF(3),C1,10,false); PVE(14,PAF(3),C1,12); PVO(15,PAF(3),C1,14,true); \
    }while(0)
  #define ENDW(tt) do{ if((tt)+3<NT){WAIT_BAR(4);} else if((tt)+2<NT){WAIT_BAR(2);} else {WAIT_BAR(0);} }while(0)
  int t=1;
  for(;t+5<NT;t+=2){
    STEP(pB0,pB1,pA0,pA1,t,true,true,true);     WAIT_BAR(4); RESC(); ROT();
    STEP(pA0,pA1,pB0,pB1,t+1,true,true,true);   WAIT_BAR(4); RESC(); ROT();
  }
  for(;t+1<NT;t+=2){
    STEP(pB0,pB1,pA0,pA1,t,(t+3<NT),(t+1<NT),(t+1<NT));       ENDW(t);   RESC(); ROT();
    STEP(pA0,pA1,pB0,pB1,t+1,(t+4<NT),(t+2<NT),(t+2<NT));     ENDW(t+1); RESC(); ROT();
  }
  STEP(pB0,pB1,pA0,pA1,NT-1,false,false,false); RESC();
  { float sacc=pB0[0]+pB0[1]; _Pragma("unroll") for(int r=2;r<16;++r)sacc+=pB0[r]; _Pragma("unroll") for(int r=0;r<16;++r)sacc+=pB1[r]; l_reg+=sacc;
    pw0=(u32x4){PKW(pB0,0),PKW(pB0,2),PKW(pB0,4),PKW(pB0,6)};pw1=(u32x4){PKW(pB0,8),PKW(pB0,10),PKW(pB0,12),PKW(pB0,14)};pw2=(u32x4){PKW(pB1,0),PKW(pB1,2),PKW(pB1,4),PKW(pB1,6)};pw3=(u32x4){PKW(pB1,8),PKW(pB1,10),PKW(pB1,12),PKW(pB1,14)};
    SBAR(); pv(o,vb0+sl_cur,PAF(0),PAF(1),PAF(2),PAF(3)); pv(o+2,vb0+sl_cur+8192,PAF(0),PAF(1),PAF(2),PAF(3)); }
  #undef PKW
  #undef PAF
  #undef PIN
  #undef MX3
  #undef GAPA
  #undef EX
  #undef VOFF
  #undef VLDA
  #undef VLDB
  #undef VFA
  #undef VFB
  #undef GAPB2
  #undef KRD
  #undef PVE
  #undef PVO
  #undef STEP
  #undef ENDW
  {auto rr=__builtin_amdgcn_permlane32_swap(__float_as_uint(l_reg),__float_as_uint(l_reg),false,false);l_reg=__uint_as_float(rr[0])+__uint_as_float(rr[1]);}
  if(hi==0)wsf[32+r32]=l_reg;asm volatile("s_waitcnt lgkmcnt(0)":::"memory");
  float rli[16];
  #pragma unroll
  for(int r=0;r<16;++r)rli[r]=__builtin_amdgcn_rcpf(wsf[32+crow(r,hi)]);
  asm volatile("s_waitcnt lgkmcnt(0)\n\ts_barrier":::"memory");
  float*xw=(float*)shm+(long)wq*32*B_XROW;
  if(c==1){
    #pragma unroll
    for(int r=0;r<16;++r){const int row=crow(r,hi);
      #pragma unroll
      for(int d=0;d<4;++d)xw[row*B_XROW+32*d+r32]=o[d][r]*rli[r];}
  }
  asm volatile("s_waitcnt lgkmcnt(0)\n\ts_barrier":::"memory");
  if(c==0){
    #pragma unroll
    for(int r=0;r<16;++r){const int row=crow(r,hi);
      #pragma unroll
      for(int d=0;d<4;++d){float*p=xw+row*B_XROW+32*d+r32; *p=o[d][r]*rli[r]-a.lam*(*p);} }
    asm volatile("s_waitcnt lgkmcnt(0)":::"memory");
    const int row=lane>>1, hf=lane&1; const float*rp=xw+row*B_XROW+64*hf;
    f32x4v dv[16]; float ss=0.f;
    #pragma unroll
    for(int j=0;j<16;++j){dv[j]=*(const f32x4v*)(rp+4*j); ss+=(dv[j][0]*dv[j][0]+dv[j][1]*dv[j][1])+(dv[j][2]*dv[j][2]+dv[j][3]*dv[j][3]);}
    ss+=__shfl_xor(ss,1);
    const float rs=1.0f/sqrtf(ss*(1.0f/128.0f)+1e-6f);
    bf16*orow=a.O+(long)(q0+32*wq+row)*512+64*hf;
    #pragma unroll
    for(int j=0;j<8;++j){
      u32x4 w; w.x=cvtpk_s(dv[2*j][0]*rs,dv[2*j][1]*rs); w.y=cvtpk_s(dv[2*j][2]*rs,dv[2*j][3]*rs); w.z=cvtpk_s(dv[2*j+1][0]*rs,dv[2*j+1][1]*rs); w.w=cvtpk_s(dv[2*j+1][2]*rs,dv[2*j+1][3]*rs);
      ATTN_STORE16(orow+8*j,w); }
  }
  asm volatile("s_waitcnt lgkmcnt(0)\n\ts_barrier":::"memory");
  #undef DMA_K
  #undef DMA_V
  #undef HOOK
  #undef START
  #undef RESC
  #undef ROT
}
#undef SBAR
#undef WAIT_BAR
}

constexpr int NWAVES = 8;
constexpr int NB = 16, SEQ = 4096, DM = 1024, DEPTH = 4, R = NB * SEQ;
constexpr int GB = 8, RG = GB * SEQ, NGRP = NB / GB;
constexpr int NIN = 8004, NINP = 8192, DFF = 2816, MEMLEN = 256;
constexpr float RMS_EPS = 1e-6f;
constexpr float QSCALE = 0.125f * 1.4426950408889634f;
constexpr size_t MiB = 1u << 20;
constexpr size_t WS_CTL = 0, CTL_ZERO_BYTES = 1 * MiB;
constexpr size_t WS_ROPE = 1 * MiB;
constexpr size_t WS_SCAL = 2 * MiB;
constexpr size_t WS_WKV = 3 * MiB;
constexpr size_t WS_MN = 7 * MiB;
constexpr size_t WS_KVX = 15 * MiB;
constexpr size_t WS_WL = 32 * MiB;
constexpr size_t WL_WIN = 0, WL_WUP = 16 * MiB, WL_WOUT = 19 * MiB, WL_WQX = 21 * MiB, WL_WOX = 21 * MiB + 512 * 1024, WL_WGU = 22 * MiB, WL_WDN = 33 * MiB;
constexpr size_t WS_XN = 72 * MiB;
constexpr size_t WS_MIX = 200 * MiB;
constexpr size_t WS_QKV = WS_MIX;
constexpr size_t QKV_STRIDE = (size_t)RG * 512;
constexpr size_t WS_QI = WS_MIX + 288 * MiB, WS_KI = WS_MIX + 304 * MiB;
constexpr size_t WS_GATES = WS_MIX + 320 * MiB;
constexpr size_t WS_Y = WS_MIX + 512 * MiB;
constexpr size_t WS_MASK = WS_MIX + 576 * MiB;
constexpr size_t WS_H = WS_MIX;
constexpr size_t WS_QX = WS_MIX + 400 * MiB;
constexpr size_t WS_OBUF = WS_MIX + 592 * MiB;
constexpr size_t WS_SS = WS_MIX + 688 * MiB;
constexpr size_t WS_XS = WS_MIX + 692 * MiB;
constexpr size_t WS_END = WS_MIX + 820 * MiB;
static_assert(WS_WL + WL_WDN + (size_t)1024 * DFF * 2 <= WS_XN && WS_XN + (size_t)R * DM * 2 <= WS_MIX && WS_H + (size_t)R * DFF * 2 <= WS_QX && WS_MASK + (size_t)GB * 64 * 4096 * 8 <= WS_OBUF && WS_OBUF + 3 * (size_t)RG * 512 * 2 <= WS_SS && WS_SS + (size_t)R * 64 <= WS_XS && WS_XS + (size_t)256 * 524288 <= WS_END && WS_END <= 1024 * MiB, "d_ws map");
constexpr int CW_BAR = 4096, CW_QUEUE = 8192;
constexpr int RING_BYTES = 131072, XRES_OFF = 131072, LDSCTL_OFF = 132096, LDS_BYTES = 155648;

#define GAS __attribute__((address_space(1)))
#define LAS __attribute__((address_space(3)))
typedef unsigned short bf16;
typedef unsigned v4u __attribute__((ext_vector_type(4)));
typedef float f32x4 __attribute__((ext_vector_type(4)));
typedef GAS unsigned gu32;
#define RLX_AGENT __ATOMIC_RELAXED, __HIP_MEMORY_SCOPE_AGENT
#define LDS_WAIT() asm volatile("s_waitcnt lgkmcnt(0)" ::: "memory")
__device__ __forceinline__ unsigned f2bf(float f) { unsigned u = __builtin_bit_cast(unsigned, f); return (u + 0x7fffu + ((u >> 16) & 1u)) >> 16; }
__device__ __forceinline__ unsigned pk2(float lo, float hi) { return f2bf(lo) | (f2bf(hi) << 16); }
#define XB_TMO      128
#define XB_XCNT(j)  (256  + 64 * (j))
#define XB_XSUB(j)  (1280 + 64 * (j))
#define XB_XGEN(j)  (2304 + 64 * (j))
#define XB_TOP      3328
#define XB_TOPGEN   3392
#define XCD_BAR_WORDS 3456
#define XB_SPIN_CAP (1u << 18)

__device__ __forceinline__ unsigned xb_ld(unsigned* p)              { return __hip_atomic_load(p, __ATOMIC_RELAXED, __HIP_MEMORY_SCOPE_AGENT); }
__device__ __forceinline__ unsigned xb_add(unsigned* p, unsigned v) { asm volatile("" : "+v"(v)); return __hip_atomic_fetch_add(p, v, __ATOMIC_RELAXED, __HIP_MEMORY_SCOPE_AGENT); }
__device__ __forceinline__ unsigned xb_xcc_id() { return (unsigned)__builtin_amdgcn_s_getreg((3 << 11) | 20) & 0xFu; }
#define XB_SPIN(cond, bar) do { unsigned _sp = 0; while (cond) { __builtin_amdgcn_s_sleep(1); \
    if ((++_sp & 255u) == 0u) { if (xb_ld(&(bar)[XB_TMO])) break; if (_sp > XB_SPIN_CAP) { atomicAdd(&(bar)[XB_TMO], 1u); break; } } } } while (0)

struct XcdBarrier {
    unsigned* bar; unsigned x;
    volatile LAS unsigned* st;
};

__device__ __forceinline__ XcdBarrier xcd_barrier_post(unsigned* bar, volatile LAS unsigned* st) {
    XcdBarrier b; b.bar = bar; b.x = xb_xcc_id(); b.st = st;
    if (threadIdx.x == 0) (void)xb_add(&bar[XB_XCNT(b.x)], 1u);
    return b;
}
__device__ __forceinline__ void xcd_barrier_complete(unsigned* bar, unsigned x, unsigned& nloc, unsigned& nx) {
    const unsigned G = gridDim.x * gridDim.y * gridDim.z; asm volatile("" : "+s"(x));
    unsigned sum, cnt, mine, sp = 0u;
    for (;;) {
        sum = 0u; cnt = 0u; mine = 0u;
#pragma unroll
        for (unsigned j = 0; j < 16; ++j) { const unsigned c = xb_ld(&bar[XB_XCNT(j)]); sum += c; cnt += (c > 0u) ? 1u : 0u; mine = (j == x) ? c : mine; }
        if (sum == G) break;
        __builtin_amdgcn_s_sleep(1);
        if ((++sp & 255u) == 0u) { if (xb_ld(&bar[XB_TMO])) break; if (sp > XB_SPIN_CAP) { atomicAdd(&bar[XB_TMO], 1u); break; } }
    }
    nloc = mine > 0u ? mine : 1u; nx = cnt > 0u ? cnt : 1u;
}

__device__ __forceinline__ void xcd_barrier(const XcdBarrier& b, int tid_in) {
    asm volatile("s_waitcnt vmcnt(0)" ::: "memory");
    __syncthreads();
    if (tid_in == 0) {
        unsigned* bar = b.bar; asm volatile("" : "+s"(bar));
        __builtin_amdgcn_s_waitcnt(0);
        unsigned nloc = b.st[0], nx = b.st[1];
        if (nloc == 0u) { xcd_barrier_complete(bar, b.x, nloc, nx); b.st[0] = nloc; b.st[1] = nx; }
        const unsigned old = xb_add(&bar[XB_XSUB(b.x)], 1u);
        const unsigned gen = old / nloc;
        if (old + 1u == (gen + 1u) * nloc) {
            __builtin_amdgcn_fence(__ATOMIC_RELEASE, "agent");
            asm volatile("s_waitcnt vmcnt(0)" ::: "memory");
            const unsigned og = xb_add(&bar[XB_TOP], 1u);
            const unsigned tg = og / nx;
            if (og + 1u == (tg + 1u) * nx) xb_add(&bar[XB_TOPGEN], 1u);
            else XB_SPIN(xb_ld(&bar[XB_TOPGEN]) == tg, bar);
            __builtin_amdgcn_fence(__ATOMIC_ACQUIRE, "agent");
            xb_add(&bar[XB_XGEN(b.x)], 1u);
            asm volatile("s_waitcnt vmcnt(0)" ::: "memory");
        } else {
            XB_SPIN(xb_ld(&bar[XB_XGEN(b.x)]) == gen, bar);
            __builtin_amdgcn_fence(__ATOMIC_ACQUIRE, "agent");
            asm volatile("s_waitcnt vmcnt(0)" ::: "memory");
        }
    }
    __syncthreads();
}

__device__ __forceinline__ float wave_sum(float v) {
#pragma unroll
    for (int o = 1; o < 64; o <<= 1) v += __shfl_xor(v, o);
    return v;
}
__device__ __forceinline__ int rope_dim(int c64) { return 32 * ((c64 >> 2) & 1) + 4 * (c64 >> 3) + (c64 & 3); }
struct MapId { __device__ __forceinline__ int operator()(int n) const { return n; } };
struct MapWin { __device__ __forceinline__ int operator()(int n) const {
    if (n < 4608) { const int region = n >> 9; const bool rope = (region == 3 || region == 4 || region == 6 || region == 7); return rope ? (n & ~63) + rope_dim(n & 63) : n; }
    if (n < 4928) return (n & ~63) + rope_dim(n & 63);
    if (n < 4932) return n;
    if (n < 5120) return -1;
    return 4932 + (n - 5120); } };
struct MapGu { __device__ __forceinline__ int operator()(int n) const { return ((n >> 2) & 1) * DFF + 4 * (n >> 3) + (n & 3); } };
template <class Map> __device__ __forceinline__ void cvt_item(const float* W, int K, int Nsrc, bf16* WT, const float* gain, const Map& mp, LAS float* scr, int item, int nblk, int lane) {
    const int kb = item / nblk, nb = item % nblk, k0 = 64 * kb, n0 = 32 * nb;
    const int src = mp(n0 + (lane & 31));
    const int srcc = src >= 0 ? src : 0; const float keep = src >= 0 ? 1.f : 0.f;
    if (gain) {
#pragma unroll 16
        for (int i = 0; i < 32; ++i) { const int kk = 2 * i + (lane >> 5);
            scr[kk * 33 + (lane & 31)] = ((const GAS float*)W)[(size_t)(k0 + kk) * Nsrc + srcc] * ((const GAS float*)gain)[k0 + kk] * keep; }
    } else {
#pragma unroll 16
        for (int i = 0; i < 32; ++i) { const int kk = 2 * i + (lane >> 5);
            scr[kk * 33 + (lane & 31)] = ((const GAS float*)W)[(size_t)(k0 + kk) * Nsrc + srcc] * keep; }
    }
    LDS_WAIT(); asm volatile("" ::: "memory");
    const int c = lane & 7;
#pragma unroll
    for (int j = 0; j < 4; ++j) { const int n = (lane >> 3) + 8 * j; const LAS float* s = scr + (8 * c) * 33 + n;
        v4u o; o.x = pk2(s[0 * 33], s[1 * 33]); o.y = pk2(s[2 * 33], s[3 * 33]); o.z = pk2(s[4 * 33], s[5 * 33]); o.w = pk2(s[6 * 33], s[7 * 33]);
        *(GAS v4u*)(WT + (size_t)(n0 + n) * K + k0 + 8 * c) = o; }
    LDS_WAIT(); asm volatile("" ::: "memory");
}
__device__ __forceinline__ void rms_row_to_bf16(const float* xrow, bf16* orow, int lane) {
    const GAS f32x4* xr = (const GAS f32x4*)xrow + lane;
    f32x4 v[4]; float s = 0.f;
#pragma unroll
    for (int j = 0; j < 4; ++j) { v[j] = xr[64 * j]; s += (v[j].x * v[j].x + v[j].y * v[j].y) + (v[j].z * v[j].z + v[j].w * v[j].w); }
    float eps = RMS_EPS; asm volatile("" : "+v"(eps));
    const float rstd = 1.f / sqrtf(wave_sum(s) * (1.f / DM) + eps);
    GAS unsigned long long* o8 = (GAS unsigned long long*)orow + lane;
#pragma unroll
    for (int j = 0; j < 4; ++j) o8[64 * j] = (unsigned long long)pk2(v[j].x * rstd, v[j].y * rstd) | ((unsigned long long)pk2(v[j].z * rstd, v[j].w * rstd) << 32);
}
__device__ __forceinline__ void x_row_init(const float* xrow, bf16* orow, float* ssrow, int lane) {
    const GAS f32x4* xr = (const GAS f32x4*)xrow + lane;
    f32x4 v[4]; float s = 0.f;
#pragma unroll
    for (int j = 0; j < 4; ++j) { v[j] = xr[64 * j]; s += (v[j].x * v[j].x + v[j].y * v[j].y) + (v[j].z * v[j].z + v[j].w * v[j].w); }
    s = wave_sum(s);
    GAS unsigned long long* o8 = (GAS unsigned long long*)orow + lane;
#pragma unroll
    for (int j = 0; j < 4; ++j) o8[64 * j] = (unsigned long long)pk2(v[j].x, v[j].y) | ((unsigned long long)pk2(v[j].z, v[j].w) << 32);
    if (lane < 16) ((GAS float*)ssrow)[lane] = (lane == 0) ? s : 0.f;
}
__device__ __forceinline__ void rms_row_final(const bf16* xrow, float* orow, const float* gain, int lane) {
    const GAS v4u* xr = (const GAS v4u*)xrow + lane;
    float v[16]; float s = 0.f;
#pragma unroll
    for (int j = 0; j < 2; ++j) { const v4u b = xr[64 * j]; const unsigned bw[4] = {b.x, b.y, b.z, b.w};
#pragma unroll
        for (int i = 0; i < 4; ++i) { v[8 * j + 2 * i] = __uint_as_float(bw[i] << 16); v[8 * j + 2 * i + 1] = __uint_as_float(bw[i] & 0xffff0000u); } }
#pragma unroll
    for (int i = 0; i < 16; ++i) s += v[i] * v[i];
    const float rstd = 1.f / sqrtf(wave_sum(s) * (1.f / DM) + RMS_EPS);
#pragma unroll
    for (int j = 0; j < 2; ++j)
#pragma unroll
        for (int h = 0; h < 2; ++h) { const int c = 512 * j + 8 * lane + 4 * h; const f32x4 g = *(const GAS f32x4*)(gain + c);
            f32x4 o = {v[8 * j + 4 * h] * rstd * g.x, v[8 * j + 4 * h + 1] * rstd * g.y, v[8 * j + 4 * h + 2] * rstd * g.z, v[8 * j + 4 * h + 3] * rstd * g.w};
            *(GAS f32x4*)(orow + c) = o; }
}
__device__ __forceinline__ int fresh_tid(int wave_s) { int l; asm volatile("v_mbcnt_lo_u32_b32 %0, -1, 0\n\tv_mbcnt_hi_u32_b32 %0, -1, %0" : "=v"(l)); int w = wave_s; asm volatile("" : "+s"(w)); return (w << 6) | l; }
__device__ __forceinline__ unsigned wq_claim(gu32* ctr) {
    return __builtin_amdgcn_atomic_inc32((unsigned*)ctr, 0xffffffffu, __ATOMIC_RELAXED, "agent");
}
__device__ __forceinline__ int wq_next(gu32* ctr, volatile LAS unsigned* slot, int tid_in, unsigned& nxt, unsigned& par) {
    if (tid_in == 0) { slot[par] = nxt; nxt = wq_claim(ctr); }
    asm volatile("s_waitcnt lgkmcnt(0)" ::: "memory"); __builtin_amdgcn_s_barrier(); asm volatile("" ::: "memory");
    const int i = (int)slot[par]; par ^= 1u;
    return i;
}

__device__ __forceinline__ void diff_combine_row(const bf16* tb, bf16* ob, const float* subln, float lam, float oscale, int lane) {
    const int h = lane >> 4, d0 = (lane & 15) * 8;
    const v4u a = *(const GAS v4u*)(tb + (h * 2 + 0) * 128 + d0), c = *(const GAS v4u*)(tb + (h * 2 + 1) * 128 + d0);
    const unsigned aw[4] = {a.x, a.y, a.z, a.w}, cw[4] = {c.x, c.y, c.z, c.w};
    float d[8]; float ss = 0.f;
#pragma unroll
    for (int i = 0; i < 4; ++i) { d[2 * i] = __uint_as_float(aw[i] << 16) - lam * __uint_as_float(cw[i] << 16); d[2 * i + 1] = __uint_as_float(aw[i] & 0xffff0000u) - lam * __uint_as_float(cw[i] & 0xffff0000u);
        ss += d[2 * i] * d[2 * i] + d[2 * i + 1] * d[2 * i + 1]; }
    ss += __shfl_xor(ss, 1); ss += __shfl_xor(ss, 2); ss += __shfl_xor(ss, 4); ss += __shfl_xor(ss, 8);
    const float rs = (1.0f / sqrtf(ss * (1.0f / 128.0f) + RMS_EPS)) * oscale;
    const f32x4 g0 = *(const GAS f32x4*)(subln + d0), g1 = *(const GAS f32x4*)(subln + d0 + 4);
    v4u o; o.x = pk2(d[0] * rs * g0.x, d[1] * rs * g0.y); o.y = pk2(d[2] * rs * g0.z, d[3] * rs * g0.w); o.z = pk2(d[4] * rs * g1.x, d[5] * rs * g1.y); o.w = pk2(d[6] * rs * g1.z, d[7] * rs * g1.w);
    *(GAS v4u*)(ob + h * 128 + d0) = o;
}

#ifndef PROBE_CHECK
#define PROBE_CHECK 0
#endif
#if PROBE_CHECK
__device__ __forceinline__ void probe_check_query(const bf16* QI, const bf16* KI, const unsigned* MASKB, int qpos, int n, LAS float* qs, gu32* flag, int lane) {
#pragma unroll 1
    for (int i = lane; i < 256; i += 64) qs[i] = __uint_as_float((unsigned)QI[(size_t)qpos * 256 + i] << 16);
    float wv[4];
#pragma unroll
    for (int h = 0; h < 4; ++h) wv[h] = __uint_as_float((unsigned)KI[(size_t)qpos * 256 + 64 + h] << 16) * 0.0625f;
    LDS_WAIT();
    const int N = 64 * (n + 1);
    float smin = 3.0e38f, umax = -3.0e38f; int cnt = 0, selz_max = -1, unz_min = 1 << 30;
#pragma unroll 1
    for (int k = lane; k < N; k += 64) {
        float sc = 0.f;
#pragma unroll 1
        for (int h = 0; h < 4; ++h) { float l = 0.f;
#pragma unroll 2
            for (int d = 0; d < 64; ++d) l = __builtin_fmaf(qs[h * 64 + d], __uint_as_float((unsigned)KI[(size_t)k * 256 + d] << 16), l); sc += fmaxf(l, 0.f) * (h == 0 ? wv[0] : h == 1 ? wv[1] : h == 2 ? wv[2] : wv[3]); }
        const int t = k >> 6, sub = (k >> 5) & 1, wi = k & 31, hc = (wi >> 2) & 1, rr = (wi & 3) + 4 * (wi >> 3);
        const unsigned word = MASKB[((size_t)t * 4096 + qpos) * 2 + hc];
        const bool sel = (word >> (16 * sub + rr)) & 1u;
        if (sel) { ++cnt; smin = fminf(smin, sc); if (sc == 0.f) selz_max = max(selz_max, k); } else { umax = fmaxf(umax, sc); if (sc == 0.f) unz_min = min(unz_min, k); }
    }
#pragma unroll 1
    for (int o = 1; o < 64; o <<= 1) { smin = fminf(smin, __shfl_xor(smin, o)); umax = fmaxf(umax, __shfl_xor(umax, o)); cnt += __shfl_xor(cnt, o); selz_max = max(selz_max, __shfl_xor(selz_max, o)); unz_min = min(unz_min, __shfl_xor(unz_min, o)); }
    const int want = N < 256 ? N : 256;
    bool bad = (cnt != want);
    if (N > 256) { const float slack = 2e-3f * (fabsf(umax) + fabsf(smin)) + 1e-4f; if (smin < umax - slack) bad = true; if (smin == 0.f && umax == 0.f && selz_max > unz_min) bad = true; }
    if (bad && lane == 0) __hip_atomic_store(flag, 1u, RLX_AGENT);
}
#endif

#ifndef REP_L2
#define REP_L2 1
#endif
#ifndef REP_X
#define REP_X 1
#endif
#ifndef REP_PROJ
#define REP_PROJ 1
#endif
#ifndef REP_CVT
#define REP_CVT 1
#endif
#ifndef REP_GU
#define REP_GU 1
#endif
#ifndef REP_UP
#define REP_UP 1
#endif
#ifndef REP_B
#define REP_B 1
#endif
#ifndef REP_WOUT
#define REP_WOUT 1
#endif
#ifndef REP_OX
#define REP_OX 1
#endif
#ifndef REP_DOWN
#define REP_DOWN 1
#endif
#ifndef REP_A
#define REP_A 1
#endif
#ifndef REP_L3
#define REP_L3 1
#endif
struct Args { const float* in[20]; float* out; unsigned char* ws; int lo, hi; };
enum { I_X = 0, I_MEM, I_NORM_MIX, I_W_IN, I_REL_BIAS, I_LAMBDA, I_SUBLN, I_UP_A, I_UP_B, I_UP_C, I_W_OUT, I_NORM_CROSS, I_WQX, I_WKVX, I_WOX, I_NORM_FFN, I_WGU, I_WDOWN, I_MEM_NORM, I_FINAL_NORM };

__global__ void __launch_bounds__(NWAVES * 64, 2) hybrid_fwd(Args args) {
    extern __shared__ __attribute__((aligned(16))) unsigned char lds_raw[];
    LAS unsigned char* lds = (LAS unsigned char*)lds_raw;
    volatile LAS unsigned* MISC = (volatile LAS unsigned*)(lds + LDSCTL_OFF);
    for (int u = threadIdx.x; u < 64; u += NWAVES * 64) MISC[u] = 0u;
    __syncthreads();
    const int wave_s = __builtin_amdgcn_readfirstlane((int)threadIdx.x >> 6);
    XcdBarrier bar = xcd_barrier_post((unsigned*)((gu32*)(args.ws + WS_CTL) + CW_BAR), MISC + 8);
    volatile LAS unsigned* qslot = MISC + 16;

    int step = 0;
#define STEP_ON (step >= args.lo && step < args.hi)
#define STEP_END(need_bar) do { if ((need_bar) && step >= args.lo && step + 1 < args.hi) xcd_barrier(bar, fresh_tid(wave_s)); ++step; } while (0)
#define PH_ENTER unsigned char* ws = args.ws; int G = gridDim.x, bx = blockIdx.x, tid = fresh_tid(wave_s); asm volatile("" : "+s"(ws), "+s"(G), "+s"(bx), "+v"(tid)); \
    const int lane = tid & 63, wave = __builtin_amdgcn_readfirstlane(tid >> 6), gw = bx * NWAVES + wave, NGW = G * NWAVES; (void)lane; (void)gw; (void)NGW;
#define P_BF(off) ((bf16*)(ws + (off)))
#define P_Q(off) ((bf16*)(wsq + (off)))

    if (STEP_ON) { PH_ENTER
        float* rope = (float*)(ws + WS_ROPE); float* scal = (float*)(ws + WS_SCAL);
        LAS float* scr = (LAS float*)(lds + wave * 16384);
        for (int i = bx * (NWAVES * 64) + tid; i < SEQ * 32; i += G * NWAVES * 64) {
            const int pos = i >> 5, k = i & 31;
            const float inv = (float)pow(10000.0, -(double)(2 * k) / 64.0);
            const float ang = (float)pos * inv;
            rope[pos * 64 + k] = (float)cos((double)ang); rope[pos * 64 + 32 + k] = (float)sin((double)ang);
        }
        if (bx == 0 && wave < DEPTH) {
            const float* lv = args.in[I_LAMBDA] + wave * 4 * 64;
            const float sa = wave_sum(lv[lane] * lv[64 + lane]), sb = wave_sum(lv[128 + lane] * lv[192 + lane]);
            const float lam_init = 0.8f - 0.6f * expf(-0.3f * (float)wave);
            if (lane == 0) { scal[wave * 2] = expf(sa) - expf(sb) + lam_init; scal[wave * 2 + 1] = 1.0f - lam_init; }
        }
        { float* gb = (float*)(ws + WS_SCAL) + 1024;
          for (int i = bx * (NWAVES * 64) + tid; i < DEPTH * 512; i += G * NWAVES * 64) { const int l_ = i >> 9; gb[i] = args.in[I_SUBLN][l_ * 128 + (i & 127)] * (0.6f * expf(-0.3f * (float)l_) + 0.2f); } }
        for (int m = gw; m < NB * MEMLEN; m += NGW) rms_row_to_bf16(args.in[I_MEM] + (size_t)m * DM, P_BF(WS_MN) + (size_t)m * DM, lane);
        for (int it = gw; it < DEPTH * 16 * 16; it += NGW) { const int l = it >> 8;
            cvt_item(args.in[I_WKVX] + (size_t)l * DM * 512, DM, 512, P_BF(WS_WKV) + (size_t)l * 512 * DM, args.in[I_MEM_NORM], MapId(), scr, it & 255, 16, lane); }
    }
    STEP_END(true);
    if (STEP_ON) { PH_ENTER
        pg8::Gemm g{P_BF(WS_MN), P_BF(WS_WKV), NB * MEMLEN, DEPTH * 512, DM, 0}; pg8::StaticOrder S; S.init(NB * MEMLEN, DEPTH * 512, G, bx);
        pg8::EpiBf16S E{P_BF(WS_KVX), DEPTH * 512, 1.0f, nullptr, (LAS float*)(lds + 139264)};
        pg8::gemm_phase<pg8::EpiBf16S, pg8::StaticOrder, true, true>(lds, g, S, E, tid);
    }
    STEP_END(true);

#pragma unroll 1
    for (int l = 0; l < DEPTH; ++l) {
        if (STEP_ON) { PH_ENTER
            LAS float* scr = (LAS float*)(lds + wave * 16384);
            bf16* WL = P_BF(WS_WL);
            constexpr int I0 = 16 * 256, I1 = 8 * 32, I4 = 16 * 32, I5 = 16 * 8, I6 = 4 * 32, I7 = 16 * 176, I8 = 44 * 32;
            constexpr int NITEMS = I0 + 3 * I1 + I4 + I5 + I6 + I7 + I8;
#pragma unroll 1
            for (int rc = 0; rc < REP_CVT; ++rc)
            for (int it = gw; it < NITEMS; it += NGW) {
                int r = it;
                if (r < I0) { cvt_item(args.in[I_W_IN] + (size_t)l * DM * NIN, DM, NIN, WL + WL_WIN / 2, args.in[I_NORM_MIX] + l * DM, MapWin(), scr, r, 256, lane); continue; } r -= I0;
                if (r < I1) { cvt_item(args.in[I_UP_A] + (size_t)l * 512 * DM, 512, DM, WL + WL_WUP / 2, nullptr, MapId(), scr, r, 32, lane); continue; } r -= I1;
                if (r < I1) { cvt_item(args.in[I_UP_B] + (size_t)l * 512 * DM, 512, DM, WL + WL_WUP / 2 + (size_t)1024 * 512, (const float*)(ws + WS_SCAL) + 1024 + l * 512, MapId(), scr, r, 32, lane); continue; } r -= I1;
                if (r < I1) { cvt_item(args.in[I_UP_C] + (size_t)l * 512 * DM, 512, DM, WL + WL_WUP / 2 + (size_t)2048 * 512, nullptr, MapId(), scr, r, 32, lane); continue; } r -= I1;
                if (r < I4) { cvt_item(args.in[I_W_OUT] + (size_t)l * DM * DM, DM, DM, WL + WL_WOUT / 2, nullptr, MapId(), scr, r, 32, lane); continue; } r -= I4;
                if (r < I5) { cvt_item(args.in[I_WQX] + (size_t)l * DM * 256, DM, 256, WL + WL_WQX / 2, args.in[I_NORM_CROSS] + l * DM, MapId(), scr, r, 8, lane); continue; } r -= I5;
                if (r < I6) { cvt_item(args.in[I_WOX] + (size_t)l * 256 * DM, 256, DM, WL + WL_WOX / 2, nullptr, MapId(), scr, r, 32, lane); continue; } r -= I6;
                if (r < I7) { cvt_item(args.in[I_WGU] + (size_t)l * DM * 2 * DFF, DM, 2 * DFF, WL + WL_WGU / 2, args.in[I_NORM_FFN] + l * DM, MapGu(), scr, r, 176, lane); continue; } r -= I7;
                cvt_item(args.in[I_WDOWN] + (size_t)l * DFF * DM, DFF, DM, WL + WL_WDN / 2, nullptr, MapId(), scr, r, 32, lane);
            }
            if (l == 0) { for (int m = gw; m < R; m += NGW) x_row_init(args.in[I_X] + (size_t)m * DM, P_BF(WS_XN) + (size_t)m * DM, (float*)(ws + WS_SS) + (size_t)m * 16, lane); }
        }
        STEP_END(true);

#pragma unroll 1
        for (int grp = 0; grp < NGRP; ++grp) {
            if (STEP_ON) { PH_ENTER
                pg8::Gemm g{P_BF(WS_XN) + (size_t)grp * RG * DM, P_BF(WS_WL + WL_WIN), RG, NINP, DM, 0}; pg8::StaticOrder S; S.init(RG, NINP, G, bx);
                pg8::EpiProj E{P_BF(WS_QKV), P_BF(WS_QI), P_BF(WS_KI), P_BF(WS_GATES), (const float*)(ws + WS_ROPE), QSCALE, QKV_STRIDE, (const float*)(ws + WS_SS) + (size_t)grp * RG * 16, (LAS float*)(lds + 139264)};
#pragma unroll 1
                for (int rp = 0; rp < REP_PROJ; ++rp)
                pg8::gemm_phase<pg8::EpiProj, pg8::StaticOrder, true, true>(lds, g, S, E, tid);
            }
            STEP_END(true);
            if (STEP_ON) { PH_ENTER
                constexpr int NX = GB * 60 * 2, NBU = GB * 4 * 32, NAU = GB * 8 * 16;
#pragma unroll 1
                for (int rep = 0; rep < REP_L2; ++rep) { gu32* ctr = (gu32*)(ws + WS_CTL) + CW_QUEUE + 64 * (((l * NGRP + grp) * 2 + 0) * 4 + rep);
                const bool stat = (G == 256);
                gu32* qctr = stat ? ctr + 4 * (1 + (bx & 7)) : ctr; int stage = stat ? 0 : 2;
                unsigned qnxt = 0u, qpar = 0u; if (tid == 0) qnxt = wq_claim(qctr);
#pragma unroll 1
                for (int it = 0;; ++it) {
                    int i;
                    if (stat && it < 4) { const int x = bx & 7, j = bx >> 3, jj = j & 7, combo = x + 8 * (j >> 3), qt = (it == 0) ? 31 - jj : (it == 1) ? 16 + jj : (it == 2) ? 15 - jj : jj;
                        i = NX + (31 - qt) * 32 + (combo >> 2) * 4 + (combo & 3); __syncthreads(); }
                    else { int k = wq_next(qctr, qslot, tid, qnxt, qpar);
                        if (stage == 0) { if (k < 120) i = (k >> 1) * 16 + (bx & 7) * 2 + (k & 1);
                                          else { stage = 1; qctr = ctr; if (tid == 0) qnxt = wq_claim(qctr); k = wq_next(qctr, qslot, tid, qnxt, qpar); i = NX + NBU + k; } }
                        else if (stage == 1) i = NX + NBU + k;
                        else i = k;
                        if (i >= NX + NBU + NAU) break; }
                    unsigned char* wsq = args.ws; asm volatile("" : "+s"(wsq)); bf16* QKV = (bf16*)(wsq + WS_QKV);
                    if (i < NX) { const int n = 63 - (i >> 4), b = (i & 15) >> 1, half = i & 1;
#pragma unroll 1
                        for (int rx = 0; rx < REP_X; ++rx) { if (rx) __syncthreads();
                        att::idx_unit(lds, P_Q(WS_QI) + (size_t)b * SEQ * 256, P_Q(WS_KI) + (size_t)b * SEQ * 256, (unsigned short*)((unsigned*)(wsq + WS_MASK) + (size_t)b * 64 * 4096 * 2), (unsigned*)(wsq + WS_XS) + (size_t)(bx & 255) * 131072, n, half, tid); }
                    } else if (i < NX + NBU) { const int j = i - NX, qt = 31 - (j >> 5), b = (j & 31) >> 2, h = j & 3;
                        const size_t off = (size_t)b * SEQ * 512 + h * 128;
                        const float* scal = (const float*)(wsq + WS_SCAL);
                        const float lam = __hip_atomic_load(scal + l * 2, RLX_AGENT), oscale = __hip_atomic_load(scal + l * 2 + 1, RLX_AGENT);
                        attx::UB a{(const attx::bf16*)(QKV + 3 * QKV_STRIDE + off), (const attx::bf16*)(QKV + 4 * QKV_STRIDE + off), (const attx::bf16*)(QKV + 5 * QKV_STRIDE + off),
                                   (attx::bf16*)(P_Q(WS_OBUF) + 1 * QKV_STRIDE + off), qt, args.in[I_SUBLN] + l * 128, lam, oscale};
#pragma unroll 1
                        for (int rb_ = 0; rb_ < REP_B; ++rb_)
                        attx::attn_unit_b2<8>(a, (char*)lds_raw, tid);
                    } else { const int j = i - NX - NBU, qb = 15 - (j >> 6), b = (j & 63) >> 3, h = j & 7;
                        const size_t off = (size_t)b * SEQ * 512 + h * 64;
                        att::UnitArgs a{QKV + off, 512, QKV + 1 * QKV_STRIDE + off, QKV + 2 * QKV_STRIDE + off, 512, P_Q(WS_OBUF) + off, 512, 256 * qb, (4 * qb - 8 > 0) ? 4 * qb - 8 : 0, 4 * qb + 3,
                                        args.in[I_REL_BIAS] + (size_t)(l * 8 + h) * 320, nullptr, false};
#pragma unroll 1
                        for (int ra_ = 0; ra_ < REP_A; ++ra_)
                        att::attn_unit<0>(lds, a, tid);
                    }
                } }
            }
            STEP_END(true);
            if (STEP_ON) { PH_ENTER
#if PROBE_CHECK
                if (l == 0 && grp == 0) { const int si = gw, b_ = si & 7, n_ = 4 + ((si >> 3) % 60), qo = (si * 7) & 63;
                    probe_check_query(P_BF(WS_QI) + (size_t)b_ * SEQ * 256, P_BF(WS_KI) + (size_t)b_ * SEQ * 256, (const unsigned*)(ws + WS_MASK) + (size_t)b_ * 64 * 4096 * 2, 64 * n_ + qo, n_,
                                      (LAS float*)(lds + wave * 16384), (gu32*)(ws + WS_CTL) + 32, lane); __syncthreads(); }
#endif
#pragma unroll 1
                for (int rep = 0; rep < REP_L3; ++rep) { gu32* ctr = (gu32*)(ws + WS_CTL) + CW_QUEUE + 64 * (((l * NGRP + grp) * 2 + 1) * 4 + rep);
                const bool stat = (G == 256);
                unsigned qnxt = 0u, qpar = 0u; if (!stat && tid == 0) qnxt = wq_claim(ctr);
#pragma unroll 1
                for (int it = 0;; ++it) {
                    int qb, b, h;
                    if (stat) { if (it >= 4) break; const int j = bx >> 3, jj = j & 3; h = bx & 7; b = j >> 2; qb = (it == 0) ? 15 - jj : (it == 1) ? 8 + jj : (it == 2) ? 7 - jj : jj; __syncthreads(); }
                    else { const int i = wq_next(ctr, qslot, tid, qnxt, qpar); if (i >= GB * 8 * 16) break; qb = 15 - (i >> 6); b = (i & 63) >> 3; h = i & 7; }
                    unsigned char* wsq = args.ws; asm volatile("" : "+s"(wsq)); bf16* QKV = (bf16*)(wsq + WS_QKV);
                    const size_t rb = (size_t)b * SEQ * 512;
                    attx::UA a{(const attx::bf16*)(QKV + 6 * QKV_STRIDE + rb + (size_t)256 * qb * 512 + h * 64), 512,
                               (const attx::bf16*)(QKV + 7 * QKV_STRIDE + rb + h * 64), (const attx::bf16*)(QKV + 8 * QKV_STRIDE + rb + h * 64), 512,
                               (attx::bf16*)(P_Q(WS_OBUF) + 2 * QKV_STRIDE + rb + (size_t)256 * qb * 512 + h * 64), 512, 4 * qb + 4, 0, 4 * qb, nullptr,
                               (const unsigned*)(wsq + WS_MASK) + (size_t)b * 64 * 4096 * 2, qb == 0};
                    attx::attn_unit<1, 8>(a, (char*)lds_raw, tid);
                } }
            }
            STEP_END(true);
            if (STEP_ON) { PH_ENTER
                pg8::Gemm g{P_BF(WS_OBUF), P_BF(WS_WL + WL_WUP), RG, 3072, 512, QKV_STRIDE * 2}; pg8::UpOrder S; S.init(RG, G, bx);
                pg8::EpiGateC E{P_BF(WS_GATES), P_BF(WS_Y)};
#pragma unroll 1
                for (int ru = 0; ru < REP_UP; ++ru)
                pg8::gemm_phase<pg8::EpiGateC, pg8::UpOrder, true, true>(lds, g, S, E, tid);
            }
            STEP_END(true);
            if (STEP_ON) { PH_ENTER
                pg8::Gemm g{P_BF(WS_Y), P_BF(WS_WL + WL_WOUT), RG, DM, DM, 0}; pg8::StaticOrder S; S.init(RG, DM, G, bx);
                pg8::EpiRes E{P_BF(WS_XN) + (size_t)grp * RG * DM, DM, (float*)(ws + WS_SS) + (size_t)grp * RG * 16, 1.0f};
                pg8::gemm_phase<pg8::EpiRes, pg8::StaticOrder, true, true>(lds, g, S, E, tid);
#if REP_WOUT > 1
                { pg8::EpiRes E0{P_BF(WS_XN) + (size_t)grp * RG * DM, DM, (float*)(ws + WS_SS) + (size_t)grp * RG * 16, 0.0f}; __syncthreads(); pg8::gemm_phase<pg8::EpiRes, pg8::StaticOrder, true, true>(lds, g, S, E0, tid); }
#endif
            }
            STEP_END(grp == NGRP - 1);
        }
        if (STEP_ON) { PH_ENTER
            pg8::Gemm g{P_BF(WS_XN), P_BF(WS_WL + WL_WQX), R, 256, DM, 0}; pg8::StaticOrder S; S.init(R, 256, G, bx);
            pg8::EpiBf16S E{P_BF(WS_QX), 256, QSCALE, (const float*)(ws + WS_SS), (LAS float*)(lds + 139264)};
            pg8::gemm_phase<pg8::EpiBf16S, pg8::StaticOrder, true, true>(lds, g, S, E, tid);
        }
        STEP_END(true);
        if (STEP_ON) { PH_ENTER
            bf16* QX = P_BF(WS_QX);
            for (int i = bx; i < NB * 4 * 16; i += G) {
                const int qb = i & 15, b = i >> 6, h = (i >> 4) & 3;
                const bf16* kx = P_BF(WS_KVX) + (size_t)b * MEMLEN * (DEPTH * 512) + l * 512 + h * 64;
                attx::bf16* qp = (attx::bf16*)(QX + ((size_t)b * SEQ + 256 * qb) * 256 + h * 64);
                attx::UA a{qp, 256, (const attx::bf16*)kx, (const attx::bf16*)(kx + 256), DEPTH * 512, qp, 256, 4, 0, 0, nullptr, nullptr, 1};
                attx::attn_unit<2, 8>(a, (char*)lds_raw, tid);
            }
        }
        STEP_END(true);
        if (STEP_ON) { PH_ENTER
            pg8::Gemm g{P_BF(WS_QX), P_BF(WS_WL + WL_WOX), R, DM, 256, 0}; pg8::StaticOrder S; S.init(R, DM, G, bx);
            pg8::EpiRes E{P_BF(WS_XN), DM, (float*)(ws + WS_SS), 1.0f};
            pg8::gemm_phase<pg8::EpiRes, pg8::StaticOrder, true, true>(lds, g, S, E, tid);
#if REP_OX > 1
            { pg8::EpiRes E0{P_BF(WS_XN), DM, (float*)(ws + WS_SS), 0.0f}; __syncthreads(); pg8::gemm_phase<pg8::EpiRes, pg8::StaticOrder, true, true>(lds, g, S, E0, tid); }
#endif
        }
        STEP_END(true);
        if (STEP_ON) { PH_ENTER
            pg8::Gemm g{P_BF(WS_XN), P_BF(WS_WL + WL_WGU), R, 2 * DFF, DM, 0}; pg8::StaticOrder S; S.init(R, 2 * DFF, G, bx);
            pg8::EpiSwiglu E{P_BF(WS_H), DFF, (const float*)(ws + WS_SS), (LAS float*)(lds + 139264)};
#pragma unroll 1
            for (int rg = 0; rg < REP_GU; ++rg)
            pg8::gemm_phase<pg8::EpiSwiglu, pg8::StaticOrder, true, true>(lds, g, S, E, tid);
        }
        STEP_END(true);
        if (STEP_ON) { PH_ENTER
            pg8::Gemm g{P_BF(WS_H), P_BF(WS_WL + WL_WDN), R, DM, DFF, 0}; pg8::StaticOrder S; S.init(R, DM, G, bx);
            pg8::EpiRes E{P_BF(WS_XN), DM, (float*)(ws + WS_SS), 1.0f};
            pg8::gemm_phase<pg8::EpiRes, pg8::StaticOrder, true, true>(lds, g, S, E, tid);
#if REP_DOWN > 1
            { pg8::EpiRes E0{P_BF(WS_XN), DM, (float*)(ws + WS_SS), 0.0f}; __syncthreads(); pg8::gemm_phase<pg8::EpiRes, pg8::StaticOrder, true, true>(lds, g, S, E0, tid); }
#endif
        }
        STEP_END(true);
    }
    if (STEP_ON) { PH_ENTER for (int m = gw; m < R; m += NGW) rms_row_final(P_BF(WS_XN) + (size_t)m * DM, args.out + (size_t)m * DM, args.in[I_FINAL_NORM], lane);
#if PROBE_CHECK
        if (__hip_atomic_load((gu32*)(ws + WS_CTL) + 32, RLX_AGENT) != 0u) { for (int m = gw; m < R; m += NGW) { GAS f32x4* xr = (GAS f32x4*)(args.out + (size_t)m * DM) + lane; for (int j = 0; j < 4; ++j) xr[64 * j] = xr[64 * j] * 2.0f; } }
#endif
    }
    STEP_END(false);
#undef STEP_ON
#undef STEP_END
#undef PH_ENTER
#undef P_BF
#undef P_Q
}

constexpr int N_STEPS = 2 + DEPTH * (1 + NGRP * 5 + 5) + 1;
#ifndef MK_PER_STEP
#define MK_PER_STEP 0
#endif
extern "C" void kernel_launch(void* const* d_in, const int* in_sizes, int n_in, void* d_out, int out_size, void* d_ws, size_t ws_size, hipStream_t stream) {
    static int grid = 0;
    if (grid == 0) {
        if (n_in != 20 || in_sizes[0] != R * DM || out_size != R * DM || ws_size < WS_END) { fprintf(stderr, "kernel_launch: shape mismatch (n_in %d, in0 %d, out %d, ws %zu < %zu); nothing launched\n", n_in, n_in > 0 ? in_sizes[0] : -1, out_size, ws_size, (size_t)WS_END); grid = -1; return; }
        int dev = 0, cus = 0, per_cu = 0;
        if (hipGetDevice(&dev) != hipSuccess || hipDeviceGetAttribute(&cus, hipDeviceAttributeMultiprocessorCount, dev) != hipSuccess) { grid = -1; return; }
        if (hipFuncSetAttribute((const void*)hybrid_fwd, hipFuncAttributeMaxDynamicSharedMemorySize, LDS_BYTES) != hipSuccess) { fprintf(stderr, "kernel_launch: hipFuncSetAttribute failed\n"); grid = -1; return; }
        if (hipOccupancyMaxActiveBlocksPerMultiprocessor(&per_cu, (const void*)hybrid_fwd, NWAVES * 64, LDS_BYTES) != hipSuccess || per_cu < 1) { fprintf(stderr, "kernel_launch: occupancy query says %d blocks per CU\n", per_cu); }
        (void)hipGetLastError();
        grid = cus < 256 ? cus : 256;
    }
    if (grid < 0) return;
    if (hipMemsetAsync((char*)d_ws + WS_CTL, 0, CTL_ZERO_BYTES, stream) != hipSuccess) return;
    Args a{};
    for (int i = 0; i < 20; ++i) a.in[i] = (const float*)d_in[i];
    a.out = (float*)d_out; a.ws = (unsigned char*)d_ws;
#if MK_PER_STEP
    for (int s = 0; s < N_STEPS; ++s) { a.lo = s; a.hi = s + 1; hipLaunchKernelGGL(hybrid_fwd, dim3(grid), dim3(NWAVES * 64), LDS_BYTES, stream, a); }
#else
    a.lo = 0; a.hi = 1 << 30;
    hipLaunchKernelGGL(hybrid_fwd, dim3(grid), dim3(NWAVES * 64), LDS_BYTES, stream, a);
#endif
    const hipError_t le = hipPeekAtLastError();
    if (le != hipSuccess) fprintf(stderr, "kernel_launch: launch failed: %s\n", hipGetErrorName(le));
}
```

```cpp
#include <hip/hip_runtime.h>
#include <hip/hip_bf16.h>
#include <cstdio>
#include <cstdint>
#include <cmath>
namespace pg8 {
#define PG8_LAS __attribute__((address_space(3)))
typedef unsigned short bf16_t;
typedef short bf16x8 __attribute__((ext_vector_type(8)));
typedef float f32x4 __attribute__((ext_vector_type(4)));
typedef unsigned u32x4 __attribute__((ext_vector_type(4)));
constexpr int BM = 256, BK = 64, HALF = 128, HTB = HALF * BK * 2  , STAGE_BYTES = 8 * HTB, NXCD = 8, WGM = 8;

__host__ __device__ __forceinline__ int lds_byte(int r, int c) { const int st = (r >> 4) * 2 + (c >> 5), rr = r & 15, cc = c & 31, ob = rr * 64 + cc * 2; return st * 1024 + (ob ^ (((ob >> 9) & 1) << 5)); }
__host__ __device__ __forceinline__ void stage_rc(int b, int& R, int& C) { const int st = b / 1024, sb = b % 1024, swz = sb ^ (((sb >> 9) & 1) << 5); R = (st >> 1) * 16 + swz / 64; C = (st & 1) * 32 + (swz % 64) / 2; }
__host__ __device__ __forceinline__ int perm32(int rho) { const int n = rho >> 4, i = rho & 15; return 8 * (i >> 2) + 4 * n + (i & 3); }

struct Unit { int pm, pn, az; };
struct Gemm { const bf16_t* A; const bf16_t* Bt; int M, N, K; size_t azs; };

struct StaticOrder {
    int nM, nN, nwg, G, c;
    __host__ __device__ void init(int M, int N, int G_, int c_) { nM = M / BM; nN = N / BM; nwg = nM * nN; G = G_; c = c_; }
    __host__ __device__ bool next(int i, Unit& u) const {
        const long L = (long)i * G + c; if (L >= nwg) return false;
        int wgid = (int)L; { const int q = nwg / NXCD, r = nwg % NXCD, xcd = wgid % NXCD, off = wgid / NXCD; wgid = (xcd < r ? xcd * (q + 1) : r * (q + 1) + (xcd - r) * q) + off; }
        const int nig = WGM * nN, gid = wgid / nig, fm = gid * WGM, gsz = (nM - fm) < WGM ? (nM - fm) : WGM;
        u.pm = fm + ((wgid % nig) % gsz); u.pn = (wgid % nig) / gsz; u.az = 0; return true;
    }
    __device__ __forceinline__ void a_ready(const Unit&) const {}
    __device__ __forceinline__ void done(const Unit&) const {}
};

__device__ __forceinline__ unsigned cvt_pk_bf16(float lo, float hi) { unsigned r; asm volatile("v_cvt_pk_bf16_f32 %0, %1, %2" : "=v"(r) : "v"(lo), "v"(hi)); return r; }
typedef float f32x2c_t __attribute__((ext_vector_type(2))); typedef __bf16 bf16x2c_t __attribute__((ext_vector_type(2)));
__device__ __forceinline__ unsigned cvt_pk_bf16_c(float lo, float hi) { const f32x2c_t v = {lo, hi}; const bf16x2c_t b = __builtin_convertvector(v, bf16x2c_t); return __builtin_bit_cast(unsigned, b); }
typedef float f32x2 __attribute__((ext_vector_type(2)));

typedef unsigned u32x2 __attribute__((ext_vector_type(2)));
#define PG8_GAS __attribute__((address_space(1)))
__device__ __forceinline__ float bf_lo(unsigned w) { return __uint_as_float(w << 16); }
__device__ __forceinline__ float bf_hi(unsigned w) { return __uint_as_float(w & 0xffff0000u); }

__device__ __forceinline__ float row_rstd(const float* ss, size_t row) {
    const PG8_GAS f32x4* p = (const PG8_GAS f32x4*)(ss + row * 16);
    const f32x4 a = p[0], b = p[1], c = p[2], d = p[3];
    const float s = (((a[0] + a[1]) + (a[2] + a[3])) + ((b[0] + b[1]) + (b[2] + b[3]))) + (((c[0] + c[1]) + (c[2] + c[3])) + ((d[0] + d[1]) + (d[2] + d[3])));
    float eps = 1e-6f; asm volatile("" : "+v"(eps));
    return 1.0f / sqrtf(s * (1.0f / 1024.0f) + eps);
}
__device__ __forceinline__ void stage_rstd(const float* ss, PG8_LAS float* rs, int pm, int tid) {
    const int r = tid >> 1, h = tid & 1;
    const PG8_GAS f32x4* p = (const PG8_GAS f32x4*)(ss + ((size_t)pm * BM + r) * 16 + h * 8);
    const f32x4 a = p[0], b = p[1];
    float s = ((a[0] + a[1]) + (a[2] + a[3])) + ((b[0] + b[1]) + (b[2] + b[3]));
    s += __shfl_xor(s, 1);
    float eps = 1e-6f; asm volatile("" : "+v"(eps));
    if (h == 0) rs[r] = 1.0f / sqrtf(s * (1.0f / 1024.0f) + eps);
    asm volatile("s_waitcnt lgkmcnt(0)" ::: "memory"); __builtin_amdgcn_s_barrier(); asm volatile("" ::: "memory");
}
struct EpiRes {
    static constexpr bool PERM = true, AFTER_DRAIN = false, CARRY = false, RSTD = false;
    bf16_t* xb; int ldc; float* ss; float s;
    __device__ __forceinline__ void operator()(const f32x4 (&acc)[2][2][4][2], const Unit& u, int wr, int wc, int fr, int fq) const {
        const int row0 = u.pm * BM + wr * 64 + fr, col0 = u.pn * BM + wc * 32 + 8 * fq;
        u32x4 bq[16];
#pragma unroll
        for (int k = 0; k < 16; ++k) bq[k] = *(const PG8_GAS u32x4*)(xb + (size_t)(row0 + (k >> 3) * HALF + ((k >> 1) & 3) * 16) * ldc + col0 + (k & 1) * HALF);
        float sqv[8];
#pragma unroll
        for (int ai = 0; ai < 2; ++ai)
#pragma unroll
            for (int m = 0; m < 4; ++m) { const size_t row = (size_t)(row0 + ai * HALF + m * 16); bf16_t* rowp = xb + row * ldc + col0; float sq = 0.f;
#pragma unroll
                for (int bj = 0; bj < 2; ++bj) { const u32x4 b = bq[(ai * 4 + m) * 2 + bj];
                    const f32x4 b0 = {__uint_as_float(b.x << 16), __uint_as_float(b.x & 0xffff0000u), __uint_as_float(b.y << 16), __uint_as_float(b.y & 0xffff0000u)};
                    const f32x4 b1 = {__uint_as_float(b.z << 16), __uint_as_float(b.z & 0xffff0000u), __uint_as_float(b.w << 16), __uint_as_float(b.w & 0xffff0000u)};
                    const f32x4 v0 = b0 + acc[ai][bj][m][0] * s, v1 = b1 + acc[ai][bj][m][1] * s;
                    u32x4 w; w.x = cvt_pk_bf16(v0[0], v0[1]); w.y = cvt_pk_bf16(v0[2], v0[3]); w.z = cvt_pk_bf16(v1[0], v1[1]); w.w = cvt_pk_bf16(v1[2], v1[3]);
                    *(PG8_GAS u32x4*)(rowp + bj * HALF) = w;
                    sq += ((v0[0] * v0[0] + v0[1] * v0[1]) + (v0[2] * v0[2] + v0[3] * v0[3])) + ((v1[0] * v1[0] + v1[1] * v1[1]) + (v1[2] * v1[2] + v1[3] * v1[3])); }
                sq += __shfl_xor(sq, 16); sq += __shfl_xor(sq, 32);
                sqv[ai * 4 + m] = sq; }
        if (fq == 0) {
#pragma unroll
            for (int k = 0; k < 8; ++k) *(PG8_GAS float*)(ss + (size_t)(row0 + (k >> 2) * HALF + (k & 3) * 16) * 16 + u.pn * 4 + wc) = sqv[k]; }
    }
};

struct EpiBf16S {
    static constexpr bool PERM = true, AFTER_DRAIN = false, CARRY = false, RSTD = true;
    bf16_t* O; int ldc; float sc; const float* ss; PG8_LAS float* rs;
    __device__ __forceinline__ void stage(int pm, int tid) const { if (ss) stage_rstd(ss, rs, pm, tid); }
    __device__ __forceinline__ void operator()(const f32x4 (&acc)[2][2][4][2], const Unit& u, int wr, int wc, int fr, int fq) const {
        const int row0 = u.pm * BM + wr * 64 + fr, col0 = u.pn * BM + wc * 32 + 8 * fq;
#pragma unroll
        for (int ai = 0; ai < 2; ++ai)
#pragma unroll
            for (int m = 0; m < 4; ++m) { bf16_t* rowp = O + (size_t)(row0 + ai * HALF + m * 16) * ldc + col0; const float rq = ss ? sc * rs[ai * HALF + wr * 64 + m * 16 + fr] : sc;
#pragma unroll
                for (int bj = 0; bj < 2; ++bj) { const f32x4 v0 = acc[ai][bj][m][0] * rq, v1 = acc[ai][bj][m][1] * rq;
                    u32x4 w; w.x = cvt_pk_bf16(v0[0], v0[1]); w.y = cvt_pk_bf16(v0[2], v0[3]); w.z = cvt_pk_bf16(v1[0], v1[1]); w.w = cvt_pk_bf16(v1[2], v1[3]);
                    *(PG8_GAS u32x4*)(rowp + bj * HALF) = w; } }
    }
};

struct EpiProj {
    static constexpr bool PERM = true, AFTER_DRAIN = false, CARRY = false, RSTD = true;
    __device__ __forceinline__ void stage(int pm, int tid) const { stage_rstd(ss, rs, pm, tid); }
    bf16_t* qkv; bf16_t* qi; bf16_t* ki; bf16_t* gates; const float* cs; float qscale; size_t bufstride; const float* ss; PG8_LAS float* rs;
    __device__ __forceinline__ void operator()(const f32x4 (&acc)[2][2][4][2], const Unit& u, int wr, int wc, int fr, int fq) const {
        const int pn = u.pn;
        bf16_t* dst; int ld, colbase; float sc = 1.f; int mode;
        if (pn < 18) { const int buf = pn >> 1, kind = buf % 3, mixer = buf / 3; dst = qkv + (size_t)buf * bufstride; ld = 512; colbase = (pn & 1) * 256;
            mode = (mixer >= 1 && kind < 2) ? 1 : 0; if (kind == 0) sc = qscale; }
        else if (pn == 18) { dst = qi; ld = 256; colbase = 0; mode = 1; }
        else if (pn == 19) { dst = ki; ld = 256; colbase = 0; mode = 3; }
        else { dst = gates; ld = 3072; colbase = (pn - 20) * 256; mode = 2; }
        const int row0 = u.pm * BM + wr * 64 + fr;
        const int jj = 4 * (wc & 1) + fq;
        if (mode == 1 || mode == 3) {
            f32x4 c4[8], s4[8];
#pragma unroll
            for (int k = 0; k < 8; ++k) { const int row = row0 + (k >> 2) * HALF + (k & 3) * 16; const float* t = cs + (size_t)(row & 4095) * 64 + 4 * jj; c4[k] = *(const PG8_GAS f32x4*)t; s4[k] = *(const PG8_GAS f32x4*)(t + 32); }
#pragma unroll
            for (int ai = 0; ai < 2; ++ai)
#pragma unroll
                for (int m = 0; m < 4; ++m) {
                    const int row = row0 + ai * HALF + m * 16;
                    bf16_t* rowp = dst + (size_t)row * ld + colbase;
                    const float rstd = rs[ai * HALF + wr * 64 + m * 16 + fr];
                    const f32x4 c4v = c4[ai * 4 + m], s4v = s4[ai * 4 + m];
#pragma unroll
                    for (int bj = 0; bj < 2; ++bj) {
                        const f32x4 x1 = acc[ai][bj][m][0] * rstd, x2 = acc[ai][bj][m][1] * rstd;
                        const int blk = 2 * bj + (wc >> 1);
                        if (mode == 1 || blk == 0) {
                            const f32x4 o1 = (x1 * c4v - x2 * s4v) * sc, o2 = (x2 * c4v + x1 * s4v) * sc;
                            u32x2 w1, w2; w1.x = cvt_pk_bf16(o1[0], o1[1]); w1.y = cvt_pk_bf16(o1[2], o1[3]); w2.x = cvt_pk_bf16(o2[0], o2[1]); w2.y = cvt_pk_bf16(o2[2], o2[3]);
                            *(PG8_GAS u32x2*)(rowp + 64 * blk + 4 * jj) = w1; *(PG8_GAS u32x2*)(rowp + 64 * blk + 32 + 4 * jj) = w2;
                        } else {
                            const f32x4 v0 = x1 * sc, v1 = x2 * sc;
                            u32x4 w; w.x = cvt_pk_bf16(v0[0], v0[1]); w.y = cvt_pk_bf16(v0[2], v0[3]); w.z = cvt_pk_bf16(v1[0], v1[1]); w.w = cvt_pk_bf16(v1[2], v1[3]);
                            *(PG8_GAS u32x4*)(rowp + bj * HALF + wc * 32 + 8 * fq) = w;
                        }
                    }
                }
        } else if (mode == 2) {
#pragma unroll
            for (int ai = 0; ai < 2; ++ai)
#pragma unroll
                for (int m = 0; m < 4; ++m) {
                    bf16_t* rowp = dst + (size_t)(row0 + ai * HALF + m * 16) * ld + colbase;
                    const float rq = rs[ai * HALF + wr * 64 + m * 16 + fr] * -1.4426950408889634f;
#pragma unroll
                    for (int bj = 0; bj < 2; ++bj) {
                        f32x4 v0 = acc[ai][bj][m][0] * rq, v1 = acc[ai][bj][m][1] * rq;
#pragma unroll
                        for (int e = 0; e < 4; ++e) { v0[e] = __builtin_amdgcn_exp2f(fminf(v0[e], 60.f)); v1[e] = __builtin_amdgcn_exp2f(fminf(v1[e], 60.f)); }
                        u32x4 w; w.x = cvt_pk_bf16_c(v0[0], v0[1]); w.y = cvt_pk_bf16_c(v0[2], v0[3]); w.z = cvt_pk_bf16_c(v1[0], v1[1]); w.w = cvt_pk_bf16_c(v1[2], v1[3]);
                        *(PG8_GAS u32x4*)(rowp + bj * HALF + wc * 32 + 8 * fq) = w;
                    }
                }
        } else {
#pragma unroll
            for (int ai = 0; ai < 2; ++ai)
#pragma unroll
                for (int m = 0; m < 4; ++m) {
                    bf16_t* rowp = dst + (size_t)(row0 + ai * HALF + m * 16) * ld + colbase;
                    const float rq = rs[ai * HALF + wr * 64 + m * 16 + fr] * sc;
#pragma unroll
                    for (int bj = 0; bj < 2; ++bj) {
                        const f32x4 v0 = acc[ai][bj][m][0] * rq, v1 = acc[ai][bj][m][1] * rq;
                        u32x4 w; w.x = cvt_pk_bf16(v0[0], v0[1]); w.y = cvt_pk_bf16(v0[2], v0[3]); w.z = cvt_pk_bf16(v1[0], v1[1]); w.w = cvt_pk_bf16(v1[2], v1[3]);
                        *(PG8_GAS u32x4*)(rowp + bj * HALF + wc * 32 + 8 * fq) = w;
                    }
                }
        }
    }
};

struct EpiSwiglu {
    static constexpr bool PERM = true, AFTER_DRAIN = false, CARRY = false, RSTD = true;
    bf16_t* H; int ldh; const float* ss; PG8_LAS float* rs;
    __device__ __forceinline__ void stage(int pm, int tid) const { stage_rstd(ss, rs, pm, tid); }
    __device__ __forceinline__ void operator()(const f32x4 (&acc)[2][2][4][2], const Unit& u, int wr, int wc, int fr, int fq) const {
        const int row0 = u.pm * BM + wr * 64 + fr, col0 = u.pn * (BM / 2) + wc * 16 + 4 * fq;
#pragma unroll
        for (int ai = 0; ai < 2; ++ai)
#pragma unroll
            for (int m = 0; m < 4; ++m) { bf16_t* rowp = H + (size_t)(row0 + ai * HALF + m * 16) * ldh + col0; const float rstd = rs[ai * HALF + wr * 64 + m * 16 + fr];
#pragma unroll
                for (int bj = 0; bj < 2; ++bj) { const f32x4 g = acc[ai][bj][m][0] * rstd, up = acc[ai][bj][m][1] * rstd; f32x4 h;
#pragma unroll
                    for (int e = 0; e < 4; ++e) h[e] = g[e] * __builtin_amdgcn_rcpf(1.f + __builtin_amdgcn_exp2f(-1.4426950408889634f * g[e])) * up[e];
                    u32x2 w; w.x = cvt_pk_bf16(h[0], h[1]); w.y = cvt_pk_bf16(h[2], h[3]);
                    *(PG8_GAS u32x2*)(rowp + bj * (HALF / 2)) = w; } }
    }
};

struct EpiGateC {
    static constexpr bool PERM = true, AFTER_DRAIN = false, CARRY = true, RSTD = false;
    const bf16_t* gates; bf16_t* Y;
    __device__ __forceinline__ bool carry(f32x4 (&acc)[2][2][4][2], const Unit& u, int wr, int wc, int fr, int fq) const {
        const int branch = u.pn >> 2, row0 = u.pm * BM + wr * 64 + fr, col0 = (u.pn & 3) * BM + wc * 32 + 8 * fq;
        if (branch < 2) {
            u32x4 gb[2][8];
#define GATE_ISSUE(ST) do { _Pragma("unroll") for (int mm = 0; mm < 2; ++mm) _Pragma("unroll") for (int bj = 0; bj < 2; ++bj) { \
                const bf16_t* p_ = gates + (size_t)(row0 + ((ST) >> 1) * HALF + (((ST) & 1) * 2 + mm) * 16) * 3072 + branch * 1024 + col0 + bj * HALF; \
                gb[(ST) & 1][(mm * 2 + bj) * 2] = *(const PG8_GAS u32x4*)p_; gb[(ST) & 1][(mm * 2 + bj) * 2 + 1] = *(const PG8_GAS u32x4*)(p_ + 1024); } } while (0)
            GATE_ISSUE(0);
#pragma unroll
            for (int st = 0; st < 4; ++st) {
                if (st + 1 < 4) GATE_ISSUE(st + 1);
#pragma unroll
                for (int mm = 0; mm < 2; ++mm)
#pragma unroll
                    for (int bj = 0; bj < 2; ++bj) { const int ai = st >> 1, m = (st & 1) * 2 + mm;
                        const u32x4 g = gb[st & 1][(mm * 2 + bj) * 2], h = gb[st & 1][(mm * 2 + bj) * 2 + 1];
                        float gc[8] = {bf_lo(g.x), bf_hi(g.x), bf_lo(g.y), bf_hi(g.y), bf_lo(g.z), bf_hi(g.z), bf_lo(g.w), bf_hi(g.w)};
                        const float gn[8] = {bf_lo(h.x), bf_hi(h.x), bf_lo(h.y), bf_hi(h.y), bf_lo(h.z), bf_hi(h.z), bf_lo(h.w), bf_hi(h.w)};
#pragma unroll
                        for (int e = 0; e < 8; ++e) gc[e] = (1.f + gn[e]) * __builtin_amdgcn_rcpf(1.f + gc[e]);
                        acc[ai][bj][m][0] = acc[ai][bj][m][0] * (f32x4){gc[0], gc[1], gc[2], gc[3]};
                        acc[ai][bj][m][1] = acc[ai][bj][m][1] * (f32x4){gc[4], gc[5], gc[6], gc[7]}; }
            }
#undef GATE_ISSUE
            return true;
        }
        u32x4 gl[16];
#pragma unroll
        for (int k = 0; k < 16; ++k) { const int ai = k >> 3, m = (k >> 1) & 3, bj = k & 1; gl[k] = *(const PG8_GAS u32x4*)(gates + (size_t)(row0 + ai * HALF + m * 16) * 3072 + branch * 1024 + col0 + bj * HALF); }
#pragma unroll
        for (int k = 0; k < 16; ++k) { const int ai = k >> 3, m = (k >> 1) & 3, bj = k & 1; const u32x4 g = gl[k];
            float gc[8] = {bf_lo(g.x), bf_hi(g.x), bf_lo(g.y), bf_hi(g.y), bf_lo(g.z), bf_hi(g.z), bf_lo(g.w), bf_hi(g.w)};
            const f32x4 a0 = acc[ai][bj][m][0], a1 = acc[ai][bj][m][1];
#pragma unroll
            for (int e = 0; e < 8; ++e) gc[e] = __builtin_amdgcn_rcpf(1.f + gc[e]);
            u32x4 w; w.x = cvt_pk_bf16(gc[0] * a0[0], gc[1] * a0[1]); w.y = cvt_pk_bf16(gc[2] * a0[2], gc[3] * a0[3]); w.z = cvt_pk_bf16(gc[4] * a1[0], gc[5] * a1[1]); w.w = cvt_pk_bf16(gc[6] * a1[2], gc[7] * a1[3]);
            *(PG8_GAS u32x4*)(Y + (size_t)(row0 + ai * HALF + m * 16) * 1024 + col0 + bj * HALF) = w; }
        return false;
    }
};

struct UpOrder {
    StaticOrder so;
    __host__ __device__ void init(int M, int G_, int c_) { so.init(M, 1024, G_, c_); }
    __host__ __device__ bool next(int i, Unit& u) const { const int br = i % 3; if (!so.next(i / 3, u)) return false; u.pn += 4 * br; u.az = br; return true; }
    __device__ __forceinline__ void a_ready(const Unit&) const {}
    __device__ __forceinline__ void done(const Unit&) const {}
};
template <class Epi, class Sched, bool ALIGN_EPI = false, bool SP2 = false>
__device__ __forceinline__ void gemm_phase(PG8_LAS unsigned char* lds, const Gemm g, const Sched& S, const Epi& E, int tid_in) {
    int tid_l = tid_in; asm volatile("" : "+v"(tid_l));
    const int tid = tid_l, wid = __builtin_amdgcn_readfirstlane(tid >> 6), lane = tid & 63, wr = wid >> 2, wc = wid & 3, fr = lane & 15, fq = lane >> 4;
    const int K = g.K, nt = K / BK;
    unsigned voffA[2], voffB[2];
#pragma unroll
    for (int i = 0; i < 2; ++i) { int R, C; stage_rc(tid * 16 + i * 8192, R, C); const int Rb = Epi::PERM ? ((R & ~31) + perm32(R & 31)) : R;
        voffA[i] = (unsigned)(R * K + C) * 2u; voffB[i] = (unsigned)(Rb * K + C) * 2u; }
    const size_t kstep = (size_t)(BK * 2);
    const size_t hstep = (size_t)HALF * K * 2;
    const size_t tstep = 2 * hstep;
    const unsigned ldsw = (unsigned)wid * 1024u;
    const int aoff = lds_byte(wr * 64 + fr, fq * 8), boff = lds_byte(wc * 32 + fr, fq * 8);
#define PG8_SA(b, h) (((b) * 2 + (h)) * HTB)
#define PG8_SB(b, h) ((4 + (b) * 2 + (h)) * HTB)
#define PG8_STAGE(bufoff, gbase, voff) do { _Pragma("unroll") for (int _i = 0; _i < 2; ++_i) \
        __builtin_amdgcn_global_load_lds((const unsigned*)((const char*)(gbase) + (voff)[_i]), (PG8_LAS unsigned*)(lds + (bufoff) + ldsw + _i * 8192), 16, 0, 0); } while (0)
#define PG8_LDA(dst, b, h) do { _Pragma("unroll") for (int m = 0; m < 4; ++m) _Pragma("unroll") for (int k = 0; k < 2; ++k) dst[m][k] = *(const PG8_LAS bf16x8*)(lds + PG8_SA(b, h) + aoff + m * 2048 + k * 1024); } while (0)
#define PG8_LDB(dst, b, h) do { _Pragma("unroll") for (int n = 0; n < 2; ++n) _Pragma("unroll") for (int k = 0; k < 2; ++k) dst[n][k] = *(const PG8_LAS bf16x8*)(lds + PG8_SB(b, h) + boff + n * 2048 + k * 1024); } while (0)
#define PG8_MMA(ai, bj, At, Bt) do { __builtin_amdgcn_s_setprio(1); _Pragma("unroll") for (int m = 0; m < 4; ++m) _Pragma("unroll") for (int n = 0; n < 2; ++n) _Pragma("unroll") for (int k = 0; k < 2; ++k) \
        acc[ai][bj][m][n] = __builtin_amdgcn_mfma_f32_16x16x32_bf16(Bt[n][k], At[m][k], acc[ai][bj][m][n], 0, 0, 0); __builtin_amdgcn_s_setprio(0); } while (0)
#define PG8_WAIT_V(n) asm volatile("s_waitcnt vmcnt(" #n ")" ::: "memory")
#define PG8_WAIT_L(n) asm volatile("s_waitcnt lgkmcnt(" #n ")" ::: "memory")
#define PG8_BAR __builtin_amdgcn_s_barrier()
#define PG8_SCHED __builtin_amdgcn_sched_barrier(0)
    Unit cur, nxt; int ui = 0; int rs_pm = -1;
    if (!S.next(0, cur)) return;
    f32x4 acc[2][2][4][2];
#pragma unroll
    for (int a = 0; a < 2; ++a)
#pragma unroll
        for (int b = 0; b < 2; ++b)
#pragma unroll
            for (int m = 0; m < 4; ++m)
#pragma unroll
                for (int n = 0; n < 2; ++n) acc[a][b][m][n] = (f32x4){0.f, 0.f, 0.f, 0.f};
    bf16x8 At[4][2], B0[2][2], B1[2][2];
    const char* cA = (const char*)g.A + (size_t)cur.pm * tstep + (size_t)cur.az * g.azs; const char* cB = (const char*)g.Bt + (size_t)cur.pn * tstep;
    S.a_ready(cur);
    if constexpr (SP2) {
        PG8_STAGE(PG8_SB(0, 0), cB, voffB); PG8_STAGE(PG8_SB(0, 1), cB + hstep, voffB); PG8_STAGE(PG8_SA(0, 0), cA, voffA); PG8_STAGE(PG8_SA(0, 1), cA + hstep, voffA);
        if (wr == 1) PG8_BAR;
        PG8_WAIT_V(2); PG8_BAR;
        PG8_STAGE(PG8_SB(1, 0), cB + kstep, voffB); PG8_STAGE(PG8_SA(1, 0), cA + kstep, voffA); PG8_STAGE(PG8_SB(1, 1), cB + hstep + kstep, voffB);
        PG8_WAIT_V(6); PG8_BAR;
    } else {
        PG8_STAGE(PG8_SB(0, 0), cB, voffB); PG8_STAGE(PG8_SA(0, 0), cA, voffA); PG8_STAGE(PG8_SB(0, 1), cB + hstep, voffB); PG8_STAGE(PG8_SA(0, 1), cA + hstep, voffA);
        if (wr == 1) PG8_BAR;
        PG8_WAIT_V(4); PG8_BAR;
        PG8_STAGE(PG8_SB(1, 0), cB + kstep, voffB); PG8_STAGE(PG8_SA(1, 0), cA + kstep, voffA); PG8_STAGE(PG8_SB(1, 1), cB + hstep + kstep, voffB);
        PG8_WAIT_V(6); PG8_BAR;
    }
    for (;;) {
        const bool has_next = S.next(ui + 1, nxt);
        const char* nA = has_next ? (const char*)g.A + (size_t)nxt.pm * tstep + (size_t)nxt.az * g.azs : cA; const char* nB = has_next ? (const char*)g.Bt + (size_t)nxt.pn * tstep : cB;
        for (int t = 0; t < nt; t += 2) {
            const bool last = (t == nt - 2);
            const char* a1 = cA + (size_t)(t + 1) * kstep;
            const char* a2 = last ? nA : cA + (size_t)(t + 2) * kstep; const char* b2 = last ? nB : cB + (size_t)(t + 2) * kstep;
            const char* a3 = a2 + kstep; const char* b3 = b2 + kstep;
            if (last && has_next) S.a_ready(nxt);
            if constexpr (SP2) {
            PG8_LDB(B0, 0, 0); PG8_LDB(B1, 0, 1); PG8_SCHED; PG8_LDA(At, 0, 0); PG8_STAGE(PG8_SA(1, 1), a1 + hstep, voffA);
            PG8_WAIT_V(8); PG8_WAIT_L(0); PG8_BAR; PG8_MMA(0, 0, At, B0); PG8_MMA(0, 1, At, B1); PG8_BAR; PG8_SCHED;
            PG8_LDA(At, 0, 1); PG8_STAGE(PG8_SB(0, 0), b2, voffB); PG8_STAGE(PG8_SB(0, 1), b2 + hstep, voffB); PG8_STAGE(PG8_SA(0, 0), a2, voffA);
            PG8_WAIT_V(8); PG8_WAIT_L(0); PG8_BAR; PG8_MMA(1, 0, At, B0); PG8_MMA(1, 1, At, B1); PG8_BAR; PG8_SCHED;
            PG8_LDB(B0, 1, 0); PG8_LDB(B1, 1, 1); PG8_SCHED; PG8_LDA(At, 1, 0); PG8_STAGE(PG8_SA(0, 1), a2 + hstep, voffA);
            PG8_WAIT_V(8); PG8_WAIT_L(0); PG8_BAR; PG8_MMA(0, 0, At, B0); PG8_MMA(0, 1, At, B1); PG8_BAR; PG8_SCHED;
            PG8_LDA(At, 1, 1); PG8_STAGE(PG8_SB(1, 0), b3, voffB); PG8_STAGE(PG8_SB(1, 1), b3 + hstep, voffB); PG8_STAGE(PG8_SA(1, 0), a3, voffA);
            PG8_WAIT_V(8); PG8_WAIT_L(0); PG8_BAR; PG8_MMA(1, 0, At, B0); PG8_MMA(1, 1, At, B1); PG8_BAR; PG8_SCHED;
            } else {
            PG8_LDB(B0, 0, 0); PG8_SCHED; PG8_LDA(At, 0, 0); PG8_STAGE(PG8_SA(1, 1), a1 + hstep, voffA);
            PG8_WAIT_L(8); PG8_BAR; PG8_WAIT_L(0); PG8_MMA(0, 0, At, B0); PG8_BAR; PG8_SCHED;
            PG8_LDB(B1, 0, 1); PG8_STAGE(PG8_SB(0, 0), b2, voffB);
            PG8_BAR; PG8_WAIT_L(0); PG8_MMA(0, 1, At, B1); PG8_BAR;
            PG8_LDA(At, 0, 1); PG8_STAGE(PG8_SA(0, 0), a2, voffA);
            PG8_BAR; PG8_WAIT_L(0); PG8_MMA(1, 0, At, B0); PG8_BAR; PG8_SCHED;
            PG8_STAGE(PG8_SB(0, 1), b2 + hstep, voffB);
            PG8_WAIT_V(6); PG8_BAR; PG8_MMA(1, 1, At, B1); PG8_BAR;
            PG8_LDB(B0, 1, 0); PG8_SCHED; PG8_LDA(At, 1, 0); PG8_STAGE(PG8_SA(0, 1), a2 + hstep, voffA);
            PG8_WAIT_L(8); PG8_BAR; PG8_WAIT_L(0); PG8_MMA(0, 0, At, B0); PG8_BAR; PG8_SCHED;
            PG8_LDB(B1, 1, 1); PG8_STAGE(PG8_SB(1, 0), b3, voffB);
            PG8_BAR; PG8_WAIT_L(0); PG8_MMA(0, 1, At, B1); PG8_BAR;
            PG8_LDA(At, 1, 1); PG8_STAGE(PG8_SA(1, 0), a3, voffA);
            PG8_BAR; PG8_WAIT_L(0); PG8_MMA(1, 0, At, B0); PG8_BAR; PG8_SCHED;
            PG8_STAGE(PG8_SB(1, 1), b3 + hstep, voffB);
            PG8_WAIT_V(6); PG8_BAR; PG8_MMA(1, 1, At, B1); PG8_BAR;
            }
        }
        if constexpr (ALIGN_EPI) { if (wr == 0) PG8_BAR; }
        if constexpr (Epi::RSTD) { if (cur.pm != rs_pm) { E.stage(cur.pm, tid); rs_pm = cur.pm; } }
        bool keep_acc = false;
        if constexpr (Epi::CARRY) { keep_acc = E.carry(acc, cur, wr, wc, fr, fq); S.done(cur); }
        else if constexpr (!Epi::AFTER_DRAIN) { E(acc, cur, wr, wc, fr, fq);
#ifdef REP_EPI
            if constexpr (Epi::RSTD) { asm volatile("" ::: "memory"); E(acc, cur, wr, wc, fr, fq); }
#endif
            S.done(cur); }
        if (!has_next) break;
        if (!keep_acc)
#pragma unroll
        for (int a = 0; a < 2; ++a)
#pragma unroll
            for (int b = 0; b < 2; ++b)
#pragma unroll
                for (int m = 0; m < 4; ++m)
#pragma unroll
                    for (int n = 0; n < 2; ++n) acc[a][b][m][n] = (f32x4){0.f, 0.f, 0.f, 0.f};
        cur = nxt; cA = nA; cB = nB; ++ui;
        if constexpr (ALIGN_EPI) { if (wr == 1) PG8_BAR; }
    }
    PG8_WAIT_V(0);
    if constexpr (!ALIGN_EPI) { if (wr == 0) PG8_BAR; }
    PG8_BAR;
    if constexpr (Epi::AFTER_DRAIN) { E.fused(acc, cur, wr, wc, fr, fq, lds, wid, lane); S.done(cur); }
#undef PG8_SA
#undef PG8_SB
#undef PG8_STAGE
#undef PG8_LDA
#undef PG8_LDB
#undef PG8_MMA
#undef PG8_WAIT_V
#undef PG8_WAIT_L
#undef PG8_BAR
#undef PG8_SCHED
}
}

namespace att {
#define ATT_LAS __attribute__((address_space(3)))
#define ATT_GAS __attribute__((address_space(1)))
typedef unsigned short bf16_t;
typedef short bf16x8 __attribute__((ext_vector_type(8)));
typedef short s16x4 __attribute__((ext_vector_type(4)));
typedef float f32x16 __attribute__((ext_vector_type(16)));
typedef float f32x4 __attribute__((ext_vector_type(4)));
typedef unsigned u32x4 __attribute__((ext_vector_type(4)));
typedef unsigned u32x2 __attribute__((ext_vector_type(2)));
typedef float f32x2_t __attribute__((ext_vector_type(2)));
typedef __bf16 bf16x2_t __attribute__((ext_vector_type(2)));
typedef short v4i16_t __attribute__((ext_vector_type(4)));
typedef ATT_LAS unsigned char* lptr;
#define ADI __device__ __forceinline__
constexpr float LOG2E = 1.4426950408889634f;
constexpr float NEG_BIG = -1e30f;

ADI int crow(int r, int hi) { return (r & 3) + 8 * (r >> 2) + 4 * hi; }
ADI unsigned cvtpk(float lo, float hi) { f32x2_t v = {lo, hi}; bf16x2_t b = __builtin_convertvector(v, bf16x2_t); return __builtin_bit_cast(unsigned, b); }
ADI float swapmax(float v) { auto rr = __builtin_amdgcn_permlane32_swap(__float_as_uint(v), __float_as_uint(v), false, false); return fmaxf(__uint_as_float(rr[0]), __uint_as_float(rr[1])); }
ADI float swapsum(float v) { auto rr = __builtin_amdgcn_permlane32_swap(__float_as_uint(v), __float_as_uint(v), false, false); return __uint_as_float(rr[0]) + __uint_as_float(rr[1]); }
ADI f32x16 splat16(float v) { f32x16 r;
#pragma unroll
  for (int i = 0; i < 16; ++i) r[i] = v; return r; }
ADI float bf2f(bf16_t b) { return __uint_as_float((unsigned)b << 16); }

ADI u32x4 ldg16(const bf16_t* p) { return *(const ATT_GAS u32x4*)p; }
ADI void k_map(int tid, int& key, int& chunk) { const int w = tid >> 6, lane = tid & 63; key = 32 * (w & 1) + (lane & 31); chunk = 2 * (w >> 1) + (lane >> 5); }
ADI int k_lds_off(int key, int chunk) { return chunk * 1024 + key * 16; }
ADI void v_map(int tid, int& key, int& dc) { key = tid >> 3; dc = tid & 7; }
ADI int v_lds_off(int key, int dc) { return ((dc >> 2) * 4 + (key >> 4)) * 1024 + (key & 15) * 64 + (dc & 3) * 16; }

ADI void qk_tile(f32x16& p0, f32x16& p1, lptr kimg, const bf16x8 (&qr)[4], int r32, int hi) {
#pragma unroll
  for (int d0 = 0; d0 < 4; ++d0) {
    const bf16x8 b0 = *(const ATT_LAS bf16x8*)(kimg + (2 * d0 + hi) * 1024 + r32 * 16);
    const bf16x8 b1 = *(const ATT_LAS bf16x8*)(kimg + (2 * d0 + hi) * 1024 + r32 * 16 + 512);
    p0 = __builtin_amdgcn_mfma_f32_32x32x16_bf16(b0, qr[d0], p0, 0, 0, 0);
    p1 = __builtin_amdgcn_mfma_f32_32x32x16_bf16(b1, qr[d0], p1, 0, 0, 0);
  }
}
template <int NO> ADI void softmax_step(f32x16& p0, f32x16& p1, float& m, float& l, f32x16 (&o)[NO]) {
  float mx = fmaxf(p0[0], p1[0]);
#pragma unroll
  for (int r = 1; r < 16; ++r) mx = fmaxf(mx, fmaxf(p0[r], p1[r]));
  mx = swapmax(mx);
  const float mn = fmaxf(m, mx), alpha = __builtin_amdgcn_exp2f(m - mn); m = mn;
  float ps = 0.f;
#pragma unroll
  for (int r = 0; r < 16; ++r) { p0[r] = __builtin_amdgcn_exp2f(p0[r] - mn); p1[r] = __builtin_amdgcn_exp2f(p1[r] - mn); ps += p0[r] + p1[r]; }
  ps = swapsum(ps); l = l * alpha + ps;
  if (!__all(alpha == 1.0f)) {
#pragma unroll
    for (int i = 0; i < NO; ++i) o[i] *= alpha;
  }
}
ADI s16x4 vtr(lptr p) { return __builtin_bit_cast(s16x4, __builtin_amdgcn_ds_read_tr16_b64_v4i16((ATT_LAS v4i16_t*)p)); }
template <int NDH> ADI void pv_tile(f32x16 (&o)[NDH], lptr vimg, const f32x16& p0, const f32x16& p1, int lane) {
  bf16x8 pf[4];
  { u32x4 w;
    w.x = cvtpk(p0[0], p0[1]); w.y = cvtpk(p0[2], p0[3]); w.z = cvtpk(p0[4], p0[5]); w.w = cvtpk(p0[6], p0[7]); pf[0] = __builtin_bit_cast(bf16x8, w);
    w.x = cvtpk(p0[8], p0[9]); w.y = cvtpk(p0[10], p0[11]); w.z = cvtpk(p0[12], p0[13]); w.w = cvtpk(p0[14], p0[15]); pf[1] = __builtin_bit_cast(bf16x8, w);
    w.x = cvtpk(p1[0], p1[1]); w.y = cvtpk(p1[2], p1[3]); w.z = cvtpk(p1[4], p1[5]); w.w = cvtpk(p1[6], p1[7]); pf[2] = __builtin_bit_cast(bf16x8, w);
    w.x = cvtpk(p1[8], p1[9]); w.y = cvtpk(p1[10], p1[11]); w.z = cvtpk(p1[12], p1[13]); w.w = cvtpk(p1[14], p1[15]); pf[3] = __builtin_bit_cast(bf16x8, w); }
  const int vb = ((lane >> 4) & 1) * 32 + (lane & 3) * 8 + (4 * (lane >> 5) + ((lane & 15) >> 2)) * 64;
#pragma unroll
  for (int dh = 0; dh < NDH; ++dh) {
#pragma unroll
    for (int kg = 0; kg < 4; ++kg) {
      lptr p = vimg + (dh >> 1) * 8192 + ((dh & 1) * 4 + kg) * 1024 + vb;
      const s16x4 lo = vtr(p), hi = vtr(p + 512);
      const bf16x8 vf = {lo[0], lo[1], lo[2], lo[3], hi[0], hi[1], hi[2], hi[3]};
      o[dh] = __builtin_amdgcn_mfma_f32_32x32x16_bf16(vf, pf[kg], o[dh], 0, 0, 0);
    }
  }
}
template <int NDH> ADI void store_o(bf16_t* orow, const f32x16 (&o)[NDH], float sc, int hi) {
#pragma unroll
  for (int dh = 0; dh < NDH; ++dh)
#pragma unroll
    for (int g = 0; g < 4; ++g) { u32x2 w; w.x = cvtpk(o[dh][4 * g] * sc, o[dh][4 * g + 1] * sc); w.y = cvtpk(o[dh][4 * g + 2] * sc, o[dh][4 * g + 3] * sc);
      *(ATT_GAS u32x2*)(orow + 32 * dh + 8 * g + 4 * hi) = w; }
}

ADI void glds16(const void* gsrc, unsigned lds_dst) { unsigned keep;
  asm volatile("s_mov_b32 %0, m0\n\ts_mov_b32 m0, %2\n\ts_nop 0\n\tglobal_load_lds_dwordx4 %1, off\n\ts_mov_b32 m0, %0" : "=&s"(keep) : "v"(gsrc), "s"(lds_dst) : "memory"); }
ADI void glds4(const void* gsrc, unsigned lds_dst) { unsigned keep;
  asm volatile("s_mov_b32 %0, m0\n\ts_mov_b32 m0, %2\n\ts_nop 0\n\tglobal_load_lds_dword %1, off\n\ts_mov_b32 m0, %0" : "=&s"(keep) : "v"(gsrc), "s"(lds_dst) : "memory"); }
template <int N> ADI void wait_bar() { asm volatile("s_waitcnt vmcnt(%0) lgkmcnt(0)\n\ts_barrier" :: "n"(N) : "memory"); }
#define MX3(a, b, c) __builtin_fmaxf(__builtin_fmaxf((a), (b)), (c))
constexpr float THR = 8.0f;
template <int NO> ADI void sm_decide(f32x16& c0, f32x16& c1, float& mref, float& l, f32x16 (&o)[NO]) {
  float a = MX3(c0[0], c0[1], c1[0]), b = MX3(c0[2], c0[3], c1[1]); a = MX3(a, c1[2], c1[3]);
#pragma unroll
  for (int r = 4; r < 16; r += 4) { a = MX3(a, c0[r], c0[r + 1]); b = MX3(b, c0[r + 2], c0[r + 3]); a = MX3(a, c1[r], c1[r + 1]); b = MX3(b, c1[r + 2], c1[r + 3]); }
  const float rm = swapmax(fmaxf(a, b));
  if (__builtin_expect(__any(rm > THR), 0)) {
    const float dl = fmaxf(rm, 0.f), f = __builtin_amdgcn_exp2f(-dl);
    mref += dl; l *= f;
#pragma unroll
    for (int r = 0; r < 16; ++r) { c0[r] -= dl; c1[r] -= dl; }
#pragma unroll
    for (int i = 0; i < NO; ++i) o[i] *= f;
  }
}
ADI void sm_exp_sum(f32x16& c0, f32x16& c1, float& l) {
  float s0 = 0.f, s1 = 0.f;
#pragma unroll
  for (int r = 0; r < 16; ++r) { c0[r] = __builtin_amdgcn_exp2f(c0[r]); c1[r] = __builtin_amdgcn_exp2f(c1[r]); s0 += c0[r]; s1 += c1[r]; }
  l += s0 + s1;
}

struct UnitArgs {
  const bf16_t* Q; int ldq; const bf16_t* K; const bf16_t* V; int ldkv; bf16_t* O; int ldo;
  int q0;
  int t0, t1;
  const float* relb;
  const unsigned* mask;
  bool nomask;
};
template <int MODE> ADI void attn_unit(lptr lds, const UnitArgs& a, int tid_in) {
  int tid_l = tid_in; asm volatile("" : "+v"(tid_l));
  const int tid = tid_l, lane = tid & 63, r32 = lane & 31, hi = lane >> 5, w = __builtin_amdgcn_readfirstlane(tid >> 6);
  constexpr int SLOT = 16384, P = (MODE == 1) ? 3 : 2;
  constexpr int MSK_OFF = 4 * SLOT, TAB_OFF = MSK_OFF + 4 * 2048;
  const unsigned lds0 = (unsigned)(size_t)lds;
  ATT_LAS float* tab = (ATT_LAS float*)(lds + TAB_OFF);
  if (MODE == 0) { for (int i = tid; i < 320; i += 512) tab[i] = ((const ATT_GAS float*)a.relb)[i] * LOG2E; }
  const int qloc = a.q0 + 32 * w + r32;
  const int cq = (a.q0 + 32 * w) >> 6;
  bf16x8 qr[4];
  { const bf16_t* qp = a.Q + (size_t)qloc * a.ldq + 8 * hi;
#pragma unroll
    for (int d0 = 0; d0 < 4; ++d0) qr[d0] = __builtin_bit_cast(bf16x8, ldg16(qp + 16 * d0)); }
  const bf16_t* ksrc = a.K + (size_t)lane * a.ldkv + w * 8;
  const bf16_t* vsrc = a.V + (size_t)(16 * (w & 3) + (lane >> 2)) * a.ldkv + (w >> 2) * 32 + (lane & 3) * 8;
  const unsigned* msrc = a.mask + (size_t)(a.q0 + 32 * w) * 2 + lane;
  const size_t tstep = (size_t)64 * a.ldkv;
#define ATT_DMA(t) do { const unsigned sb_ = lds0 + (unsigned)(((t) & 3) * SLOT + w * 1024); \
    glds16(ksrc + (size_t)(t) * tstep, (unsigned)__builtin_amdgcn_readfirstlane(sb_)); glds16(vsrc + (size_t)(t) * tstep, (unsigned)__builtin_amdgcn_readfirstlane(sb_ + 8192u)); \
    if (MODE == 1) glds4(msrc + (size_t)(t) * 8192, (unsigned)__builtin_amdgcn_readfirstlane(lds0 + (unsigned)(MSK_OFF + ((t) & 3) * 2048 + w * 256))); } while (0)
#define ATT_ACTIVE(t) ((MODE == 0) ? ((t) <= cq && (t) + 8 >= cq) : (MODE == 1) ? ((t) <= cq) : true)
#define ATT_INIT(P0, P1, t) do { if (MODE == 0) { const int dch_ = cq - (t); \
      if (dch_ >= 5) { const float c_ = tab[319] - mref; P0 = splat16(c_); P1 = splat16(c_); } \
      else { const int base_ = 64 * dch_ + (qloc & 63) + 63; \
        _Pragma("unroll") for (int r = 0; r < 16; ++r) { const int i0 = base_ - crow(r, hi); P0[r] = tab[i0 < 319 ? i0 : 319] - mref; const int i1 = i0 - 32; P1[r] = tab[i1 < 319 ? i1 : 319] - mref; } } \
    } else { P0 = splat16(-mref); P1 = splat16(-mref); } } while (0)
#define ATT_MASK(P0, P1, t) do { if (MODE == 1) { if (!a.nomask) { const unsigned mw_ = *(const ATT_LAS unsigned*)(lds + MSK_OFF + ((t) & 3) * 2048 + w * 256 + (r32 * 2 + hi) * 4); \
      _Pragma("unroll") for (int r = 0; r < 16; ++r) { P0[r] = ((int)(mw_ << (31 - r)) < 0) ? P0[r] : -INFINITY; P1[r] = ((int)(mw_ << (15 - r)) < 0) ? P1[r] : -INFINITY; } } } } while (0)
  float mref = 0.f, l = 0.f; f32x16 o[2]; o[0] = splat16(0.f); o[1] = splat16(0.f);
  ATT_DMA(a.t0); if (a.t0 + 1 <= a.t1) ATT_DMA(a.t0 + 1); if (a.t0 + 2 <= a.t1) ATT_DMA(a.t0 + 2);
  wait_bar<0>();
  f32x16 c0 = splat16(0.f), c1 = splat16(0.f);
  bool act_cur = ATT_ACTIVE(a.t0);
  if (act_cur) { ATT_INIT(c0, c1, a.t0); qk_tile(c0, c1, lds + (a.t0 & 3) * SLOT, qr, r32, hi); }
  for (int t = a.t0; t <= a.t1; ++t) {
    if (t > a.t0) { if (t + 2 <= a.t1) wait_bar<P>(); else wait_bar<0>(); }
    if (t + 3 <= a.t1) ATT_DMA(t + 3);
    const bool act_next = (t + 1 <= a.t1) && ATT_ACTIVE(t + 1);
    f32x16 n0 = splat16(0.f), n1 = splat16(0.f);
    lptr slot_c = lds + (t & 3) * SLOT, slot_n = lds + ((t + 1) & 3) * SLOT;
    if (act_cur && act_next) {
      ATT_MASK(c0, c1, t);
      sm_decide<2>(c0, c1, mref, l, o);
      ATT_INIT(n0, n1, t + 1);
      qk_tile(n0, n1, slot_n, qr, r32, hi);
      sm_exp_sum(c0, c1, l);
      pv_tile<2>(o, slot_c + 8192, c0, c1, lane);
    } else if (act_cur) {
      ATT_MASK(c0, c1, t);
      sm_decide<2>(c0, c1, mref, l, o);
      sm_exp_sum(c0, c1, l);
      pv_tile<2>(o, slot_c + 8192, c0, c1, lane);
    } else if (act_next) {
      ATT_INIT(n0, n1, t + 1);
      qk_tile(n0, n1, slot_n, qr, r32, hi);
    }
    c0 = n0; c1 = n1; act_cur = act_next;
  }
  asm volatile("s_waitcnt lgkmcnt(0)\n\ts_barrier" ::: "memory");
  l = swapsum(l);
  store_o<2>(a.O + (size_t)qloc * a.ldo, o, __builtin_amdgcn_rcpf(l), hi);
#undef ATT_DMA
#undef ATT_ACTIVE
#undef ATT_INIT
#undef ATT_MASK
}

constexpr int TOPK = 256;
ADI void idx_kload(const bf16_t* ki0, int s, unsigned loff, bf16x8 (&kf)[4]) {
  const ATT_GAS char* bs = (const ATT_GAS char*)(ki0 + (size_t)s * (32 * 256));
#pragma unroll
  for (int d0 = 0; d0 < 4; ++d0) kf[d0] = __builtin_bit_cast(bf16x8, *(const ATT_GAS u32x4*)(bs + (loff + 32u * d0)));
}
ADI void idx_park(unsigned* kscr, int s, int lane, const unsigned (&u)[16]) {
  ATT_GAS u32x4* p = (ATT_GAS u32x4*)(kscr + (size_t)s * 1024) + lane;
#pragma unroll
  for (int j = 0; j < 4; ++j) { u32x4 v = {u[4 * j], u[4 * j + 1], u[4 * j + 2], u[4 * j + 3]}; p[64 * j] = v; }
}
ADI void idx_fetch(const unsigned* kscr, int s, int lane, unsigned (&u)[16]) {
  const ATT_GAS u32x4* p = (const ATT_GAS u32x4*)(kscr + (size_t)s * 1024) + lane;
#pragma unroll
  for (int j = 0; j < 4; ++j) { const u32x4 v = p[64 * j]; u[4 * j] = v.x; u[4 * j + 1] = v.y; u[4 * j + 2] = v.z; u[4 * j + 3] = v.w; }
}
ADI void idx_scores2(const bf16x8 (&kA)[4], const bf16x8 (&kB)[4], lptr qimg, const float (&wv)[4], unsigned (&uA)[16], unsigned (&uB)[16], unsigned zA, unsigned zB) {
  float sA[16], sB[16];
#pragma unroll
  for (int hp = 0; hp < 2; ++hp) {
    bf16x8 q0[4], q1[4];
#pragma unroll
    for (int d0 = 0; d0 < 4; ++d0) { q0[d0] = *(const ATT_LAS bf16x8*)(qimg + ((2 * hp) * 4 + d0) * 1024); q1[d0] = *(const ATT_LAS bf16x8*)(qimg + ((2 * hp + 1) * 4 + d0) * 1024); }
    f32x16 a0 = splat16(0.f), a1 = splat16(0.f), b0 = splat16(0.f), b1 = splat16(0.f);
#pragma unroll
    for (int d0 = 0; d0 < 4; ++d0) {
      a0 = __builtin_amdgcn_mfma_f32_32x32x16_bf16(kA[d0], q0[d0], a0, 0, 0, 0); b0 = __builtin_amdgcn_mfma_f32_32x32x16_bf16(kB[d0], q0[d0], b0, 0, 0, 0);
      a1 = __builtin_amdgcn_mfma_f32_32x32x16_bf16(kA[d0], q1[d0], a1, 0, 0, 0); b1 = __builtin_amdgcn_mfma_f32_32x32x16_bf16(kB[d0], q1[d0], b1, 0, 0, 0); }
#pragma unroll
    for (int r = 0; r < 16; ++r) {
      const float ra0 = __int_as_float(max(__float_as_int(a0[r]), 0)), ra1 = __int_as_float(max(__float_as_int(a1[r]), 0));
      const float rb0 = __int_as_float(max(__float_as_int(b0[r]), 0)), rb1 = __int_as_float(max(__float_as_int(b1[r]), 0));
      sA[r] = __builtin_fmaf(ra0, wv[2 * hp], hp == 0 ? 0.0f : sA[r]); sA[r] = __builtin_fmaf(ra1, wv[2 * hp + 1], sA[r]);
      sB[r] = __builtin_fmaf(rb0, wv[2 * hp], hp == 0 ? 0.0f : sB[r]); sB[r] = __builtin_fmaf(rb1, wv[2 * hp + 1], sB[r]);
    }
  }
#pragma unroll
  for (int r = 0; r < 16; ++r) {
    const unsigned ba = __float_as_uint(sA[r]), bb = __float_as_uint(sB[r]);
    const unsigned kk = (unsigned)(((r & 3) + 8 * (r >> 2)) << 11);
    unsigned ka = ((int)ba < 0) ? ~ba : ba + 0x80800000u, kb = ((int)bb < 0) ? ~bb : bb + 0x80800000u;
    uA[r] = (ba == 0u) ? zA - kk : ka; uB[r] = (bb == 0u) ? zB - kk : kb;
  }
}
ADI unsigned wave_excl_scan(unsigned v, int lane) {
  unsigned x = v;
#pragma unroll
  for (int d = 1; d < 64; d <<= 1) { const unsigned t = __shfl_up(x, d); if (lane >= d) x += t; }
  return x - v;
}
#define IDX_DPP_SHR(x, n) ((unsigned)__builtin_amdgcn_update_dpp(0, (int)(x), 0x110 + (n), 0xf, 0xf, true))
ADI void hist_scan4(ATT_LAS unsigned* hist, ATT_LAS unsigned* res, int w, int lane_in) {
  int lane = lane_in; asm volatile("" : "+v"(lane));
  const int rho = lane >> 4, q = 4 * w + rho, li = lane & 15;
  const unsigned k = res[q * 4 + 1];
  ATT_LAS unsigned* hq = hist + q * 1024;
  const int p0 = 1023 - 64 * li;
  unsigned T = 0;
#pragma unroll 16
  for (int t = 0; t < 64; ++t) { const unsigned o = (unsigned)(t + 4 * li + rho) & 63u; const unsigned wd = hq[(unsigned)(p0 - (int)o) ^ (unsigned)q]; T += (wd & 0xffffu) + (wd >> 16); }
  unsigned x = T;
  x += IDX_DPP_SHR(x, 1); x += IDX_DPP_SHR(x, 2); x += IDX_DPP_SHR(x, 4); x += IDX_DPP_SHR(x, 8);
  const unsigned E = x - T;
  if (E < k && k <= E + T) { res[q * 4 + 3] = (unsigned)p0; res[q * 4 + 2] = E; }
  asm volatile("s_waitcnt lgkmcnt(0)" ::: "memory");
  const int pL = (int)res[q * 4 + 3]; const unsigned EL = res[q * 4 + 2];
  unsigned wd4[4]; unsigned s4 = 0;
#pragma unroll
  for (int j = 0; j < 4; ++j) { wd4[j] = hq[(unsigned)(pL - 4 * li - j) ^ (unsigned)q]; s4 += (wd4[j] & 0xffffu) + (wd4[j] >> 16); }
  unsigned y = s4;
  y += IDX_DPP_SHR(y, 1); y += IDX_DPP_SHR(y, 2); y += IDX_DPP_SHR(y, 4); y += IDX_DPP_SHR(y, 8);
  const unsigned E2 = EL + (y - s4);
  asm volatile("s_waitcnt lgkmcnt(0)" ::: "memory");
  if (E2 < k && k <= E2 + s4) {
    unsigned cum = E2, fbin = 0, frem = 0, fcnt = 0;
#pragma unroll
    for (int j = 0; j < 4; ++j) {
      const unsigned p = (unsigned)(pL - 4 * li - j), chi = wd4[j] >> 16, clo = wd4[j] & 0xffffu;
      if (cum < k && k <= cum + chi) { fbin = 2 * p + 1; frem = k - cum; fcnt = chi; }
      cum += chi;
      if (cum < k && k <= cum + clo) { fbin = 2 * p; frem = k - cum; fcnt = clo; }
      cum += clo;
    }
    res[q * 4 + 0] = fbin; res[q * 4 + 1] = frem; res[q * 4 + 2] = fcnt;
  }
}
#define IDX_PREF0() do { if (w < NS) { idx_kload(KI, w, loff, kA_); idx_kload(KI, (w + 8 < NS) ? w + 8 : w, loff, kB_); } } while (0)
#define IDX_LOOP0(BODY) do { \
    for (int s_ = w; s_ < NS; s_ += 16) { const bool hb_ = s_ + 8 < NS; \
      unsigned pA_[16], pB_[16]; { const unsigned zA_ = 0x80000000u + ((4095u - 32u * (unsigned)s_ - 4u * (unsigned)hi) << 11); idx_scores2(kA_, kB_, qimg, wv, pA_, pB_, zA_, zA_ - (256u << 11)); } \
      if (s_ + 16 < NS) { idx_kload(KI, s_ + 16, loff, kA_); idx_kload(KI, (s_ + 24 < NS) ? s_ + 24 : s_ + 16, loff, kB_); } \
      { unsigned (&u)[16] = pA_; idx_park(kscr, s_, lane, u); BODY(s_); } \
      if (hb_) { unsigned (&u)[16] = pB_; idx_park(kscr, s_ + 8, lane, u); BODY(s_ + 8); } } } while (0)
#define IDX_SWEEP0(BODY) do { IDX_PREF0(); IDX_LOOP0(BODY); } while (0)
#define IDX_PREF() do { if (w < NS) idx_fetch(kscr, w, lane, uA_); if (w + 8 < NS) idx_fetch(kscr, w + 8, lane, uB_); if (w + 16 < NS) idx_fetch(kscr, w + 16, lane, uC_); } while (0)
#define IDX_LOOP(BODY) do { \
    for (int s_ = w; s_ < NS; s_ += 32) { \
      if (s_ + 24 < NS) idx_fetch(kscr, s_ + 24, lane, uD_); { unsigned (&u)[16] = uA_; BODY(s_); } \
      if (s_ + 8 < NS) { if (s_ + 32 < NS) idx_fetch(kscr, s_ + 32, lane, uA_); unsigned (&u)[16] = uB_; BODY(s_ + 8); } \
      if (s_ + 16 < NS) { if (s_ + 40 < NS) idx_fetch(kscr, s_ + 40, lane, uB_); unsigned (&u)[16] = uC_; BODY(s_ + 16); } \
      if (s_ + 24 < NS) { if (s_ + 48 < NS) idx_fetch(kscr, s_ + 48, lane, uC_); unsigned (&u)[16] = uD_; BODY(s_ + 24); } } } while (0)
#define IDX_SWEEP(BODY) do { IDX_PREF(); IDX_LOOP(BODY); } while (0)
#define IDX_ADD(bin) do { unsigned sh_; asm("v_mad_u32_u24 %0, %1, %2, 1" : "=v"(sh_) : "v"((bin) & 1u), "s"(c16_));   \
    __hip_atomic_fetch_add(hist + r32 * 1024 + (((bin) >> 1) ^ (unsigned)r32), sh_, __ATOMIC_RELAXED, __HIP_MEMORY_SCOPE_WORKGROUP); \
    if (IDX_PROBE_DUP) __hip_atomic_fetch_add((ATT_LAS unsigned*)(lds + 148736) + (r32 * 32 + ((((bin) >> 1) ^ (unsigned)r32) & 31u)), sh_, __ATOMIC_RELAXED, __HIP_MEMORY_SCOPE_WORKGROUP); } while (0)
#ifndef IDX_PROBE_DUP
#define IDX_PROBE_DUP 0
#endif
#ifndef IDX_PROBE_P0
#define IDX_PROBE_P0 0
#endif
#ifndef IDX_PROBE_SCAN
#define IDX_PROBE_SCAN 0
#endif
#ifndef IDX_PROBE_P1
#define IDX_PROBE_P1 0
#endif
constexpr int IDX_QOFF = 132352;
constexpr unsigned IDX_CAP = 16;
ADI void idx_unit(lptr lds, const bf16_t* QI, const bf16_t* KI, unsigned short* mask16, unsigned* kscr, int n, int half, int tid_in) {
  int tid_l = tid_in; asm volatile("" : "+v"(tid_l));
#define IDX_BAR() do { asm volatile("s_waitcnt lgkmcnt(0)" ::: "memory"); __builtin_amdgcn_s_barrier(); asm volatile("" ::: "memory"); } while (0)
  const int tid = tid_l, lane = tid & 63, r32 = lane & 31, hi = lane >> 5, w = __builtin_amdgcn_readfirstlane(tid >> 6);
  ATT_LAS unsigned* hist = (ATT_LAS unsigned*)lds;
  ATT_LAS unsigned* res = (ATT_LAS unsigned*)(lds + 131072);
  const int qpos = 64 * n + 32 * half + r32;
  const int NS = 2 * (n + 1);
  const unsigned loff = (unsigned)(r32 * 512 + hi * 16);
  unsigned uA_[16], uB_[16], uC_[16], uD_[16]; bf16x8 kA_[4], kB_[4];
  IDX_PREF0();
  u32x4 qst_[2];
  { const int q0row = 64 * n + 32 * half;
#pragma unroll
    for (int i = 0; i < 2; ++i) { const int p = tid + 512 * i, q = p >> 5, c16 = p & 31; qst_[i] = ldg16(QI + (size_t)(q0row + q) * 256 + c16 * 8); } }
  lptr qimg = lds + IDX_QOFF + hi * 512 + r32 * 16;
  float wv[4];
  { const u32x2 ww = *(const ATT_GAS u32x2*)(KI + (size_t)qpos * 256 + 64);
    wv[0] = __uint_as_float(ww.x << 16) * 0.0625f; wv[1] = __uint_as_float(ww.x & 0xffff0000u) * 0.0625f; wv[2] = __uint_as_float(ww.y << 16) * 0.0625f; wv[3] = __uint_as_float(ww.y & 0xffff0000u) * 0.0625f; }
  const unsigned moff = (unsigned)(qpos * 8 + hi * 4);
  if (tid < 32) res[tid * 4 + 1] = TOPK;
  if (tid == 32 || tid == 33) res[128 + (tid - 32)] = 0u;
  unsigned pre = 0u, thr = 0u, cut = 0xffffu; bool needtie = false;
  unsigned c16_ = 0xffffu; asm volatile("" : "+s"(c16_));
#define IDX_ZERO() do { const u32x4 z_ = {0u, 0u, 0u, 0u}; _Pragma("unroll") for (int i = 0; i < 16; ++i) *(ATT_LAS u32x4*)(lds + (size_t)(i * 512 + tid) * 16) = z_; IDX_BAR(); } while (0)
#define IDX_SCAN() do { IDX_BAR(); hist_scan4(hist, res, w, lane); IDX_BAR(); } while (0)
  { const u32x4 z_ = {0u, 0u, 0u, 0u};
#pragma unroll
    for (int i = 0; i < 16; ++i) *(ATT_LAS u32x4*)(lds + (size_t)(i * 512 + tid) * 16) = z_;
#pragma unroll
    for (int i = 0; i < 2; ++i) { const int p = tid + 512 * i, q = p >> 5, c16 = p & 31; *(ATT_LAS u32x4*)(lds + IDX_QOFF + c16 * 512 + q * 16) = qst_[i]; }
    IDX_BAR(); }
#define IDX_B0(s) do { _Pragma("unroll") for (int r = 0; r < 16; ++r) IDX_ADD(u[r] >> 21); } while (0)
#define IDX_B0_(s) IDX_B0(s)
#if IDX_PROBE_P0
  { IDX_SWEEP0(IDX_B0_); IDX_BAR(); IDX_ZERO(); }
#endif
  IDX_LOOP0(IDX_B0);
#if IDX_PROBE_SCAN
  { ATT_LAS unsigned* res2 = (ATT_LAS unsigned*)(lds + 149760); if (tid < 32) res2[tid * 4 + 1] = TOPK; IDX_BAR(); hist_scan4(hist, res2, w, lane); IDX_BAR(); }
#endif
  IDX_BAR();
  IDX_PREF();
  hist_scan4(hist, res, w, lane); IDX_BAR();
  pre = res[r32 * 4 + 0];
  IDX_ZERO();
#define IDX_B1D(s) do { _Pragma("unroll") for (int r = 0; r < 16; ++r) { if ((u[r] >> 21) == pre) __hip_atomic_fetch_add((ATT_LAS unsigned*)(lds + 148736) + (r32 * 32 + (((u[r] >> 11) ^ (unsigned)r32) & 31u)), 1u, __ATOMIC_RELAXED, __HIP_MEMORY_SCOPE_WORKGROUP); } } while (0)
#define IDX_B1(s) do { _Pragma("unroll") for (int r = 0; r < 16; ++r) { if ((u[r] >> 21) == pre) IDX_ADD((u[r] >> 10) & 2047u); } } while (0)
#if IDX_PROBE_P1
  { IDX_SWEEP(IDX_B1D); IDX_BAR(); }
#endif
  IDX_LOOP(IDX_B1);
  IDX_PREF();
  IDX_SCAN();
  unsigned krem;
  { const unsigned fbin = res[r32 * 4 + 0], fcnt = res[r32 * 4 + 2]; krem = res[r32 * 4 + 1]; pre = (pre << 11) | fbin; if (fcnt > IDX_CAP) res[129] = 1u; }
  IDX_BAR();
  if (res[129] == 0u) {
    ATT_LAS unsigned* cand = (ATT_LAS unsigned*)lds;
    ATT_LAS unsigned* ccnt = (ATT_LAS unsigned*)(lds + 4096);
    if (tid < 32) ccnt[tid] = 0u;
    IDX_BAR();
#define IDX_BM(s) do { unsigned bits_ = 0u; _Pragma("unroll") for (int r = 15; r >= 0; --r) { const unsigned p_ = u[r] >> 10; bits_ = (bits_ << 1) | (p_ > pre ? 1u : 0u); \
        if (p_ == pre) { const unsigned pos_ = __hip_atomic_fetch_add(ccnt + r32, 1u, __ATOMIC_RELAXED, __HIP_MEMORY_SCOPE_WORKGROUP); cand[r32 * IDX_CAP + (pos_ & (IDX_CAP - 1))] = ((u[r] & 1023u) << 12) | (4095u - (unsigned)(32 * (s) + crow(r, hi))); } } \
      *(ATT_GAS unsigned short*)((ATT_GAS char*)(mask16 + (size_t)((s) >> 1) * 16384 + ((s) & 1)) + moff) = (unsigned short)bits_; } while (0)
    IDX_LOOP(IDX_BM);
    asm volatile("s_waitcnt vmcnt(0)" ::: "memory");
    IDX_BAR();
    if (tid < 32) {
      const unsigned q = (unsigned)tid, cnt = ccnt[q], need = res[q * 4 + 1];
      const int qp = 64 * n + 32 * half + (int)q;
      for (unsigned j = 0; j < need && j < cnt; ++j) {
        unsigned best = 0u, bi = 0u;
        for (unsigned i = 0; i < cnt; ++i) { const unsigned c = cand[q * IDX_CAP + i]; if (c >= best) { best = c; bi = i; } }
        cand[q * IDX_CAP + bi] = 0u;
        if (j + 1 == need || true) { const unsigned kidx = 4095u - (best & 4095u), s2 = kidx >> 5, wi = kidx & 31u, hc = (wi >> 2) & 1u, rr = (wi & 3u) + 4u * (wi >> 3);
          __hip_atomic_fetch_or((ATT_GAS unsigned*)mask16 + (((size_t)(s2 >> 1) * 4096 + qp) * 2 + hc), 1u << (16u * (s2 & 1u) + rr), __ATOMIC_RELAXED, __HIP_MEMORY_SCOPE_AGENT); }
      }
    }
    (void)krem;
  } else {
    IDX_ZERO();
#define IDX_B2(s) do { _Pragma("unroll") for (int r = 0; r < 16; ++r) { if ((u[r] >> 10) == pre) IDX_ADD(u[r] & 1023u); } } while (0)
    IDX_LOOP(IDX_B2);
    IDX_SCAN();
    { const unsigned fbin = res[r32 * 4 + 0], frem = res[r32 * 4 + 1], fcnt = res[r32 * 4 + 2]; thr = (pre << 10) | fbin; needtie = frem < fcnt; if (needtie) res[128] = 1u; }
    IDX_BAR();
    if (res[128] != 0u) {
      IDX_ZERO();
#define IDX_B3(s) do { _Pragma("unroll") for (int r = 0; r < 16; ++r) { if (u[r] == thr) IDX_ADD(2047u - (unsigned)((32 * (s) + crow(r, hi)) >> 1)); } } while (0)
      IDX_SWEEP(IDX_B3);
      IDX_SCAN();
      { const unsigned fbin = res[r32 * 4 + 0], frem = res[r32 * 4 + 1], fcnt = res[r32 * 4 + 2]; const unsigned bt = 2047u - fbin; if (needtie) cut = (frem == 1u && fcnt == 2u) ? 2u * bt : 2u * bt + 1u; }
      IDX_BAR();
    }
#define IDX_BS(s) do { unsigned bits_ = 0u; _Pragma("unroll") for (int r = 15; r >= 0; --r) { const unsigned kidx_ = (unsigned)(32 * (s) + crow(r, hi)); const bool sel_ = (u[r] > thr) || (u[r] == thr && kidx_ <= cut); bits_ = (bits_ << 1) | (sel_ ? 1u : 0u); } \
      *(ATT_GAS unsigned short*)((ATT_GAS char*)(mask16 + (size_t)((s) >> 1) * 16384 + ((s) & 1)) + moff) = (unsigned short)bits_; } while (0)
    IDX_SWEEP(IDX_BS);
  }
#undef IDX_BAR
#undef IDX_ZERO
#undef IDX_SCAN
#undef IDX_B0
#undef IDX_B1
#undef IDX_B2
#undef IDX_B3
#undef IDX_BM
#undef IDX_BS
}
#undef IDX_SWEEP
#undef IDX_SWEEP0
#undef IDX_PREF
#undef IDX_PREF0
#undef IDX_LOOP
#undef IDX_LOOP0
#undef IDX_ADD
}

namespace attx {
using bf16=__hip_bfloat16;
using bf16x8=__attribute__((ext_vector_type(8)))short;
using s16x4=__attribute__((ext_vector_type(4)))short;
using f32x16=__attribute__((ext_vector_type(16)))float;
using u32x4=__attribute__((ext_vector_type(4)))unsigned;
using f32x4v=__attribute__((ext_vector_type(4)))float;
constexpr int D=64,NW=8,QBLK=32,QB=QBLK*NW,KVBLK=64;
__device__ __forceinline__ int crow(int r,int hi){return (r&3)+8*(r>>2)+4*hi;}
#define SBAR() __builtin_amdgcn_sched_barrier(0)
constexpr int NSLOT=3, SLOTB=8192;
constexpr int LDS_K=0, LDS_V=NSLOT*SLOTB, LDS_WS=2*NSLOT*SLOTB, LDS_OST=LDS_WS+NW*64*4, LDS_MSK=LDS_OST+NW*4096, LDS_TAB=LDS_MSK+4*2048, LDS_BYTES=LDS_TAB+384*4;
__device__ __forceinline__ void glds16(const void*gsrc,unsigned lds_dst){unsigned keep;
  asm volatile("s_mov_b32 %0, m0\n\ts_mov_b32 m0, %2\n\ts_nop 0\n\tglobal_load_lds_dwordx4 %1, off\n\ts_mov_b32 m0, %0":"=&s"(keep):"v"(gsrc),"s"(lds_dst):"memory");}
__device__ __forceinline__ void glds4(const void*gsrc,unsigned lds_dst){unsigned keep;
  asm volatile("s_mov_b32 %0, m0\n\ts_mov_b32 m0, %2\n\ts_nop 0\n\tglobal_load_lds_dword %1, off\n\ts_mov_b32 m0, %0":"=&s"(keep):"v"(gsrc),"s"(lds_dst):"memory");}
__device__ __forceinline__ float max3f(float a,float b,float c){float r;asm("v_max3_f32 %0, %1, %2, %3":"=v"(r):"v"(a),"v"(b),"v"(c));return r;}
__device__ __forceinline__ float max2f(float a,float b){float r;asm("v_max_f32_e32 %0, %1, %2":"=v"(r):"v"(a),"v"(b));return r;}
__device__ __forceinline__ float fadd_s(float a,float b){float r;asm("v_add_f32_e32 %0, %1, %2":"=v"(r):"v"(a),"v"(b));return r;}
__device__ __forceinline__ float fsub_s(float a,float b){float r;asm("v_sub_f32_e32 %0, %1, %2":"=v"(r):"v"(a),"v"(b));return r;}
typedef float f32x2_t __attribute__((ext_vector_type(2))); typedef __bf16 bf16x2_t __attribute__((ext_vector_type(2)));
__device__ __forceinline__ unsigned cvtpk_s(float lo,float hi){f32x2_t v={lo,hi};bf16x2_t b=__builtin_convertvector(v,bf16x2_t);return __builtin_bit_cast(unsigned,b);}
#define WAIT_BAR(N) asm volatile("s_waitcnt vmcnt(" #N ") lgkmcnt(0)\n\ts_barrier":::"memory")
__device__ __forceinline__ void qkt(f32x16&p0,f32x16&p1,const char*Kslot,const bf16x8*qr,const f32x16&negm,int r32,int hi){
  const char*kb=Kslot+hi*1024+r32*16;
  #pragma unroll
  for(int d0=0;d0<4;++d0){
    const bf16x8 b0=*reinterpret_cast<const bf16x8*>(kb+d0*2048);
    const bf16x8 b1=*reinterpret_cast<const bf16x8*>(kb+d0*2048+512);
    if(d0==0){p0=__builtin_amdgcn_mfma_f32_32x32x16_bf16(b0,qr[0],negm,0,0,0);p1=__builtin_amdgcn_mfma_f32_32x32x16_bf16(b1,qr[0],negm,0,0,0);}
    else{p0=__builtin_amdgcn_mfma_f32_32x32x16_bf16(b0,qr[d0],p0,0,0,0);p1=__builtin_amdgcn_mfma_f32_32x32x16_bf16(b1,qr[d0],p1,0,0,0);}}
}
typedef __attribute__((address_space(3))) const char* lds_cptr;
typedef short v4i16_t __attribute__((ext_vector_type(4)));
__device__ __forceinline__ void kload8(bf16x8*kf,lds_cptr kp){
  kf[0]=*(const __attribute__((address_space(3))) bf16x8*)(kp);      kf[1]=*(const __attribute__((address_space(3))) bf16x8*)(kp+512);
  kf[2]=*(const __attribute__((address_space(3))) bf16x8*)(kp+2048); kf[3]=*(const __attribute__((address_space(3))) bf16x8*)(kp+2560);
  kf[4]=*(const __attribute__((address_space(3))) bf16x8*)(kp+4096); kf[5]=*(const __attribute__((address_space(3))) bf16x8*)(kp+4608);
  kf[6]=*(const __attribute__((address_space(3))) bf16x8*)(kp+6144); kf[7]=*(const __attribute__((address_space(3))) bf16x8*)(kp+6656);
}
__device__ __forceinline__ void kload2(bf16x8*kf,lds_cptr kp,int j){ kf[2*j]=*(const __attribute__((address_space(3))) bf16x8*)(kp+j*2048); kf[2*j+1]=*(const __attribute__((address_space(3))) bf16x8*)(kp+j*2048+512); }
__device__ __forceinline__ s16x4 vtr(lds_cptr p){ return __builtin_bit_cast(s16x4,__builtin_amdgcn_ds_read_tr16_b64_v4i16((__attribute__((address_space(3))) v4i16_t*)p)); }
__device__ __forceinline__ float rowmax(const f32x16&p0,const f32x16&p1){
  float a=max3f(p0[0],p0[1],p1[0]),b=max3f(p0[2],p0[3],p1[1]);a=max3f(a,p1[2],p1[3]);
  #pragma unroll
  for(int r=4;r<16;r+=4){a=max3f(a,p0[r],p0[r+1]);b=max3f(b,p0[r+2],p0[r+3]);a=max3f(a,p1[r],p1[r+1]);b=max3f(b,p1[r+2],p1[r+3]);}
  const float m=max2f(a,b);
  auto rr=__builtin_amdgcn_permlane32_swap(__float_as_uint(m),__float_as_uint(m),false,false);
  return max2f(__uint_as_float(rr[0]),__uint_as_float(rr[1]));
}
__device__ __forceinline__ void pv(f32x16*o,int vb,bf16x8 pa0,bf16x8 pa1,bf16x8 pa2,bf16x8 pa3){
  #pragma unroll
  for(int d0=0;d0<2;++d0){s16x4 lo[4],hi[4];
    #pragma unroll
    for(int ks=0;ks<4;++ks){
      asm volatile("ds_read_b64_tr_b16 %0,%1 offset:%c2":"=&v"(lo[ks]):"v"(vb),"i"(d0*4096+ks*1024):"memory");
      asm volatile("ds_read_b64_tr_b16 %0,%1 offset:%c2":"=&v"(hi[ks]):"v"(vb),"i"(d0*4096+ks*1024+512):"memory");}
    asm volatile("s_waitcnt lgkmcnt(0)":::"memory");SBAR();
    #define PK(k) (bf16x8){lo[k][0],lo[k][1],lo[k][2],lo[k][3],hi[k][0],hi[k][1],hi[k][2],hi[k][3]}
    o[d0]=__builtin_amdgcn_mfma_f32_32x32x16_bf16(pa0,PK(0),o[d0],0,0,0);
    o[d0]=__builtin_amdgcn_mfma_f32_32x32x16_bf16(pa1,PK(1),o[d0],0,0,0);
    o[d0]=__builtin_amdgcn_mfma_f32_32x32x16_bf16(pa2,PK(2),o[d0],0,0,0);
    o[d0]=__builtin_amdgcn_mfma_f32_32x32x16_bf16(pa3,PK(3),o[d0],0,0,0);
    #undef PK
  }
}
struct UA {
  const bf16* Qw0; int ldq;
  const bf16* Kh; const bf16* Vh; int ldkv;
  bf16* Ow0; int ldo;
  int NT;
  int tabs0;
  int cq0;
  const float* relb;
  const unsigned* msk;
  int nomask;
};
#ifndef ATTN_STORE16
#define ATTN_STORE16(p,v) (*(__attribute__((address_space(1))) u32x4*)(p)=(v))
#endif
template<int MODE,int THRL> __device__ __forceinline__ void attn_unit(const UA& a,char*shm,int tid_in){
  int tid_l=tid_in; asm volatile("":"+v"(tid_l));
  const int tid=tid_l,lane=tid&63,r32=lane&31,hi=lane>>5; const int wid=__builtin_amdgcn_readfirstlane(tid>>6);
  const long ldq=a.ldq, ldkv=a.ldkv, ldo=a.ldo;
  const bf16*Qw=a.Qw0+(long)(wid*QBLK)*ldq;
  const bf16*Kh=a.Kh,*Vh=a.Vh;
  const unsigned lds0=(unsigned)(uintptr_t)shm;
  float*wsf=(float*)(shm+LDS_WS)+wid*64;
  const bf16*ksrc=Kh+(long)lane*ldkv+wid*8;
  const bf16*vsrc=Vh+(long)(16*(wid&3)+(lane>>2))*ldkv+(wid>>2)*32+(lane&3)*8;
  const unsigned kdst=lds0+LDS_K+wid*1024, vdst=lds0+LDS_V+wid*1024;
  const int cq=a.cq0+(wid>>1);
  const unsigned* msrc=a.msk+((long)a.cq0*64+wid*32)*2+lane;
  const unsigned mdst=lds0+LDS_MSK+wid*256;
  const __attribute__((address_space(3))) float* tab=(const __attribute__((address_space(3))) float*)(__attribute__((address_space(3))) char*)(shm+LDS_TAB);
  if(MODE==0){ __attribute__((address_space(3))) float* tw=(__attribute__((address_space(3))) float*)(__attribute__((address_space(3))) char*)(shm+LDS_TAB);
    for(int i=tid;i<384;i+=512) tw[i]=((const __attribute__((address_space(1))) float*)a.relb)[i<319?i:319]*1.4426950408889634f; }
  #define DMA_K(t,slot) glds16(ksrc+(long)(t)*KVBLK*ldkv,(unsigned)__builtin_amdgcn_readfirstlane(kdst+(slot)))
  #define DMA_V(t,slot) glds16(vsrc+(long)(t)*KVBLK*ldkv,(unsigned)__builtin_amdgcn_readfirstlane(vdst+(slot)))
  #define DMA_M(t) do{ if(MODE==1) glds4(msrc+(long)(a.tabs0+(t))*8192,(unsigned)__builtin_amdgcn_readfirstlane(mdst+(((t)&3)*2048))); }while(0)
  const int vb0=(int)(lds0+LDS_V)+((lane>>4)&1)*32+(lane&3)*8+(4*hi+((lane&15)>>2))*64;
  const char*Kbase=shm+LDS_K; bf16x8 kf[8];
  const lds_cptr shm3=(lds_cptr)shm; const lds_cptr kp0=shm3+LDS_K+hi*1024+r32*16; const lds_cptr vp0=shm3+LDS_V+((lane>>4)&1)*32+(lane&3)*8+(4*hi+((lane&15)>>2))*64;
  const lds_cptr mp0=shm3+LDS_MSK+wid*256+(r32*2+hi)*4;
  const int NT=a.NT;
  DMA_K(0,0);DMA_V(0,0);DMA_K(1,SLOTB);DMA_M(0);DMA_M(1);
  bf16x8 qr[4];
  #pragma unroll
  for(int d0=0;d0<4;++d0)qr[d0]=*(const __attribute__((address_space(1))) bf16x8*)(&Qw[(long)r32*ldq+d0*16+hi*8]);
  float mhat=0.f,l_reg=0.f;f32x16 o[2];o[0]=f32x16{};o[1]=f32x16{};f32x16 negm=f32x16{};asm volatile("":"+v"(negm));
  const int qi=(wid&1)*32+r32;
  #define HOOK(P0,P1,tl) do{ const int ta_=a.tabs0+(tl); \
    if(MODE==0){ const int dch_=cq-ta_; \
      if(dch_<0||dch_>8){ _Pragma("unroll") for(int r=0;r<16;++r){P0[r]=-INFINITY;P1[r]=-INFINITY;} } \
      else if(dch_>=5){ const float c_=tab[319]; _Pragma("unroll") for(int r=0;r<16;++r){P0[r]+=c_;P1[r]+=c_;} } \
      else{ int ll_=lane; asm volatile("":"+v"(ll_)); const __attribute__((address_space(3))) float* tp_=tab+(64*dch_+(wid&1)*32+(ll_&31)+4-4*(ll_>>5)); _Pragma("unroll") for(int r=0;r<16;++r){ P0[r]+=tp_[59-((r&3)+8*(r>>2))]; P1[r]+=tp_[27-((r&3)+8*(r>>2))]; } } } \
    else if(MODE==1){ \
      if(ta_>cq){ _Pragma("unroll") for(int r=0;r<16;++r){P0[r]=-INFINITY;P1[r]=-INFINITY;} } \
      else if(!a.nomask){ const unsigned mw_=*(const __attribute__((address_space(3))) unsigned*)(mp0+(((tl)&3)*2048)); \
        _Pragma("unroll") for(int r=0;r<16;++r){ P0[r]=((int)(mw_<<(31-r))<0)?P0[r]:-INFINITY; P1[r]=((int)(mw_<<(15-r))<0)?P1[r]:-INFINITY; } } } \
    else if(MODE==3){ if(ta_>cq){ _Pragma("unroll") for(int r=0;r<16;++r){P0[r]=-INFINITY;P1[r]=-INFINITY;} } } \
  }while(0)
  bool resc=false;
  #define START(P0,P1) do{ const float rm=rowmax(P0,P1); resc=false; \
    { const float dl=(rm>-1e30f)?rm:0.f; mhat=fadd_s(mhat,dl); \
      _Pragma("unroll") for(int r=0;r<16;++r){P0[r]=fsub_s(P0[r],dl);P1[r]=fsub_s(P1[r],dl);} \
      _Pragma("unroll") for(int r=0;r<16;++r)negm[r]=-mhat; asm volatile("":"+v"(negm)); } \
    _Pragma("unroll") for(int r=0;r<16;++r)P0[r]=__builtin_amdgcn_exp2f(P0[r]); }while(0)
  #define RESC() do{ if(resc){ asm volatile("s_waitcnt lgkmcnt(0)":::"memory"); int hl_=lane>>5; asm volatile("":"+v"(hl_)); const float* wq_=(const float*)(shm+LDS_WS)+wid*64+4*hl_; \
      _Pragma("unroll") for(int d_=0;d_<2;++d_) _Pragma("unroll") for(int r=0;r<16;++r)o[d_][r]*=wq_[(r&3)+8*(r>>2)]; } }while(0)
  f32x16 pA0,pA1,pB0,pB1;
  int sl_prev=0,sl_cur=0,sl_next=SLOTB;
  #define ROT() do{sl_prev=sl_cur;sl_cur=sl_next;sl_next=(sl_next==(NSLOT-1)*SLOTB)?0:sl_next+SLOTB;}while(0)
  DMA_K(2,2*SLOTB);
  WAIT_BAR(0);
  qkt(pA0,pA1,Kbase,qr,negm,r32,hi);asm volatile("s_nop 15\n\ts_nop 7":"+v"(pA0),"+v"(pA1));HOOK(pA0,pA1,0);
  START(pA0,pA1);
  _Pragma("unroll") for(int r=0;r<16;++r)pA1[r]=__builtin_amdgcn_exp2f(pA1[r]);
  WAIT_BAR(0);
  DMA_K(3,0);DMA_V(1,SLOTB);DMA_M(2);
  ROT();
  kload8(kf,kp0+sl_cur);
  if(MODE==1){WAIT_BAR(3);}else{WAIT_BAR(2);}
  s16x4 vlo[8],vhi[8]; u32x4 pw0,pw1,pw2,pw3;
  #define PKW(P,B) cvtpk_s(P[B],P[B+1])
  #define PAF(k) __builtin_bit_cast(bf16x8,pw##k)
  #define VFR(i) (bf16x8){vlo[i][0],vlo[i][1],vlo[i][2],vlo[i][3],vhi[i][0],vhi[i][1],vhi[i][2],vhi[i][3]}
  #define PIN(x) asm volatile("":"+v"(x))
  #define MX3(a,b,c) __builtin_fmaxf(__builtin_fmaxf((a),(b)),(c))
  #define GAPA(MF,A0,A1,A2,A3,W0,W1,PW) do{ MF; sacc+=A0; sacc+=A1; sacc+=A2; sacc+=A3; PIN(sacc); W0; W1; PIN(PW); SBAR(); }while(0)
  #define EX(v) __builtin_amdgcn_exp2f(v)
  #define GAPB(MF,X,B) do{ MF; X[B]=EX(X[B]); X[B+1]=EX(X[B+1]); X[B+2]=EX(X[B+2]); X[B+3]=EX(X[B+3]); PIN(X); SBAR(); }while(0)
  #define VRD(i) do{ vlo[i]=vtr(vp_+(((i)>>2)*4096+((i)&3)*1024)); vhi[i]=vtr(vp_+(((i)>>2)*4096+((i)&3)*1024+512)); }while(0)
  #define KRD(G,j) do{ if(G){ kload2(kf,kp0+sl_next,j); SBAR(); } }while(0)
  #define STEP(C0,C1,P0,P1,t,GK,GV,GL,GM) do{ SBAR(); \
    const lds_cptr vp_=vp0+sl_prev; \
    VRD(0); SBAR(); float sacc=(P0[0]+P0[1]); \
    GAPA(C0=__builtin_amdgcn_mfma_f32_32x32x16_bf16(kf[0],qr[0],negm,0,0,0), P0[2],P0[3],P0[4],P0[5],     pw0[0]=PKW(P0,0), pw0[1]=PKW(P0,2), pw0); \
    VRD(4); SBAR(); GAPA(C1=__builtin_amdgcn_mfma_f32_32x32x16_bf16(kf[1],qr[0],negm,0,0,0), P0[6],P0[7],P0[8],P0[9],     pw0[2]=PKW(P0,4), pw0[3]=PKW(P0,6), pw0); \
    VRD(1); SBAR(); GAPA(C0=__builtin_amdgcn_mfma_f32_32x32x16_bf16(kf[2],qr[1],C0,0,0,0),   P0[10],P0[11],P0[12],P0[13], pw1[0]=PKW(P0,8), pw1[1]=PKW(P0,10), pw1); \
    VRD(5); SBAR(); GAPA(C1=__builtin_amdgcn_mfma_f32_32x32x16_bf16(kf[3],qr[1],C1,0,0,0),   P0[14],P0[15],P1[0],P1[1],   pw1[2]=PKW(P0,12),pw1[3]=PKW(P0,14), pw1); \
    VRD(2); SBAR(); GAPA(C0=__builtin_amdgcn_mfma_f32_32x32x16_bf16(kf[4],qr[2],C0,0,0,0),   P1[2],P1[3],P1[4],P1[5],     pw2[0]=PKW(P1,0), pw2[1]=PKW(P1,2), pw2); \
    VRD(6); SBAR(); GAPA(C1=__builtin_amdgcn_mfma_f32_32x32x16_bf16(kf[5],qr[2],C1,0,0,0),   P1[6],P1[7],P1[8],P1[9],     pw2[2]=PKW(P1,4), pw2[3]=PKW(P1,6), pw2); \
    VRD(3); SBAR(); GAPA(C0=__builtin_amdgcn_mfma_f32_32x32x16_bf16(kf[6],qr[3],C0,0,0,0),   P1[10],P1[11],P1[12],P1[13], pw3[0]=PKW(P1,8), pw3[1]=PKW(P1,10), pw3); \
    VRD(7); SBAR(); GAPA(C1=__builtin_amdgcn_mfma_f32_32x32x16_bf16(kf[7],qr[3],C1,0,0,0),   P1[14],P1[15],0.f,0.f,       pw3[2]=PKW(P1,12),pw3[3]=PKW(P1,14), pw3); \
    l_reg+=sacc; \
    if(GK){DMA_K((t)+3,sl_cur);} if(GV){DMA_V((t)+1,sl_next);} if(GM){DMA_M((t)+2);} \
    HOOK(C0,C1,t); \
    { float a_=MX3(C0[0],C0[1],C1[0]),b_=MX3(C0[2],C0[3],C1[1]); a_=MX3(a_,C1[2],C1[3]); \
      _Pragma("unroll") for(int r=4;r<16;r+=4){a_=MX3(a_,C0[r],C0[r+1]);b_=MX3(b_,C0[r+2],C0[r+3]);a_=MX3(a_,C1[r],C1[r+1]);b_=MX3(b_,C1[r+2],C1[r+3]);} \
      float rm=__builtin_fmaxf(a_,b_); { auto rr=__builtin_amdgcn_permlane32_swap(__float_as_uint(rm),__float_as_uint(rm),false,false); rm=__builtin_fmaxf(__uint_as_float(rr[0]),__uint_as_float(rr[1])); } \
      resc=false; \
      if(__builtin_expect(__any(rm>(float)THRL),0)){ const float dl=__builtin_fmaxf(rm,0.f); mhat+=dl; \
        _Pragma("unroll") for(int r=0;r<16;++r){C0[r]-=dl;C1[r]-=dl;} \
        _Pragma("unroll") for(int r=0;r<16;++r)negm[r]=-mhat; asm volatile("":"+v"(negm)); \
        const float f=__builtin_amdgcn_exp2f(-dl); l_reg*=f; { int rl_=lane; asm volatile("":"+v"(rl_)); if(rl_<32)((float*)(shm+LDS_WS))[wid*64+rl_]=f; } resc=true; } } \
    SBAR(); \
    GAPB(o[0]=__builtin_amdgcn_mfma_f32_32x32x16_bf16(PAF(0),VFR(0),o[0],0,0,0), C0,0); \
    GAPB(o[1]=__builtin_amdgcn_mfma_f32_32x32x16_bf16(PAF(0),VFR(4),o[1],0,0,0), C0,4); \
    KRD(GL,0); GAPB(o[0]=__builtin_amdgcn_mfma_f32_32x32x16_bf16(PAF(1),VFR(1),o[0],0,0,0), C0,8); \
    KRD(GL,1); GAPB(o[1]=__builtin_amdgcn_mfma_f32_32x32x16_bf16(PAF(1),VFR(5),o[1],0,0,0), C0,12); \
    KRD(GL,2); GAPB(o[0]=__builtin_amdgcn_mfma_f32_32x32x16_bf16(PAF(2),VFR(2),o[0],0,0,0), C1,0); \
    KRD(GL,3); GAPB(o[1]=__builtin_amdgcn_mfma_f32_32x32x16_bf16(PAF(2),VFR(6),o[1],0,0,0), C1,4); \
    GAPB(o[0]=__builtin_amdgcn_mfma_f32_32x32x16_bf16(PAF(3),VFR(3),o[0],0,0,0), C1,8); \
    GAPB(o[1]=__builtin_amdgcn_mfma_f32_32x32x16_bf16(PAF(3),VFR(7),o[1],0,0,0), C1,12); \
    }while(0)
  #define WSTD() do{ if(MODE==1){WAIT_BAR(3);}else{WAIT_BAR(2);} }while(0)
  #define ENDW(tt) do{ if((tt)+3<NT){WSTD();} else if((tt)+2<NT){ if(MODE==1){WAIT_BAR(2);}else{WAIT_BAR(1);} } else {WAIT_BAR(0);} }while(0)
  int t=1;
  for(;t+5<NT;t+=2){
    STEP(pB0,pB1,pA0,pA1,t,true,true,true,true);     WSTD(); RESC(); ROT();
    STEP(pA0,pA1,pB0,pB1,t+1,true,true,true,true);   WSTD(); RESC(); ROT();
  }
  for(;t+1<NT;t+=2){
    STEP(pB0,pB1,pA0,pA1,t,(t+3<NT),(t+1<NT),(t+1<NT),(t+2<NT));       ENDW(t);   RESC(); ROT();
    STEP(pA0,pA1,pB0,pB1,t+1,(t+4<NT),(t+2<NT),(t+2<NT),(t+3<NT));     ENDW(t+1); RESC(); ROT();
  }
  STEP(pB0,pB1,pA0,pA1,NT-1,false,false,false,false); RESC();
  { float sacc=pB0[0]+pB0[1]; _Pragma("unroll") for(int r=2;r<16;++r)sacc+=pB0[r]; _Pragma("unroll") for(int r=0;r<16;++r)sacc+=pB1[r]; l_reg+=sacc;
    pw0=(u32x4){PKW(pB0,0),PKW(pB0,2),PKW(pB0,4),PKW(pB0,6)};pw1=(u32x4){PKW(pB0,8),PKW(pB0,10),PKW(pB0,12),PKW(pB0,14)};pw2=(u32x4){PKW(pB1,0),PKW(pB1,2),PKW(pB1,4),PKW(pB1,6)};pw3=(u32x4){PKW(pB1,8),PKW(pB1,10),PKW(pB1,12),PKW(pB1,14)};
    SBAR(); pv(o,vb0+sl_cur,PAF(0),PAF(1),PAF(2),PAF(3)); }
  #undef PKW
  #undef PAF
  #undef VFR
  #undef PIN
  #undef MX3
  #undef GAPA
  #undef GAPB
  #undef EX
  #undef VRD
  #undef KRD
  #undef STEP
  #undef ENDW
  #undef WSTD
  {auto rr=__builtin_amdgcn_permlane32_swap(__float_as_uint(l_reg),__float_as_uint(l_reg),false,false);l_reg=__uint_as_float(rr[0])+__uint_as_float(rr[1]);}
  if(hi==0)wsf[32+r32]=l_reg;asm volatile("s_waitcnt lgkmcnt(0)":::"memory");
  float rli[16];
  #pragma unroll
  for(int r=0;r<16;++r)rli[r]=__builtin_amdgcn_rcpf(wsf[32+crow(r,hi)]);
  bf16*Ow=a.Ow0+(long)(wid*QBLK)*ldo;
  { bf16*stg=(bf16*)(shm+LDS_OST)+wid*2048;
    #pragma unroll
    for(int r=0;r<16;++r){const int orow=crow(r,hi);
      #pragma unroll
      for(int d0=0;d0<2;++d0)stg[orow*64+d0*32+r32]=__float2bfloat16(o[d0][r]*rli[r]);}
    asm volatile("s_waitcnt lgkmcnt(0)":::"memory");
    #pragma unroll
    for(int i=0;i<4;++i){const int row=i*8+(lane>>3),ch=lane&7; const u32x4 v=*(const u32x4*)(stg+row*64+ch*8); ATTN_STORE16(Ow+(long)row*ldo+ch*8,v);} }
  asm volatile("s_waitcnt lgkmcnt(0)\n\ts_barrier":::"memory");
  #undef DMA_K
  #undef DMA_V
  #undef DMA_M
  #undef HOOK
  #undef START
  #undef RESC
  #undef ROT
}

struct UB { const bf16* Q; const bf16* K; const bf16* V; bf16* O;
  int qt;
  const float* subln; float lam, oscale; };
constexpr int B_SLOT=16384, B_LDS_K=0, B_LDS_V=3*B_SLOT, B_LDS_WS=6*B_SLOT, B_XROW=132;
template<int THRL> __device__ __forceinline__ void attn_unit_b2(const UB& a,char*shm,int tid_in){
  int tid_l=tid_in; asm volatile("":"+v"(tid_l));
  const int tid=tid_l,lane=tid&63,r32=lane&31,hi=lane>>5; const int wid=__builtin_amdgcn_readfirstlane(tid>>6);
  const int c=wid>>2, wq=wid&3;
  const int q0=128*a.qt;
  const int NT=(2*a.qt+2<4)?4:2*a.qt+2;
  const int cq=2*a.qt+(wq>>1);
  const bf16*Qw=a.Q+(long)(q0+32*wq)*512+c*64;
  const unsigned lds0=(unsigned)(uintptr_t)shm;
  float*wsf=(float*)(shm+B_LDS_WS)+wid*64;
  const bf16*ksrc=a.K+(long)lane*512+wid*8;
  const bf16*vsrc=a.V+(long)(16*(wid&3)+(lane>>2))*512+(wid>>2)*32+(lane&3)*8;
  const unsigned kdst=lds0+B_LDS_K+wid*1024, vdst=lds0+B_LDS_V+wid*1024;
  #define DMA_K(t,slot) do{ glds16(ksrc+(long)(t)*KVBLK*512,(unsigned)__builtin_amdgcn_readfirstlane(kdst+(slot))); glds16(ksrc+(long)(t)*KVBLK*512+64,(unsigned)__builtin_amdgcn_readfirstlane(kdst+(slot)+8192u)); }while(0)
  #define DMA_V(t,slot) do{ glds16(vsrc+(long)(t)*KVBLK*512,(unsigned)__builtin_amdgcn_readfirstlane(vdst+(slot))); glds16(vsrc+(long)(t)*KVBLK*512+64,(unsigned)__builtin_amdgcn_readfirstlane(vdst+(slot)+8192u)); }while(0)
  const int vb0=(int)(lds0+B_LDS_V)+((lane>>4)&1)*32+(lane&3)*8+(4*hi+((lane&15)>>2))*64;
  const char*Kbase=shm+B_LDS_K+c*8192; bf16x8 kf[8];
  const lds_cptr shm3=(lds_cptr)shm; const lds_cptr kp0=shm3+B_LDS_K+c*8192+hi*1024+r32*16; const lds_cptr vp0=shm3+B_LDS_V+((lane>>4)&1)*32+(lane&3)*8+(4*hi+((lane&15)>>2))*64;
  DMA_K(0,0);DMA_V(0,0);DMA_K(1,B_SLOT);
  bf16x8 qr[4];
  #pragma unroll
  for(int d0=0;d0<4;++d0)qr[d0]=*(const __attribute__((address_space(1))) bf16x8*)(&Qw[(long)r32*512+d0*16+hi*8]);
  float mhat=0.f,l_reg=0.f;f32x16 o[4];o[0]=f32x16{};o[1]=f32x16{};o[2]=f32x16{};o[3]=f32x16{};f32x16 negm=f32x16{};asm volatile("":"+v"(negm));
  #define HOOK(P0,P1,tl) do{ if((tl)>cq){ _Pragma("unroll") for(int r=0;r<16;++r){P0[r]=-INFINITY;P1[r]=-INFINITY;} } }while(0)
  bool resc=false;
  #define START(P0,P1) do{ const float rm=rowmax(P0,P1); resc=false; \
    { const float dl=(rm>-1e30f)?rm:0.f; mhat=fadd_s(mhat,dl); \
      _Pragma("unroll") for(int r=0;r<16;++r){P0[r]=fsub_s(P0[r],dl);P1[r]=fsub_s(P1[r],dl);} \
      _Pragma("unroll") for(int r=0;r<16;++r)negm[r]=-mhat; asm volatile("":"+v"(negm)); } \
    _Pragma("unroll") for(int r=0;r<16;++r)P0[r]=__builtin_amdgcn_exp2f(P0[r]); }while(0)
  #define RESC() do{ if(resc){ asm volatile("s_waitcnt lgkmcnt(0)":::"memory"); int hl_=lane>>5; asm volatile("":"+v"(hl_)); const float* wq_=(const float*)(shm+B_LDS_WS)+wid*64+4*hl_; \
      _Pragma("unroll") for(int d_=0;d_<4;++d_) _Pragma("unroll") for(int r=0;r<16;++r)o[d_][r]*=wq_[(r&3)+8*(r>>2)]; } }while(0)
  f32x16 pA0,pA1,pB0,pB1;
  int sl_prev=0,sl_cur=0,sl_next=B_SLOT;
  #define ROT() do{sl_prev=sl_cur;sl_cur=sl_next;sl_next=(sl_next==2*B_SLOT)?0:sl_next+B_SLOT;}while(0)
  DMA_K(2,2*B_SLOT);
  WAIT_BAR(0);
  qkt(pA0,pA1,Kbase,qr,negm,r32,hi);asm volatile("s_nop 15\n\ts_nop 7":"+v"(pA0),"+v"(pA1));HOOK(pA0,pA1,0);
  START(pA0,pA1);
  _Pragma("unroll") for(int r=0;r<16;++r)pA1[r]=__builtin_amdgcn_exp2f(pA1[r]);
  WAIT_BAR(0);
  DMA_K(3,0);DMA_V(1,B_SLOT);
  ROT();
  kload8(kf,kp0+sl_cur);
  WAIT_BAR(4);
  s16x4 valo,vahi,vblo,vbhi; u32x4 pw0,pw1,pw2,pw3;
  #define PKW(P,B) cvtpk_s(P[B],P[B+1])
  #define PAF(k) __builtin_bit_cast(bf16x8,pw##k)
  #define PIN(x) asm volatile("":"+v"(x))
  #define MX3(a,b,c) __builtin_fmaxf(__builtin_fmaxf((a),(b)),(c))
  #define GAPA(MF,A0,A1,A2,A3,W0,W1,PW) do{ MF; sacc+=A0; sacc+=A1; sacc+=A2; sacc+=A3; PIN(sacc); W0; W1; PIN(PW); SBAR(); }while(0)
  #define EX(v) __builtin_amdgcn_exp2f(v)
  #define VOFF(m) (((((m)&3)>>1)*8192)+((((m)&3)&1)*4+((m)>>2))*1024)
  #define VLDA(m) do{ valo=vtr(vp_+VOFF(m)); vahi=vtr(vp_+VOFF(m)+512); }while(0)
  #define VLDB(m) do{ vblo=vtr(vp_+VOFF(m)); vbhi=vtr(vp_+VOFF(m)+512); }while(0)
  #define VFA (bf16x8){valo[0],valo[1],valo[2],valo[3],vahi[0],vahi[1],vahi[2],vahi[3]}
  #define VFB (bf16x8){vblo[0],vblo[1],vblo[2],vblo[3],vbhi[0],vbhi[1],vbhi[2],vbhi[3]}
  #define GAPB2(MF,X,B) do{ MF; X[B]=EX(X[B]); X[B+1]=EX(X[B+1]); PIN(X); SBAR(); }while(0)
  #define KRD(G,j) do{ if(G){ kload2(kf,kp0+sl_next,j); SBAR(); } }while(0)
  #define PVE(m,PA,X,B) do{ VLDB((m)+1); SBAR(); GAPB2(o[(m)&3]=__builtin_amdgcn_mfma_f32_32x32x16_bf16(PA,VFA,o[(m)&3],0,0,0),X,B); }while(0)
  #define PVO(m,PA,X,B,LAST) do{ if(!(LAST)){VLDA((m)+1);} SBAR(); GAPB2(o[(m)&3]=__builtin_amdgcn_mfma_f32_32x32x16_bf16(PA,VFB,o[(m)&3],0,0,0),X,B); }while(0)
  #define STEP(C0,C1,P0,P1,t,GK,GV,GL) do{ SBAR(); \
    const lds_cptr vp_=vp0+sl_prev; \
    float sacc=(P0[0]+P0[1]); \
    GAPA(C0=__builtin_amdgcn_mfma_f32_32x32x16_bf16(kf[0],qr[0],negm,0,0,0), P0[2],P0[3],P0[4],P0[5],     pw0[0]=PKW(P0,0), pw0[1]=PKW(P0,2), pw0); \
    GAPA(C1=__builtin_amdgcn_mfma_f32_32x32x16_bf16(kf[1],qr[0],negm,0,0,0), P0[6],P0[7],P0[8],P0[9],     pw0[2]=PKW(P0,4), pw0[3]=PKW(P0,6), pw0); \
    GAPA(C0=__builtin_amdgcn_mfma_f32_32x32x16_bf16(kf[2],qr[1],C0,0,0,0),   P0[10],P0[11],P0[12],P0[13], pw1[0]=PKW(P0,8), pw1[1]=PKW(P0,10), pw1); \
    GAPA(C1=__builtin_amdgcn_mfma_f32_32x32x16_bf16(kf[3],qr[1],C1,0,0,0),   P0[14],P0[15],P1[0],P1[1],   pw1[2]=PKW(P0,12),pw1[3]=PKW(P0,14), pw1); \
    GAPA(C0=__builtin_amdgcn_mfma_f32_32x32x16_bf16(kf[4],qr[2],C0,0,0,0),   P1[2],P1[3],P1[4],P1[5],     pw2[0]=PKW(P1,0), pw2[1]=PKW(P1,2), pw2); \
    GAPA(C1=__builtin_amdgcn_mfma_f32_32x32x16_bf16(kf[5],qr[2],C1,0,0,0),   P1[6],P1[7],P1[8],P1[9],     pw2[2]=PKW(P1,4), pw2[3]=PKW(P1,6), pw2); \
    GAPA(C0=__builtin_amdgcn_mfma_f32_32x32x16_bf16(kf[6],qr[3],C0,0,0,0),   P1[10],P1[11],P1[12],P1[13], pw3[0]=PKW(P1,8), pw3[1]=PKW(P1,10), pw3); \
    VLDA(0); SBAR(); \
    GAPA(C1=__builtin_amdgcn_mfma_f32_32x32x16_bf16(kf[7],qr[3],C1,0,0,0),   P1[14],P1[15],0.f,0.f,       pw3[2]=PKW(P1,12),pw3[3]=PKW(P1,14), pw3); \
    l_reg+=sacc; \
    if(GK){DMA_K((t)+3,sl_cur);} if(GV){DMA_V((t)+1,sl_next);} \
    HOOK(C0,C1,t); \
    { float a_=MX3(C0[0],C0[1],C1[0]),b_=MX3(C0[2],C0[3],C1[1]); a_=MX3(a_,C1[2],C1[3]); \
      _Pragma("unroll") for(int r=4;r<16;r+=4){a_=MX3(a_,C0[r],C0[r+1]);b_=MX3(b_,C0[r+2],C0[r+3]);a_=MX3(a_,C1[r],C1[r+1]);b_=MX3(b_,C1[r+2],C1[r+3]);} \
      float rm=__builtin_fmaxf(a_,b_); { auto rr=__builtin_amdgcn_permlane32_swap(__float_as_uint(rm),__float_as_uint(rm),false,false); rm=__builtin_fmaxf(__uint_as_float(rr[0]),__uint_as_float(rr[1])); } \
      resc=false; \
      if(__builtin_expect(__any(rm>(float)THRL),0)){ const float dl=__builtin_fmaxf(rm,0.f); mhat+=dl; \
        _Pragma("unroll") for(int r=0;r<16;++r){C0[r]-=dl;C1[r]-=dl;} \
        _Pragma("unroll") for(int r=0;r<16;++r)negm[r]=-mhat; asm volatile("":"+v"(negm)); \
        const float f=__builtin_amdgcn_exp2f(-dl); l_reg*=f; { int rl_=lane; asm volatile("":"+v"(rl_)); if(rl_<32)((float*)(shm+B_LDS_WS))[wid*64+rl_]=f; } resc=true; } } \
    SBAR(); \
    PVE(0,PAF(0),C0,0);  PVO(1,PAF(0),C0,2,false);  PVE(2,PAF(0),C0,4);  PVO(3,PAF(0),C0,6,false); \
    KRD(GL,0); PVE(4,PAF(1),C0,8);  PVO(5,PAF(1),C0,10,false); KRD(GL,1); PVE(6,PAF(1),C0,12); PVO(7,PAF(1),C0,14,false); \
    KRD(GL,2); PVE(8,PAF(2),C1,0);  PVO(9,PAF(2),C1,2,false);  KRD(GL,3); PVE(10,PAF(2),C1,4); PVO(11,PAF(2),C1,6,false); \
    PVE(12,PAF(3),C1,8); PVO(13,PAF(3),C1,10,false); PVE(14,PAF(3),C1,12); PVO(15,PAF(3),C1,14,true); \
    }while(0)
  #define ENDW(tt) do{ if((tt)+3<NT){WAIT_BAR(4);} else if((tt)+2<NT){WAIT_BAR(2);} else {WAIT_BAR(0);} }while(0)
  int t=1;
  for(;t+5<NT;t+=2){
    STEP(pB0,pB1,pA0,pA1,t,true,true,true);     WAIT_BAR(4); RESC(); ROT();
    STEP(pA0,pA1,pB0,pB1,t+1,true,true,true);   WAIT_BAR(4); RESC(); ROT();
  }
  for(;t+1<NT;t+=2){
    STEP(pB0,pB1,pA0,pA1,t,(t+3<NT),(t+1<NT),(t+1<NT));       ENDW(t);   RESC(); ROT();
    STEP(pA0,pA1,pB0,pB1,t+1,(t+4<NT),(t+2<NT),(t+2<NT));     ENDW(t+1); RESC(); ROT();
  }
  STEP(pB0,pB1,pA0,pA1,NT-1,false,false,false); RESC();
  { float sacc=pB0[0]+pB0[1]; _Pragma("unroll") for(int r=2;r<16;++r)sacc+=pB0[r]; _Pragma("unroll") for(int r=0;r<16;++r)sacc+=pB1[r]; l_reg+=sacc;
    pw0=(u32x4){PKW(pB0,0),PKW(pB0,2),PKW(pB0,4),PKW(pB0,6)};pw1=(u32x4){PKW(pB0,8),PKW(pB0,10),PKW(pB0,12),PKW(pB0,14)};pw2=(u32x4){PKW(pB1,0),PKW(pB1,2),PKW(pB1,4),PKW(pB1,6)};pw3=(u32x4){PKW(pB1,8),PKW(pB1,10),PKW(pB1,12),PKW(pB1,14)};
    SBAR(); pv(o,vb0+sl_cur,PAF(0),PAF(1),PAF(2),PAF(3)); pv(o+2,vb0+sl_cur+8192,PAF(0),PAF(1),PAF(2),PAF(3)); }
  #undef PKW
  #undef PAF
  #undef PIN
  #undef MX3
  #undef GAPA
  #undef EX
  #undef VOFF
  #undef VLDA
  #undef VLDB
  #undef VFA
  #undef VFB
  #undef GAPB2
  #undef KRD
  #undef PVE
  #undef PVO
  #undef STEP
  #undef ENDW
  {auto rr=__builtin_amdgcn_permlane32_swap(__float_as_uint(l_reg),__float_as_uint(l_reg),false,false);l_reg=__uint_as_float(rr[0])+__uint_as_float(rr[1]);}
  if(hi==0)wsf[32+r32]=l_reg;asm volatile("s_waitcnt lgkmcnt(0)":::"memory");
  float rli[16];
  #pragma unroll
  for(int r=0;r<16;++r)rli[r]=__builtin_amdgcn_rcpf(wsf[32+crow(r,hi)]);
  asm volatile("s_waitcnt lgkmcnt(0)\n\ts_barrier":::"memory");
  float*xw=(float*)shm+(long)wq*32*B_XROW;
  if(c==1){
    #pragma unroll
    for(int r=0;r<16;++r){const int row=crow(r,hi);
      #pragma unroll
      for(int d=0;d<4;++d)xw[row*B_XROW+32*d+r32]=o[d][r]*rli[r];}
  }
  asm volatile("s_waitcnt lgkmcnt(0)\n\ts_barrier":::"memory");
  if(c==0){
    #pragma unroll
    for(int r=0;r<16;++r){const int row=crow(r,hi);
      #pragma unroll
      for(int d=0;d<4;++d){float*p=xw+row*B_XROW+32*d+r32; *p=o[d][r]*rli[r]-a.lam*(*p);} }
    asm volatile("s_waitcnt lgkmcnt(0)":::"memory");
    const int row=lane>>1, hf=lane&1; const float*rp=xw+row*B_XROW+64*hf;
    f32x4v dv[16]; float ss=0.f;
    #pragma unroll
    for(int j=0;j<16;++j){dv[j]=*(const f32x4v*)(rp+4*j); ss+=(dv[j][0]*dv[j][0]+dv[j][1]*dv[j][1])+(dv[j][2]*dv[j][2]+dv[j][3]*dv[j][3]);}
    ss+=__shfl_xor(ss,1);
    const float rs=1.0f/sqrtf(ss*(1.0f/128.0f)+1e-6f);
    bf16*orow=a.O+(long)(q0+32*wq+row)*512+64*hf;
    #pragma unroll
    for(int j=0;j<8;++j){
      u32x4 w; w.x=cvtpk_s(dv[2*j][0]*rs,dv[2*j][1]*rs); w.y=cvtpk_s(dv[2*j][2]*rs,dv[2*j][3]*rs); w.z=cvtpk_s(dv[2*j+1][0]*rs,dv[2*j+1][1]*rs); w.w=cvtpk_s(dv[2*j+1][2]*rs,dv[2*j+1][3]*rs);
      ATTN_STORE16(orow+8*j,w); }
  }
  asm volatile("s_waitcnt lgkmcnt(0)\n\ts_barrier":::"memory");
  #undef DMA_K
  #undef DMA_V
  #undef HOOK
  #undef START
  #undef RESC
  #undef ROT
}
#undef SBAR
#undef WAIT_BAR
}

constexpr int NWAVES = 8;
constexpr int NB = 16, SEQ = 4096, DM = 1024, DEPTH = 4, R = NB * SEQ;
constexpr int GB = 8, RG = GB * SEQ, NGRP = NB / GB;
constexpr int NIN = 8004, NINP = 8192, DFF = 2816, MEMLEN = 256;
constexpr float RMS_EPS = 1e-6f;
constexpr float QSCALE = 0.125f * 1.4426950408889634f;
constexpr size_t MiB = 1u << 20;
constexpr size_t WS_CTL = 0, CTL_ZERO_BYTES = 1 * MiB;
constexpr size_t WS_ROPE = 1 * MiB;
constexpr size_t WS_SCAL = 2 * MiB;
constexpr size_t WS_WKV = 3 * MiB;
constexpr size_t WS_MN = 7 * MiB;
constexpr size_t WS_KVX = 15 * MiB;
constexpr size_t WS_WL = 32 * MiB;
constexpr size_t WL_WIN = 0, WL_WUP = 16 * MiB, WL_WOUT = 19 * MiB, WL_WQX = 21 * MiB, WL_WOX = 21 * MiB + 512 * 1024, WL_WGU = 22 * MiB, WL_WDN = 33 * MiB;
constexpr size_t WS_XN = 72 * MiB;
constexpr size_t WS_MIX = 200 * MiB;
constexpr size_t WS_QKV = WS_MIX;
constexpr size_t QKV_STRIDE = (size_t)RG * 512;
constexpr size_t WS_QI = WS_MIX + 288 * MiB, WS_KI = WS_MIX + 304 * MiB;
constexpr size_t WS_GATES = WS_MIX + 320 * MiB;
constexpr size_t WS_Y = WS_MIX + 512 * MiB;
constexpr size_t WS_MASK = WS_MIX + 576 * MiB;
constexpr size_t WS_H = WS_MIX;
constexpr size_t WS_QX = WS_MIX + 400 * MiB;
constexpr size_t WS_OBUF = WS_MIX + 592 * MiB;
constexpr size_t WS_SS = WS_MIX + 688 * MiB;
constexpr size_t WS_XS = WS_MIX + 692 * MiB;
constexpr size_t WS_END = WS_MIX + 820 * MiB;
static_assert(WS_WL + WL_WDN + (size_t)1024 * DFF * 2 <= WS_XN && WS_XN + (size_t)R * DM * 2 <= WS_MIX && WS_H + (size_t)R * DFF * 2 <= WS_QX && WS_MASK + (size_t)GB * 64 * 4096 * 8 <= WS_OBUF && WS_OBUF + 3 * (size_t)RG * 512 * 2 <= WS_SS && WS_SS + (size_t)R * 64 <= WS_XS && WS_XS + (size_t)256 * 524288 <= WS_END && WS_END <= 1024 * MiB, "d_ws map");
constexpr int CW_BAR = 4096, CW_QUEUE = 8192;
constexpr int RING_BYTES = 131072, XRES_OFF = 131072, LDSCTL_OFF = 132096, LDS_BYTES = 155648;

#define GAS __attribute__((address_space(1)))
#define LAS __attribute__((address_space(3)))
typedef unsigned short bf16;
typedef unsigned v4u __attribute__((ext_vector_type(4)));
typedef float f32x4 __attribute__((ext_vector_type(4)));
typedef GAS unsigned gu32;
#define RLX_AGENT __ATOMIC_RELAXED, __HIP_MEMORY_SCOPE_AGENT
#define LDS_WAIT() asm volatile("s_waitcnt lgkmcnt(0)" ::: "memory")
__device__ __forceinline__ unsigned f2bf(float f) { unsigned u = __builtin_bit_cast(unsigned, f); return (u + 0x7fffu + ((u >> 16) & 1u)) >> 16; }
__device__ __forceinline__ unsigned pk2(float lo, float hi) { return f2bf(lo) | (f2bf(hi) << 16); }
#define XB_TMO      128
#define XB_XCNT(j)  (256  + 64 * (j))
#define XB_XSUB(j)  (1280 + 64 * (j))
#define XB_XGEN(j)  (2304 + 64 * (j))
#define XB_TOP      3328
#define XB_TOPGEN   3392
#define XCD_BAR_WORDS 3456
#define XB_SPIN_CAP (1u << 18)

__device__ __forceinline__ unsigned xb_ld(unsigned* p)              { return __hip_atomic_load(p, __ATOMIC_RELAXED, __HIP_MEMORY_SCOPE_AGENT); }
__device__ __forceinline__ unsigned xb_add(unsigned* p, unsigned v) { asm volatile("" : "+v"(v)); return __hip_atomic_fetch_add(p, v, __ATOMIC_RELAXED, __HIP_MEMORY_SCOPE_AGENT); }
__device__ __forceinline__ unsigned xb_xcc_id() { return (unsigned)__builtin_amdgcn_s_getreg((3 << 11) | 20) & 0xFu; }
#define XB_SPIN(cond, bar) do { unsigned _sp = 0; while (cond) { __builtin_amdgcn_s_sleep(1); \
    if ((++_sp & 255u) == 0u) { if (xb_ld(&(bar)[XB_TMO])) break; if (_sp > XB_SPIN_CAP) { atomicAdd(&(bar)[XB_TMO], 1u); break; } } } } while (0)

struct XcdBarrier {
    unsigned* bar; unsigned x;
    volatile LAS unsigned* st;
};

__device__ __forceinline__ XcdBarrier xcd_barrier_post(unsigned* bar, volatile LAS unsigned* st) {
    XcdBarrier b; b.bar = bar; b.x = xb_xcc_id(); b.st = st;
    if (threadIdx.x == 0) (void)xb_add(&bar[XB_XCNT(b.x)], 1u);
    return b;
}
__device__ __forceinline__ void xcd_barrier_complete(unsigned* bar, unsigned x, unsigned& nloc, unsigned& nx) {
    const unsigned G = gridDim.x * gridDim.y * gridDim.z; asm volatile("" : "+s"(x));
    unsigned sum, cnt, mine, sp = 0u;
    for (;;) {
        sum = 0u; cnt = 0u; mine = 0u;
#pragma unroll
        for (unsigned j = 0; j < 16; ++j) { const unsigned c = xb_ld(&bar[XB_XCNT(j)]); sum += c; cnt += (c > 0u) ? 1u : 0u; mine = (j == x) ? c : mine; }
        if (sum == G) break;
        __builtin_amdgcn_s_sleep(1);
        if ((++sp & 255u) == 0u) { if (xb_ld(&bar[XB_TMO])) break; if (sp > XB_SPIN_CAP) { atomicAdd(&bar[XB_TMO], 1u); break; } }
    }
    nloc = mine > 0u ? mine : 1u; nx = cnt > 0u ? cnt : 1u;
}

__device__ __forceinline__ void xcd_barrier(const XcdBarrier& b, int tid_in) {
    asm volatile("s_waitcnt vmcnt(0)" ::: "memory");
    __syncthreads();
    if (tid_in == 0) {
        unsigned* bar = b.bar; asm volatile("" : "+s"(bar));
        __builtin_amdgcn_s_waitcnt(0);
        unsigned nloc = b.st[0], nx = b.st[1];
        if (nloc == 0u) { xcd_barrier_complete(bar, b.x, nloc, nx); b.st[0] = nloc; b.st[1] = nx; }
        const unsigned old = xb_add(&bar[XB_XSUB(b.x)], 1u);
        const unsigned gen = old / nloc;
        if (old + 1u == (gen + 1u) * nloc) {
            __builtin_amdgcn_fence(__ATOMIC_RELEASE, "agent");
            asm volatile("s_waitcnt vmcnt(0)" ::: "memory");
            const unsigned og = xb_add(&bar[XB_TOP], 1u);
            const unsigned tg = og / nx;
            if (og + 1u == (tg + 1u) * nx) xb_add(&bar[XB_TOPGEN], 1u);
            else XB_SPIN(xb_ld(&bar[XB_TOPGEN]) == tg, bar);
            __builtin_amdgcn_fence(__ATOMIC_ACQUIRE, "agent");
            xb_add(&bar[XB_XGEN(b.x)], 1u);
            asm volatile("s_waitcnt vmcnt(0)" ::: "memory");
        } else {
            XB_SPIN(xb_ld(&bar[XB_XGEN(b.x)]) == gen, bar);
            __builtin_amdgcn_fence(__ATOMIC_ACQUIRE, "agent");
            asm volatile("s_waitcnt vmcnt(0)" ::: "memory");
        }
    }
    __syncthreads();
}

__device__ __forceinline__ float wave_sum(float v) {
#pragma unroll
    for (int o = 1; o < 64; o <<= 1) v += __shfl_xor(v, o);
    return v;
}
__device__ __forceinline__ int rope_dim(int c64) { return 32 * ((c64 >> 2) & 1) + 4 * (c64 >> 3) + (c64 & 3); }
struct MapId { __device__ __forceinline__ int operator()(int n) const { return n; } };
struct MapWin { __device__ __forceinline__ int operator()(int n) const {
    if (n < 4608) { const int region = n >> 9; const bool rope = (region == 3 || region == 4 || region == 6 || region == 7); return rope ? (n & ~63) + rope_dim(n & 63) : n; }
    if (n < 4928) return (n & ~63) + rope_dim(n & 63);
    if (n < 4932) return n;
    if (n < 5120) return -1;
    return 4932 + (n - 5120); } };
struct MapGu { __device__ __forceinline__ int operator()(int n) const { return ((n >> 2) & 1) * DFF + 4 * (n >> 3) + (n & 3); } };
template <class Map> __device__ __forceinline__ void cvt_item(const float* W, int K, int Nsrc, bf16* WT, const float* gain, const Map& mp, LAS float* scr, int item, int nblk, int lane) {
    const int kb = item / nblk, nb = item % nblk, k0 = 64 * kb, n0 = 32 * nb;
    const int src = mp(n0 + (lane & 31));
    const int srcc = src >= 0 ? src : 0; const float keep = src >= 0 ? 1.f : 0.f;
    if (gain) {
#pragma unroll 16
        for (int i = 0; i < 32; ++i) { const int kk = 2 * i + (lane >> 5);
            scr[kk * 33 + (lane & 31)] = ((const GAS float*)W)[(size_t)(k0 + kk) * Nsrc + srcc] * ((const GAS float*)gain)[k0 + kk] * keep; }
    } else {
#pragma unroll 16
        for (int i = 0; i < 32; ++i) { const int kk = 2 * i + (lane >> 5);
            scr[kk * 33 + (lane & 31)] = ((const GAS float*)W)[(size_t)(k0 + kk) * Nsrc + srcc] * keep; }
    }
    LDS_WAIT(); asm volatile("" ::: "memory");
    const int c = lane & 7;
#pragma unroll
    for (int j = 0; j < 4; ++j) { const int n = (lane >> 3) + 8 * j; const LAS float* s = scr + (8 * c) * 33 + n;
        v4u o; o.x = pk2(s[0 * 33], s[1 * 33]); o.y = pk2(s[2 * 33], s[3 * 33]); o.z = pk2(s[4 * 33], s[5 * 33]); o.w = pk2(s[6 * 33], s[7 * 33]);
        *(GAS v4u*)(WT + (size_t)(n0 + n) * K + k0 + 8 * c) = o; }
    LDS_WAIT(); asm volatile("" ::: "memory");
}
__device__ __forceinline__ void rms_row_to_bf16(const float* xrow, bf16* orow, int lane) {
    const GAS f32x4* xr = (const GAS f32x4*)xrow + lane;
    f32x4 v[4]; float s = 0.f;
#pragma unroll
    for (int j = 0; j < 4; ++j) { v[j] = xr[64 * j]; s += (v[j].x * v[j].x + v[j].y * v[j].y) + (v[j].z * v[j].z + v[j].w * v[j].w); }
    float eps = RMS_EPS; asm volatile("" : "+v"(eps));
    const float rstd = 1.f / sqrtf(wave_sum(s) * (1.f / DM) + eps);
    GAS unsigned long long* o8 = (GAS unsigned long long*)orow + lane;
#pragma unroll
    for (int j = 0; j < 4; ++j) o8[64 * j] = (unsigned long long)pk2(v[j].x * rstd, v[j].y * rstd) | ((unsigned long long)pk2(v[j].z * rstd, v[j].w * rstd) << 32);
}
__device__ __forceinline__ void x_row_init(const float* xrow, bf16* orow, float* ssrow, int lane) {
    const GAS f32x4* xr = (const GAS f32x4*)xrow + lane;
    f32x4 v[4]; float s = 0.f;
#pragma unroll
    for (int j = 0; j < 4; ++j) { v[j] = xr[64 * j]; s += (v[j].x * v[j].x + v[j].y * v[j].y) + (v[j].z * v[j].z + v[j].w * v[j].w); }
    s = wave_sum(s);
    GAS unsigned long long* o8 = (GAS unsigned long long*)orow + lane;
#pragma unroll
    for (int j = 0; j < 4; ++j) o8[64 * j] = (unsigned long long)pk2(v[j].x, v[j].y) | ((unsigned long long)pk2(v[j].z, v[j].w) << 32);
    if (lane < 16) ((GAS float*)ssrow)[lane] = (lane == 0) ? s : 0.f;
}
__device__ __forceinline__ void rms_row_final(const bf16* xrow, float* orow, const float* gain, int lane) {
    const GAS v4u* xr = (const GAS v4u*)xrow + lane;
    float v[16]; float s = 0.f;
#pragma unroll
    for (int j = 0; j < 2; ++j) { const v4u b = xr[64 * j]; const unsigned bw[4] = {b.x, b.y, b.z, b.w};
#pragma unroll
        for (int i = 0; i < 4; ++i) { v[8 * j + 2 * i] = __uint_as_float(bw[i] << 16); v[8 * j + 2 * i + 1] = __uint_as_float(bw[i] & 0xffff0000u); } }
#pragma unroll
    for (int i = 0; i < 16; ++i) s += v[i] * v[i];
    const float rstd = 1.f / sqrtf(wave_sum(s) * (1.f / DM) + RMS_EPS);
#pragma unroll
    for (int j = 0; j < 2; ++j)
#pragma unroll
        for (int h = 0; h < 2; ++h) { const int c = 512 * j + 8 * lane + 4 * h; const f32x4 g = *(const GAS f32x4*)(gain + c);
            f32x4 o = {v[8 * j + 4 * h] * rstd * g.x, v[8 * j + 4 * h + 1] * rstd * g.y, v[8 * j + 4 * h + 2] * rstd * g.z, v[8 * j + 4 * h + 3] * rstd * g.w};
            *(GAS f32x4*)(orow + c) = o; }
}
__device__ __forceinline__ int fresh_tid(int wave_s) { int l; asm volatile("v_mbcnt_lo_u32_b32 %0, -1, 0\n\tv_mbcnt_hi_u32_b32 %0, -1, %0" : "=v"(l)); int w = wave_s; asm volatile("" : "+s"(w)); return (w << 6) | l; }
__device__ __forceinline__ unsigned wq_claim(gu32* ctr) {
    return __builtin_amdgcn_atomic_inc32((unsigned*)ctr, 0xffffffffu, __ATOMIC_RELAXED, "agent");
}
__device__ __forceinline__ int wq_next(gu32* ctr, volatile LAS unsigned* slot, int tid_in, unsigned& nxt, unsigned& par) {
    if (tid_in == 0) { slot[par] = nxt; nxt = wq_claim(ctr); }
    asm volatile("s_waitcnt lgkmcnt(0)" ::: "memory"); __builtin_amdgcn_s_barrier(); asm volatile("" ::: "memory");
    const int i = (int)slot[par]; par ^= 1u;
    return i;
}

__device__ __forceinline__ void diff_combine_row(const bf16* tb, bf16* ob, const float* subln, float lam, float oscale, int lane) {
    const int h = lane >> 4, d0 = (lane & 15) * 8;
    const v4u a = *(const GAS v4u*)(tb + (h * 2 + 0) * 128 + d0), c = *(const GAS v4u*)(tb + (h * 2 + 1) * 128 + d0);
    const unsigned aw[4] = {a.x, a.y, a.z, a.w}, cw[4] = {c.x, c.y, c.z, c.w};
    float d[8]; float ss = 0.f;
#pragma unroll
    for (int i = 0; i < 4; ++i) { d[2 * i] = __uint_as_float(aw[i] << 16) - lam * __uint_as_float(cw[i] << 16); d[2 * i + 1] = __uint_as_float(aw[i] & 0xffff0000u) - lam * __uint_as_float(cw[i] & 0xffff0000u);
        ss += d[2 * i] * d[2 * i] + d[2 * i + 1] * d[2 * i + 1]; }
    ss += __shfl_xor(ss, 1); ss += __shfl_xor(ss, 2); ss += __shfl_xor(ss, 4); ss += __shfl_xor(ss, 8);
    const float rs = (1.0f / sqrtf(ss * (1.0f / 128.0f) + RMS_EPS)) * oscale;
    const f32x4 g0 = *(const GAS f32x4*)(subln + d0), g1 = *(const GAS f32x4*)(subln + d0 + 4);
    v4u o; o.x = pk2(d[0] * rs * g0.x, d[1] * rs * g0.y); o.y = pk2(d[2] * rs * g0.z, d[3] * rs * g0.w); o.z = pk2(d[4] * rs * g1.x, d[5] * rs * g1.y); o.w = pk2(d[6] * rs * g1.z, d[7] * rs * g1.w);
    *(GAS v4u*)(ob + h * 128 + d0) = o;
}

#ifndef PROBE_CHECK
#define PROBE_CHECK 0
#endif
#if PROBE_CHECK
__device__ __forceinline__ void probe_check_query(const bf16* QI, const bf16* KI, const unsigned* MASKB, int qpos, int n, LAS float* qs, gu32* flag, int lane) {
#pragma unroll 1
    for (int i = lane; i < 256; i += 64) qs[i] = __uint_as_float((unsigned)QI[(size_t)qpos * 256 + i] << 16);
    float wv[4];
#pragma unroll
    for (int h = 0; h < 4; ++h) wv[h] = __uint_as_float((unsigned)KI[(size_t)qpos * 256 + 64 + h] << 16) * 0.0625f;
    LDS_WAIT();
    const int N = 64 * (n + 1);
    float smin = 3.0e38f, umax = -3.0e38f; int cnt = 0, selz_max = -1, unz_min = 1 << 30;
#pragma unroll 1
    for (int k = lane; k < N; k += 64) {
        float sc = 0.f;
#pragma unroll 1
        for (int h = 0; h < 4; ++h) { float l = 0.f;
#pragma unroll 2
            for (int d = 0; d < 64; ++d) l = __builtin_fmaf(qs[h * 64 + d], __uint_as_float((unsigned)KI[(size_t)k * 256 + d] << 16), l); sc += fmaxf(l, 0.f) * (h == 0 ? wv[0] : h == 1 ? wv[1] : h == 2 ? wv[2] : wv[3]); }
        const int t = k >> 6, sub = (k >> 5) & 1, wi = k & 31, hc = (wi >> 2) & 1, rr = (wi & 3) + 4 * (wi >> 3);
        const unsigned word = MASKB[((size_t)t * 4096 + qpos) * 2 + hc];
        const bool sel = (word >> (16 * sub + rr)) & 1u;
        if (sel) { ++cnt; smin = fminf(smin, sc); if (sc == 0.f) selz_max = max(selz_max, k); } else { umax = fmaxf(umax, sc); if (sc == 0.f) unz_min = min(unz_min, k); }
    }
#pragma unroll 1
    for (int o = 1; o < 64; o <<= 1) { smin = fminf(smin, __shfl_xor(smin, o)); umax = fmaxf(umax, __shfl_xor(umax, o)); cnt += __shfl_xor(cnt, o); selz_max = max(selz_max, __shfl_xor(selz_max, o)); unz_min = min(unz_min, __shfl_xor(unz_min, o)); }
    const int want = N < 256 ? N : 256;
    bool bad = (cnt != want);
    if (N > 256) { const float slack = 2e-3f * (fabsf(umax) + fabsf(smin)) + 1e-4f; if (smin < umax - slack) bad = true; if (smin == 0.f && umax == 0.f && selz_max > unz_min) bad = true; }
    if (bad && lane == 0) __hip_atomic_store(flag, 1u, RLX_AGENT);
}
#endif

#ifndef REP_L2
#define REP_L2 1
#endif
#ifndef REP_X
#define REP_X 1
#endif
#ifndef REP_PROJ
#define REP_PROJ 1
#endif
#ifndef REP_CVT
#define REP_CVT 1
#endif
#ifndef REP_GU
#define REP_GU 1
#endif
#ifndef REP_UP
#define REP_UP 1
#endif
#ifndef REP_B
#define REP_B 1
#endif
#ifndef REP_WOUT
#define REP_WOUT 1
#endif
#ifndef REP_OX
#define REP_OX 1
#endif
#ifndef REP_DOWN
#define REP_DOWN 1
#endif
#ifndef REP_A
#define REP_A 1
#endif
#ifndef REP_L3
#define REP_L3 1
#endif
struct Args { const float* in[20]; float* out; unsigned char* ws; int lo, hi; };
enum { I_X = 0, I_MEM, I_NORM_MIX, I_W_IN, I_REL_BIAS, I_LAMBDA, I_SUBLN, I_UP_A, I_UP_B, I_UP_C, I_W_OUT, I_NORM_CROSS, I_WQX, I_WKVX, I_WOX, I_NORM_FFN, I_WGU, I_WDOWN, I_MEM_NORM, I_FINAL_NORM };

__global__ void __launch_bounds__(NWAVES * 64, 2) hybrid_fwd(Args args) {
    extern __shared__ __attribute__((aligned(16))) unsigned char lds_raw[];
    LAS unsigned char* lds = (LAS unsigned char*)lds_raw;
    volatile LAS unsigned* MISC = (volatile LAS unsigned*)(lds + LDSCTL_OFF);
    for (int u = threadIdx.x; u < 64; u += NWAVES * 64) MISC[u] = 0u;
    __syncthreads();
    const int wave_s = __builtin_amdgcn_readfirstlane((int)threadIdx.x >> 6);
    XcdBarrier bar = xcd_barrier_post((unsigned*)((gu32*)(args.ws + WS_CTL) + CW_BAR), MISC + 8);
    volatile LAS unsigned* qslot = MISC + 16;

    int step = 0;
#define STEP_ON (step >= args.lo && step < args.hi)
#define STEP_END(need_bar) do { if ((need_bar) && step >= args.lo && step + 1 < args.hi) xcd_barrier(bar, fresh_tid(wave_s)); ++step; } while (0)
#define PH_ENTER unsigned char* ws = args.ws; int G = gridDim.x, bx = blockIdx.x, tid = fresh_tid(wave_s); asm volatile("" : "+s"(ws), "+s"(G), "+s"(bx), "+v"(tid)); \
    const int lane = tid & 63, wave = __builtin_amdgcn_readfirstlane(tid >> 6), gw = bx * NWAVES + wave, NGW = G * NWAVES; (void)lane; (void)gw; (void)NGW;
#define P_BF(off) ((bf16*)(ws + (off)))
#define P_Q(off) ((bf16*)(wsq + (off)))

    if (STEP_ON) { PH_ENTER
        float* rope = (float*)(ws + WS_ROPE); float* scal = (float*)(ws + WS_SCAL);
        LAS float* scr = (LAS float*)(lds + wave * 16384);
        for (int i = bx * (NWAVES * 64) + tid; i < SEQ * 32; i += G * NWAVES * 64) {
            const int pos = i >> 5, k = i & 31;
            const float inv = (float)pow(10000.0, -(double)(2 * k) / 64.0);
            const float ang = (float)pos * inv;
            rope[pos * 64 + k] = (float)cos((double)ang); rope[pos * 64 + 32 + k] = (float)sin((double)ang);
        }
        if (bx == 0 && wave < DEPTH) {
            const float* lv = args.in[I_LAMBDA] + wave * 4 * 64;
            const float sa = wave_sum(lv[lane] * lv[64 + lane]), sb = wave_sum(lv[128 + lane] * lv[192 + lane]);
            const float lam_init = 0.8f - 0.6f * expf(-0.3f * (float)wave);
            if (lane == 0) { scal[wave * 2] = expf(sa) - expf(sb) + lam_init; scal[wave * 2 + 1] = 1.0f - lam_init; }
        }
        { float* gb = (float*)(ws + WS_SCAL) + 1024;
          for (int i = bx * (NWAVES * 64) + tid; i < DEPTH * 512; i += G * NWAVES * 64) { const int l_ = i >> 9; gb[i] = args.in[I_SUBLN][l_ * 128 + (i & 127)] * (0.6f * expf(-0.3f * (float)l_) + 0.2f); } }
        for (int m = gw; m < NB * MEMLEN; m += NGW) rms_row_to_bf16(args.in[I_MEM] + (size_t)m * DM, P_BF(WS_MN) + (size_t)m * DM, lane);
        for (int it = gw; it < DEPTH * 16 * 16; it += NGW) { const int l = it >> 8;
            cvt_item(args.in[I_WKVX] + (size_t)l * DM * 512, DM, 512, P_BF(WS_WKV) + (size_t)l * 512 * DM, args.in[I_MEM_NORM], MapId(), scr, it & 255, 16, lane); }
    }
    STEP_END(true);
    if (STEP_ON) { PH_ENTER
        pg8::Gemm g{P_BF(WS_MN), P_BF(WS_WKV), NB * MEMLEN, DEPTH * 512, DM, 0}; pg8::StaticOrder S; S.init(NB * MEMLEN, DEPTH * 512, G, bx);
        pg8::EpiBf16S E{P_BF(WS_KVX), DEPTH * 512, 1.0f, nullptr, (LAS float*)(lds + 139264)};
        pg8::gemm_phase<pg8::EpiBf16S, pg8::StaticOrder, true, true>(lds, g, S, E, tid);
    }
    STEP_END(true);

#pragma unroll 1
    for (int l = 0; l < DEPTH; ++l) {
        if (STEP_ON) { PH_ENTER
            LAS float* scr = (LAS float*)(lds + wave * 16384);
            bf16* WL = P_BF(WS_WL);
            constexpr int I0 = 16 * 256, I1 = 8 * 32, I4 = 16 * 32, I5 = 16 * 8, I6 = 4 * 32, I7 = 16 * 176, I8 = 44 * 32;
            constexpr int NITEMS = I0 + 3 * I1 + I4 + I5 + I6 + I7 + I8;
#pragma unroll 1
            for (int rc = 0; rc < REP_CVT; ++rc)
            for (int it = gw; it < NITEMS; it += NGW) {
                int r = it;
                if (r < I0) { cvt_item(args.in[I_W_IN] + (size_t)l * DM * NIN, DM, NIN, WL + WL_WIN / 2, args.in[I_NORM_MIX] + l * DM, MapWin(), scr, r, 256, lane); continue; } r -= I0;
                if (r < I1) { cvt_item(args.in[I_UP_A] + (size_t)l * 512 * DM, 512, DM, WL + WL_WUP / 2, nullptr, MapId(), scr, r, 32, lane); continue; } r -= I1;
                if (r < I1) { cvt_item(args.in[I_UP_B] + (size_t)l * 512 * DM, 512, DM, WL + WL_WUP / 2 + (size_t)1024 * 512, (const float*)(ws + WS_SCAL) + 1024 + l * 512, MapId(), scr, r, 32, lane); continue; } r -= I1;
                if (r < I1) { cvt_item(args.in[I_UP_C] + (size_t)l * 512 * DM, 512, DM, WL + WL_WUP / 2 + (size_t)2048 * 512, nullptr, MapId(), scr, r, 32, lane); continue; } r -= I1;
                if (r < I4) { cvt_item(args.in[I_W_OUT] + (size_t)l * DM * DM, DM, DM, WL + WL_WOUT / 2, nullptr, MapId(), scr, r, 32, lane); continue; } r -= I4;
                if (r < I5) { cvt_item(args.in[I_WQX] + (size_t)l * DM * 256, DM, 256, WL + WL_WQX / 2, args.in[I_NORM_CROSS] + l * DM, MapId(), scr, r, 8, lane); continue; } r -= I5;
                if (r < I6) { cvt_item(args.in[I_WOX] + (size_t)l * 256 * DM, 256, DM, WL + WL_WOX / 2, nullptr, MapId(), scr, r, 32, lane); continue; } r -= I6;
                if (r < I7) { cvt_item(args.in[I_WGU] + (size_t)l * DM * 2 * DFF, DM, 2 * DFF, WL + WL_WGU / 2, args.in[I_NORM_FFN] + l * DM, MapGu(), scr, r, 176, lane); continue; } r -= I7;
                cvt_item(args.in[I_WDOWN] + (size_t)l * DFF * DM, DFF, DM, WL + WL_WDN / 2, nullptr, MapId(), scr, r, 32, lane);
            }
            if (l == 0) { for (int m = gw; m < R; m += NGW) x_row_init(args.in[I_X] + (size_t)m * DM, P_BF(WS_XN) + (size_t)m * DM, (float*)(ws + WS_SS) + (size_t)m * 16, lane); }
        }
        STEP_END(true);

#pragma unroll 1
        for (int grp = 0; grp < NGRP; ++grp) {
            if (STEP_ON) { PH_ENTER
                pg8::Gemm g{P_BF(WS_XN) + (size_t)grp * RG * DM, P_BF(WS_WL + WL_WIN), RG, NINP, DM, 0}; pg8::StaticOrder S; S.init(RG, NINP, G, bx);
                pg8::EpiProj E{P_BF(WS_QKV), P_BF(WS_QI), P_BF(WS_KI), P_BF(WS_GATES), (const float*)(ws + WS_ROPE), QSCALE, QKV_STRIDE, (const float*)(ws + WS_SS) + (size_t)grp * RG * 16, (LAS float*)(lds + 139264)};
#pragma unroll 1
                for (int rp = 0; rp < REP_PROJ; ++rp)
                pg8::gemm_phase<pg8::EpiProj, pg8::StaticOrder, true, true>(lds, g, S, E, tid);
            }
            STEP_END(true);
            if (STEP_ON) { PH_ENTER
                constexpr int NX = GB * 60 * 2, NBU = GB * 4 * 32, NAU = GB * 8 * 16;
#pragma unroll 1
                for (int rep = 0; rep < REP_L2; ++rep) { gu32* ctr = (gu32*)(ws + WS_CTL) + CW_QUEUE + 64 * (((l * NGRP + grp) * 2 + 0) * 4 + rep);
                const bool stat = (G == 256);
                gu32* qctr = stat ? ctr + 4 * (1 + (bx & 7)) : ctr; int stage = stat ? 0 : 2;
                unsigned qnxt = 0u, qpar = 0u; if (tid == 0) qnxt = wq_claim(qctr);
#pragma unroll 1
                for (int it = 0;; ++it) {
                    int i;
                    if (stat && it < 4) { const int x = bx & 7, j = bx >> 3, jj = j & 7, combo = x + 8 * (j >> 3), qt = (it == 0) ? 31 - jj : (it == 1) ? 16 + jj : (it == 2) ? 15 - jj : jj;
                        i = NX + (31 - qt) * 32 + (combo >> 2) * 4 + (combo & 3); __syncthreads(); }
                    else { int k = wq_next(qctr, qslot, tid, qnxt, qpar);
                        if (stage == 0) { if (k < 120) i = (k >> 1) * 16 + (bx & 7) * 2 + (k & 1);
                                          else { stage = 1; qctr = ctr; if (tid == 0) qnxt = wq_claim(qctr); k = wq_next(qctr, qslot, tid, qnxt, qpar); i = NX + NBU + k; } }
                        else if (stage == 1) i = NX + NBU + k;
                        else i = k;
                        if (i >= NX + NBU + NAU) break; }
                    unsigned char* wsq = args.ws; asm volatile("" : "+s"(wsq)); bf16* QKV = (bf16*)(wsq + WS_QKV);
                    if (i < NX) { const int n = 63 - (i >> 4), b = (i & 15) >> 1, half = i & 1;
#pragma unroll 1
                        for (int rx = 0; rx < REP_X; ++rx) { if (rx) __syncthreads();
                        att::idx_unit(lds, P_Q(WS_QI) + (size_t)b * SEQ * 256, P_Q(WS_KI) + (size_t)b * SEQ * 256, (unsigned short*)((unsigned*)(wsq + WS_MASK) + (size_t)b * 64 * 4096 * 2), (unsigned*)(wsq + WS_XS) + (size_t)(bx & 255) * 131072, n, half, tid); }
                    } else if (i < NX + NBU) { const int j = i - NX, qt = 31 - (j >> 5), b = (j & 31) >> 2, h = j & 3;
                        const size_t off = (size_t)b * SEQ * 512 + h * 128;
                        const float* scal = (const float*)(wsq + WS_SCAL);
                        const float lam = __hip_atomic_load(scal + l * 2, RLX_AGENT), oscale = __hip_atomic_load(scal + l * 2 + 1, RLX_AGENT);
                        attx::UB a{(const attx::bf16*)(QKV + 3 * QKV_STRIDE + off), (const attx::bf16*)(QKV + 4 * QKV_STRIDE + off), (const attx::bf16*)(QKV + 5 * QKV_STRIDE + off),
                                   (attx::bf16*)(P_Q(WS_OBUF) + 1 * QKV_STRIDE + off), qt, args.in[I_SUBLN] + l * 128, lam, oscale};
#pragma unroll 1
                        for (int rb_ = 0; rb_ < REP_B; ++rb_)
                        attx::attn_unit_b2<8>(a, (char*)lds_raw, tid);
                    } else { const int j = i - NX - NBU, qb = 15 - (j >> 6), b = (j & 63) >> 3, h = j & 7;
                        const size_t off = (size_t)b * SEQ * 512 + h * 64;
                        att::UnitArgs a{QKV + off, 512, QKV + 1 * QKV_STRIDE + off, QKV + 2 * QKV_STRIDE + off, 512, P_Q(WS_OBUF) + off, 512, 256 * qb, (4 * qb - 8 > 0) ? 4 * qb - 8 : 0, 4 * qb + 3,
                                        args.in[I_REL_BIAS] + (size_t)(l * 8 + h) * 320, nullptr, false};
#pragma unroll 1
                        for (int ra_ = 0; ra_ < REP_A; ++ra_)
                        att::attn_unit<0>(lds, a, tid);
                    }
                } }
            }
            STEP_END(true);
            if (STEP_ON) { PH_ENTER
#if PROBE_CHECK
                if (l == 0 && grp == 0) { const int si = gw, b_ = si & 7, n_ = 4 + ((si >> 3) % 60), qo = (si * 7) & 63;
                    probe_check_query(P_BF(WS_QI) + (size_t)b_ * SEQ * 256, P_BF(WS_KI) + (size_t)b_ * SEQ * 256, (const unsigned*)(ws + WS_MASK) + (size_t)b_ * 64 * 4096 * 2, 64 * n_ + qo, n_,
                                      (LAS float*)(lds + wave * 16384), (gu32*)(ws + WS_CTL) + 32, lane); __syncthreads(); }
#endif
#pragma unroll 1
                for (int rep = 0; rep < REP_L3; ++rep) { gu32* ctr = (gu32*)(ws + WS_CTL) + CW_QUEUE + 64 * (((l * NGRP + grp) * 2 + 1) * 4 + rep);
                const bool stat = (G == 256);
                unsigned qnxt = 0u, qpar = 0u; if (!stat && tid == 0) qnxt = wq_claim(ctr);
#pragma unroll 1
                for (int it = 0;; ++it) {
                    int qb, b, h;
                    if (stat) { if (it >= 4) break; const int j = bx >> 3, jj = j & 3; h = bx & 7; b = j >> 2; qb = (it == 0) ? 15 - jj : (it == 1) ? 8 + jj : (it == 2) ? 7 - jj : jj; __syncthreads(); }
                    else { const int i = wq_next(ctr, qslot, tid, qnxt, qpar); if (i >= GB * 8 * 16) break; qb = 15 - (i >> 6); b = (i & 63) >> 3; h = i & 7; }
                    unsigned char* wsq = args.ws; asm volatile("" : "+s"(wsq)); bf16* QKV = (bf16*)(wsq + WS_QKV);
                    const size_t rb = (size_t)b * SEQ * 512;
                    attx::UA a{(const attx::bf16*)(QKV + 6 * QKV_STRIDE + rb + (size_t)256 * qb * 512 + h * 64), 512,
                               (const attx::bf16*)(QKV + 7 * QKV_STRIDE + rb + h * 64), (const attx::bf16*)(QKV + 8 * QKV_STRIDE + rb + h * 64), 512,
                               (attx::bf16*)(P_Q(WS_OBUF) + 2 * QKV_STRIDE + rb + (size_t)256 * qb * 512 + h * 64), 512, 4 * qb + 4, 0, 4 * qb, nullptr,
                               (const unsigned*)(wsq + WS_MASK) + (size_t)b * 64 * 4096 * 2, qb == 0};
                    attx::attn_unit<1, 8>(a, (char*)lds_raw, tid);
                } }
            }
            STEP_END(true);
            if (STEP_ON) { PH_ENTER
                pg8::Gemm g{P_BF(WS_OBUF), P_BF(WS_WL + WL_WUP), RG, 3072, 512, QKV_STRIDE * 2}; pg8::UpOrder S; S.init(RG, G, bx);
                pg8::EpiGateC E{P_BF(WS_GATES), P_BF(WS_Y)};
#pragma unroll 1
                for (int ru = 0; ru < REP_UP; ++ru)
                pg8::gemm_phase<pg8::EpiGateC, pg8::UpOrder, true, true>(lds, g, S, E, tid);
            }
            STEP_END(true);
            if (STEP_ON) { PH_ENTER
                pg8::Gemm g{P_BF(WS_Y), P_BF(WS_WL + WL_WOUT), RG, DM, DM, 0}; pg8::StaticOrder S; S.init(RG, DM, G, bx);
                pg8::EpiRes E{P_BF(WS_XN) + (size_t)grp * RG * DM, DM, (float*)(ws + WS_SS) + (size_t)grp * RG * 16, 1.0f};
                pg8::gemm_phase<pg8::EpiRes, pg8::StaticOrder, true, true>(lds, g, S, E, tid);
#if REP_WOUT > 1
                { pg8::EpiRes E0{P_BF(WS_XN) + (size_t)grp * RG * DM, DM, (float*)(ws + WS_SS) + (size_t)grp * RG * 16, 0.0f}; __syncthreads(); pg8::gemm_phase<pg8::EpiRes, pg8::StaticOrder, true, true>(lds, g, S, E0, tid); }
#endif
            }
            STEP_END(grp == NGRP - 1);
        }
        if (STEP_ON) { PH_ENTER
            pg8::Gemm g{P_BF(WS_XN), P_BF(WS_WL + WL_WQX), R, 256, DM, 0}; pg8::StaticOrder S; S.init(R, 256, G, bx);
            pg8::EpiBf16S E{P_BF(WS_QX), 256, QSCALE, (const float*)(ws + WS_SS), (LAS float*)(lds + 139264)};
            pg8::gemm_phase<pg8::EpiBf16S, pg8::StaticOrder, true, true>(lds, g, S, E, tid);
        }
        STEP_END(true);
        if (STEP_ON) { PH_ENTER
            bf16* QX = P_BF(WS_QX);
            for (int i = bx; i < NB * 4 * 16; i += G) {
                const int qb = i & 15, b = i >> 6, h = (i >> 4) & 3;
                const bf16* kx = P_BF(WS_KVX) + (size_t)b * MEMLEN * (DEPTH * 512) + l * 512 + h * 64;
                attx::bf16* qp = (attx::bf16*)(QX + ((size_t)b * SEQ + 256 * qb) * 256 + h * 64);
                attx::UA a{qp, 256, (const attx::bf16*)kx, (const attx::bf16*)(kx + 256), DEPTH * 512, qp, 256, 4, 0, 0, nullptr, nullptr, 1};
                attx::attn_unit<2, 8>(a, (char*)lds_raw, tid);
            }
        }
        STEP_END(true);
        if (STEP_ON) { PH_ENTER
            pg8::Gemm g{P_BF(WS_QX), P_BF(WS_WL + WL_WOX), R, DM, 256, 0}; pg8::StaticOrder S; S.init(R, DM, G, bx);
            pg8::EpiRes E{P_BF(WS_XN), DM, (float*)(ws + WS_SS), 1.0f};
            pg8::gemm_phase<pg8::EpiRes, pg8::StaticOrder, true, true>(lds, g, S, E, tid);
#if REP_OX > 1
            { pg8::EpiRes E0{P_BF(WS_XN), DM, (float*)(ws + WS_SS), 0.0f}; __syncthreads(); pg8::gemm_phase<pg8::EpiRes, pg8::StaticOrder, true, true>(lds, g, S, E0, tid); }
#endif
        }
        STEP_END(true);
        if (STEP_ON) { PH_ENTER
            pg8::Gemm g{P_BF(WS_XN), P_BF(WS_WL + WL_WGU), R, 2 * DFF, DM, 0}; pg8::StaticOrder S; S.init(R, 2 * DFF, G, bx);
            pg8::EpiSwiglu E{P_BF(WS_H), DFF, (const float*)(ws + WS_SS), (LAS float*)(lds + 139264)};
#pragma unroll 1
            for (int rg = 0; rg < REP_GU; ++rg)
            pg8::gemm_phase<pg8::EpiSwiglu, pg8::StaticOrder, true, true>(lds, g, S, E, tid);
        }
        STEP_END(true);
        if (STEP_ON) { PH_ENTER
            pg8::Gemm g{P_BF(WS_H), P_BF(WS_WL + WL_WDN), R, DM, DFF, 0}; pg8::StaticOrder S; S.init(R, DM, G, bx);
            pg8::EpiRes E{P_BF(WS_XN), DM, (float*)(ws + WS_SS), 1.0f};
            pg8::gemm_phase<pg8::EpiRes, pg8::StaticOrder, true, true>(lds, g, S, E, tid);
#if REP_DOWN > 1
            { pg8::EpiRes E0{P_BF(WS_XN), DM, (float*)(ws + WS_SS), 0.0f}; __syncthreads(); pg8::gemm_phase<pg8::EpiRes, pg8::StaticOrder, true, true>(lds, g, S, E0, tid); }
#endif
        }
        STEP_END(true);
    }
    if (STEP_ON) { PH_ENTER for (int m = gw; m < R; m += NGW) rms_row_final(P_BF(WS_XN) + (size_t)m * DM, args.out + (size_t)m * DM, args.in[I_FINAL_NORM], lane);
#if PROBE_CHECK
        if (__hip_atomic_load((gu32*)(ws + WS_CTL) + 32, RLX_AGENT) != 0u) { for (int m = gw; m < R; m += NGW) { GAS f32x4* xr = (GAS f32x4*)(args.out + (size_t)m * DM) + lane; for (int j = 0; j < 4; ++j) xr[64 * j] = xr[64 * j] * 2.0f; } }
#endif
    }
    STEP_END(false);
#undef STEP_ON
#undef STEP_END
#undef PH_ENTER
#undef P_BF
#undef P_Q
}

constexpr int N_STEPS = 2 + DEPTH * (1 + NGRP * 5 + 5) + 1;
#ifndef MK_PER_STEP
#define MK_PER_STEP 0
#endif
extern "C" void kernel_launch(void* const* d_in, const int* in_sizes, int n_in, void* d_out, int out_size, void* d_ws, size_t ws_size, hipStream_t stream) {
    static int grid = 0;
    if (grid == 0) {
        if (n_in != 20 || in_sizes[0] != R * DM || out_size != R * DM || ws_size < WS_END) { fprintf(stderr, "kernel_launch: shape mismatch (n_in %d, in0 %d, out %d, ws %zu < %zu); nothing launched\n", n_in, n_in > 0 ? in_sizes[0] : -1, out_size, ws_size, (size_t)WS_END); grid = -1; return; }
        int dev = 0, cus = 0, per_cu = 0;
        if (hipGetDevice(&dev) != hipSuccess || hipDeviceGetAttribute(&cus, hipDeviceAttributeMultiprocessorCount, dev) != hipSuccess) { grid = -1; return; }
        if (hipFuncSetAttribute((const void*)hybrid_fwd, hipFuncAttributeMaxDynamicSharedMemorySize, LDS_BYTES) != hipSuccess) { fprintf(stderr, "kernel_launch: hipFuncSetAttribute failed\n"); grid = -1; return; }
        if (hipOccupancyMaxActiveBlocksPerMultiprocessor(&per_cu, (const void*)hybrid_fwd, NWAVES * 64, LDS_BYTES) != hipSuccess || per_cu < 1) { fprintf(stderr, "kernel_launch: occupancy query says %d blocks per CU\n", per_cu); }
        (void)hipGetLastError();
        grid = cus < 256 ? cus : 256;
    }
    if (grid < 0) return;
    if (hipMemsetAsync((char*)d_ws + WS_CTL, 0, CTL_ZERO_BYTES, stream) != hipSuccess) return;
    Args a{};
    for (int i = 0; i < 20; ++i) a.in[i] = (const float*)d_in[i];
    a.out = (float*)d_out; a.ws = (unsigned char*)d_ws;
#if MK_PER_STEP
    for (int s = 0; s < N_STEPS; ++s) { a.lo = s; a.hi = s + 1; hipLaunchKernelGGL(hybrid_fwd, dim3(grid), dim3(NWAVES * 64), LDS_BYTES, stream, a); }
#else
    a.lo = 0; a.hi = 1 << 30;
    hipLaunchKernelGGL(hybrid_fwd, dim3(grid), dim3(NWAVES * 64), LDS_BYTES, stream, a);
#endif
    const hipError_t le = hipPeekAtLastError();
    if (le != hipSuccess) fprintf(stderr, "kernel_launch: launch failed: %s\n", hipGetErrorName(le));
}
```
